# Optimizing an MI355X kernel written in HIP

```python
import math
import jax, jax.numpy as jnp
from jax import lax
import numpy as np

D_MODEL = 1024
BATCH = 4
SEQ = 8192
DEPTH = 4
DEC_BATCH = 16
DEC_SEQ = 16
PAST_LEN = 1024

CHUNK = 64
D_S5 = 512
S5_GROUP = 16
S5_GROUPS = D_S5 // S5_GROUP
S5_STATE = 64
RET_HEADS = 4
RET_DK = 128
RET_DV = 128
D_RET = RET_HEADS * RET_DV
D_MIX = D_S5 + D_RET
D_IN = D_S5 + 2 * RET_HEADS * RET_DK + 2 * D_RET
N_MEM = 256
X_HEADS = 4
X_DH = D_MODEL // X_HEADS
D_FF = 2816
ROPE_BASE = 10000.0
EPS = 1e-6

kernel_name = "hybrid_s5_retention_streaming_step"

F32 = jnp.float32


def rms_norm(x, g):
    xf = x.astype(F32)
    y = xf * lax.rsqrt(jnp.mean(xf * xf, axis=-1, keepdims=True) + EPS)
    return y * g.astype(F32)


def rope(x, pos):
    half = x.shape[-1] // 2
    inv = ROPE_BASE ** (-jnp.arange(half, dtype=F32) / half)
    ang = pos.astype(F32)[:, None] * inv[None, :]
    cos = jnp.cos(ang)[None, :, None, :]
    sin = jnp.sin(ang)[None, :, None, :]
    x1, x2 = x[..., :half], x[..., half:]
    return jnp.concatenate([x1 * cos - x2 * sin, x1 * sin + x2 * cos], axis=-1)


def retention_log_decay():
    return jnp.log(1.0 - 2.0 ** (-5.0 - jnp.arange(RET_HEADS, dtype=F32)))


def retention(q, k, v, s0):
    B, L, H, dk = q.shape
    dv = v.shape[-1]
    C = CHUNK if L >= CHUNK else L
    nc = L // C
    lg = retention_log_decay()
    pos = jnp.arange(C, dtype=F32)
    q = q.reshape(B, nc, C, H, dk) * (dk ** -0.5)
    k = k.reshape(B, nc, C, H, dk)
    v = v.reshape(B, nc, C, H, dv)
    dmat = jnp.exp(lg[:, None, None] * jnp.abs(pos[:, None] - pos[None, :]))
    scores = jnp.einsum('bnihd,bnjhd->bnhij', q, k) * dmat
    inner = jnp.einsum('bnhij,bnjhe->bnihe', scores, v)
    k_dec = k * jnp.exp(lg[None, :] * (C - 1.0 - pos)[:, None])[:, :, None]
    kv = jnp.einsum('bnjhd,bnjhe->nbhde', k_dec, v)
    g_chunk = jnp.exp(lg * C)[None, :, None, None]
    if s0 is None:
        s0 = jnp.zeros((B, H, dk, dv), F32)

    def step(S, kv_c):
        return g_chunk * S + kv_c, S

    s_final, s_before = lax.scan(step, s0.astype(F32), kv)
    q_dec = q * jnp.exp(lg[None, :] * (pos + 1.0)[:, None])[:, :, None]
    cross = jnp.einsum('bnihd,nbhde->bnihe', q_dec, s_before)
    return (inner + cross).reshape(B, L, H, dv), s_final


def _complex_linear_combine(e1, e2):
    a1r, a1i, b1r, b1i = e1
    a2r, a2i, b2r, b2i = e2
    return (a2r * a1r - a2i * a1i,
            a2r * a1i + a2i * a1r,
            a2r * b1r - a2i * b1i + b2r,
            a2r * b1i + a2i * b1r + b2i)


def s5_ssm(u, lam_re, lam_im, log_step, b_re, b_im, c_re, c_im, d_skip, x0_re, x0_im):
    B, L, _ = u.shape
    uf = u.astype(F32).reshape(B, L, S5_GROUPS, S5_GROUP)
    lam_re = lam_re.astype(F32)
    lam_im = lam_im.astype(F32)
    dt = jnp.exp(log_step.astype(F32))[:, None]
    ar = lam_re * dt
    ai = lam_im * dt
    mag = jnp.exp(ar)
    abar_re = mag * jnp.cos(ai)
    abar_im = mag * jnp.sin(ai)
    den = lam_re * lam_re + lam_im * lam_im
    nr = abar_re - 1.0
    ni = abar_im
    f_re = (nr * lam_re + ni * lam_im) / den
    f_im = (ni * lam_re - nr * lam_im) / den
    b_re = b_re.astype(F32)
    b_im = b_im.astype(F32)
    bb_re = f_re[..., None] * b_re - f_im[..., None] * b_im
    bb_im = f_re[..., None] * b_im + f_im[..., None] * b_re
    bu_re = jnp.einsum('blgh,gph->blgp', uf, bb_re)
    bu_im = jnp.einsum('blgh,gph->blgp', uf, bb_im)
    a_re = jnp.broadcast_to(abar_re[None, None], (1, L, S5_GROUPS, S5_STATE))
    a_im = jnp.broadcast_to(abar_im[None, None], (1, L, S5_GROUPS, S5_STATE))
    _, _, xr, xi = lax.associative_scan(_complex_linear_combine, (a_re, a_im, bu_re, bu_im), axis=1)
    if x0_re is not None:
        t = jnp.arange(1, L + 1, dtype=F32)[:, None, None]
        pm = jnp.exp(t * ar)
        pr = pm * jnp.cos(t * ai)
        pi = pm * jnp.sin(t * ai)
        x0r = x0_re.astype(F32)[:, None]
        x0i = x0_im.astype(F32)[:, None]
        xr = xr + pr * x0r - pi * x0i
        xi = xi + pr * x0i + pi * x0r
    y = (jnp.einsum('blgp,ghp->blgh', xr, c_re.astype(F32))
         - jnp.einsum('blgp,ghp->blgh', xi, c_im.astype(F32))
         + d_skip.astype(F32) * uf)
    return y.reshape(B, L, D_S5), xr[:, -1], xi[:, -1]


def mixer_sublayer(x, pos0, s5_x0_re, s5_x0_im, ret_s0, p, i):
    B, L, _ = x.shape
    h = rms_norm(x, p['mix_norm_pre'][i]).astype(x.dtype)
    proj = (h @ p['w_in'][i]).astype(F32)
    o1 = D_S5
    o2 = o1 + RET_HEADS * RET_DK
    o3 = o2 + RET_HEADS * RET_DK
    o4 = o3 + D_RET
    u = proj[..., :o1]
    q = proj[..., o1:o2].reshape(B, L, RET_HEADS, RET_DK)
    k = proj[..., o2:o3].reshape(B, L, RET_HEADS, RET_DK)
    v = proj[..., o3:o4].reshape(B, L, RET_HEADS, RET_DV)
    g = proj[..., o4:]
    y, s5r, s5i = s5_ssm(u, p['s5_lambda_re'][i], p['s5_lambda_im'][i], p['s5_log_step'][i],
                         p['s5_b_re'][i], p['s5_b_im'][i], p['s5_c_re'][i], p['s5_c_im'][i],
                         p['s5_d'][i], s5_x0_re, s5_x0_im)
    z = jax.nn.gelu(y)
    z = z * jax.nn.sigmoid(z @ p['s5_w_glu'][i].astype(F32) + p['s5_b_glu'][i].astype(F32))
    s5_out = rms_norm(z, p['s5_out_norm'][i])
    pos = pos0 + jnp.arange(L)
    o, s_ret = retention(rope(q, pos), rope(k, pos), v, ret_s0)
    o = rms_norm(o, p['ret_out_norm'][i]).reshape(B, L, D_RET)
    ret_out = jax.nn.silu(g) * o
    mix = jnp.concatenate([s5_out, ret_out], axis=-1).astype(x.dtype) @ p['w_out'][i]
    x = x + rms_norm(mix, p['mix_norm_post'][i]).astype(x.dtype)
    return x, s5r, s5i, s_ret


def memory_kv(mem, g_mem, w_ck, w_cv):
    B = mem.shape[0]
    m = rms_norm(mem, g_mem).astype(mem.dtype)
    k = (m @ w_ck).reshape(B, N_MEM, X_HEADS, X_DH)
    v = (m @ w_cv).reshape(B, N_MEM, X_HEADS, X_DH)
    return k, v


def cross_sublayer(x, mem_k, mem_v, p, i):
    B, L, _ = x.shape
    h = rms_norm(x, p['xattn_norm_pre'][i]).astype(x.dtype)
    q = (h @ p['w_cq'][i]).reshape(B, L, X_HEADS, X_DH).astype(F32)
    s = jnp.einsum('blhd,bmhd->bhlm', q, mem_k.astype(F32)) * (X_DH ** -0.5)
    pr = jax.nn.softmax(s, axis=-1)
    o = jnp.einsum('bhlm,bmhd->blhd', pr, mem_v.astype(F32)).reshape(B, L, D_MODEL)
    out = o.astype(x.dtype) @ p['w_co'][i]
    return x + rms_norm(out, p['xattn_norm_post'][i]).astype(x.dtype)


def ffn_sublayer(x, p, i):
    h = rms_norm(x, p['ffn_norm_pre'][i]).astype(x.dtype)
    f = (jax.nn.silu(h @ p['w_gate'][i]) * (h @ p['w_up'][i])) @ p['w_down'][i]
    return x + rms_norm(f, p['ffn_norm_post'][i]).astype(x.dtype)


def trunk(x, pos0, mem_k, mem_v, s5_re0, s5_im0, ret0, p):
    s5r_all, s5i_all, ret_all = [], [], []
    for i in range(DEPTH):
        if ret0 is None:
            x, s5r, s5i, s_ret = mixer_sublayer(x, pos0, None, None, None, p, i)
        else:
            x, s5r, s5i, s_ret = mixer_sublayer(x, pos0, s5_re0[i], s5_im0[i], ret0[i], p, i)
        x = cross_sublayer(x, mem_k[i], mem_v[i], p, i)
        x = ffn_sublayer(x, p, i)
        s5r_all.append(s5r)
        s5i_all.append(s5i)
        ret_all.append(s_ret)
    return x, jnp.stack(s5r_all), jnp.stack(s5i_all), jnp.stack(ret_all)


def setup_inputs(seed: int = 0) -> dict:
    key = jax.random.key(seed)
    ks = iter(jax.random.split(key, 48))

    def nrm(shape, scale):
        return jax.random.normal(next(ks), shape, F32) * scale

    def gain(shape):
        return 1.0 + nrm(shape, 0.01)

    G, P = S5_GROUPS, S5_STATE
    return {
        'x_prompt': nrm((BATCH, SEQ, D_MODEL), 1.0),
        'x_sample': nrm((DEC_BATCH, DEC_SEQ, D_MODEL), 1.0),
        'mem_prompt': nrm((BATCH, N_MEM, D_MODEL), 1.0),
        'state_s5_re': nrm((DEPTH, DEC_BATCH, G, P), 0.1),
        'state_s5_im': nrm((DEPTH, DEC_BATCH, G, P), 0.1),
        'state_ret': nrm((DEPTH, DEC_BATCH, RET_HEADS, RET_DK, RET_DV), 1.0),
        'cache_mem_k': nrm((DEPTH, DEC_BATCH, N_MEM, X_HEADS, X_DH), 1.0),
        'cache_mem_v': nrm((DEPTH, DEC_BATCH, N_MEM, X_HEADS, X_DH), 1.0),
        'mix_norm_pre': gain((DEPTH, D_MODEL)),
        'mix_norm_post': gain((DEPTH, D_MODEL)),
        'w_in': nrm((DEPTH, D_MODEL, D_IN), D_MODEL ** -0.5),
        's5_lambda_re': -0.5 + nrm((DEPTH, G, P), 0.01),
        's5_lambda_im': jnp.pi * jnp.arange(P, dtype=F32) + nrm((DEPTH, G, P), 0.01),
        's5_log_step': jax.random.uniform(next(ks), (DEPTH, G), F32, math.log(1e-3), math.log(1e-1)),
        's5_b_re': nrm((DEPTH, G, P, S5_GROUP), (2 * S5_GROUP) ** -0.5),
        's5_b_im': nrm((DEPTH, G, P, S5_GROUP), (2 * S5_GROUP) ** -0.5),
        's5_c_re': nrm((DEPTH, G, S5_GROUP, P), (2 * P) ** -0.5),
        's5_c_im': nrm((DEPTH, G, S5_GROUP, P), (2 * P) ** -0.5),
        's5_d': nrm((DEPTH, G, S5_GROUP), 1.0),
        's5_w_glu': nrm((DEPTH, D_S5, D_S5), D_S5 ** -0.5),
        's5_b_glu': nrm((DEPTH, D_S5), 0.01),
        's5_out_norm': gain((DEPTH, D_S5)),
        'ret_out_norm': gain((DEPTH, RET_HEADS, RET_DV)),
        'w_out': nrm((DEPTH, D_MIX, D_MODEL), D_MIX ** -0.5),
        'xattn_norm_pre': gain((DEPTH, D_MODEL)),
        'xattn_norm_post': gain((DEPTH, D_MODEL)),
        'mem_norm': gain((DEPTH, D_MODEL)),
        'w_cq': nrm((DEPTH, D_MODEL, D_MODEL), D_MODEL ** -0.5),
        'w_ck': nrm((DEPTH, D_MODEL, D_MODEL), D_MODEL ** -0.5),
        'w_cv': nrm((DEPTH, D_MODEL, D_MODEL), D_MODEL ** -0.5),
        'w_co': nrm((DEPTH, D_MODEL, D_MODEL), D_MODEL ** -0.5),
        'ffn_norm_pre': gain((DEPTH, D_MODEL)),
        'ffn_norm_post': gain((DEPTH, D_MODEL)),
        'w_gate': nrm((DEPTH, D_MODEL, D_FF), D_MODEL ** -0.5),
        'w_up': nrm((DEPTH, D_MODEL, D_FF), D_MODEL ** -0.5),
        'w_down': nrm((DEPTH, D_FF, D_MODEL), D_FF ** -0.5),
    }


def reference(x_prompt, x_sample, mem_prompt, state_s5_re, state_s5_im, state_ret, cache_mem_k, cache_mem_v,
              mix_norm_pre, mix_norm_post, w_in, s5_lambda_re, s5_lambda_im, s5_log_step,
              s5_b_re, s5_b_im, s5_c_re, s5_c_im, s5_d, s5_w_glu, s5_b_glu, s5_out_norm, ret_out_norm,
              w_out, xattn_norm_pre, xattn_norm_post, mem_norm, w_cq, w_ck, w_cv, w_co,
              ffn_norm_pre, ffn_norm_post, w_gate, w_up, w_down):
    p = {
        'mix_norm_pre': mix_norm_pre, 'mix_norm_post': mix_norm_post, 'w_in': w_in,
        's5_lambda_re': s5_lambda_re, 's5_lambda_im': s5_lambda_im, 's5_log_step': s5_log_step,
        's5_b_re': s5_b_re, 's5_b_im': s5_b_im, 's5_c_re': s5_c_re, 's5_c_im': s5_c_im, 's5_d': s5_d,
        's5_w_glu': s5_w_glu, 's5_b_glu': s5_b_glu, 's5_out_norm': s5_out_norm,
        'ret_out_norm': ret_out_norm, 'w_out': w_out,
        'xattn_norm_pre': xattn_norm_pre, 'xattn_norm_post': xattn_norm_post,
        'w_cq': w_cq, 'w_co': w_co,
        'ffn_norm_pre': ffn_norm_pre, 'ffn_norm_post': ffn_norm_post,
        'w_gate': w_gate, 'w_up': w_up, 'w_down': w_down,
    }
    mk_list, mv_list = [], []
    for i in range(DEPTH):
        mk, mv = memory_kv(mem_prompt, mem_norm[i], w_ck[i], w_cv[i])
        mk_list.append(mk)
        mv_list.append(mv)
    new_mem_k_prompt = jnp.stack(mk_list)
    new_mem_v_prompt = jnp.stack(mv_list)
    y_prompt, new_s5_re_prompt, new_s5_im_prompt, new_ret_prompt = trunk(
        x_prompt, 0, new_mem_k_prompt, new_mem_v_prompt, None, None, None, p)
    y_sample, new_s5_re_sample, new_s5_im_sample, new_ret_sample = trunk(
        x_sample, PAST_LEN, cache_mem_k, cache_mem_v, state_s5_re, state_s5_im, state_ret, p)
    return (y_prompt, y_sample, new_s5_re_prompt, new_s5_im_prompt, new_ret_prompt,
            new_mem_k_prompt, new_mem_v_prompt, new_s5_re_sample, new_s5_im_sample, new_ret_sample)
```

```cpp
#include <hip/hip_runtime.h>
#include <hip/hip_bf16.h>
#include <hip/hip_cooperative_groups.h>
#include <stdint.h>
#include <stdio.h>
namespace cg = cooperative_groups;

typedef __attribute__((ext_vector_type(8))) short bf16x8;
typedef __attribute__((ext_vector_type(4))) float f32x4;
typedef unsigned short u16;
typedef __attribute__((ext_vector_type(4))) unsigned u32x4;
typedef __attribute__((ext_vector_type(2))) unsigned u32x2;
#define DI __device__ __forceinline__
#define MFMA16(a, b, c) __builtin_amdgcn_mfma_f32_16x16x32_bf16((a), (b), (c), 0, 0, 0)
#define MFMA_FENCE() do { __builtin_amdgcn_sched_barrier(0); asm volatile("s_nop 15\n\ts_nop 15" ::: "memory"); __builtin_amdgcn_sched_barrier(0); } while (0)

constexpr int NTOK = 33024, PROWS = 32768, DM = 1024, DFF = 2816, DEPTHC = 4;
constexpr int SEQ = 8192;
constexpr float EPSF = 1e-6f;
constexpr int NTHR = 256;
constexpr int LDS_STRIDE = 80;
constexpr int SMEM_BYTES = 76800;

constexpr size_t SLOT = (size_t)NTOK * 512 * 2;
constexpr size_t OFF_BAR = 0;
constexpr size_t OFF_CTR = 16384;
constexpr size_t OFF_W = 32768;
constexpr size_t W_IN = 0, W_GLU = W_IN + 2560 * 1024, W_OUT = W_GLU + 512 * 512, W_CQ = W_OUT + 1024 * 1024,
                 W_CK = W_CQ + 1024 * 1024, W_CV = W_CK + 1024 * 1024, W_CO = W_CV + 1024 * 1024,
                 W_GU = W_CO + 1024 * 1024, W_DN = W_GU + 5632 * 1024, W_LAYER = W_DN + 1024 * 2816;
constexpr size_t OFF_S5P = OFF_W + 4 * W_LAYER * 2;
constexpr size_t S5P_BBT = 0, S5P_CM = 131072, S5P_ABAR = 262144, S5P_LAYER = 278528;
constexpr size_t OFF_HB = OFF_S5P + 4 * S5P_LAYER;
constexpr size_t OFF_MEMB = OFF_HB + (size_t)NTOK * 1024 * 2;
constexpr size_t OFF_KXP = OFF_MEMB + 1024 * 1024 * 2;
constexpr size_t OFF_VTXP = OFF_KXP + 4 * 4 * 256 * 1024 * 2;
constexpr size_t OFF_KXS = OFF_VTXP + 4 * 4 * 256 * 1024 * 2;
constexpr size_t OFF_VTXS = OFF_KXS + 16 * 256 * 1024 * 2;
constexpr size_t OFF_SLOC = OFF_VTXS + 16 * 256 * 1024 * 2;
constexpr size_t OFF_ELOC = OFF_SLOC + 16 * 16 * 128 * 128 * 4;
constexpr size_t OFF_ZSQ = OFF_ELOC + 4 * 16 * 32 * 64 * 2 * 4;
constexpr size_t OFF_RSQ = OFF_ZSQ + (size_t)NTOK * 8 * 4;
constexpr size_t OFF_ARENA = OFF_RSQ + (size_t)NTOK * 16 * 4;
constexpr size_t WS_NEEDED = OFF_ARENA + 8 * SLOT;

constexpr size_t O_Y = 0, O_S5RE_P = 33816576, O_S5IM_P = 33849344, O_RET_P = 33882112, O_MK_P = 34930688,
                 O_MV_P = 39124992, O_S5RE_S = 43319296, O_S5IM_S = 43450368, O_RET_S = 43581440;

struct Params {
  const float *x_prompt, *x_sample, *mem_prompt, *s5re0, *s5im0, *ret0, *cmk, *cmv;
  const float *mix_pre, *mix_post, *w_in, *lam_re, *lam_im, *log_step, *b_re, *b_im, *c_re, *c_im, *s5_d, *w_glu,
      *b_glu, *s5_onorm, *ret_onorm, *w_out, *xa_pre, *xa_post, *mem_norm, *w_cq, *w_ck, *w_cv, *w_co, *ffn_pre,
      *ffn_post, *w_gate, *w_up, *w_down;
  float* out;
  char* ws;
  int never;
  int ph_lo;
  int ph_hi;
  int pad;
};

DI u16 f2bf(float f) {
  unsigned u = __float_as_uint(f);
  u += 0x7fffu + ((u >> 16) & 1u);
  return (u16)(u >> 16);
}
DI float bf2f(u16 h) { return __uint_as_float(((unsigned)h) << 16); }
DI unsigned pack2(float a, float b) { return (unsigned)f2bf(a) | ((unsigned)f2bf(b) << 16); }
DI float sigmoidf_(float x) { return 1.0f / (1.0f + __expf(-x)); }
DI float siluf_(float x) { return x * sigmoidf_(x); }
DI float geluf_(float x) {
  float t = 0.7978845608028654f * (x + 0.044715f * x * x * x);
  return 0.5f * x * (1.0f + tanhf(t));
}
DI float red16(float v) {
  v += __shfl_xor(v, 1); v += __shfl_xor(v, 2); v += __shfl_xor(v, 4); v += __shfl_xor(v, 8);
  return v;
}
DI float max16(float v) {
  v = fmaxf(v, __shfl_xor(v, 1)); v = fmaxf(v, __shfl_xor(v, 2)); v = fmaxf(v, __shfl_xor(v, 4)); v = fmaxf(v, __shfl_xor(v, 8));
  return v;
}
DI float red64(float v) {
  v = red16(v); v += __shfl_xor(v, 16); v += __shfl_xor(v, 32);
  return v;
}
DI void sincos_cw(float x, float* sn, float* cs) {
  const float k = rintf(x * 0.15915494309189535f);
  float r = fmaf(-k, 6.2831854820251465f, x);
  r = fmaf(-k, -1.7484555e-07f, r);
  *sn = __sinf(r); *cs = __cosf(r);
}
DI int ltid() { int x = threadIdx.x; asm volatile("" : "+v"(x)); return x; }
DI int lsgpr(int x) { asm volatile("" : "+s"(x)); return x; }
DI u32x4 ld_sc1_16(const void* p) {
  const unsigned long long* q = (const unsigned long long*)p;
  const unsigned long long a = __hip_atomic_load(q, __ATOMIC_RELAXED, __HIP_MEMORY_SCOPE_AGENT);
  const unsigned long long b = __hip_atomic_load(q + 1, __ATOMIC_RELAXED, __HIP_MEMORY_SCOPE_AGENT);
  return (u32x4){(unsigned)a, (unsigned)(a >> 32), (unsigned)b, (unsigned)(b >> 32)};
}
DI __amdgpu_buffer_rsrc_t mk_rsrc(const void* p) {
  const unsigned long long a = (unsigned long long)p;
  const unsigned lo = __builtin_amdgcn_readfirstlane((unsigned)a), hi = __builtin_amdgcn_readfirstlane((unsigned)(a >> 32));
  return __builtin_amdgcn_make_buffer_rsrc((void*)(((unsigned long long)hi << 32) | lo), 0, 0x7fffffff, 0x00020000);
}
DI u32x4 bld16(__amdgpu_buffer_rsrc_t r, unsigned voff, unsigned soff) { return __builtin_amdgcn_raw_buffer_load_b128(r, voff, soff, 16); }
DI u32x2 ld_sc1_8(const void* p) {
  const unsigned long long a = __hip_atomic_load((const unsigned long long*)p, __ATOMIC_RELAXED, __HIP_MEMORY_SCOPE_AGENT);
  return (u32x2){(unsigned)a, (unsigned)(a >> 32)};
}
DI u16 ld_sc1_2(const u16* p) { return __hip_atomic_load(p, __ATOMIC_RELAXED, __HIP_MEMORY_SCOPE_AGENT); }
DI float ld_sc1_f(const float* p) { return __hip_atomic_load(p, __ATOMIC_RELAXED, __HIP_MEMORY_SCOPE_AGENT); }
DI float gamma_l2(int h) { return log2f(1.0f - exp2f(-5.0f - (float)h)); }

#define XB_TMO 128
#define XB_XCNT(j) (256 + 64 * (j))
#define XB_XSUB(j) (1280 + 64 * (j))
#define XB_XGEN(j) (2304 + 64 * (j))
#define XB_TOP 3328
#define XB_TOPGEN 3392
#define XB_SPIN_CAP (1u << 26)
DI unsigned xb_ld(unsigned* p) { return __hip_atomic_load(p, __ATOMIC_RELAXED, __HIP_MEMORY_SCOPE_AGENT); }
DI unsigned xb_add(unsigned* p, unsigned v) { return __hip_atomic_fetch_add(p, v, __ATOMIC_RELAXED, __HIP_MEMORY_SCOPE_AGENT); }
DI unsigned xb_xcc_id() { return (unsigned)__builtin_amdgcn_s_getreg((3 << 11) | 20) & 0xFu; }
#define XB_SPIN(cond, bar) do { unsigned _sp = 0; while (cond) { __builtin_amdgcn_s_sleep(1); \
    if ((++_sp & 255u) == 0u) { if (xb_ld(&(bar)[XB_TMO])) break; if (_sp > XB_SPIN_CAP) { atomicAdd(&(bar)[XB_TMO], 1u); break; } } } } while (0)

__shared__ unsigned g_xb[4];
__shared__ __attribute__((aligned(16))) char smem[SMEM_BYTES];

DI void xcd_complete(unsigned* bar, unsigned x, unsigned& nloc, unsigned& nx) {
  const unsigned G = gridDim.x;
  unsigned sum, cnt, mine, sp = 0u;
  for (;;) {
    sum = 0u; cnt = 0u; mine = 0u;
#pragma unroll
    for (unsigned j = 0; j < 16; ++j) { const unsigned c = xb_ld(&bar[XB_XCNT(j)]); sum += c; cnt += (c > 0u) ? 1u : 0u; mine = (j == x) ? c : mine; }
    if (sum == G) break;
    __builtin_amdgcn_s_sleep(1);
    if ((++sp & 255u) == 0u) { if (xb_ld(&bar[XB_TMO])) break; if (sp > XB_SPIN_CAP) { atomicAdd(&bar[XB_TMO], 1u); break; } }
  }
  nloc = mine > 0u ? mine : 1u; nx = cnt > 0u ? cnt : 1u;
}
#ifndef USE_XCD_BARRIER
#define USE_XCD_BARRIER 1
#endif
DI void grid_barrier(unsigned* bar) {
  if (!USE_XCD_BARRIER) {
    asm volatile("s_waitcnt vmcnt(0)" ::: "memory");
    __syncthreads();
    if (threadIdx.x == 0) asm volatile("buffer_wbl2 sc0 sc1\n\ts_waitcnt vmcnt(0)" ::: "memory");
    cg::this_grid().sync();
    if (threadIdx.x == 0) asm volatile("buffer_inv sc0 sc1\n\ts_waitcnt vmcnt(0)" ::: "memory");
    __syncthreads();
    return;
  }
  asm volatile("s_waitcnt vmcnt(0)" ::: "memory");
  __syncthreads();
  if (threadIdx.x == 0) {
    __builtin_amdgcn_s_waitcnt(0);
    const unsigned xcc = xb_xcc_id();
    unsigned nloc = g_xb[0], nx = g_xb[1];
    if (nloc == 0u) { xcd_complete(bar, xcc, nloc, nx); g_xb[0] = nloc; g_xb[1] = nx; }
    const unsigned old = xb_add(&bar[XB_XSUB(xcc)], 1u);
    const unsigned gen = old / nloc;
    if (old + 1u == (gen + 1u) * nloc) {
      __builtin_amdgcn_fence(__ATOMIC_RELEASE, "agent");
      asm volatile("s_waitcnt vmcnt(0)" ::: "memory");
      const unsigned og = xb_add(&bar[XB_TOP], 1u);
      const unsigned tg = og / nx;
      if (og + 1u == (tg + 1u) * nx) xb_add(&bar[XB_TOPGEN], 1u);
      else XB_SPIN(xb_ld(&bar[XB_TOPGEN]) == tg, bar);
      __builtin_amdgcn_fence(__ATOMIC_ACQUIRE, "agent");
      xb_add(&bar[XB_XGEN(xcc)], 1u);
      asm volatile("s_waitcnt vmcnt(0)" ::: "memory");
    } else {
      XB_SPIN(xb_ld(&bar[XB_XGEN(xcc)]) == gen, bar);
      __builtin_amdgcn_fence(__ATOMIC_ACQUIRE, "agent");
      asm volatile("s_waitcnt vmcnt(0)" ::: "memory");
    }
  }
  __syncthreads();
}

#define DUMP_OFF (OFF_ELOC)
#define DUMP_N ((size_t)524288)
#define DUMP_F32 0
#ifndef MAXPH
#define MAXPH 10
#endif
#ifndef STATIC_SCHED
#define STATIC_SCHED 0
#endif
#ifndef ONE_XCD
#define ONE_XCD 0
#endif
DI int next_task(unsigned* ctr) {
  __syncthreads();
#ifdef LDS_NAN_PER_TASK
  __syncthreads();
#endif
  if (ONE_XCD) {
    if (threadIdx.x == 0) g_xb[2] = (xb_xcc_id() == 0u) ? atomicAdd(ctr, 1u) : 0x7fffffffu;
    __syncthreads();
    return (int)g_xb[2];
  }
  if (STATIC_SCHED) {
    if (threadIdx.x == 0) { unsigned it = g_xb[3]; g_xb[3] = it + 1u; g_xb[2] = blockIdx.x + it * gridDim.x; }
  } else {
    if (threadIdx.x == 0) g_xb[2] = atomicAdd(ctr, 1u);
  }
  __syncthreads();
  return (int)g_xb[2];
}
DI unsigned task_prefetch(unsigned* ctr) { unsigned v = 0u; if (threadIdx.x == 0) v = atomicAdd(ctr, 1u); return v; }
DI int task_commit(unsigned v) {
  __syncthreads();
  if (threadIdx.x == 0) g_xb[2] = v;
  __syncthreads();
  return (int)g_xb[2];
}
#define TASK_LOOP(ctr, N, BODY) { int t = next_task(ctr); while (t < (N)) { const unsigned tn_ = task_prefetch(ctr); BODY; t = task_commit(tn_); } }
DI void phase_begin() { __syncthreads(); if (threadIdx.x == 0) g_xb[3] = 0u; __syncthreads(); }

template <int BM, int BN, int WGM, int WGN, class Hook>
DI void gemm_mainloop(const u16* A, int lda, const u16* B, int ldb, int K, int kvalid,
                      f32x4 (&acc)[BM / WGM / 16][BN / WGN / 16], u16* sA, u16* sB, Hook hook) {
  constexpr int MT = BM / WGM / 16, NTL = BN / WGN / 16, CA = BM / 32, CB = BN / 32;
  const int tid = ltid(), lane = tid & 63, wid = tid >> 6, wm = wid / WGN, wn = wid % WGN;
  const __amdgpu_buffer_rsrc_t ra_ = mk_rsrc(A), rb_ = mk_rsrc(B);
  u32x4 ra0[CA], rb0[CB], ra1[CA], rb1[CB];
  unsigned va[CA], vb[CB];
  const u32x4 z4 = (u32x4){0u, 0u, 0u, 0u};
  const int cc0 = (tid & 7) * 8;
#pragma unroll
  for (int i = 0; i < CA; ++i) { const int r = (tid + i * NTHR) >> 3; va[i] = (unsigned)(r * lda + cc0) * 2u; }
#pragma unroll
  for (int i = 0; i < CB; ++i) { const int r = (tid + i * NTHR) >> 3; vb[i] = (unsigned)(r * ldb + cc0) * 2u; }
#define GM_LOAD(RA, RB, kn)                                                                          \
  {                                                                                                  \
    const bool kok = ((kn) + cc0) < kvalid;                                                          \
    _Pragma("unroll") for (int i = 0; i < CA; ++i) RA[i] = kok ? bld16(ra_, va[i], (unsigned)(kn) * 2u) : z4; \
    _Pragma("unroll") for (int i = 0; i < CB; ++i) RB[i] = kok ? bld16(rb_, vb[i], (unsigned)(kn) * 2u) : z4; \
  }
#define GM_STEP(RA, RB, kcur)                                                                        \
  {                                                                                                  \
    __syncthreads();                                                                                 \
    _Pragma("unroll") for (int i = 0; i < CA; ++i) { const int r = (tid + i * NTHR) >> 3; *(u32x4*)(sA + r * LDS_STRIDE + cc0) = RA[i]; } \
    _Pragma("unroll") for (int i = 0; i < CB; ++i) { const int r = (tid + i * NTHR) >> 3; *(u32x4*)(sB + r * LDS_STRIDE + cc0) = RB[i]; } \
    __syncthreads();                                                                                 \
    if ((kcur) + 128 < K) GM_LOAD(RA, RB, (kcur) + 128)                                              \
    _Pragma("unroll") for (int kk = 0; kk < 2; ++kk) {                                               \
      bf16x8 af[MT], bfr[NTL];                                                                       \
      _Pragma("unroll") for (int m = 0; m < MT; ++m) af[m] = *(const bf16x8*)(sA + (wm * (BM / WGM) + m * 16 + (lane & 15)) * LDS_STRIDE + kk * 32 + (lane >> 4) * 8); \
      _Pragma("unroll") for (int n = 0; n < NTL; ++n) bfr[n] = *(const bf16x8*)(sB + (wn * (BN / WGN) + n * 16 + (lane & 15)) * LDS_STRIDE + kk * 32 + (lane >> 4) * 8); \
      _Pragma("unroll") for (int m = 0; m < MT; ++m)                                                 \
        _Pragma("unroll") for (int n = 0; n < NTL; ++n) acc[m][n] = MFMA16(af[m], bfr[n], acc[m][n]); \
    }                                                                                                \
    hook((kcur), acc);                                                                               \
  }
  GM_LOAD(ra0, rb0, 0)
  if (64 < K) GM_LOAD(ra1, rb1, 64)
#pragma unroll 1
  for (int k0 = 0; k0 < K; k0 += 128) {
    GM_STEP(ra0, rb0, k0)
    GM_STEP(ra1, rb1, k0 + 64)
  }
  MFMA_FENCE();
#undef GM_LOAD
#undef GM_STEP
}
struct NoHook { template <class T> DI void operator()(int, T&) const {} };

template <int BM, int BN, int WGM, int WGN>
DI void gemm_mainloop_alds(const u16* sAimg, int lda_s, const u16* B, int ldb, int K,
                           f32x4 (&acc)[BM / WGM / 16][BN / WGN / 16], u16* sB) {
  constexpr int MT = BM / WGM / 16, NTL = BN / WGN / 16, CB = BN / 32;
  const int tid = ltid(), lane = tid & 63, wid = tid >> 6, wm = wid / WGN, wn = wid % WGN;
  const __amdgpu_buffer_rsrc_t rb_ = mk_rsrc(B);
  u32x4 rb0[CB], rb1[CB];
  unsigned vb[CB];
  const int cc0 = (tid & 7) * 8;
#pragma unroll
  for (int i = 0; i < CB; ++i) { const int r = (tid + i * NTHR) >> 3; vb[i] = (unsigned)(r * ldb + cc0) * 2u; }
#define GA_STEP(RB, kcur)                                                                            \
  {                                                                                                  \
    __syncthreads();                                                                                 \
    _Pragma("unroll") for (int i = 0; i < CB; ++i) { const int r = (tid + i * NTHR) >> 3; *(u32x4*)(sB + r * LDS_STRIDE + cc0) = RB[i]; } \
    __syncthreads();                                                                                 \
    if ((kcur) + 128 < K) { _Pragma("unroll") for (int i = 0; i < CB; ++i) RB[i] = bld16(rb_, vb[i], (unsigned)((kcur) + 128) * 2u); } \
    _Pragma("unroll") for (int kk = 0; kk < 2; ++kk) {                                               \
      bf16x8 af[MT], bfr[NTL];                                                                       \
      _Pragma("unroll") for (int m = 0; m < MT; ++m) af[m] = *(const bf16x8*)(sAimg + (wm * (BM / WGM) + m * 16 + (lane & 15)) * lda_s + (kcur) + kk * 32 + (lane >> 4) * 8); \
      _Pragma("unroll") for (int n = 0; n < NTL; ++n) bfr[n] = *(const bf16x8*)(sB + (wn * (BN / WGN) + n * 16 + (lane & 15)) * LDS_STRIDE + kk * 32 + (lane >> 4) * 8); \
      _Pragma("unroll") for (int m = 0; m < MT; ++m)                                                 \
        _Pragma("unroll") for (int n = 0; n < NTL; ++n) acc[m][n] = MFMA16(af[m], bfr[n], acc[m][n]); \
    }                                                                                                \
  }
#pragma unroll
  for (int i = 0; i < CB; ++i) rb0[i] = bld16(rb_, vb[i], 0u);
#pragma unroll
  for (int i = 0; i < CB; ++i) rb1[i] = bld16(rb_, vb[i], 128u);
#pragma unroll 1
  for (int k0 = 0; k0 < K; k0 += 128) {
    GA_STEP(rb0, k0)
    GA_STEP(rb1, k0 + 64)
  }
  MFMA_FENCE();
#undef GA_STEP
}

template <int MT, int NTL>
DI void zero_acc(f32x4 (&acc)[MT][NTL]) {
#pragma unroll
  for (int m = 0; m < MT; ++m)
#pragma unroll
    for (int n = 0; n < NTL; ++n) acc[m][n] = (f32x4){0.f, 0.f, 0.f, 0.f};
}

DI int dst_row_map(int n, int mode) {
  if (mode == 0) return n;
  if (mode == 1) {
    if (n < 512 || n >= 1536) return n;
    int sec = n & ~127, d = n & 127;
    int xh = d >> 6, idx = d & 63;
    return sec + (((idx >> 4) * 2 + xh) << 4) + (idx & 15);
  }
  if (mode == 2) return (n >> 4) * 32 + (n & 15);
  return (n >> 4) * 32 + 16 + (n & 15);
}
DI void transpose_tile(const float* src, int lds_, int k0, int n0, u16* dst, int ldd,
                       const float* gain, int mode, float scale) {
  float* t = (float*)smem;
  const int tid = ltid(), ty = tid >> 4, tx = tid & 15;
  __syncthreads();
#pragma unroll
  for (int i = 0; i < 4; ++i) {
    int k = ty + 16 * i;
    float4 v = *(const float4*)(src + (size_t)(k0 + k) * lds_ + n0 + tx * 4);
    float g = gain ? gain[k0 + k] : 1.0f;
    t[k * 65 + tx * 4 + 0] = v.x * g; t[k * 65 + tx * 4 + 1] = v.y * g;
    t[k * 65 + tx * 4 + 2] = v.z * g; t[k * 65 + tx * 4 + 3] = v.w * g;
  }
  __syncthreads();
  const int nl = tid >> 2, ks = (tid & 3) * 16;
  const int n = n0 + nl;
  float sc = scale;
  if (mode == 1) sc = (n >= 512 && n < 1024) ? 0.08838834764831845f : 1.0f;
  unsigned w[8];
#pragma unroll
  for (int i = 0; i < 8; ++i) w[i] = pack2(t[(ks + 2 * i) * 65 + nl] * sc, t[(ks + 2 * i + 1) * 65 + nl] * sc);
  u16* d = dst + (size_t)dst_row_map(n, mode) * ldd + k0 + ks;
  *(u32x4*)d = (u32x4){w[0], w[1], w[2], w[3]};
  *(u32x4*)(d + 8) = (u32x4){w[4], w[5], w[6], w[7]};
}

DI void rownorm_task(const float* src, float* xs_out, u16* dst) {
  const int lane = ltid() & 63;
  float4 v[4];
  float ss = 0.f;
#pragma unroll
  for (int i = 0; i < 4; ++i) {
    v[i] = *(const float4*)(src + i * 256 + lane * 4);
    ss += v[i].x * v[i].x + v[i].y * v[i].y + v[i].z * v[i].z + v[i].w * v[i].w;
  }
  ss = red64(ss);
  const float r = rsqrtf(ss * (1.0f / 1024.0f) + EPSF);
  if (xs_out && lane == 0) *xs_out = 1.0f / r;
#pragma unroll
  for (int i = 0; i < 4; ++i) {
    u32x2 o; o.x = pack2(v[i].x * r, v[i].y * r); o.y = pack2(v[i].z * r, v[i].w * r);
    *(u32x2*)(dst + i * 256 + lane * 4) = o;
  }
}

DI void phase_prep(const Params& p, unsigned* ctr) {
  char* ws = p.ws;
  const int tid = ltid();
  constexpr int T_W = 16384, T_X = NTOK / 4, T_M = 256, T_S = 128;
  constexpr int TOT = T_W + T_X + T_M + T_S;
  for (;;) {
    int t = next_task(ctr);
    if (t >= TOT) break;
    if (t < T_W) {
      const int l = t >> 12; int q = t & 4095;
      u16* wl = (u16*)(ws + OFF_W) + (size_t)l * W_LAYER;
      if (q < 640) {
        transpose_tile(p.w_in + (size_t)l * 1024 * 2560, 2560, (q / 40) * 64, (q % 40) * 64, wl + W_IN, 1024, p.mix_pre + l * 1024, 1, 1.0f);
      } else if ((q -= 640) < 64) {
        transpose_tile(p.w_glu + (size_t)l * 512 * 512, 512, (q / 8) * 64, (q % 8) * 64, wl + W_GLU, 512, nullptr, 0, 1.0f);
      } else if ((q -= 64) < 256) {
        const int k0 = (q / 16) * 64;
        const float* gain = (k0 < 512) ? (p.s5_onorm + l * 512) : (p.ret_onorm + l * 512 - 512);
        transpose_tile(p.w_out + (size_t)l * 1024 * 1024, 1024, k0, (q % 16) * 64, wl + W_OUT, 1024, gain, 0, 1.0f);
      } else if ((q -= 256) < 256) {
        transpose_tile(p.w_cq + (size_t)l * 1024 * 1024, 1024, (q / 16) * 64, (q % 16) * 64, wl + W_CQ, 1024, p.xa_pre + l * 1024, 0, 0.0625f);
      } else if ((q -= 256) < 256) {
        transpose_tile(p.w_ck + (size_t)l * 1024 * 1024, 1024, (q / 16) * 64, (q % 16) * 64, wl + W_CK, 1024, p.mem_norm + l * 1024, 0, 1.0f);
      } else if ((q -= 256) < 256) {
        transpose_tile(p.w_cv + (size_t)l * 1024 * 1024, 1024, (q / 16) * 64, (q % 16) * 64, wl + W_CV, 1024, p.mem_norm + l * 1024, 0, 1.0f);
      } else if ((q -= 256) < 256) {
        transpose_tile(p.w_co + (size_t)l * 1024 * 1024, 1024, (q / 16) * 64, (q % 16) * 64, wl + W_CO, 1024, nullptr, 0, 1.0f);
      } else if ((q -= 256) < 704) {
        transpose_tile(p.w_gate + (size_t)l * 1024 * 2816, 2816, (q / 44) * 64, (q % 44) * 64, wl + W_GU, 1024, p.ffn_pre + l * 1024, 2, 1.0f);
      } else if ((q -= 704) < 704) {
        transpose_tile(p.w_up + (size_t)l * 1024 * 2816, 2816, (q / 44) * 64, (q % 44) * 64, wl + W_GU, 1024, p.ffn_pre + l * 1024, 3, 1.0f);
      } else {
        q -= 704;
        transpose_tile(p.w_down + (size_t)l * 2816 * 1024, 1024, (q / 16) * 64, (q % 16) * 64, wl + W_DN, 2816, nullptr, 0, 1.0f);
      }
    } else if (t < T_W + T_X) {
      const int row = (t - T_W) * 4 + (tid >> 6);
      const float* src = (row < PROWS) ? p.x_prompt + (size_t)row * 1024 : p.x_sample + (size_t)(row - PROWS) * 1024;
      rownorm_task(src, (float*)(ws + OFF_RSQ) + row, (u16*)(ws + OFF_HB) + (size_t)row * 1024);
    } else if (t < T_W + T_X + T_M) {
      const int row = (t - T_W - T_X) * 4 + (tid >> 6);
      rownorm_task(p.mem_prompt + (size_t)row * 1024, nullptr, (u16*)(ws + OFF_MEMB) + (size_t)row * 1024);
    } else {
      const int lg = t - T_W - T_X - T_M, l = lg >> 5, g = lg & 31;
      char* sp = ws + OFF_S5P + (size_t)l * S5P_LAYER;
      u16* bbt = (u16*)(sp + S5P_BBT) + g * 2048;
      u16* cm = (u16*)(sp + S5P_CM) + g * 2048;
      float* ab = (float*)(sp + S5P_ABAR) + g * 128;
      const float dt = __expf(p.log_step[l * 32 + g]);
      for (int e = tid; e < 1024; e += NTHR) {
        const int pp = e >> 4, h = e & 15;
        const float lr = p.lam_re[(l * 32 + g) * 64 + pp], li = p.lam_im[(l * 32 + g) * 64 + pp];
        const float ar = lr * dt, ai = li * dt, mag = expf(ar);
        float sn_, cs_; sincos_cw(ai, &sn_, &cs_);
        const float abr = mag * cs_, abi = mag * sn_;
        const float den = lr * lr + li * li, nr = abr - 1.0f, ni = abi;
        const float fr = (nr * lr + ni * li) / den, fi = (ni * lr - nr * li) / den;
        const float br = p.b_re[((size_t)(l * 32 + g) * 64 + pp) * 16 + h], bi = p.b_im[((size_t)(l * 32 + g) * 64 + pp) * 16 + h];
        bbt[pp * 16 + h] = f2bf(fr * br - fi * bi);
        bbt[(64 + pp) * 16 + h] = f2bf(fr * bi + fi * br);
        if (h == 0) { ab[pp * 2] = abr; ab[pp * 2 + 1] = abi; }
        const int hh = e >> 6, kk = e & 63;
        cm[hh * 128 + kk] = f2bf(p.c_re[((size_t)(l * 32 + g) * 16 + hh) * 64 + kk]);
        cm[hh * 128 + 64 + kk] = f2bf(-p.c_im[((size_t)(l * 32 + g) * 16 + hh) * 64 + kk]);
      }
    }
  }
}

DI void memkv_tile(const Params& p, int t) {
  char* ws = p.ws;
  const int l = t >> 7, rt = (t >> 4) & 7, ct = t & 15;
  const int isv = ct >> 3, col0 = (ct & 7) * 128, row0 = rt * 128;
  const u16* A = (const u16*)(ws + OFF_MEMB) + (size_t)row0 * 1024;
  const u16* B = (const u16*)(ws + OFF_W) + (size_t)l * W_LAYER + (isv ? W_CV : W_CK) + (size_t)col0 * 1024;
  f32x4 acc[4][4];
  zero_acc(acc);
  u16* sA = (u16*)smem; u16* sB = sA + 128 * LDS_STRIDE;
  gemm_mainloop<128, 128, 2, 2>(A, 1024, B, 1024, 1024, 1 << 30, acc, sA, sB, NoHook());
  const int lane = ltid() & 63, wid = ltid() >> 6, wm = wid >> 1, wn = wid & 1;
  float* of = p.out + (isv ? O_MV_P : O_MK_P) + (size_t)l * 1024 * 1024;
  u16* kx = (u16*)(ws + OFF_KXP) + (size_t)l * 1024 * 1024;
  u16* vx = (u16*)(ws + OFF_VTXP) + (size_t)l * 1024 * 1024;
#pragma unroll
  for (int m = 0; m < 4; ++m)
#pragma unroll
    for (int n = 0; n < 4; ++n) {
      const int r = row0 + wm * 64 + m * 16 + (lane >> 4) * 4, c = col0 + wn * 64 + n * 16 + (lane & 15);
#pragma unroll
      for (int j = 0; j < 4; ++j) of[(size_t)(r + j) * 1024 + c] = acc[m][n][j];
      if (!isv) {
#pragma unroll
        for (int j = 0; j < 4; ++j) kx[(size_t)(r + j) * 1024 + c] = f2bf(acc[m][n][j]);
      } else {
        const int b = r >> 8, mm = r & 255, h = c >> 8, d = c & 255;
        u32x2 o; o.x = pack2(acc[m][n][0], acc[m][n][1]); o.y = pack2(acc[m][n][2], acc[m][n][3]);
        *(u32x2*)(vx + ((size_t)((b * 4 + h) * 256 + d)) * 256 + mm) = o;
      }
    }
}
DI void cache_task(const Params& p, int l, int t) {
  char* ws = p.ws;
  if (t < 1024) {
    const float* src = p.cmk + (size_t)l * 16 * 256 * 1024 + (size_t)t * 4096 + ltid() * 16;
    u16* dst = (u16*)(ws + OFF_KXS) + (size_t)t * 4096 + ltid() * 16;
    float4 a = *(const float4*)src, b = *(const float4*)(src + 4), c = *(const float4*)(src + 8), d = *(const float4*)(src + 12);
    *(u32x4*)dst = (u32x4){pack2(a.x, a.y), pack2(a.z, a.w), pack2(b.x, b.y), pack2(b.z, b.w)};
    *(u32x4*)(dst + 8) = (u32x4){pack2(c.x, c.y), pack2(c.z, c.w), pack2(d.x, d.y), pack2(d.z, d.w)};
  } else {
    t -= 1024;
    const int bh = t >> 4, q = t & 15, b = bh >> 2, h = bh & 3;
    const float* src = p.cmv + ((size_t)(l * 16 + b) * 256) * 1024 + h * 256;
    u16* dst = (u16*)(ws + OFF_VTXS) + (size_t)bh * 256 * 256;
    transpose_tile(src, 1024, (q >> 2) * 64, (q & 3) * 64, dst, 256, nullptr, 0, 1.0f);
  }
}

DI void g1_tile(const Params& p, int l, int t) {
  char* ws = p.ws;
  const int rt = t / 20, ct = t % 20;
  const int row0 = rt * 128, col0 = ct * 128;
  const u16* A = (const u16*)(ws + OFF_HB) + (size_t)row0 * 1024;
  const u16* B = (const u16*)(ws + OFF_W) + (size_t)l * W_LAYER + W_IN + (size_t)col0 * 1024;
  f32x4 acc[4][4];
  zero_acc(acc);
  u16* sA = (u16*)smem; u16* sB = sA + 128 * LDS_STRIDE;
  gemm_mainloop<128, 128, 2, 2>(A, 1024, B, 1024, 1024, 1 << 30, acc, sA, sB, NoHook());
  const int lane = ltid() & 63, wid = ltid() >> 6, wm = wid >> 1, wn = wid & 1;
  char* arena = ws + OFF_ARENA;
  const int sec = ct >> 2, hd = ct & 3;
  const bool samp = row0 >= PROWS;
  if (sec == 0 || sec == 4) {
    u16* dst = (u16*)(arena + (sec == 0 ? 0 : 3) * SLOT);
#pragma unroll
    for (int m = 0; m < 4; ++m)
#pragma unroll
      for (int n = 0; n < 4; ++n) {
        const int r = row0 + wm * 64 + m * 16 + (lane >> 4) * 4, c = hd * 128 + wn * 64 + n * 16 + (lane & 15);
#pragma unroll
        for (int j = 0; j < 4; ++j) dst[(size_t)(r + j) * 512 + c] = f2bf(acc[m][n][j]);
      }
  } else if (sec == 3) {
    u16* vt = (u16*)(arena + 4 * SLOT);
#pragma unroll
    for (int m = 0; m < 4; ++m)
#pragma unroll
      for (int n = 0; n < 4; ++n) {
        const int r = row0 + wm * 64 + m * 16 + (lane >> 4) * 4, e = wn * 64 + n * 16 + (lane & 15);
        u32x2 o; o.x = pack2(acc[m][n][0], acc[m][n][1]); o.y = pack2(acc[m][n][2], acc[m][n][3]);
        size_t off;
        if (!samp) { const int b = r >> 13, tt = r & 8191; off = ((size_t)((b * 4 + hd) * 128 + e)) * SEQ + tt; }
        else { const int sr = r - PROWS, b = sr >> 4, tt = sr & 15; off = (size_t)16 * 128 * SEQ + ((size_t)((b * 4 + hd) * 128 + e)) * 16 + tt; }
        *(u32x2*)(vt + off) = o;
      }
  } else {
    u16* dst = (u16*)(arena + (sec == 1 ? 1 : 2) * SLOT);
    u16* ktd = (u16*)(arena + 5 * SLOT);
    const float gl2 = gamma_l2(hd);
#pragma unroll
    for (int m = 0; m < 4; ++m)
#pragma unroll
      for (int np = 0; np < 2; ++np) {
        const int r = row0 + wm * 64 + m * 16 + (lane >> 4) * 4;
        const int idx = (wn * 2 + np) * 16 + (lane & 15);
        const float inv = exp2f(-(float)idx * (13.287712379549449f / 64.0f));
        float o1[4], o2[4];
#pragma unroll
        for (int j = 0; j < 4; ++j) {
          const int rr = r + j;
          const int pos = samp ? (1024 + ((rr - PROWS) & 15)) : (rr & 8191);
          float sn, cs;
          sincos_cw((float)pos * inv, &sn, &cs);
          const float x1 = acc[m][2 * np][j], x2 = acc[m][2 * np + 1][j];
          o1[j] = x1 * cs - x2 * sn; o2[j] = x1 * sn + x2 * cs;
          dst[(size_t)rr * 512 + hd * 128 + idx] = f2bf(o1[j]);
          dst[(size_t)rr * 512 + hd * 128 + 64 + idx] = f2bf(o2[j]);
        }
        if (sec == 2) {
          size_t off1; int tloc;
          if (!samp) { const int b = r >> 13, tt = r & 8191; off1 = ((size_t)((b * 4 + hd) * 128 + idx)) * SEQ + tt; tloc = 63 - (tt & 63); }
          else { const int sr = r - PROWS, b = sr >> 4, tt = sr & 15; off1 = (size_t)16 * 128 * SEQ + ((size_t)((b * 4 + hd) * 128 + idx)) * 16 + tt; tloc = 15 - tt; }
          const size_t off2 = off1 + (size_t)64 * (samp ? 16 : SEQ);
          float dc[4];
#pragma unroll
          for (int j = 0; j < 4; ++j) dc[j] = exp2f(gl2 * (float)(tloc - j));
          u32x2 a, b2;
          a.x = pack2(o1[0] * dc[0], o1[1] * dc[1]); a.y = pack2(o1[2] * dc[2], o1[3] * dc[3]);
          b2.x = pack2(o2[0] * dc[0], o2[1] * dc[1]); b2.y = pack2(o2[2] * dc[2], o2[3] * dc[3]);
          *(u32x2*)(ktd + off1) = a;
          *(u32x2*)(ktd + off2) = b2;
        }
      }
  }
}

struct DecayHook {
  float g64;
  template <class T> DI void operator()(int k0, T& acc) const {
    if (k0 + 64 < 512) {
#pragma unroll
      for (int m = 0; m < 4; ++m)
#pragma unroll
        for (int n = 0; n < 4; ++n) acc[m][n] *= g64;
    }
  }
};
DI void ret_local_task(const Params& p, int t) {
  char* ws = p.ws;
  char* arena = ws + OFF_ARENA;
  const int bh = t >> 4, sc = t & 15, h = bh & 3;
  const u16* A = (const u16*)(arena + 5 * SLOT) + (size_t)bh * 128 * SEQ + sc * 512;
  const u16* B = (const u16*)(arena + 4 * SLOT) + (size_t)bh * 128 * SEQ + sc * 512;
  f32x4 acc[4][4];
  zero_acc(acc);
  u16* sA = (u16*)smem; u16* sB = sA + 128 * LDS_STRIDE;
  DecayHook hk; hk.g64 = exp2f(gamma_l2(h) * 64.0f);
  gemm_mainloop<128, 128, 2, 2>(A, SEQ, B, SEQ, 512, 1 << 30, acc, sA, sB, hk);
  const int lane = ltid() & 63, wid = ltid() >> 6, wm = wid >> 1, wn = wid & 1;
  float* dst = (float*)(ws + OFF_SLOC) + (size_t)t * 16384;
#pragma unroll
  for (int m = 0; m < 4; ++m)
#pragma unroll
    for (int n = 0; n < 4; ++n) {
      const int r = wm * 64 + m * 16 + (lane >> 4) * 4, c = wn * 64 + n * 16 + (lane & 15);
#pragma unroll
      for (int j = 0; j < 4; ++j) dst[(r + j) * 128 + c] = acc[m][n][j];
    }
}

DI void ret_final_task(const Params& p, int l, int t) {
  char* ws = p.ws;
  char* arena = ws + OFF_ARENA;
  const int tid = ltid(), lane = tid & 63, w = tid >> 6;
  const bool samp = t >= 256;
  int bh, sc, nchunk, C, row_base;
  size_t tr_base; int tr_ld;
  if (!samp) { bh = t >> 4; sc = t & 15; nchunk = 8; C = 64; row_base = (bh >> 2) * SEQ + sc * 512; tr_base = (size_t)bh * 128 * SEQ + sc * 512; tr_ld = SEQ; }
  else { bh = t - 256; sc = 0; nchunk = 1; C = 16; row_base = PROWS + (bh >> 2) * 16; tr_base = (size_t)16 * 128 * SEQ + (size_t)bh * 128 * 16; tr_ld = 16; }
  const int h = bh & 3;
  const float gl2 = gamma_l2(h);
  const float gC = exp2f(gl2 * (float)C);
  const u16* Qg = (const u16*)(arena + 1 * SLOT);
  const u16* Kg = (const u16*)(arena + 2 * SLOT);
  const u16* Gg = (const u16*)(arena + 3 * SLOT);
  const u16* Vt = (const u16*)(arena + 4 * SLOT) + tr_base;
  const u16* Ktd = (const u16*)(arena + 5 * SLOT) + tr_base;
  u16* reto = (u16*)(arena + 7 * SLOT);
  u16* sQ = (u16*)smem;
  u16* sK = sQ + 64 * 144;
  u16* sV = sK + 128 * LDS_STRIDE;
  u16* sS = sV + 128 * LDS_STRIDE;
  float* sR = (float*)(sS + 64 * LDS_STRIDE);

  f32x4 S[8][2];
  if (samp) {
    const float* s0 = p.ret0 + ((size_t)(l * 64 + bh)) * 16384;
#pragma unroll
    for (int mt = 0; mt < 8; ++mt)
#pragma unroll
      for (int nt = 0; nt < 2; ++nt)
#pragma unroll
        for (int j = 0; j < 4; ++j) S[mt][nt][j] = s0[(mt * 16 + (lane >> 4) * 4 + j) * 128 + 32 * w + nt * 16 + (lane & 15)];
  } else {
#pragma unroll
    for (int mt = 0; mt < 8; ++mt)
#pragma unroll
      for (int nt = 0; nt < 2; ++nt) S[mt][nt] = (f32x4){0.f, 0.f, 0.f, 0.f};
    const float g512 = exp2f(gl2 * 512.0f);
    for (int s2 = 0; s2 < sc; ++s2) {
      const float* sl = (const float*)(ws + OFF_SLOC) + ((size_t)(bh * 16 + s2)) * 16384;
#pragma unroll
      for (int mt = 0; mt < 8; ++mt)
#pragma unroll
        for (int nt = 0; nt < 2; ++nt)
#pragma unroll
          for (int j = 0; j < 4; ++j)
            S[mt][nt][j] = S[mt][nt][j] * g512 + ld_sc1_f(sl + (mt * 16 + (lane >> 4) * 4 + j) * 128 + 32 * w + nt * 16 + (lane & 15));
    }
  }
  const u32x4 z4 = (u32x4){0, 0, 0, 0};
  for (int c = 0; c < nchunk; ++c) {
    const int r0 = row_base + c * 64;
    __syncthreads();
#pragma unroll
    for (int i = 0; i < 4; ++i) {
      const int id = tid + i * NTHR, r = id >> 4, cc = (id & 15) * 8;
      u32x4 q4 = z4, k4 = z4;
      if (r < C) {
        q4 = ld_sc1_16(Qg + (size_t)(r0 + r) * 512 + h * 128 + cc);
        k4 = ld_sc1_16(Kg + (size_t)(r0 + r) * 512 + h * 128 + cc);
      }
      *(u32x4*)(sQ + r * 144 + cc) = q4;
      *(u32x4*)(sK + r * 144 + cc) = k4;
    }
#pragma unroll
    for (int i = 0; i < 4; ++i) {
      const int id = tid + i * NTHR, r = id >> 3, cc = (id & 7) * 8;
      u32x4 v4 = z4;
      if (cc < C) v4 = ld_sc1_16(Vt + (size_t)r * tr_ld + c * 64 + cc);
      *(u32x4*)(sV + r * LDS_STRIDE + cc) = v4;
    }
    __syncthreads();
    {
      f32x4 sc4[4];
#pragma unroll
      for (int m = 0; m < 4; ++m) sc4[m] = (f32x4){0.f, 0.f, 0.f, 0.f};
#pragma unroll
      for (int ks = 0; ks < 4; ++ks) {
        const bf16x8 bk = *(const bf16x8*)(sK + (16 * w + (lane & 15)) * 144 + ks * 32 + (lane >> 4) * 8);
#pragma unroll
        for (int m = 0; m < 4; ++m) {
          const bf16x8 aq = *(const bf16x8*)(sQ + (m * 16 + (lane & 15)) * 144 + ks * 32 + (lane >> 4) * 8);
          sc4[m] = MFMA16(aq, bk, sc4[m]);
        }
      }
      MFMA_FENCE();
      const int jc = 16 * w + (lane & 15);
#pragma unroll
      for (int m = 0; m < 4; ++m)
#pragma unroll
        for (int j = 0; j < 4; ++j) {
          const int i = m * 16 + (lane >> 4) * 4 + j;
          const int dd = i > jc ? i - jc : jc - i;
          sS[i * LDS_STRIDE + jc] = f2bf(sc4[m][j] * exp2f(gl2 * (float)dd));
        }
    }
    __syncthreads();
#pragma unroll
    for (int i = 0; i < 4; ++i) {
      const int id = tid + i * NTHR, r = id >> 3, cc = (id & 7) * 8;
      u32x4 v4 = z4;
      if (cc < C) v4 = ld_sc1_16(Ktd + (size_t)r * tr_ld + c * 64 + cc);
      *(u32x4*)(sK + r * LDS_STRIDE + cc) = v4;
    }
    f32x4 o[4][2];
#pragma unroll
    for (int m = 0; m < 4; ++m) { o[m][0] = (f32x4){0.f, 0.f, 0.f, 0.f}; o[m][1] = o[m][0]; }
#pragma unroll
    for (int a = 0; a < 4; ++a) {
      bf16x8 bs[2];
#pragma unroll
      for (int nt = 0; nt < 2; ++nt) {
        u32x4 u;
        u.x = pack2(S[2 * a][nt][0], S[2 * a][nt][1]); u.y = pack2(S[2 * a][nt][2], S[2 * a][nt][3]);
        u.z = pack2(S[2 * a + 1][nt][0], S[2 * a + 1][nt][1]); u.w = pack2(S[2 * a + 1][nt][2], S[2 * a + 1][nt][3]);
        bs[nt] = __builtin_bit_cast(bf16x8, u);
      }
#pragma unroll
      for (int m = 0; m < 4; ++m) {
        const u16* qp = sQ + (m * 16 + (lane & 15)) * 144 + (lane >> 4) * 4;
        const u32x2 lo = *(const u32x2*)(qp + (2 * a) * 16);
        const u32x2 hi = *(const u32x2*)(qp + (2 * a + 1) * 16);
        const bf16x8 aq = __builtin_bit_cast(bf16x8, ((u32x4){lo.x, lo.y, hi.x, hi.y}));
        o[m][0] = MFMA16(aq, bs[0], o[m][0]);
        o[m][1] = MFMA16(aq, bs[1], o[m][1]);
      }
      __builtin_amdgcn_sched_barrier(0);
    }
    MFMA_FENCE();
#pragma unroll
    for (int m = 0; m < 4; ++m)
#pragma unroll
      for (int j = 0; j < 4; ++j) {
        const int i = m * 16 + (lane >> 4) * 4 + j;
        const float f = exp2f(gl2 * (float)(i + 1));
        o[m][0][j] *= f;
        o[m][1][j] *= f;
      }
#pragma unroll
    for (int ks = 0; ks < 2; ++ks) {
      bf16x8 bv[2];
#pragma unroll
      for (int nt = 0; nt < 2; ++nt) bv[nt] = *(const bf16x8*)(sV + (32 * w + nt * 16 + (lane & 15)) * LDS_STRIDE + ks * 32 + (lane >> 4) * 8);
#pragma unroll
      for (int m = 0; m < 4; ++m) {
        const bf16x8 as = *(const bf16x8*)(sS + (m * 16 + (lane & 15)) * LDS_STRIDE + ks * 32 + (lane >> 4) * 8);
        o[m][0] = MFMA16(as, bv[0], o[m][0]);
        o[m][1] = MFMA16(as, bv[1], o[m][1]);
      }
      __builtin_amdgcn_sched_barrier(0);
    }
    MFMA_FENCE();
#pragma unroll
    for (int m = 0; m < 4; ++m)
#pragma unroll
      for (int j = 0; j < 4; ++j) {
        float v = o[m][0][j] * o[m][0][j] + o[m][1][j] * o[m][1][j];
        v = red16(v);
        if ((lane & 15) == 0) sR[w * 64 + m * 16 + (lane >> 4) * 4 + j] = v;
      }
    __syncthreads();
#pragma unroll
    for (int m = 0; m < 4; ++m)
#pragma unroll
      for (int j = 0; j < 4; ++j) {
        const int i = m * 16 + (lane >> 4) * 4 + j;
        if (i < C) {
          const float ss = sR[i] + sR[64 + i] + sR[128 + i] + sR[192 + i];
          const float rs = rsqrtf(ss * (1.0f / 128.0f) + EPSF);
#pragma unroll
          for (int nt = 0; nt < 2; ++nt) {
            const int e = 32 * w + nt * 16 + (lane & 15);
            const float g = bf2f(ld_sc1_2(Gg + (size_t)(r0 + i) * 512 + h * 128 + e));
            reto[(size_t)(r0 + i) * 512 + h * 128 + e] = f2bf(o[m][nt][j] * rs * siluf_(g));
          }
        }
      }
#pragma unroll
    for (int mt = 0; mt < 8; ++mt) { S[mt][0] *= gC; S[mt][1] *= gC; }
#pragma unroll 1
    for (int ks = 0; ks < 2; ++ks) {
      bf16x8 bv[2];
#pragma unroll
      for (int nt = 0; nt < 2; ++nt) bv[nt] = *(const bf16x8*)(sV + (32 * w + nt * 16 + (lane & 15)) * LDS_STRIDE + ks * 32 + (lane >> 4) * 8);
#pragma unroll
      for (int mt = 0; mt < 8; ++mt) {
        const bf16x8 ak = *(const bf16x8*)(sK + (mt * 16 + (lane & 15)) * LDS_STRIDE + ks * 32 + (lane >> 4) * 8);
        S[mt][0] = MFMA16(ak, bv[0], S[mt][0]);
        S[mt][1] = MFMA16(ak, bv[1], S[mt][1]);
      }
    }
    MFMA_FENCE();
  }
  if (samp || sc == 15) {
    float* so = samp ? (p.out + O_RET_S + ((size_t)(l * 64 + bh)) * 16384) : (p.out + O_RET_P + ((size_t)(l * 16 + bh)) * 16384);
#pragma unroll
    for (int mt = 0; mt < 8; ++mt)
#pragma unroll
      for (int nt = 0; nt < 2; ++nt)
#pragma unroll
        for (int j = 0; j < 4; ++j) so[(mt * 16 + (lane >> 4) * 4 + j) * 128 + 32 * w + nt * 16 + (lane & 15)] = S[mt][nt][j];
  }
}

DI void s5_task(const Params& p, int l, int t, int mode) {
  char* ws = p.ws;
  char* arena = ws + OFF_ARENA;
  const int tid = ltid(), lane = tid & 63, w = tid >> 6;
  const bool samp = t >= 512;
  int b, lc, g, row_base, nsub;
  if (!samp) { b = t >> 7; lc = (t >> 3) & 15; g = (t & 7) * 4 + w; row_base = b * SEQ + lc * 512; nsub = 32; }
  else { const int q = t - 512; b = q >> 3; lc = 0; g = (q & 7) * 4 + w; row_base = PROWS + b * 16; nsub = 1; }
  const char* sp = ws + OFF_S5P + (size_t)l * S5P_LAYER;
  const u16* bbt = (const u16*)(sp + S5P_BBT) + g * 2048;
  const u16* cm = (const u16*)(sp + S5P_CM) + g * 2048;
  const float* ab = (const float*)(sp + S5P_ABAR) + g * 128;
  const u16* U = (const u16*)(arena + 0 * SLOT);
  u16* Z = (u16*)(arena + 6 * SLOT);
  float* bu = (float*)(smem + w * 13056);
  u16* xs = (u16*)(smem + w * 13056 + 8448);
  const float ar = ld_sc1_f(ab + lane * 2), ai = ld_sc1_f(ab + lane * 2 + 1);
  const int slab = lane >> 4;
  const u32x4 z4 = (u32x4){0, 0, 0, 0};
  bf16x8 Bf[8], Cf[4];
#pragma unroll
  for (int nt = 0; nt < 8; ++nt) {
    u32x4 u = z4;
    if (slab < 2) u = ld_sc1_16(bbt + (nt * 16 + (lane & 15)) * 16 + slab * 8);
    Bf[nt] = __builtin_bit_cast(bf16x8, u);
  }
#pragma unroll
  for (int ks = 0; ks < 4; ++ks) Cf[ks] = __builtin_bit_cast(bf16x8, ld_sc1_16(cm + (lane & 15) * 128 + ks * 32 + slab * 8));
  const float Dh = p.s5_d[(l * 32 + g) * 16 + (lane & 15)];
  float xr = 0.f, xi = 0.f;
  if (samp) {
    xr = p.s5re0[((size_t)(l * 16 + b) * 32 + g) * 64 + lane];
    xi = p.s5im0[((size_t)(l * 16 + b) * 32 + g) * 64 + lane];
  } else if (mode == 1 && lc > 0) {
    float pr = ar, pi = ai;
#pragma unroll
    for (int s = 0; s < 9; ++s) { const float nr = pr * pr - pi * pi, ni = 2.f * pr * pi; pr = nr; pi = ni; }
    const float* el = (const float*)(ws + OFF_ELOC);
    for (int c2 = 0; c2 < lc; ++c2) {
      const float er = ld_sc1_f(el + (((size_t)(b * 16 + c2) * 32 + g) * 64 + lane) * 2), ei = ld_sc1_f(el + (((size_t)(b * 16 + c2) * 32 + g) * 64 + lane) * 2 + 1);
      const float nr = pr * xr - pi * xi + er, ni = pr * xi + pi * xr + ei;
      xr = nr; xi = ni;
    }
  }
  u16* usm = (u16*)(smem + 52224 + w * 512);
  const u16* up = U + (size_t)(row_base + (lane & 15)) * 512 + g * 16 + (slab & 1) * 8;
  u32x4 ua = ld_sc1_16(up);
  for (int sub = 0; sub < nsub; ++sub) {
    const int r0 = row_base + sub * 16;
    u32x4 un = z4;
    if (sub + 1 < nsub) un = ld_sc1_16(up + (size_t)(sub + 1) * 16 * 512);
    if (slab >= 2) ua = z4;
    const bf16x8 Af = __builtin_bit_cast(bf16x8, ua);
    __syncthreads();
    if (mode == 1 && slab < 2) *(u32x4*)(usm + (lane & 15) * 16 + slab * 8) = ua;
    f32x4 a8[8];
#pragma unroll
    for (int nt = 0; nt < 8; ++nt) a8[nt] = MFMA16(Af, Bf[nt], ((f32x4){0.f, 0.f, 0.f, 0.f}));
    __builtin_amdgcn_sched_barrier(0);
    asm volatile("s_nop 15\n\ts_nop 15\n\ts_nop 15" ::: "memory");
    __builtin_amdgcn_sched_barrier(0);
#pragma unroll
    for (int nt = 0; nt < 8; ++nt) {
#pragma unroll
      for (int j = 0; j < 4; ++j) bu[(slab * 4 + j) * 132 + nt * 16 + (lane & 15)] = a8[nt][j];
    }
    __syncthreads();
#pragma unroll
    for (int tt = 0; tt < 16; ++tt) {
      const float br = bu[tt * 132 + lane], bi = bu[tt * 132 + 64 + lane];
      const float nr = ar * xr - ai * xi + br, ni = ar * xi + ai * xr + bi;
      xr = nr; xi = ni;
      if (mode == 1) { xs[tt * 144 + lane] = f2bf(xr); xs[tt * 144 + 64 + lane] = f2bf(xi); }
    }
    if (mode == 1) {
      __syncthreads();
      f32x4 y = (f32x4){0.f, 0.f, 0.f, 0.f};
#pragma unroll
      for (int ks = 0; ks < 4; ++ks) {
        const bf16x8 ax = *(const bf16x8*)(xs + (lane & 15) * 144 + ks * 32 + slab * 8);
        y = MFMA16(ax, Cf[ks], y);
      }
      __builtin_amdgcn_sched_barrier(0);
      asm volatile("s_nop 15\n\ts_nop 15" ::: "memory");
      __builtin_amdgcn_sched_barrier(0);
#pragma unroll
      for (int j = 0; j < 4; ++j) {
        const int rr = r0 + slab * 4 + j, cc = g * 16 + (lane & 15);
        const float u = bf2f(usm[(slab * 4 + j) * 16 + (lane & 15)]);
        Z[(size_t)rr * 512 + cc] = f2bf(geluf_(y[j] + Dh * u));
      }
    }
    ua = un;
  }
  if (mode == 0) {
    float* el = (float*)(ws + OFF_ELOC);
    el[(((size_t)(b * 16 + lc) * 32 + g) * 64 + lane) * 2] = xr;
    el[(((size_t)(b * 16 + lc) * 32 + g) * 64 + lane) * 2 + 1] = xi;
  } else if (samp) {
    p.out[O_S5RE_S + ((size_t)(l * 16 + b) * 32 + g) * 64 + lane] = xr;
    p.out[O_S5IM_S + ((size_t)(l * 16 + b) * 32 + g) * 64 + lane] = xi;
  } else if (lc == 15) {
    p.out[O_S5RE_P + ((size_t)(l * 4 + b) * 32 + g) * 64 + lane] = xr;
    p.out[O_S5IM_P + ((size_t)(l * 4 + b) * 32 + g) * 64 + lane] = xi;
  }
}

DI void glu_tile(const Params& p, int l, int t) {
  char* ws = p.ws;
  char* arena = ws + OFF_ARENA;
  const int rt = t >> 2, ct = t & 3, row0 = rt * 128, col0 = ct * 128;
  const u16* Zb = (const u16*)(arena + 6 * SLOT);
  const u16* A = Zb + (size_t)row0 * 512;
  const u16* B = (const u16*)(ws + OFF_W) + (size_t)l * W_LAYER + W_GLU + (size_t)col0 * 512;
  f32x4 acc[4][4];
  zero_acc(acc);
  u16* sA = (u16*)smem; u16* sB = sA + 128 * LDS_STRIDE;
  gemm_mainloop<128, 128, 2, 2>(A, 512, B, 512, 512, 1 << 30, acc, sA, sB, NoHook());
  const int lane = ltid() & 63, wid = ltid() >> 6, wm = wid >> 1, wn = wid & 1;
  u16* Z2 = (u16*)(arena + 0 * SLOT);
  float* zsq = (float*)(ws + OFF_ZSQ);
  const float* bg = p.b_glu + l * 512;
#pragma unroll
  for (int m = 0; m < 4; ++m) {
    float ss[4] = {0.f, 0.f, 0.f, 0.f};
    const int r = row0 + wm * 64 + m * 16 + (lane >> 4) * 4;
#pragma unroll
    for (int n = 0; n < 4; ++n) {
      const int c = col0 + wn * 64 + n * 16 + (lane & 15);
      const float bb = bg[c];
#pragma unroll
      for (int j = 0; j < 4; ++j) {
        const float z = bf2f(ld_sc1_2(Zb + (size_t)(r + j) * 512 + c));
        const float z2 = z * sigmoidf_(acc[m][n][j] + bb);
        ss[j] += z2 * z2;
        Z2[(size_t)(r + j) * 512 + c] = f2bf(z2);
      }
    }
#pragma unroll
    for (int j = 0; j < 4; ++j) {
      const float v = red16(ss[j]);
      if ((lane & 15) == 0) zsq[(size_t)(ct * 2 + wn) * NTOK + r + j] = v;
    }
  }
}

DI void store_raw_rsq(const f32x4 (&acc)[4][4], u16* raw, float* rsq, int row0, int col0, int ct) {
  const int lane = ltid() & 63, wid = ltid() >> 6, wm = wid >> 1, wn = wid & 1;
#pragma unroll
  for (int m = 0; m < 4; ++m) {
    const int r = row0 + wm * 64 + m * 16 + (lane >> 4) * 4;
#pragma unroll
    for (int n = 0; n < 4; ++n) {
      const int c = col0 + wn * 64 + n * 16 + (lane & 15);
#pragma unroll
      for (int j = 0; j < 4; ++j) raw[(size_t)(r + j) * 1024 + c] = f2bf(acc[m][n][j]);
    }
  }
}

DI void out_tile(const Params& p, int l, int t) {
  char* ws = p.ws;
  char* arena = ws + OFF_ARENA;
  const int rt = t >> 3, ct = t & 7, row0 = rt * 128, col0 = ct * 128;
  const u16* B = (const u16*)(ws + OFF_W) + (size_t)l * W_LAYER + W_OUT + (size_t)col0 * 1024;
  f32x4 acc[4][4];
  zero_acc(acc);
  u16* sA = (u16*)smem; u16* sB = sA + 128 * LDS_STRIDE;
  gemm_mainloop<128, 128, 2, 2>((const u16*)(arena + 0 * SLOT) + (size_t)row0 * 512, 512, B, 1024, 512, 1 << 30, acc, sA, sB, NoHook());
  const int lane = ltid() & 63, wid = ltid() >> 6, wm = wid >> 1;
  const float* zsq = (const float*)(ws + OFF_ZSQ);
#pragma unroll
  for (int m = 0; m < 4; ++m)
#pragma unroll
    for (int j = 0; j < 4; ++j) {
      const int r = row0 + wm * 64 + m * 16 + (lane >> 4) * 4 + j;
      float zs = 0.f;
#pragma unroll
      for (int q = 0; q < 8; ++q) zs += ld_sc1_f(zsq + (size_t)q * NTOK + r);
      const float rs = rsqrtf(zs * (1.0f / 512.0f) + EPSF);
#pragma unroll
      for (int n = 0; n < 4; ++n) acc[m][n][j] *= rs;
    }
  gemm_mainloop<128, 128, 2, 2>((const u16*)(arena + 7 * SLOT) + (size_t)row0 * 512, 512, B + 512, 1024, 512, 1 << 30, acc, sA, sB, NoHook());
  store_raw_rsq(acc, (u16*)(arena + 1 * SLOT), (float*)(ws + OFF_RSQ), row0, col0, ct);
}

DI void raw_tile(const Params& p, const u16* Abase, int lda, const u16* Bbase, int K, u16* raw, int t) {
  char* ws = p.ws;
  const int rt = t >> 3, ct = t & 7, row0 = rt * 128, col0 = ct * 128;
  f32x4 acc[4][4];
  zero_acc(acc);
  u16* sA = (u16*)smem; u16* sB = sA + 128 * LDS_STRIDE;
  gemm_mainloop<128, 128, 2, 2>(Abase + (size_t)row0 * lda, lda, Bbase + (size_t)col0 * K, K, K, 1 << 30, acc, sA, sB, NoHook());
  store_raw_rsq(acc, raw, (float*)(ws + OFF_RSQ), row0, col0, ct);
}

DI void post_task(const Params& p, const u16* raw, const float* gpost, int t, bool last) {
  char* ws = p.ws;
  const int lane = ltid() & 63;
  const int row = t * 4 + (ltid() >> 6);
  const u16* rw = raw + (size_t)row * 1024;
  u16* hb = (u16*)(ws + OFF_HB) + (size_t)row * 1024;
  float* xsp = (float*)(ws + OFF_RSQ) + row;
  const float xscale = ld_sc1_f(xsp);
  float4 rv[4];
  float s = 0.f;
#pragma unroll
  for (int i = 0; i < 4; ++i) {
    const int c = i * 256 + lane * 4;
    const u32x2 r2 = ld_sc1_8(rw + c);
    rv[i].x = bf2f((u16)(r2.x & 0xffff)); rv[i].y = bf2f((u16)(r2.x >> 16));
    rv[i].z = bf2f((u16)(r2.y & 0xffff)); rv[i].w = bf2f((u16)(r2.y >> 16));
    s += rv[i].x * rv[i].x + rv[i].y * rv[i].y + rv[i].z * rv[i].z + rv[i].w * rv[i].w;
  }
  s = red64(s);
  const float rr = rsqrtf(s * (1.0f / 1024.0f) + EPSF);
  float4 v[4];
  float ss = 0.f;
#pragma unroll
  for (int i = 0; i < 4; ++i) {
    const int c = i * 256 + lane * 4;
    const u32x2 h2 = ld_sc1_8(hb + c);
    const float4 g = *(const float4*)(gpost + c);
    v[i].x = bf2f((u16)(h2.x & 0xffff)) * xscale + rv[i].x * rr * g.x;
    v[i].y = bf2f((u16)(h2.x >> 16)) * xscale + rv[i].y * rr * g.y;
    v[i].z = bf2f((u16)(h2.y & 0xffff)) * xscale + rv[i].z * rr * g.z;
    v[i].w = bf2f((u16)(h2.y >> 16)) * xscale + rv[i].w * rr * g.w;
    ss += v[i].x * v[i].x + v[i].y * v[i].y + v[i].z * v[i].z + v[i].w * v[i].w;
  }
  ss = red64(ss);
  const float r = rsqrtf(ss * (1.0f / 1024.0f) + EPSF);
  if (lane == 0) *xsp = 1.0f / r;
  float* y = p.out + O_Y + (size_t)row * 1024;
#pragma unroll
  for (int i = 0; i < 4; ++i) {
    const int c = i * 256 + lane * 4;
    if (last) *(float4*)(y + c) = v[i];
    u32x2 o; o.x = pack2(v[i].x * r, v[i].y * r); o.y = pack2(v[i].z * r, v[i].w * r);
    *(u32x2*)(hb + c) = o;
  }
}

DI void cq_tile(const Params& p, int l, int t) {
  char* ws = p.ws;
  char* arena = ws + OFF_ARENA;
  const int rt = t >> 3, ct = t & 7, row0 = rt * 128, col0 = ct * 128;
  f32x4 acc[4][4];
  zero_acc(acc);
  u16* sA = (u16*)smem; u16* sB = sA + 128 * LDS_STRIDE;
  gemm_mainloop<128, 128, 2, 2>((const u16*)(ws + OFF_HB) + (size_t)row0 * 1024, 1024,
                                (const u16*)(ws + OFF_W) + (size_t)l * W_LAYER + W_CQ + (size_t)col0 * 1024, 1024, 1024, 1 << 30, acc, sA, sB, NoHook());
  const int lane = ltid() & 63, wid = ltid() >> 6, wm = wid >> 1, wn = wid & 1;
  u16* qx = (u16*)(arena + 3 * SLOT);
#pragma unroll
  for (int m = 0; m < 4; ++m)
#pragma unroll
    for (int n = 0; n < 4; ++n) {
      const int r = row0 + wm * 64 + m * 16 + (lane >> 4) * 4, c = col0 + wn * 64 + n * 16 + (lane & 15);
#pragma unroll
      for (int j = 0; j < 4; ++j) qx[(size_t)(r + j) * 1024 + c] = f2bf(acc[m][n][j]);
    }
}

DI void att_task(const Params& p, int l, int t) {
  char* ws = p.ws;
  char* arena = ws + OFF_ARENA;
  const int tid = ltid(), lane = tid & 63, w = tid >> 6;
  int row0, h, nvalid;
  const u16 *KX, *VTX;
  if (t < 2048) {
    const int rt = t >> 2; h = t & 3; row0 = rt * 64; nvalid = 64;
    const int b = row0 >> 13;
    KX = (const u16*)(ws + OFF_KXP) + ((size_t)(l * 4 + b)) * 256 * 1024 + h * 256;
    VTX = (const u16*)(ws + OFF_VTXP) + ((size_t)((l * 4 + b) * 4 + h)) * 65536;
  } else {
    const int q = t - 2048, b = q >> 2; h = q & 3; row0 = PROWS + b * 16; nvalid = 16;
    KX = (const u16*)(ws + OFF_KXS) + (size_t)b * 256 * 1024 + h * 256;
    VTX = (const u16*)(ws + OFF_VTXS) + ((size_t)(b * 4 + h)) * 65536;
  }
  const u16* QX = (const u16*)(arena + 3 * SLOT);
  u16* OX = (u16*)(arena + 5 * SLOT);
#ifdef EXP_ATT_COPY
  for (int e = tid; e < nvalid * 256; e += NTHR) { const int r = e >> 8, c = e & 255; OX[(size_t)(row0 + r) * 1024 + h * 256 + c] = QX[(size_t)(row0 + r) * 1024 + h * 256 + c]; }
  return;
#endif
  const int arow0 = (row0 + 64 <= NTOK) ? row0 : (NTOK - 64);
  const int shift = row0 - arow0;
  u16* sA = (u16*)smem;
  u16* sB = (u16*)(smem + 34816);
  f32x4 acc[1][16];
  zero_acc(acc);
  gemm_mainloop<64, 256, 4, 1>(QX + (size_t)arow0 * 1024 + h * 256, 1024, KX, 1024, 256, 1 << 30, acc, sA, sB, NoHook());
  float inv[4];
#pragma unroll
  for (int j = 0; j < 4; ++j) {
    float mx = -3.0e38f;
#pragma unroll
    for (int n = 0; n < 16; ++n) mx = fmaxf(mx, acc[0][n][j]);
    mx = max16(mx);
    float s = 0.f;
#pragma unroll
    for (int n = 0; n < 16; ++n) { const float e = __expf(acc[0][n][j] - mx); acc[0][n][j] = e; s += e; }
    s = red16(s);
    inv[j] = 1.0f / s;
  }
  __syncthreads();
  u16* sP = (u16*)smem;
#pragma unroll
  for (int n = 0; n < 16; ++n)
#pragma unroll
    for (int j = 0; j < 4; ++j) sP[(w * 16 + (lane >> 4) * 4 + j) * 272 + n * 16 + (lane & 15)] = f2bf(acc[0][n][j] * inv[j]);
  zero_acc(acc);
  gemm_mainloop_alds<64, 256, 4, 1>(sP, 272, VTX, 256, 256, acc, sB);
#pragma unroll
  for (int n = 0; n < 16; ++n)
#pragma unroll
    for (int j = 0; j < 4; ++j) {
      const int rl = w * 16 + (lane >> 4) * 4 + j - shift;
      if (rl >= 0 && rl < nvalid) OX[(size_t)(row0 + rl) * 1024 + h * 256 + n * 16 + (lane & 15)] = f2bf(acc[0][n][j]);
    }
}

DI void gu_tile(const Params& p, int l, int t) {
  char* ws = p.ws;
  char* arena = ws + OFF_ARENA;
  const int rt = t / 44, ct = t % 44, row0 = rt * 128, col0 = ct * 128;
  f32x4 acc[4][4];
  zero_acc(acc);
  u16* sA = (u16*)smem; u16* sB = sA + 128 * LDS_STRIDE;
  gemm_mainloop<128, 128, 2, 2>((const u16*)(ws + OFF_HB) + (size_t)row0 * 1024, 1024,
                                (const u16*)(ws + OFF_W) + (size_t)l * W_LAYER + W_GU + (size_t)col0 * 1024, 1024, 1024, 1 << 30, acc, sA, sB, NoHook());
  const int lane = ltid() & 63, wid = ltid() >> 6, wm = wid >> 1, wn = wid & 1;
  u16* act = (u16*)(arena + 2 * SLOT);
#pragma unroll
  for (int m = 0; m < 4; ++m)
#pragma unroll
    for (int np = 0; np < 2; ++np) {
      const int r = row0 + wm * 64 + m * 16 + (lane >> 4) * 4;
      const int c = ((col0 + wn * 64) >> 5) * 16 + np * 16 + (lane & 15);
#pragma unroll
      for (int j = 0; j < 4; ++j) act[(size_t)(r + j) * DFF + c] = f2bf(siluf_(acc[m][2 * np][j]) * acc[m][2 * np + 1][j]);
    }
}

DI void dbg_dump(const Params& p) {
#ifdef DUMP_SLOT
  const u16* src = (const u16*)(p.ws + OFF_ARENA + (size_t)DUMP_SLOT * SLOT);
  float* dst = p.out + O_Y;
  for (size_t i = (size_t)blockIdx.x * NTHR + threadIdx.x; i < (size_t)NTOK * 1024; i += (size_t)gridDim.x * NTHR) dst[i] = bf2f(src[i]);
#endif
#ifdef DUMP_HB
  const u16* src = (const u16*)(p.ws + OFF_HB);
  float* dst = p.out + O_Y;
  for (size_t i = (size_t)blockIdx.x * NTHR + threadIdx.x; i < (size_t)NTOK * 1024; i += (size_t)gridDim.x * NTHR) dst[i] = bf2f(src[i]);
#endif
}
#define PH_BEGIN { const int myph = ph++; const bool act_ = (myph >= p.ph_lo && myph < p.ph_hi); if (act_) { unsigned* c = &ctr[myph]; (void)c; phase_begin();
#define PH_END } if (act_ && myph + 1 < p.ph_hi) grid_barrier(bar); }

__global__ void __launch_bounds__(NTHR, 2) fwd_megakernel(Params p) {
  unsigned* bar = (unsigned*)(p.ws + OFF_BAR);
  unsigned* ctr = (unsigned*)(p.ws + OFF_CTR);
  if (threadIdx.x == 0) { g_xb[0] = 0u; g_xb[1] = 0u; g_xb[2] = 0u; g_xb[3] = 0u; }
  __syncthreads();
  if (USE_XCD_BARRIER) { if (threadIdx.x == 0) (void)xb_add(&bar[XB_XCNT(xb_xcc_id())], 1u); }
  if (p.never) cg::this_grid().sync();
  int ph = 0;
  char* ws = p.ws;
  char* arena = ws + OFF_ARENA;
#ifdef DUMP_AFTER
  if (p.ph_lo < 0) {
    const u16* src = (const u16*)(ws + DUMP_OFF);
    for (size_t j = (size_t)blockIdx.x * NTHR + threadIdx.x; j < (size_t)1048576; j += (size_t)gridDim.x * NTHR) {
      float acc = 0.f;
      size_t idx = (j * 131u) % DUMP_N;
      for (int k = 0; k < 512; ++k) {
        const float e = bf2f((u16)(src[idx] & 0xBFFF));
        acc = acc * 0.75f + e * (1.0f + 0.001f * (float)(k & 15));
        idx += 65537u; if (idx >= DUMP_N) idx -= DUMP_N;
      }
      float v = acc;
      for (int k = 0; k < 200; ++k) { v = bf2f(f2bf(v * 1.37f + 0.11f)); if (fabsf(v) > 4.f) v *= 0.125f; }
      p.out[O_Y + j] = v;
    }
    return;
  }
#endif
#ifdef EXP_CHAOS
  if (p.ph_lo == 0) {
    for (size_t i = (size_t)blockIdx.x * NTHR + threadIdx.x; i < (size_t)NTOK * 1024; i += (size_t)gridDim.x * NTHR) {
      float v = (i < (size_t)PROWS * 1024) ? p.x_prompt[i] : p.x_sample[i - (size_t)PROWS * 1024];
      float w = p.w_in[i % (4u * 1024u * 2560u)];
      for (int k = 0; k < 200; ++k) { v = bf2f(f2bf(v * 1.37f + w)); if (fabsf(v) > 4.f) v *= 0.125f; }
      p.out[O_Y + i] = v;
    }
  }
  return;
#endif

  PH_BEGIN
    phase_prep(p, c);
  PH_END

  for (int l_ = 0; l_ < DEPTHC; ++l_) {
    const int l = lsgpr(l_);
    const u16* wl = (const u16*)(ws + OFF_W) + (size_t)l * W_LAYER;
    PH_BEGIN
      const int n_g1 = 258 * 20, n_mk = (l == 0) ? 512 : 0, n_cc = 2048;
      for (;;) {
        int t = next_task(c);
        if (t >= n_g1 + n_mk + n_cc) break;
        if (t < n_g1) g1_tile(p, l, t);
        else if (t < n_g1 + n_mk) memkv_tile(p, t - n_g1);
        else cache_task(p, l, t - n_g1 - n_mk);
      }
    PH_END
    PH_BEGIN
      for (;;) {
        int t = next_task(c);
        if (t >= 256 + 512) break;
        if (t < 256) ret_local_task(p, t);
        else s5_task(p, l, t - 256, 0);
      }
    PH_END
    PH_BEGIN
      for (;;) {
        int t = next_task(c);
        if (t >= 320 + 640) break;
        if (t < 320) ret_final_task(p, l, t);
        else s5_task(p, l, t - 320, 1);
      }
    PH_END
    PH_BEGIN
      TASK_LOOP(c, 258 * 4, glu_tile(p, l, t))
    PH_END
    PH_BEGIN
      TASK_LOOP(c, 258 * 8, out_tile(p, l, t))
    PH_END
    PH_BEGIN
      TASK_LOOP(c, NTOK / 4, post_task(p, (const u16*)(arena + 1 * SLOT), p.mix_post + l * 1024, t, false))
    PH_END
    PH_BEGIN
      TASK_LOOP(c, 258 * 8, cq_tile(p, l, t))
    PH_END
    PH_BEGIN
      TASK_LOOP(c, 2112, att_task(p, l, t))
    PH_END
    PH_BEGIN
      TASK_LOOP(c, 258 * 8, raw_tile(p, (const u16*)(arena + 5 * SLOT), 1024, wl + W_CO, 1024, (u16*)(arena + 1 * SLOT), t))
    PH_END
    PH_BEGIN
      TASK_LOOP(c, NTOK / 4, post_task(p, (const u16*)(arena + 1 * SLOT), p.xa_post + l * 1024, t, false))
    PH_END
    PH_BEGIN
      TASK_LOOP(c, 258 * 44, gu_tile(p, l, t))
    PH_END
    PH_BEGIN
      TASK_LOOP(c, 258 * 8, raw_tile(p, (const u16*)(arena + 2 * SLOT), DFF, wl + W_DN, DFF, (u16*)(arena + 0 * SLOT), t))
    PH_END
    PH_BEGIN
      TASK_LOOP(c, NTOK / 4, post_task(p, (const u16*)(arena + 0 * SLOT), p.ffn_post + l * 1024, t, l == DEPTHC - 1))
    PH_END
  }
}

#ifndef N_LAUNCH_SPLIT
#define N_LAUNCH_SPLIT 0
#endif
constexpr int N_PHASES = 1 + 13 * DEPTHC;

extern "C" void kernel_launch(void* const* d_in, const int* in_sizes, int n_in, void* d_out, int out_size, void* d_ws,
                              size_t ws_size, hipStream_t stream) {
  static int grid_blocks = 0;
  if (!grid_blocks) {
    int dev = 0, cus = 0, per_cu = 0;
    (void)hipGetDevice(&dev);
    (void)hipDeviceGetAttribute(&cus, hipDeviceAttributeMultiprocessorCount, dev);
    (void)hipOccupancyMaxActiveBlocksPerMultiprocessor(&per_cu, fwd_megakernel, NTHR, 0);
    if (per_cu > 2) per_cu = 2;
    if (per_cu < 1) per_cu = 1;
    grid_blocks = cus * per_cu;
  }
  if (ws_size < WS_NEEDED) fprintf(stderr, "workspace too small: %zu < %zu\n", ws_size, (size_t)WS_NEEDED);
  Params p{};
  const float** f = (const float**)&p;
  for (int i = 0; i < 36; ++i) f[i] = (const float*)d_in[i];
  p.out = (float*)d_out;
  p.ws = (char*)d_ws;
  p.never = 0;
  p.ph_lo = 0;
  p.ph_hi = N_PHASES;
  p.pad = 0;
  (void)hipMemsetAsync(d_ws, 0, 32768, stream);
  if (N_LAUNCH_SPLIT) {
#ifdef DUMP_AFTER
    const int nrun = DUMP_AFTER;
#else
    const int nrun = N_PHASES;
#endif
    for (int i = 0; i <= nrun; ++i) {
      if (i == nrun) {
#ifdef DUMP_AFTER
        p.ph_lo = -1; p.ph_hi = -1;
#else
        break;
#endif
      } else { p.ph_lo = i; p.ph_hi = i + 1; }
      void* args[] = {&p};
      hipError_t e = hipLaunchCooperativeKernel((void*)fwd_megakernel, dim3(grid_blocks), dim3(NTHR), args, 0, stream);
      if (e != hipSuccess) fprintf(stderr, "launch failed: %s (grid %d)\n", hipGetErrorString(e), grid_blocks);
    }
  } else {
    void* args[] = {&p};
    hipError_t e = hipLaunchCooperativeKernel((void*)fwd_megakernel, dim3(grid_blocks), dim3(NTHR), args, 0, stream);
    if (e != hipSuccess) fprintf(stderr, "cooperative launch failed: %s (grid %d)\n", hipGetErrorString(e), grid_blocks);
  }
}
```

```cpp
#include <hip/hip_runtime.h>
#include <hip/hip_bf16.h>
#include <hip/hip_cooperative_groups.h>
#include <stdint.h>
#include <stdio.h>
namespace cg = cooperative_groups;

typedef __attribute__((ext_vector_type(8))) short bf16x8;
typedef __attribute__((ext_vector_type(4))) float f32x4;
typedef unsigned short u16;
typedef __attribute__((ext_vector_type(4))) unsigned u32x4;
typedef __attribute__((ext_vector_type(2))) unsigned u32x2;
#define DI __device__ __forceinline__
#define MFMA16(a, b, c) __builtin_amdgcn_mfma_f32_16x16x32_bf16((a), (b), (c), 0, 0, 0)
#define MFMA_FENCE() do { __builtin_amdgcn_sched_barrier(0); asm volatile("s_nop 15\n\ts_nop 15" ::: "memory"); __builtin_amdgcn_sched_barrier(0); } while (0)

constexpr int NTOK = 33024, PROWS = 32768, DM = 1024, DFF = 2816, DEPTHC = 4;
constexpr int SEQ = 8192;
constexpr float EPSF = 1e-6f;
constexpr int NTHR = 256;
constexpr int LDS_STRIDE = 80;
constexpr int SMEM_BYTES = 76800;

constexpr size_t SLOT = (size_t)NTOK * 512 * 2;
constexpr size_t OFF_BAR = 0;
constexpr size_t OFF_CTR = 16384;
constexpr size_t OFF_W = 32768;
constexpr size_t W_IN = 0, W_GLU = W_IN + 2560 * 1024, W_OUT = W_GLU + 512 * 512, W_CQ = W_OUT + 1024 * 1024,
                 W_CK = W_CQ + 1024 * 1024, W_CV = W_CK + 1024 * 1024, W_CO = W_CV + 1024 * 1024,
                 W_GU = W_CO + 1024 * 1024, W_DN = W_GU + 5632 * 1024, W_LAYER = W_DN + 1024 * 2816;
constexpr size_t OFF_S5P = OFF_W + 4 * W_LAYER * 2;
constexpr size_t S5P_BBT = 0, S5P_CM = 131072, S5P_ABAR = 262144, S5P_LAYER = 278528;
constexpr size_t OFF_HB = OFF_S5P + 4 * S5P_LAYER;
constexpr size_t OFF_MEMB = OFF_HB + (size_t)NTOK * 1024 * 2;
constexpr size_t OFF_KXP = OFF_MEMB + 1024 * 1024 * 2;
constexpr size_t OFF_VTXP = OFF_KXP + 4 * 4 * 256 * 1024 * 2;
constexpr size_t OFF_KXS = OFF_VTXP + 4 * 4 * 256 * 1024 * 2;
constexpr size_t OFF_VTXS = OFF_KXS + 16 * 256 * 1024 * 2;
constexpr size_t OFF_SLOC = OFF_VTXS + 16 * 256 * 1024 * 2;
constexpr size_t OFF_ELOC = OFF_SLOC + 16 * 16 * 128 * 128 * 4;
constexpr size_t OFF_ZSQ = OFF_ELOC + 4 * 16 * 32 * 64 * 2 * 4;
constexpr size_t OFF_RSQ = OFF_ZSQ + (size_t)NTOK * 8 * 4;
constexpr size_t OFF_ARENA = OFF_RSQ + (size_t)NTOK * 16 * 4;
constexpr size_t WS_NEEDED = OFF_ARENA + 8 * SLOT;

constexpr size_t O_Y = 0, O_S5RE_P = 33816576, O_S5IM_P = 33849344, O_RET_P = 33882112, O_MK_P = 34930688,
                 O_MV_P = 39124992, O_S5RE_S = 43319296, O_S5IM_S = 43450368, O_RET_S = 43581440;

struct Params {
  const float *x_prompt, *x_sample, *mem_prompt, *s5re0, *s5im0, *ret0, *cmk, *cmv;
  const float *mix_pre, *mix_post, *w_in, *lam_re, *lam_im, *log_step, *b_re, *b_im, *c_re, *c_im, *s5_d, *w_glu,
      *b_glu, *s5_onorm, *ret_onorm, *w_out, *xa_pre, *xa_post, *mem_norm, *w_cq, *w_ck, *w_cv, *w_co, *ffn_pre,
      *ffn_post, *w_gate, *w_up, *w_down;
  float* out;
  char* ws;
  int never;
  int ph_lo;
  int ph_hi;
  int pad;
};

DI u16 f2bf(float f) {
  unsigned u = __float_as_uint(f);
  u += 0x7fffu + ((u >> 16) & 1u);
  return (u16)(u >> 16);
}
DI float bf2f(u16 h) { return __uint_as_float(((unsigned)h) << 16); }
DI unsigned pack2(float a, float b) { return (unsigned)f2bf(a) | ((unsigned)f2bf(b) << 16); }
DI float sigmoidf_(float x) { return 1.0f / (1.0f + __expf(-x)); }
DI float siluf_(float x) { return x * sigmoidf_(x); }
DI float geluf_(float x) {
  float t = 0.7978845608028654f * (x + 0.044715f * x * x * x);
  return 0.5f * x * (1.0f + tanhf(t));
}
DI float red16(float v) {
  v += __shfl_xor(v, 1); v += __shfl_xor(v, 2); v += __shfl_xor(v, 4); v += __shfl_xor(v, 8);
  return v;
}
DI float max16(float v) {
  v = fmaxf(v, __shfl_xor(v, 1)); v = fmaxf(v, __shfl_xor(v, 2)); v = fmaxf(v, __shfl_xor(v, 4)); v = fmaxf(v, __shfl_xor(v, 8));
  return v;
}
DI float red64(float v) {
  v = red16(v); v += __shfl_xor(v, 16); v += __shfl_xor(v, 32);
  return v;
}
DI void sincos_cw(float x, float* sn, float* cs) {
  const float k = rintf(x * 0.15915494309189535f);
  float r = fmaf(-k, 6.2831854820251465f, x);
  r = fmaf(-k, -1.7484555e-07f, r);
  *sn = __sinf(r); *cs = __cosf(r);
}
DI int ltid() { int x = threadIdx.x; asm volatile("" : "+v"(x)); return x; }
DI int lsgpr(int x) { asm volatile("" : "+s"(x)); return x; }
DI u32x4 ld_sc1_16(const void* p) {
  const unsigned long long* q = (const unsigned long long*)p;
  const unsigned long long a = __hip_atomic_load(q, __ATOMIC_RELAXED, __HIP_MEMORY_SCOPE_AGENT);
  const unsigned long long b = __hip_atomic_load(q + 1, __ATOMIC_RELAXED, __HIP_MEMORY_SCOPE_AGENT);
  return (u32x4){(unsigned)a, (unsigned)(a >> 32), (unsigned)b, (unsigned)(b >> 32)};
}
DI __amdgpu_buffer_rsrc_t mk_rsrc(const void* p) {
  const unsigned long long a = (unsigned long long)p;
  const unsigned lo = __builtin_amdgcn_readfirstlane((unsigned)a), hi = __builtin_amdgcn_readfirstlane((unsigned)(a >> 32));
  return __builtin_amdgcn_make_buffer_rsrc((void*)(((unsigned long long)hi << 32) | lo), 0, 0x7fffffff, 0x00020000);
}
DI u32x4 bld16(__amdgpu_buffer_rsrc_t r, unsigned voff, unsigned soff) { return __builtin_amdgcn_raw_buffer_load_b128(r, voff, soff, 16); }
DI u32x2 ld_sc1_8(const void* p) {
  const unsigned long long a = __hip_atomic_load((const unsigned long long*)p, __ATOMIC_RELAXED, __HIP_MEMORY_SCOPE_AGENT);
  return (u32x2){(unsigned)a, (unsigned)(a >> 32)};
}
DI u16 ld_sc1_2(const u16* p) { return __hip_atomic_load(p, __ATOMIC_RELAXED, __HIP_MEMORY_SCOPE_AGENT); }
DI float ld_sc1_f(const float* p) { return __hip_atomic_load(p, __ATOMIC_RELAXED, __HIP_MEMORY_SCOPE_AGENT); }
DI float gamma_l2(int h) { return log2f(1.0f - exp2f(-5.0f - (float)h)); }

#define XB_TMO 128
#define XB_XCNT(j) (256 + 64 * (j))
#define XB_XSUB(j) (1280 + 64 * (j))
#define XB_XGEN(j) (2304 + 64 * (j))
#define XB_TOP 3328
#define XB_TOPGEN 3392
#define XB_SPIN_CAP (1u << 26)
DI unsigned xb_ld(unsigned* p) { return __hip_atomic_load(p, __ATOMIC_RELAXED, __HIP_MEMORY_SCOPE_AGENT); }
DI unsigned xb_add(unsigned* p, unsigned v) { return __hip_atomic_fetch_add(p, v, __ATOMIC_RELAXED, __HIP_MEMORY_SCOPE_AGENT); }
DI unsigned xb_xcc_id() { return (unsigned)__builtin_amdgcn_s_getreg((3 << 11) | 20) & 0xFu; }
#define XB_SPIN(cond, bar) do { unsigned _sp = 0; while (cond) { __builtin_amdgcn_s_sleep(1); \
    if ((++_sp & 255u) == 0u) { if (xb_ld(&(bar)[XB_TMO])) break; if (_sp > XB_SPIN_CAP) { atomicAdd(&(bar)[XB_TMO], 1u); break; } } } } while (0)

__shared__ unsigned g_xb[4];
__shared__ __attribute__((aligned(16))) char smem[SMEM_BYTES];

DI void xcd_complete(unsigned* bar, unsigned x, unsigned& nloc, unsigned& nx) {
  const unsigned G = gridDim.x;
  unsigned sum, cnt, mine, sp = 0u;
  for (;;) {
    sum = 0u; cnt = 0u; mine = 0u;
#pragma unroll
    for (unsigned j = 0; j < 16; ++j) { const unsigned c = xb_ld(&bar[XB_XCNT(j)]); sum += c; cnt += (c > 0u) ? 1u : 0u; mine = (j == x) ? c : mine; }
    if (sum == G) break;
    __builtin_amdgcn_s_sleep(1);
    if ((++sp & 255u) == 0u) { if (xb_ld(&bar[XB_TMO])) break; if (sp > XB_SPIN_CAP) { atomicAdd(&bar[XB_TMO], 1u); break; } }
  }
  nloc = mine > 0u ? mine : 1u; nx = cnt > 0u ? cnt : 1u;
}
#ifndef USE_XCD_BARRIER
#define USE_XCD_BARRIER 1
#endif
DI void grid_barrier(unsigned* bar) {
  if (!USE_XCD_BARRIER) {
    asm volatile("s_waitcnt vmcnt(0)" ::: "memory");
    __syncthreads();
    if (threadIdx.x == 0) asm volatile("buffer_wbl2 sc0 sc1\n\ts_waitcnt vmcnt(0)" ::: "memory");
    cg::this_grid().sync();
    if (threadIdx.x == 0) asm volatile("buffer_inv sc0 sc1\n\ts_waitcnt vmcnt(0)" ::: "memory");
    __syncthreads();
    return;
  }
  asm volatile("s_waitcnt vmcnt(0)" ::: "memory");
  __syncthreads();
  if (threadIdx.x == 0) {
    __builtin_amdgcn_s_waitcnt(0);
    const unsigned xcc = xb_xcc_id();
    unsigned nloc = g_xb[0], nx = g_xb[1];
    if (nloc == 0u) { xcd_complete(bar, xcc, nloc, nx); g_xb[0] = nloc; g_xb[1] = nx; }
    const unsigned old = xb_add(&bar[XB_XSUB(xcc)], 1u);
    const unsigned gen = old / nloc;
    if (old + 1u == (gen + 1u) * nloc) {
      __builtin_amdgcn_fence(__ATOMIC_RELEASE, "agent");
      asm volatile("s_waitcnt vmcnt(0)" ::: "memory");
      const unsigned og = xb_add(&bar[XB_TOP], 1u);
      const unsigned tg = og / nx;
      if (og + 1u == (tg + 1u) * nx) xb_add(&bar[XB_TOPGEN], 1u);
      else XB_SPIN(xb_ld(&bar[XB_TOPGEN]) == tg, bar);
      __builtin_amdgcn_fence(__ATOMIC_ACQUIRE, "agent");
      xb_add(&bar[XB_XGEN(xcc)], 1u);
      asm volatile("s_waitcnt vmcnt(0)" ::: "memory");
    } else {
      XB_SPIN(xb_ld(&bar[XB_XGEN(xcc)]) == gen, bar);
      __builtin_amdgcn_fence(__ATOMIC_ACQUIRE, "agent");
      asm volatile("s_waitcnt vmcnt(0)" ::: "memory");
    }
  }
  __syncthreads();
}

#define DUMP_OFF (OFF_ELOC)
#define DUMP_N ((size_t)524288)
#define DUMP_F32 0
#ifndef MAXPH
#define MAXPH 10
#endif
#ifndef STATIC_SCHED
#define STATIC_SCHED 0
#endif
#ifndef ONE_XCD
#define ONE_XCD 0
#endif
DI int next_task(unsigned* ctr) {
  __syncthreads();
#ifdef LDS_NAN_PER_TASK
  __syncthreads();
#endif
  if (ONE_XCD) {
    if (threadIdx.x == 0) g_xb[2] = (xb_xcc_id() == 0u) ? atomicAdd(ctr, 1u) : 0x7fffffffu;
    __syncthreads();
    return (int)g_xb[2];
  }
  if (STATIC_SCHED) {
    if (threadIdx.x == 0) { unsigned it = g_xb[3]; g_xb[3] = it + 1u; g_xb[2] = blockIdx.x + it * gridDim.x; }
  } else {
    if (threadIdx.x == 0) g_xb[2] = atomicAdd(ctr, 1u);
  }
  __syncthreads();
  return (int)g_xb[2];
}
DI unsigned task_prefetch(unsigned* ctr) { unsigned v = 0u; if (threadIdx.x == 0) v = atomicAdd(ctr, 1u); return v; }
DI int task_commit(unsigned v) {
  __syncthreads();
  if (threadIdx.x == 0) g_xb[2] = v;
  __syncthreads();
  return (int)g_xb[2];
}
#define TASK_LOOP(ctr, N, BODY) { int t = next_task(ctr); while (t < (N)) { const unsigned tn_ = task_prefetch(ctr); BODY; t = task_commit(tn_); } }
DI void phase_begin() { __syncthreads(); if (threadIdx.x == 0) g_xb[3] = 0u; __syncthreads(); }

template <int BM, int BN, int WGM, int WGN, class Hook>
DI void gemm_mainloop(const u16* A, int lda, const u16* B, int ldb, int K, int kvalid,
                      f32x4 (&acc)[BM / WGM / 16][BN / WGN / 16], u16* sA, u16* sB, Hook hook) {
  constexpr int MT = BM / WGM / 16, NTL = BN / WGN / 16, CA = BM / 32, CB = BN / 32;
  const int tid = ltid(), lane = tid & 63, wid = tid >> 6, wm = wid / WGN, wn = wid % WGN;
  const __amdgpu_buffer_rsrc_t ra_ = mk_rsrc(A), rb_ = mk_rsrc(B);
  u32x4 ra0[CA], rb0[CB], ra1[CA], rb1[CB];
  unsigned va[CA], vb[CB];
  const u32x4 z4 = (u32x4){0u, 0u, 0u, 0u};
  const int cc0 = (tid & 7) * 8;
#pragma unroll
  for (int i = 0; i < CA; ++i) { const int r = (tid + i * NTHR) >> 3; va[i] = (unsigned)(r * lda + cc0) * 2u; }
#pragma unroll
  for (int i = 0; i < CB; ++i) { const int r = (tid + i * NTHR) >> 3; vb[i] = (unsigned)(r * ldb + cc0) * 2u; }
#define GM_LOAD(RA, RB, kn)                                                                          \
  {                                                                                                  \
    const bool kok = ((kn) + cc0) < kvalid;                                                          \
    _Pragma("unroll") for (int i = 0; i < CA; ++i) RA[i] = kok ? bld16(ra_, va[i], (unsigned)(kn) * 2u) : z4; \
    _Pragma("unroll") for (int i = 0; i < CB; ++i) RB[i] = kok ? bld16(rb_, vb[i], (unsigned)(kn) * 2u) : z4; \
  }
#define GM_STEP(RA, RB, kcur)                                                                        \
  {                                                                                                  \
    __syncthreads();                                                                                 \
    _Pragma("unroll") for (int i = 0; i < CA; ++i) { const int r = (tid + i * NTHR) >> 3; *(u32x4*)(sA + r * LDS_STRIDE + cc0) = RA[i]; } \
    _Pragma("unroll") for (int i = 0; i < CB; ++i) { const int r = (tid + i * NTHR) >> 3; *(u32x4*)(sB + r * LDS_STRIDE + cc0) = RB[i]; } \
    __syncthreads();                                                                                 \
    if ((kcur) + 128 < K) GM_LOAD(RA, RB, (kcur) + 128)                                              \
    _Pragma("unroll") for (int kk = 0; kk < 2; ++kk) {                                               \
      bf16x8 af[MT], bfr[NTL];                                                                       \
      _Pragma("unroll") for (int m = 0; m < MT; ++m) af[m] = *(const bf16x8*)(sA + (wm * (BM / WGM) + m * 16 + (lane & 15)) * LDS_STRIDE + kk * 32 + (lane >> 4) * 8); \
      _Pragma("unroll") for (int n = 0; n < NTL; ++n) bfr[n] = *(const bf16x8*)(sB + (wn * (BN / WGN) + n * 16 + (lane & 15)) * LDS_STRIDE + kk * 32 + (lane >> 4) * 8); \
      _Pragma("unroll") for (int m = 0; m < MT; ++m)                                                 \
        _Pragma("unroll") for (int n = 0; n < NTL; ++n) acc[m][n] = MFMA16(af[m], bfr[n], acc[m][n]); \
    }                                                                                                \
    hook((kcur), acc);                                                                               \
  }
  GM_LOAD(ra0, rb0, 0)
  if (64 < K) GM_LOAD(ra1, rb1, 64)
#pragma unroll 1
  for (int k0 = 0; k0 < K; k0 += 128) {
    GM_STEP(ra0, rb0, k0)
    GM_STEP(ra1, rb1, k0 + 64)
  }
  MFMA_FENCE();
#undef GM_LOAD
#undef GM_STEP
}
struct NoHook { template <class T> DI void operator()(int, T&) const {} };

template <int BM, int BN, int WGM, int WGN>
DI void gemm_mainloop_alds(const u16* sAimg, int lda_s, const u16* B, int ldb, int K,
                           f32x4 (&acc)[BM / WGM / 16][BN / WGN / 16], u16* sB) {
  constexpr int MT = BM / WGM / 16, NTL = BN / WGN / 16, CB = BN / 32;
  const int tid = ltid(), lane = tid & 63, wid = tid >> 6, wm = wid / WGN, wn = wid % WGN;
  const __amdgpu_buffer_rsrc_t rb_ = mk_rsrc(B);
  u32x4 rb0[CB], rb1[CB];
  unsigned vb[CB];
  const int cc0 = (tid & 7) * 8;
#pragma unroll
  for (int i = 0; i < CB; ++i) { const int r = (tid + i * NTHR) >> 3; vb[i] = (unsigned)(r * ldb + cc0) * 2u; }
#define GA_STEP(RB, kcur)                                                                            \
  {                                                                                                  \
    __syncthreads();                                                                                 \
    _Pragma("unroll") for (int i = 0; i < CB; ++i) { const int r = (tid + i * NTHR) >> 3; *(u32x4*)(sB + r * LDS_STRIDE + cc0) = RB[i]; } \
    __syncthreads();                                                                                 \
    if ((kcur) + 128 < K) { _Pragma("unroll") for (int i = 0; i < CB; ++i) RB[i] = bld16(rb_, vb[i], (unsigned)((kcur) + 128) * 2u); } \
    _Pragma("unroll") for (int kk = 0; kk < 2; ++kk) {                                               \
      bf16x8 af[MT], bfr[NTL];                                                                       \
      _Pragma("unroll") for (int m = 0; m < MT; ++m) af[m] = *(const bf16x8*)(sAimg + (wm * (BM / WGM) + m * 16 + (lane & 15)) * lda_s + (kcur) + kk * 32 + (lane >> 4) * 8); \
      _Pragma("unroll") for (int n = 0; n < NTL; ++n) bfr[n] = *(const bf16x8*)(sB + (wn * (BN / WGN) + n * 16 + (lane & 15)) * LDS_STRIDE + kk * 32 + (lane >> 4) * 8); \
      _Pragma("unroll") for (int m = 0; m < MT; ++m)                                                 \
        _Pragma("unroll") for (int n = 0; n < NTL; ++n) acc[m][n] = MFMA16(af[m], bfr[n], acc[m][n]); \
    }                                                                                                \
  }
#pragma unroll
  for (int i = 0; i < CB; ++i) rb0[i] = bld16(rb_, vb[i], 0u);
#pragma unroll
  for (int i = 0; i < CB; ++i) rb1[i] = bld16(rb_, vb[i], 128u);
#pragma unroll 1
  for (int k0 = 0; k0 < K; k0 += 128) {
    GA_STEP(rb0, k0)
    GA_STEP(rb1, k0 + 64)
  }
  MFMA_FENCE();
#undef GA_STEP
}

template <int MT, int NTL>
DI void zero_acc(f32x4 (&acc)[MT][NTL]) {
#pragma unroll
  for (int m = 0; m < MT; ++m)
#pragma unroll
    for (int n = 0; n < NTL; ++n) acc[m][n] = (f32x4){0.f, 0.f, 0.f, 0.f};
}

DI void tile_put(u16* sT, int stride, int r, int c, float v) { sT[r * stride + c] = f2bf(v); }
DI void tile_flush128(const u16* sT, u16* dst, int ld, int row0, int col0) {
  const int tid = ltid();
#pragma unroll
  for (int i = 0; i < 8; ++i) {
    const int id = tid + i * NTHR, r = id >> 4, c = (id & 15) * 8;
    *(u32x4*)(dst + (size_t)(row0 + r) * ld + col0 + c) = *(const u32x4*)(sT + r * 136 + c);
  }
}
DI void tile_out_128(const f32x4 (&v)[4][4], u16* dst, int ld, int row0, int col0) {
  u16* sT = (u16*)smem;
  const int lane = ltid() & 63, wid = ltid() >> 6, wm = wid >> 1, wn = wid & 1;
  __syncthreads();
#pragma unroll
  for (int m = 0; m < 4; ++m)
#pragma unroll
    for (int n = 0; n < 4; ++n)
#pragma unroll
      for (int j = 0; j < 4; ++j) tile_put(sT, 136, wm * 64 + m * 16 + (lane >> 4) * 4 + j, wn * 64 + n * 16 + (lane & 15), v[m][n][j]);
  __syncthreads();
  tile_flush128(sT, dst, ld, row0, col0);
}

DI int dst_row_map(int n, int mode) {
  if (mode == 0) return n;
  if (mode == 1) {
    if (n < 512 || n >= 1536) return n;
    int sec = n & ~127, d = n & 127;
    int xh = d >> 6, idx = d & 63;
    return sec + (((idx >> 4) * 2 + xh) << 4) + (idx & 15);
  }
  if (mode == 2) return (n >> 4) * 32 + (n & 15);
  return (n >> 4) * 32 + 16 + (n & 15);
}
DI void transpose_tile(const float* src, int lds_, int k0, int n0, u16* dst, int ldd,
                       const float* gain, int mode, float scale) {
  float* t = (float*)smem;
  const int tid = ltid(), ty = tid >> 4, tx = tid & 15;
  __syncthreads();
#pragma unroll
  for (int i = 0; i < 4; ++i) {
    int k = ty + 16 * i;
    float4 v = *(const float4*)(src + (size_t)(k0 + k) * lds_ + n0 + tx * 4);
    float g = gain ? gain[k0 + k] : 1.0f;
    t[k * 65 + tx * 4 + 0] = v.x * g; t[k * 65 + tx * 4 + 1] = v.y * g;
    t[k * 65 + tx * 4 + 2] = v.z * g; t[k * 65 + tx * 4 + 3] = v.w * g;
  }
  __syncthreads();
  const int nl = tid >> 2, ks = (tid & 3) * 16;
  const int n = n0 + nl;
  float sc = scale;
  if (mode == 1) sc = (n >= 512 && n < 1024) ? 0.08838834764831845f : 1.0f;
  unsigned w[8];
#pragma unroll
  for (int i = 0; i < 8; ++i) w[i] = pack2(t[(ks + 2 * i) * 65 + nl] * sc, t[(ks + 2 * i + 1) * 65 + nl] * sc);
  u16* d = dst + (size_t)dst_row_map(n, mode) * ldd + k0 + ks;
  *(u32x4*)d = (u32x4){w[0], w[1], w[2], w[3]};
  *(u32x4*)(d + 8) = (u32x4){w[4], w[5], w[6], w[7]};
}

DI void rownorm_task(const float* src, float* xs_out, u16* dst) {
  const int lane = ltid() & 63;
  float4 v[4];
  float ss = 0.f;
#pragma unroll
  for (int i = 0; i < 4; ++i) {
    v[i] = *(const float4*)(src + i * 256 + lane * 4);
    ss += v[i].x * v[i].x + v[i].y * v[i].y + v[i].z * v[i].z + v[i].w * v[i].w;
  }
  ss = red64(ss);
  const float r = rsqrtf(ss * (1.0f / 1024.0f) + EPSF);
  if (xs_out && lane == 0) *xs_out = 1.0f / r;
#pragma unroll
  for (int i = 0; i < 4; ++i) {
    u32x2 o; o.x = pack2(v[i].x * r, v[i].y * r); o.y = pack2(v[i].z * r, v[i].w * r);
    *(u32x2*)(dst + i * 256 + lane * 4) = o;
  }
}

DI void phase_prep(const Params& p, unsigned* ctr) {
  char* ws = p.ws;
  const int tid = ltid();
  constexpr int T_W = 16384, T_X = NTOK / 4, T_M = 256, T_S = 128;
  constexpr int TOT = T_W + T_X + T_M + T_S;
  for (int t = blockIdx.x; t < TOT; t += gridDim.x) {
    if (t < T_W) {
      const int l = t >> 12; int q = t & 4095;
      u16* wl = (u16*)(ws + OFF_W) + (size_t)l * W_LAYER;
      if (q < 640) {
        transpose_tile(p.w_in + (size_t)l * 1024 * 2560, 2560, (q / 40) * 64, (q % 40) * 64, wl + W_IN, 1024, p.mix_pre + l * 1024, 1, 1.0f);
      } else if ((q -= 640) < 64) {
        transpose_tile(p.w_glu + (size_t)l * 512 * 512, 512, (q / 8) * 64, (q % 8) * 64, wl + W_GLU, 512, nullptr, 0, 1.0f);
      } else if ((q -= 64) < 256) {
        const int k0 = (q / 16) * 64;
        const float* gain = (k0 < 512) ? (p.s5_onorm + l * 512) : (p.ret_onorm + l * 512 - 512);
        transpose_tile(p.w_out + (size_t)l * 1024 * 1024, 1024, k0, (q % 16) * 64, wl + W_OUT, 1024, gain, 0, 1.0f);
      } else if ((q -= 256) < 256) {
        transpose_tile(p.w_cq + (size_t)l * 1024 * 1024, 1024, (q / 16) * 64, (q % 16) * 64, wl + W_CQ, 1024, p.xa_pre + l * 1024, 0, 0.0625f);
      } else if ((q -= 256) < 256) {
        transpose_tile(p.w_ck + (size_t)l * 1024 * 1024, 1024, (q / 16) * 64, (q % 16) * 64, wl + W_CK, 1024, p.mem_norm + l * 1024, 0, 1.0f);
      } else if ((q -= 256) < 256) {
        transpose_tile(p.w_cv + (size_t)l * 1024 * 1024, 1024, (q / 16) * 64, (q % 16) * 64, wl + W_CV, 1024, p.mem_norm + l * 1024, 0, 1.0f);
      } else if ((q -= 256) < 256) {
        transpose_tile(p.w_co + (size_t)l * 1024 * 1024, 1024, (q / 16) * 64, (q % 16) * 64, wl + W_CO, 1024, nullptr, 0, 1.0f);
      } else if ((q -= 256) < 704) {
        transpose_tile(p.w_gate + (size_t)l * 1024 * 2816, 2816, (q / 44) * 64, (q % 44) * 64, wl + W_GU, 1024, p.ffn_pre + l * 1024, 2, 1.0f);
      } else if ((q -= 704) < 704) {
        transpose_tile(p.w_up + (size_t)l * 1024 * 2816, 2816, (q / 44) * 64, (q % 44) * 64, wl + W_GU, 1024, p.ffn_pre + l * 1024, 3, 1.0f);
      } else {
        q -= 704;
        transpose_tile(p.w_down + (size_t)l * 2816 * 1024, 1024, (q / 16) * 64, (q % 16) * 64, wl + W_DN, 2816, nullptr, 0, 1.0f);
      }
    } else if (t < T_W + T_X) {
      const int row = (t - T_W) * 4 + (tid >> 6);
      const float* src = (row < PROWS) ? p.x_prompt + (size_t)row * 1024 : p.x_sample + (size_t)(row - PROWS) * 1024;
      rownorm_task(src, (float*)(ws + OFF_RSQ) + row, (u16*)(ws + OFF_HB) + (size_t)row * 1024);
    } else if (t < T_W + T_X + T_M) {
      const int row = (t - T_W - T_X) * 4 + (tid >> 6);
      rownorm_task(p.mem_prompt + (size_t)row * 1024, nullptr, (u16*)(ws + OFF_MEMB) + (size_t)row * 1024);
    } else {
      const int lg = t - T_W - T_X - T_M, l = lg >> 5, g = lg & 31;
      char* sp = ws + OFF_S5P + (size_t)l * S5P_LAYER;
      u16* bbt = (u16*)(sp + S5P_BBT) + g * 2048;
      u16* cm = (u16*)(sp + S5P_CM) + g * 2048;
      float* ab = (float*)(sp + S5P_ABAR) + g * 128;
      const float dt = __expf(p.log_step[l * 32 + g]);
      for (int e = tid; e < 1024; e += NTHR) {
        const int pp = e >> 4, h = e & 15;
        const float lr = p.lam_re[(l * 32 + g) * 64 + pp], li = p.lam_im[(l * 32 + g) * 64 + pp];
        const float ar = lr * dt, ai = li * dt, mag = expf(ar);
        float sn_, cs_; sincos_cw(ai, &sn_, &cs_);
        const float abr = mag * cs_, abi = mag * sn_;
        const float den = lr * lr + li * li, nr = abr - 1.0f, ni = abi;
        const float fr = (nr * lr + ni * li) / den, fi = (ni * lr - nr * li) / den;
        const float br = p.b_re[((size_t)(l * 32 + g) * 64 + pp) * 16 + h], bi = p.b_im[((size_t)(l * 32 + g) * 64 + pp) * 16 + h];
        bbt[pp * 16 + h] = f2bf(fr * br - fi * bi);
        bbt[(64 + pp) * 16 + h] = f2bf(fr * bi + fi * br);
        if (h == 0) { ab[pp * 2] = abr; ab[pp * 2 + 1] = abi; }
        const int hh = e >> 6, kk = e & 63;
        cm[hh * 128 + kk] = f2bf(p.c_re[((size_t)(l * 32 + g) * 16 + hh) * 64 + kk]);
        cm[hh * 128 + 64 + kk] = f2bf(-p.c_im[((size_t)(l * 32 + g) * 16 + hh) * 64 + kk]);
      }
    }
  }
}

DI void memkv_tile(const Params& p, int t) {
  char* ws = p.ws;
  const int l = t >> 7, rt = (t >> 4) & 7, ct = t & 15;
  const int isv = ct >> 3, col0 = (ct & 7) * 128, row0 = rt * 128;
  const u16* A = (const u16*)(ws + OFF_MEMB) + (size_t)row0 * 1024;
  const u16* B = (const u16*)(ws + OFF_W) + (size_t)l * W_LAYER + (isv ? W_CV : W_CK) + (size_t)col0 * 1024;
  f32x4 acc[4][4];
  zero_acc(acc);
  u16* sA = (u16*)smem; u16* sB = sA + 128 * LDS_STRIDE;
  gemm_mainloop<128, 128, 2, 2>(A, 1024, B, 1024, 1024, 1 << 30, acc, sA, sB, NoHook());
  const int lane = ltid() & 63, wid = ltid() >> 6, wm = wid >> 1, wn = wid & 1;
  float* of = p.out + (isv ? O_MV_P : O_MK_P) + (size_t)l * 1024 * 1024;
  u16* kx = (u16*)(ws + OFF_KXP) + (size_t)l * 1024 * 1024;
  u16* vx = (u16*)(ws + OFF_VTXP) + (size_t)l * 1024 * 1024;
#pragma unroll
  for (int m = 0; m < 4; ++m)
#pragma unroll
    for (int n = 0; n < 4; ++n) {
      const int r = row0 + wm * 64 + m * 16 + (lane >> 4) * 4, c = col0 + wn * 64 + n * 16 + (lane & 15);
#pragma unroll
      for (int j = 0; j < 4; ++j) of[(size_t)(r + j) * 1024 + c] = acc[m][n][j];
      if (!isv) {
#pragma unroll
        for (int j = 0; j < 4; ++j) kx[(size_t)(r + j) * 1024 + c] = f2bf(acc[m][n][j]);
      } else {
        const int b = r >> 8, mm = r & 255, h = c >> 8, d = c & 255;
        u32x2 o; o.x = pack2(acc[m][n][0], acc[m][n][1]); o.y = pack2(acc[m][n][2], acc[m][n][3]);
        *(u32x2*)(vx + ((size_t)((b * 4 + h) * 256 + d)) * 256 + mm) = o;
      }
    }
}
DI void cache_task(const Params& p, int l, int t) {
  char* ws = p.ws;
  if (t < 1024) {
    const float* src = p.cmk + (size_t)l * 16 * 256 * 1024 + (size_t)t * 4096 + ltid() * 16;
    u16* dst = (u16*)(ws + OFF_KXS) + (size_t)t * 4096 + ltid() * 16;
    float4 a = *(const float4*)src, b = *(const float4*)(src + 4), c = *(const float4*)(src + 8), d = *(const float4*)(src + 12);
    *(u32x4*)dst = (u32x4){pack2(a.x, a.y), pack2(a.z, a.w), pack2(b.x, b.y), pack2(b.z, b.w)};
    *(u32x4*)(dst + 8) = (u32x4){pack2(c.x, c.y), pack2(c.z, c.w), pack2(d.x, d.y), pack2(d.z, d.w)};
  } else {
    t -= 1024;
    const int bh = t >> 4, q = t & 15, b = bh >> 2, h = bh & 3;
    const float* src = p.cmv + ((size_t)(l * 16 + b) * 256) * 1024 + h * 256;
    u16* dst = (u16*)(ws + OFF_VTXS) + (size_t)bh * 256 * 256;
    transpose_tile(src, 1024, (q >> 2) * 64, (q & 3) * 64, dst, 256, nullptr, 0, 1.0f);
  }
}

DI void g1_tile(const Params& p, int l, int t) {
  char* ws = p.ws;
  const int rt = t / 20, ct = t % 20;
  const int row0 = rt * 128, col0 = ct * 128;
  const u16* A = (const u16*)(ws + OFF_HB) + (size_t)row0 * 1024;
  const u16* B = (const u16*)(ws + OFF_W) + (size_t)l * W_LAYER + W_IN + (size_t)col0 * 1024;
  f32x4 acc[4][4];
  zero_acc(acc);
  u16* sA = (u16*)smem; u16* sB = sA + 128 * LDS_STRIDE;
  gemm_mainloop<128, 128, 2, 2>(A, 1024, B, 1024, 1024, 1 << 30, acc, sA, sB, NoHook());
  const int lane = ltid() & 63, wid = ltid() >> 6, wm = wid >> 1, wn = wid & 1;
  char* arena = ws + OFF_ARENA;
  const int sec = ct >> 2, hd = ct & 3;
  const bool samp = row0 >= PROWS;
  if (sec == 0 || sec == 4) {
    tile_out_128(acc, (u16*)(arena + (sec == 0 ? 0 : 3) * SLOT), 512, row0, hd * 128);
  } else if (sec == 3) {
    u16* vt = (u16*)(arena + 4 * SLOT);
#pragma unroll
    for (int m = 0; m < 4; ++m)
#pragma unroll
      for (int n = 0; n < 4; ++n) {
        const int r = row0 + wm * 64 + m * 16 + (lane >> 4) * 4, e = wn * 64 + n * 16 + (lane & 15);
        u32x2 o; o.x = pack2(acc[m][n][0], acc[m][n][1]); o.y = pack2(acc[m][n][2], acc[m][n][3]);
        size_t off;
        if (!samp) { const int b = r >> 13, tt = r & 8191; off = ((size_t)((b * 4 + hd) * 128 + e)) * SEQ + tt; }
        else { const int sr = r - PROWS, b = sr >> 4, tt = sr & 15; off = (size_t)16 * 128 * SEQ + ((size_t)((b * 4 + hd) * 128 + e)) * 16 + tt; }
        *(u32x2*)(vt + off) = o;
      }
  } else {
    u16* dst = (u16*)(arena + (sec == 1 ? 1 : 2) * SLOT);
    u16* ktd = (u16*)(arena + 5 * SLOT);
    const float gl2 = gamma_l2(hd);
    u16* sT = (u16*)smem;
    __syncthreads();
#pragma unroll
    for (int m = 0; m < 4; ++m)
#pragma unroll
      for (int np = 0; np < 2; ++np) {
        const int r = row0 + wm * 64 + m * 16 + (lane >> 4) * 4;
        const int idx = (wn * 2 + np) * 16 + (lane & 15);
        const float inv = exp2f(-(float)idx * (13.287712379549449f / 64.0f));
        float o1[4], o2[4];
#pragma unroll
        for (int j = 0; j < 4; ++j) {
          const int rr = r + j;
          const int pos = samp ? (1024 + ((rr - PROWS) & 15)) : (rr & 8191);
          float sn, cs;
          sincos_cw((float)pos * inv, &sn, &cs);
          const float x1 = acc[m][2 * np][j], x2 = acc[m][2 * np + 1][j];
          o1[j] = x1 * cs - x2 * sn; o2[j] = x1 * sn + x2 * cs;
          tile_put(sT, 136, rr - row0, idx, o1[j]);
          tile_put(sT, 136, rr - row0, 64 + idx, o2[j]);
        }
        if (sec == 2) {
          size_t off1; int tloc;
          if (!samp) { const int b = r >> 13, tt = r & 8191; off1 = ((size_t)((b * 4 + hd) * 128 + idx)) * SEQ + tt; tloc = 63 - (tt & 63); }
          else { const int sr = r - PROWS, b = sr >> 4, tt = sr & 15; off1 = (size_t)16 * 128 * SEQ + ((size_t)((b * 4 + hd) * 128 + idx)) * 16 + tt; tloc = 15 - tt; }
          const size_t off2 = off1 + (size_t)64 * (samp ? 16 : SEQ);
          float dc[4];
#pragma unroll
          for (int j = 0; j < 4; ++j) dc[j] = exp2f(gl2 * (float)(tloc - j));
          u32x2 a, b2;
          a.x = pack2(o1[0] * dc[0], o1[1] * dc[1]); a.y = pack2(o1[2] * dc[2], o1[3] * dc[3]);
          b2.x = pack2(o2[0] * dc[0], o2[1] * dc[1]); b2.y = pack2(o2[2] * dc[2], o2[3] * dc[3]);
          *(u32x2*)(ktd + off1) = a;
          *(u32x2*)(ktd + off2) = b2;
        }
      }
    __syncthreads();
    tile_flush128(sT, dst, 512, row0, hd * 128);
  }
}

struct DecayHook {
  float g64;
  template <class T> DI void operator()(int k0, T& acc) const {
    if (k0 + 64 < 512) {
#pragma unroll
      for (int m = 0; m < 4; ++m)
#pragma unroll
        for (int n = 0; n < 4; ++n) acc[m][n] *= g64;
    }
  }
};
DI void ret_local_task(const Params& p, int t) {
  char* ws = p.ws;
  char* arena = ws + OFF_ARENA;
  const int bh = t >> 4, sc = t & 15, h = bh & 3;
  const u16* A = (const u16*)(arena + 5 * SLOT) + (size_t)bh * 128 * SEQ + sc * 512;
  const u16* B = (const u16*)(arena + 4 * SLOT) + (size_t)bh * 128 * SEQ + sc * 512;
  f32x4 acc[4][4];
  zero_acc(acc);
  u16* sA = (u16*)smem; u16* sB = sA + 128 * LDS_STRIDE;
  DecayHook hk; hk.g64 = exp2f(gamma_l2(h) * 64.0f);
  gemm_mainloop<128, 128, 2, 2>(A, SEQ, B, SEQ, 512, 1 << 30, acc, sA, sB, hk);
  const int lane = ltid() & 63, wid = ltid() >> 6, wm = wid >> 1, wn = wid & 1;
  float* dst = (float*)(ws + OFF_SLOC) + (size_t)t * 16384;
#pragma unroll
  for (int m = 0; m < 4; ++m)
#pragma unroll
    for (int n = 0; n < 4; ++n) {
      const int r = wm * 64 + m * 16 + (lane >> 4) * 4, c = wn * 64 + n * 16 + (lane & 15);
#pragma unroll
      for (int j = 0; j < 4; ++j) dst[(r + j) * 128 + c] = acc[m][n][j];
    }
}

DI void ret_final_task(const Params& p, int l, int t) {
  char* ws = p.ws;
  char* arena = ws + OFF_ARENA;
  const int tid = ltid(), lane = tid & 63, w = tid >> 6;
  const bool samp = t >= 256;
  int bh, sc, nchunk, C, row_base;
  size_t tr_base; int tr_ld;
  if (!samp) { bh = t >> 4; sc = t & 15; nchunk = 8; C = 64; row_base = (bh >> 2) * SEQ + sc * 512; tr_base = (size_t)bh * 128 * SEQ + sc * 512; tr_ld = SEQ; }
  else { bh = t - 256; sc = 0; nchunk = 1; C = 16; row_base = PROWS + (bh >> 2) * 16; tr_base = (size_t)16 * 128 * SEQ + (size_t)bh * 128 * 16; tr_ld = 16; }
  const int h = bh & 3;
  const float gl2 = gamma_l2(h);
  const float gC = exp2f(gl2 * (float)C);
  const u16* Qg = (const u16*)(arena + 1 * SLOT);
  const u16* Kg = (const u16*)(arena + 2 * SLOT);
  const u16* Gg = (const u16*)(arena + 3 * SLOT);
  const u16* Vt = (const u16*)(arena + 4 * SLOT) + tr_base;
  const u16* Ktd = (const u16*)(arena + 5 * SLOT) + tr_base;
  u16* reto = (u16*)(arena + 7 * SLOT);
  u16* sQ = (u16*)smem;
  u16* sK = sQ + 64 * 144;
  u16* sV = sK + 128 * LDS_STRIDE;
  u16* sS = sV + 128 * LDS_STRIDE;
  float* sR = (float*)(sS + 64 * LDS_STRIDE);

  f32x4 S[8][2];
  if (samp) {
    const float* s0 = p.ret0 + ((size_t)(l * 64 + bh)) * 16384;
#pragma unroll
    for (int mt = 0; mt < 8; ++mt)
#pragma unroll
      for (int nt = 0; nt < 2; ++nt)
#pragma unroll
        for (int j = 0; j < 4; ++j) S[mt][nt][j] = s0[(mt * 16 + (lane >> 4) * 4 + j) * 128 + 32 * w + nt * 16 + (lane & 15)];
  } else {
#pragma unroll
    for (int mt = 0; mt < 8; ++mt)
#pragma unroll
      for (int nt = 0; nt < 2; ++nt) S[mt][nt] = (f32x4){0.f, 0.f, 0.f, 0.f};
    const float g512 = exp2f(gl2 * 512.0f);
    for (int s2 = 0; s2 < sc; ++s2) {
      const float* sl = (const float*)(ws + OFF_SLOC) + ((size_t)(bh * 16 + s2)) * 16384;
#pragma unroll
      for (int mt = 0; mt < 8; ++mt)
#pragma unroll
        for (int nt = 0; nt < 2; ++nt)
#pragma unroll
          for (int j = 0; j < 4; ++j)
            S[mt][nt][j] = S[mt][nt][j] * g512 + ld_sc1_f(sl + (mt * 16 + (lane >> 4) * 4 + j) * 128 + 32 * w + nt * 16 + (lane & 15));
    }
  }
  const u32x4 z4 = (u32x4){0, 0, 0, 0};
  for (int c = 0; c < nchunk; ++c) {
    const int r0 = row_base + c * 64;
    __syncthreads();
#pragma unroll
    for (int i = 0; i < 4; ++i) {
      const int id = tid + i * NTHR, r = id >> 4, cc = (id & 15) * 8;
      u32x4 q4 = z4, k4 = z4;
      if (r < C) {
        q4 = ld_sc1_16(Qg + (size_t)(r0 + r) * 512 + h * 128 + cc);
        k4 = ld_sc1_16(Kg + (size_t)(r0 + r) * 512 + h * 128 + cc);
      }
      *(u32x4*)(sQ + r * 144 + cc) = q4;
      *(u32x4*)(sK + r * 144 + cc) = k4;
    }
#pragma unroll
    for (int i = 0; i < 4; ++i) {
      const int id = tid + i * NTHR, r = id >> 3, cc = (id & 7) * 8;
      u32x4 v4 = z4;
      if (cc < C) v4 = ld_sc1_16(Vt + (size_t)r * tr_ld + c * 64 + cc);
      *(u32x4*)(sV + r * LDS_STRIDE + cc) = v4;
    }
    __syncthreads();
    {
      f32x4 sc4[4];
#pragma unroll
      for (int m = 0; m < 4; ++m) sc4[m] = (f32x4){0.f, 0.f, 0.f, 0.f};
#pragma unroll
      for (int ks = 0; ks < 4; ++ks) {
        const bf16x8 bk = *(const bf16x8*)(sK + (16 * w + (lane & 15)) * 144 + ks * 32 + (lane >> 4) * 8);
#pragma unroll
        for (int m = 0; m < 4; ++m) {
          const bf16x8 aq = *(const bf16x8*)(sQ + (m * 16 + (lane & 15)) * 144 + ks * 32 + (lane >> 4) * 8);
          sc4[m] = MFMA16(aq, bk, sc4[m]);
        }
      }
      MFMA_FENCE();
      const int jc = 16 * w + (lane & 15);
#pragma unroll
      for (int m = 0; m < 4; ++m)
#pragma unroll
        for (int j = 0; j < 4; ++j) {
          const int i = m * 16 + (lane >> 4) * 4 + j;
          const int dd = i > jc ? i - jc : jc - i;
          sS[i * LDS_STRIDE + jc] = f2bf(sc4[m][j] * exp2f(gl2 * (float)dd));
        }
    }
    __syncthreads();
#pragma unroll
    for (int i = 0; i < 4; ++i) {
      const int id = tid + i * NTHR, r = id >> 3, cc = (id & 7) * 8;
      u32x4 v4 = z4;
      if (cc < C) v4 = ld_sc1_16(Ktd + (size_t)r * tr_ld + c * 64 + cc);
      *(u32x4*)(sK + r * LDS_STRIDE + cc) = v4;
    }
    f32x4 o[4][2];
#pragma unroll
    for (int m = 0; m < 4; ++m) { o[m][0] = (f32x4){0.f, 0.f, 0.f, 0.f}; o[m][1] = o[m][0]; }
#pragma unroll
    for (int a = 0; a < 4; ++a) {
      bf16x8 bs[2];
#pragma unroll
      for (int nt = 0; nt < 2; ++nt) {
        u32x4 u;
        u.x = pack2(S[2 * a][nt][0], S[2 * a][nt][1]); u.y = pack2(S[2 * a][nt][2], S[2 * a][nt][3]);
        u.z = pack2(S[2 * a + 1][nt][0], S[2 * a + 1][nt][1]); u.w = pack2(S[2 * a + 1][nt][2], S[2 * a + 1][nt][3]);
        bs[nt] = __builtin_bit_cast(bf16x8, u);
      }
#pragma unroll
      for (int m = 0; m < 4; ++m) {
        const u16* qp = sQ + (m * 16 + (lane & 15)) * 144 + (lane >> 4) * 4;
        const u32x2 lo = *(const u32x2*)(qp + (2 * a) * 16);
        const u32x2 hi = *(const u32x2*)(qp + (2 * a + 1) * 16);
        const bf16x8 aq = __builtin_bit_cast(bf16x8, ((u32x4){lo.x, lo.y, hi.x, hi.y}));
        o[m][0] = MFMA16(aq, bs[0], o[m][0]);
        o[m][1] = MFMA16(aq, bs[1], o[m][1]);
      }
      __builtin_amdgcn_sched_barrier(0);
    }
    MFMA_FENCE();
#pragma unroll
    for (int m = 0; m < 4; ++m)
#pragma unroll
      for (int j = 0; j < 4; ++j) {
        const int i = m * 16 + (lane >> 4) * 4 + j;
        const float f = exp2f(gl2 * (float)(i + 1));
        o[m][0][j] *= f;
        o[m][1][j] *= f;
      }
#pragma unroll
    for (int ks = 0; ks < 2; ++ks) {
      bf16x8 bv[2];
#pragma unroll
      for (int nt = 0; nt < 2; ++nt) bv[nt] = *(const bf16x8*)(sV + (32 * w + nt * 16 + (lane & 15)) * LDS_STRIDE + ks * 32 + (lane >> 4) * 8);
#pragma unroll
      for (int m = 0; m < 4; ++m) {
        const bf16x8 as = *(const bf16x8*)(sS + (m * 16 + (lane & 15)) * LDS_STRIDE + ks * 32 + (lane >> 4) * 8);
        o[m][0] = MFMA16(as, bv[0], o[m][0]);
        o[m][1] = MFMA16(as, bv[1], o[m][1]);
      }
      __builtin_amdgcn_sched_barrier(0);
    }
    MFMA_FENCE();
#pragma unroll
    for (int m = 0; m < 4; ++m)
#pragma unroll
      for (int j = 0; j < 4; ++j) {
        float v = o[m][0][j] * o[m][0][j] + o[m][1][j] * o[m][1][j];
        v = red16(v);
        if ((lane & 15) == 0) sR[w * 64 + m * 16 + (lane >> 4) * 4 + j] = v;
      }
    __syncthreads();
#pragma unroll
    for (int m = 0; m < 4; ++m)
#pragma unroll
      for (int j = 0; j < 4; ++j) {
        const int i = m * 16 + (lane >> 4) * 4 + j;
        if (i < C) {
          const float ss = sR[i] + sR[64 + i] + sR[128 + i] + sR[192 + i];
          const float rs = rsqrtf(ss * (1.0f / 128.0f) + EPSF);
#pragma unroll
          for (int nt = 0; nt < 2; ++nt) {
            const int e = 32 * w + nt * 16 + (lane & 15);
            const float g = bf2f(ld_sc1_2(Gg + (size_t)(r0 + i) * 512 + h * 128 + e));
            reto[(size_t)(r0 + i) * 512 + h * 128 + e] = f2bf(o[m][nt][j] * rs * siluf_(g));
          }
        }
      }
#pragma unroll
    for (int mt = 0; mt < 8; ++mt) { S[mt][0] *= gC; S[mt][1] *= gC; }
#pragma unroll 1
    for (int ks = 0; ks < 2; ++ks) {
      bf16x8 bv[2];
#pragma unroll
      for (int nt = 0; nt < 2; ++nt) bv[nt] = *(const bf16x8*)(sV + (32 * w + nt * 16 + (lane & 15)) * LDS_STRIDE + ks * 32 + (lane >> 4) * 8);
#pragma unroll
      for (int mt = 0; mt < 8; ++mt) {
        const bf16x8 ak = *(const bf16x8*)(sK + (mt * 16 + (lane & 15)) * LDS_STRIDE + ks * 32 + (lane >> 4) * 8);
        S[mt][0] = MFMA16(ak, bv[0], S[mt][0]);
        S[mt][1] = MFMA16(ak, bv[1], S[mt][1]);
      }
    }
    MFMA_FENCE();
  }
  if (samp || sc == 15) {
    float* so = samp ? (p.out + O_RET_S + ((size_t)(l * 64 + bh)) * 16384) : (p.out + O_RET_P + ((size_t)(l * 16 + bh)) * 16384);
#pragma unroll
    for (int mt = 0; mt < 8; ++mt)
#pragma unroll
      for (int nt = 0; nt < 2; ++nt)
#pragma unroll
        for (int j = 0; j < 4; ++j) so[(mt * 16 + (lane >> 4) * 4 + j) * 128 + 32 * w + nt * 16 + (lane & 15)] = S[mt][nt][j];
  }
}

DI void s5_task(const Params& p, int l, int t, int mode) {
  char* ws = p.ws;
  char* arena = ws + OFF_ARENA;
  const int tid = ltid(), lane = tid & 63, w = tid >> 6;
  const bool samp = t >= 512;
  int b, lc, g, row_base, nsub;
  if (!samp) { b = t >> 7; lc = (t >> 3) & 15; g = (t & 7) * 4 + w; row_base = b * SEQ + lc * 512; nsub = 32; }
  else { const int q = t - 512; b = q >> 3; lc = 0; g = (q & 7) * 4 + w; row_base = PROWS + b * 16; nsub = 1; }
  const char* sp = ws + OFF_S5P + (size_t)l * S5P_LAYER;
  const u16* bbt = (const u16*)(sp + S5P_BBT) + g * 2048;
  const u16* cm = (const u16*)(sp + S5P_CM) + g * 2048;
  const float* ab = (const float*)(sp + S5P_ABAR) + g * 128;
  const u16* U = (const u16*)(arena + 0 * SLOT);
  u16* Z = (u16*)(arena + 6 * SLOT);
  float* bu = (float*)(smem + w * 13056);
  u16* xs = (u16*)(smem + w * 13056 + 8448);
  const float ar = ld_sc1_f(ab + lane * 2), ai = ld_sc1_f(ab + lane * 2 + 1);
  const int slab = lane >> 4;
  const u32x4 z4 = (u32x4){0, 0, 0, 0};
  bf16x8 Bf[8], Cf[4];
#pragma unroll
  for (int nt = 0; nt < 8; ++nt) {
    u32x4 u = z4;
    if (slab < 2) u = ld_sc1_16(bbt + (nt * 16 + (lane & 15)) * 16 + slab * 8);
    Bf[nt] = __builtin_bit_cast(bf16x8, u);
  }
#pragma unroll
  for (int ks = 0; ks < 4; ++ks) Cf[ks] = __builtin_bit_cast(bf16x8, ld_sc1_16(cm + (lane & 15) * 128 + ks * 32 + slab * 8));
  const float Dh = p.s5_d[(l * 32 + g) * 16 + (lane & 15)];
  float xr = 0.f, xi = 0.f;
  if (samp) {
    xr = p.s5re0[((size_t)(l * 16 + b) * 32 + g) * 64 + lane];
    xi = p.s5im0[((size_t)(l * 16 + b) * 32 + g) * 64 + lane];
  } else if (mode == 1 && lc > 0) {
    float pr = ar, pi = ai;
#pragma unroll
    for (int s = 0; s < 9; ++s) { const float nr = pr * pr - pi * pi, ni = 2.f * pr * pi; pr = nr; pi = ni; }
    const float* el = (const float*)(ws + OFF_ELOC);
    for (int c2 = 0; c2 < lc; ++c2) {
      const float er = ld_sc1_f(el + (((size_t)(b * 16 + c2) * 32 + g) * 64 + lane) * 2), ei = ld_sc1_f(el + (((size_t)(b * 16 + c2) * 32 + g) * 64 + lane) * 2 + 1);
      const float nr = pr * xr - pi * xi + er, ni = pr * xi + pi * xr + ei;
      xr = nr; xi = ni;
    }
  }
  u16* usm = (u16*)(smem + 52224 + w * 512);
  const u16* up = U + (size_t)(row_base + (lane & 15)) * 512 + g * 16 + (slab & 1) * 8;
  u32x4 ua = ld_sc1_16(up);
  for (int sub = 0; sub < nsub; ++sub) {
    const int r0 = row_base + sub * 16;
    u32x4 un = z4;
    if (sub + 1 < nsub) un = ld_sc1_16(up + (size_t)(sub + 1) * 16 * 512);
    if (slab >= 2) ua = z4;
    const bf16x8 Af = __builtin_bit_cast(bf16x8, ua);
    __syncthreads();
    if (mode == 1 && slab < 2) *(u32x4*)(usm + (lane & 15) * 16 + slab * 8) = ua;
    f32x4 a8[8];
#pragma unroll
    for (int nt = 0; nt < 8; ++nt) a8[nt] = MFMA16(Af, Bf[nt], ((f32x4){0.f, 0.f, 0.f, 0.f}));
    __builtin_amdgcn_sched_barrier(0);
    asm volatile("s_nop 15\n\ts_nop 15\n\ts_nop 15" ::: "memory");
    __builtin_amdgcn_sched_barrier(0);
#pragma unroll
    for (int nt = 0; nt < 8; ++nt) {
#pragma unroll
      for (int j = 0; j < 4; ++j) bu[(slab * 4 + j) * 132 + nt * 16 + (lane & 15)] = a8[nt][j];
    }
    __syncthreads();
#pragma unroll
    for (int tt = 0; tt < 16; ++tt) {
      const float br = bu[tt * 132 + lane], bi = bu[tt * 132 + 64 + lane];
      const float nr = ar * xr - ai * xi + br, ni = ar * xi + ai * xr + bi;
      xr = nr; xi = ni;
      if (mode == 1) { xs[tt * 144 + lane] = f2bf(xr); xs[tt * 144 + 64 + lane] = f2bf(xi); }
    }
    if (mode == 1) {
      __syncthreads();
      f32x4 y = (f32x4){0.f, 0.f, 0.f, 0.f};
#pragma unroll
      for (int ks = 0; ks < 4; ++ks) {
        const bf16x8 ax = *(const bf16x8*)(xs + (lane & 15) * 144 + ks * 32 + slab * 8);
        y = MFMA16(ax, Cf[ks], y);
      }
      __builtin_amdgcn_sched_barrier(0);
      asm volatile("s_nop 15\n\ts_nop 15" ::: "memory");
      __builtin_amdgcn_sched_barrier(0);
#pragma unroll
      for (int j = 0; j < 4; ++j) {
        const int rr = r0 + slab * 4 + j, cc = g * 16 + (lane & 15);
        const float u = bf2f(usm[(slab * 4 + j) * 16 + (lane & 15)]);
        Z[(size_t)rr * 512 + cc] = f2bf(geluf_(y[j] + Dh * u));
      }
    }
    ua = un;
  }
  if (mode == 0) {
    float* el = (float*)(ws + OFF_ELOC);
    el[(((size_t)(b * 16 + lc) * 32 + g) * 64 + lane) * 2] = xr;
    el[(((size_t)(b * 16 + lc) * 32 + g) * 64 + lane) * 2 + 1] = xi;
  } else if (samp) {
    p.out[O_S5RE_S + ((size_t)(l * 16 + b) * 32 + g) * 64 + lane] = xr;
    p.out[O_S5IM_S + ((size_t)(l * 16 + b) * 32 + g) * 64 + lane] = xi;
  } else if (lc == 15) {
    p.out[O_S5RE_P + ((size_t)(l * 4 + b) * 32 + g) * 64 + lane] = xr;
    p.out[O_S5IM_P + ((size_t)(l * 4 + b) * 32 + g) * 64 + lane] = xi;
  }
}

DI void glu_tile(const Params& p, int l, int t) {
  char* ws = p.ws;
  char* arena = ws + OFF_ARENA;
  const int rt = t >> 2, ct = t & 3, row0 = rt * 128, col0 = ct * 128;
  const u16* Zb = (const u16*)(arena + 6 * SLOT);
  const u16* A = Zb + (size_t)row0 * 512;
  const u16* B = (const u16*)(ws + OFF_W) + (size_t)l * W_LAYER + W_GLU + (size_t)col0 * 512;
  f32x4 acc[4][4];
  zero_acc(acc);
  u16* sA = (u16*)smem; u16* sB = sA + 128 * LDS_STRIDE;
  gemm_mainloop<128, 128, 2, 2>(A, 512, B, 512, 512, 1 << 30, acc, sA, sB, NoHook());
  const int lane = ltid() & 63, wid = ltid() >> 6, wm = wid >> 1, wn = wid & 1;
  u16* Z2 = (u16*)(arena + 0 * SLOT);
  float* zsq = (float*)(ws + OFF_ZSQ);
  const float* bg = p.b_glu + l * 512;
#pragma unroll
  for (int m = 0; m < 4; ++m) {
    float ss[4] = {0.f, 0.f, 0.f, 0.f};
    const int r = row0 + wm * 64 + m * 16 + (lane >> 4) * 4;
#pragma unroll
    for (int n = 0; n < 4; ++n) {
      const int c = col0 + wn * 64 + n * 16 + (lane & 15);
      const float bb = bg[c];
#pragma unroll
      for (int j = 0; j < 4; ++j) {
        const float z = bf2f(ld_sc1_2(Zb + (size_t)(r + j) * 512 + c));
        const float z2 = z * sigmoidf_(acc[m][n][j] + bb);
        ss[j] += z2 * z2;
        Z2[(size_t)(r + j) * 512 + c] = f2bf(z2);
      }
    }
#pragma unroll
    for (int j = 0; j < 4; ++j) {
      const float v = red16(ss[j]);
      if ((lane & 15) == 0) zsq[(size_t)(ct * 2 + wn) * NTOK + r + j] = v;
    }
  }
}

DI void store_raw_rsq(const f32x4 (&acc)[4][4], u16* raw, float* rsq, int row0, int col0, int ct) {
  tile_out_128(acc, raw, 1024, row0, col0);
}

DI void out_tile(const Params& p, int l, int t) {
  char* ws = p.ws;
  char* arena = ws + OFF_ARENA;
  const int rt = t >> 3, ct = t & 7, row0 = rt * 128, col0 = ct * 128;
  const u16* B = (const u16*)(ws + OFF_W) + (size_t)l * W_LAYER + W_OUT + (size_t)col0 * 1024;
  f32x4 acc[4][4];
  zero_acc(acc);
  u16* sA = (u16*)smem; u16* sB = sA + 128 * LDS_STRIDE;
  gemm_mainloop<128, 128, 2, 2>((const u16*)(arena + 0 * SLOT) + (size_t)row0 * 512, 512, B, 1024, 512, 1 << 30, acc, sA, sB, NoHook());
  const int lane = ltid() & 63, wid = ltid() >> 6, wm = wid >> 1;
  const float* zsq = (const float*)(ws + OFF_ZSQ);
#pragma unroll
  for (int m = 0; m < 4; ++m)
#pragma unroll
    for (int j = 0; j < 4; ++j) {
      const int r = row0 + wm * 64 + m * 16 + (lane >> 4) * 4 + j;
      float zs = 0.f;
#pragma unroll
      for (int q = 0; q < 8; ++q) zs += ld_sc1_f(zsq + (size_t)q * NTOK + r);
      const float rs = rsqrtf(zs * (1.0f / 512.0f) + EPSF);
#pragma unroll
      for (int n = 0; n < 4; ++n) acc[m][n][j] *= rs;
    }
  gemm_mainloop<128, 128, 2, 2>((const u16*)(arena + 7 * SLOT) + (size_t)row0 * 512, 512, B + 512, 1024, 512, 1 << 30, acc, sA, sB, NoHook());
  store_raw_rsq(acc, (u16*)(arena + 1 * SLOT), (float*)(ws + OFF_RSQ), row0, col0, ct);
}

DI void raw_tile(const Params& p, const u16* Abase, int lda, const u16* Bbase, int K, u16* raw, int t) {
  char* ws = p.ws;
  const int rt = t >> 3, ct = t & 7, row0 = rt * 128, col0 = ct * 128;
  f32x4 acc[4][4];
  zero_acc(acc);
  u16* sA = (u16*)smem; u16* sB = sA + 128 * LDS_STRIDE;
  gemm_mainloop<128, 128, 2, 2>(Abase + (size_t)row0 * lda, lda, Bbase + (size_t)col0 * K, K, K, 1 << 30, acc, sA, sB, NoHook());
  store_raw_rsq(acc, raw, (float*)(ws + OFF_RSQ), row0, col0, ct);
}

DI void post_task(const Params& p, const u16* raw, const float* gpost, int t, bool last) {
  char* ws = p.ws;
  const int lane = ltid() & 63;
  const int row = t * 4 + (ltid() >> 6);
  const u16* rw = raw + (size_t)row * 1024;
  u16* hb = (u16*)(ws + OFF_HB) + (size_t)row * 1024;
  float* xsp = (float*)(ws + OFF_RSQ) + row;
  const float xscale = ld_sc1_f(xsp);
  float4 rv[4];
  float s = 0.f;
#pragma unroll
  for (int i = 0; i < 4; ++i) {
    const int c = i * 256 + lane * 4;
    const u32x2 r2 = ld_sc1_8(rw + c);
    rv[i].x = bf2f((u16)(r2.x & 0xffff)); rv[i].y = bf2f((u16)(r2.x >> 16));
    rv[i].z = bf2f((u16)(r2.y & 0xffff)); rv[i].w = bf2f((u16)(r2.y >> 16));
    s += rv[i].x * rv[i].x + rv[i].y * rv[i].y + rv[i].z * rv[i].z + rv[i].w * rv[i].w;
  }
  s = red64(s);
  const float rr = rsqrtf(s * (1.0f / 1024.0f) + EPSF);
  float4 v[4];
  float ss = 0.f;
#pragma unroll
  for (int i = 0; i < 4; ++i) {
    const int c = i * 256 + lane * 4;
    const u32x2 h2 = ld_sc1_8(hb + c);
    const float4 g = *(const float4*)(gpost + c);
    v[i].x = bf2f((u16)(h2.x & 0xffff)) * xscale + rv[i].x * rr * g.x;
    v[i].y = bf2f((u16)(h2.x >> 16)) * xscale + rv[i].y * rr * g.y;
    v[i].z = bf2f((u16)(h2.y & 0xffff)) * xscale + rv[i].z * rr * g.z;
    v[i].w = bf2f((u16)(h2.y >> 16)) * xscale + rv[i].w * rr * g.w;
    ss += v[i].x * v[i].x + v[i].y * v[i].y + v[i].z * v[i].z + v[i].w * v[i].w;
  }
  ss = red64(ss);
  const float r = rsqrtf(ss * (1.0f / 1024.0f) + EPSF);
  if (lane == 0) *xsp = 1.0f / r;
  float* y = p.out + O_Y + (size_t)row * 1024;
#pragma unroll
  for (int i = 0; i < 4; ++i) {
    const int c = i * 256 + lane * 4;
    if (last) *(float4*)(y + c) = v[i];
    u32x2 o; o.x = pack2(v[i].x * r, v[i].y * r); o.y = pack2(v[i].z * r, v[i].w * r);
    *(u32x2*)(hb + c) = o;
  }
}

DI void cq_tile(const Params& p, int l, int t) {
  char* ws = p.ws;
  char* arena = ws + OFF_ARENA;
  const int rt = t >> 3, ct = t & 7, row0 = rt * 128, col0 = ct * 128;
  f32x4 acc[4][4];
  zero_acc(acc);
  u16* sA = (u16*)smem; u16* sB = sA + 128 * LDS_STRIDE;
  gemm_mainloop<128, 128, 2, 2>((const u16*)(ws + OFF_HB) + (size_t)row0 * 1024, 1024,
                                (const u16*)(ws + OFF_W) + (size_t)l * W_LAYER + W_CQ + (size_t)col0 * 1024, 1024, 1024, 1 << 30, acc, sA, sB, NoHook());
  tile_out_128(acc, (u16*)(arena + 3 * SLOT), 1024, row0, col0);
}

DI void att_task(const Params& p, int l, int t) {
  char* ws = p.ws;
  char* arena = ws + OFF_ARENA;
  const int tid = ltid(), lane = tid & 63, w = tid >> 6;
  int row0, h, nvalid;
  const u16 *KX, *VTX;
  if (t < 2048) {
    const int rt = t >> 2; h = t & 3; row0 = rt * 64; nvalid = 64;
    const int b = row0 >> 13;
    KX = (const u16*)(ws + OFF_KXP) + ((size_t)(l * 4 + b)) * 256 * 1024 + h * 256;
    VTX = (const u16*)(ws + OFF_VTXP) + ((size_t)((l * 4 + b) * 4 + h)) * 65536;
  } else {
    const int q = t - 2048, b = q >> 2; h = q & 3; row0 = PROWS + b * 16; nvalid = 16;
    KX = (const u16*)(ws + OFF_KXS) + (size_t)b * 256 * 1024 + h * 256;
    VTX = (const u16*)(ws + OFF_VTXS) + ((size_t)(b * 4 + h)) * 65536;
  }
  const u16* QX = (const u16*)(arena + 3 * SLOT);
  u16* OX = (u16*)(arena + 5 * SLOT);
#ifdef EXP_ATT_COPY
  for (int e = tid; e < nvalid * 256; e += NTHR) { const int r = e >> 8, c = e & 255; OX[(size_t)(row0 + r) * 1024 + h * 256 + c] = QX[(size_t)(row0 + r) * 1024 + h * 256 + c]; }
  return;
#endif
  const int arow0 = (row0 + 64 <= NTOK) ? row0 : (NTOK - 64);
  const int shift = row0 - arow0;
  u16* sA = (u16*)smem;
  u16* sB = (u16*)(smem + 34816);
  f32x4 acc[1][16];
  zero_acc(acc);
  gemm_mainloop<64, 256, 4, 1>(QX + (size_t)arow0 * 1024 + h * 256, 1024, KX, 1024, 256, 1 << 30, acc, sA, sB, NoHook());
  float inv[4];
#pragma unroll
  for (int j = 0; j < 4; ++j) {
    float mx = -3.0e38f;
#pragma unroll
    for (int n = 0; n < 16; ++n) mx = fmaxf(mx, acc[0][n][j]);
    mx = max16(mx);
    float s = 0.f;
#pragma unroll
    for (int n = 0; n < 16; ++n) { const float e = __expf(acc[0][n][j] - mx); acc[0][n][j] = e; s += e; }
    s = red16(s);
    inv[j] = 1.0f / s;
  }
  __syncthreads();
  u16* sP = (u16*)smem;
#pragma unroll
  for (int n = 0; n < 16; ++n)
#pragma unroll
    for (int j = 0; j < 4; ++j) sP[(w * 16 + (lane >> 4) * 4 + j) * 272 + n * 16 + (lane & 15)] = f2bf(acc[0][n][j] * inv[j]);
  zero_acc(acc);
  gemm_mainloop_alds<64, 256, 4, 1>(sP, 272, VTX, 256, 256, acc, sB);
#pragma unroll
  for (int n = 0; n < 16; ++n)
#pragma unroll
    for (int j = 0; j < 4; ++j) {
      const int rl = w * 16 + (lane >> 4) * 4 + j - shift;
      if (rl >= 0 && rl < nvalid) OX[(size_t)(row0 + rl) * 1024 + h * 256 + n * 16 + (lane & 15)] = f2bf(acc[0][n][j]);
    }
}

DI void gu_tile(const Params& p, int l, int t) {
  char* ws = p.ws;
  char* arena = ws + OFF_ARENA;
  const int rt = t / 44, ct = t % 44, row0 = rt * 128, col0 = ct * 128;
  f32x4 acc[4][4];
  zero_acc(acc);
  u16* sA = (u16*)smem; u16* sB = sA + 128 * LDS_STRIDE;
  gemm_mainloop<128, 128, 2, 2>((const u16*)(ws + OFF_HB) + (size_t)row0 * 1024, 1024,
                                (const u16*)(ws + OFF_W) + (size_t)l * W_LAYER + W_GU + (size_t)col0 * 1024, 1024, 1024, 1 << 30, acc, sA, sB, NoHook());
  const int tid = ltid(), lane = tid & 63, wid = tid >> 6, wm = wid >> 1, wn = wid & 1;
  u16* act = (u16*)(arena + 2 * SLOT);
  u16* sT = (u16*)smem;
  __syncthreads();
#pragma unroll
  for (int m = 0; m < 4; ++m)
#pragma unroll
    for (int np = 0; np < 2; ++np)
#pragma unroll
      for (int j = 0; j < 4; ++j)
        tile_put(sT, 72, wm * 64 + m * 16 + (lane >> 4) * 4 + j, wn * 32 + np * 16 + (lane & 15), siluf_(acc[m][2 * np][j]) * acc[m][2 * np + 1][j]);
  __syncthreads();
#pragma unroll
  for (int i = 0; i < 4; ++i) {
    const int id = tid + i * NTHR, r = id >> 3, c = (id & 7) * 8;
    *(u32x4*)(act + (size_t)(row0 + r) * DFF + (col0 >> 1) + c) = *(const u32x4*)(sT + r * 72 + c);
  }
}

DI void dbg_dump(const Params& p) {
#ifdef DUMP_SLOT
  const u16* src = (const u16*)(p.ws + OFF_ARENA + (size_t)DUMP_SLOT * SLOT);
  float* dst = p.out + O_Y;
  for (size_t i = (size_t)blockIdx.x * NTHR + threadIdx.x; i < (size_t)NTOK * 1024; i += (size_t)gridDim.x * NTHR) dst[i] = bf2f(src[i]);
#endif
#ifdef DUMP_HB
  const u16* src = (const u16*)(p.ws + OFF_HB);
  float* dst = p.out + O_Y;
  for (size_t i = (size_t)blockIdx.x * NTHR + threadIdx.x; i < (size_t)NTOK * 1024; i += (size_t)gridDim.x * NTHR) dst[i] = bf2f(src[i]);
#endif
}
#define PH_BEGIN { const int myph = ph++; const bool act_ = (myph >= p.ph_lo && myph < p.ph_hi); if (act_) { unsigned* c = &ctr[myph]; (void)c; phase_begin();
#define PH_END } if (act_ && myph + 1 < p.ph_hi) grid_barrier(bar); }

__global__ void __launch_bounds__(NTHR, 2) fwd_megakernel(Params p) {
  unsigned* bar = (unsigned*)(p.ws + OFF_BAR);
  unsigned* ctr = (unsigned*)(p.ws + OFF_CTR);
  if (threadIdx.x == 0) { g_xb[0] = 0u; g_xb[1] = 0u; g_xb[2] = 0u; g_xb[3] = 0u; }
  __syncthreads();
  if (USE_XCD_BARRIER) { if (threadIdx.x == 0) (void)xb_add(&bar[XB_XCNT(xb_xcc_id())], 1u); }
  if (p.never) cg::this_grid().sync();
  int ph = 0;
  char* ws = p.ws;
  char* arena = ws + OFF_ARENA;
#ifdef DUMP_AFTER
  if (p.ph_lo < 0) {
    const u16* src = (const u16*)(ws + DUMP_OFF);
    for (size_t j = (size_t)blockIdx.x * NTHR + threadIdx.x; j < (size_t)1048576; j += (size_t)gridDim.x * NTHR) {
      float acc = 0.f;
      size_t idx = (j * 131u) % DUMP_N;
      for (int k = 0; k < 512; ++k) {
        const float e = bf2f((u16)(src[idx] & 0xBFFF));
        acc = acc * 0.75f + e * (1.0f + 0.001f * (float)(k & 15));
        idx += 65537u; if (idx >= DUMP_N) idx -= DUMP_N;
      }
      float v = acc;
      for (int k = 0; k < 200; ++k) { v = bf2f(f2bf(v * 1.37f + 0.11f)); if (fabsf(v) > 4.f) v *= 0.125f; }
      p.out[O_Y + j] = v;
    }
    return;
  }
#endif
#ifdef EXP_CHAOS
  if (p.ph_lo == 0) {
    for (size_t i = (size_t)blockIdx.x * NTHR + threadIdx.x; i < (size_t)NTOK * 1024; i += (size_t)gridDim.x * NTHR) {
      float v = (i < (size_t)PROWS * 1024) ? p.x_prompt[i] : p.x_sample[i - (size_t)PROWS * 1024];
      float w = p.w_in[i % (4u * 1024u * 2560u)];
      for (int k = 0; k < 200; ++k) { v = bf2f(f2bf(v * 1.37f + w)); if (fabsf(v) > 4.f) v *= 0.125f; }
      p.out[O_Y + i] = v;
    }
  }
  return;
#endif

  PH_BEGIN
    phase_prep(p, c);
  PH_END

  for (int l_ = 0; l_ < DEPTHC; ++l_) {
    const int l = lsgpr(l_);
    const u16* wl = (const u16*)(ws + OFF_W) + (size_t)l * W_LAYER;
    PH_BEGIN
      const int n_g1 = 258 * 20, n_mk = (l == 0) ? 512 : 0, n_cc = 2048;
      for (;;) {
        int t = next_task(c);
        if (t >= n_g1 + n_mk + n_cc) break;
        if (t < n_g1) g1_tile(p, l, t);
        else if (t < n_g1 + n_mk) memkv_tile(p, t - n_g1);
        else cache_task(p, l, t - n_g1 - n_mk);
      }
    PH_END
    PH_BEGIN
      for (;;) {
        int t = next_task(c);
        if (t >= 256 + 512) break;
        if (t < 256) ret_local_task(p, t);
        else s5_task(p, l, t - 256, 0);
      }
    PH_END
    PH_BEGIN
      for (;;) {
        int t = next_task(c);
        if (t >= 320 + 640) break;
        if (t < 320) ret_final_task(p, l, t);
        else s5_task(p, l, t - 320, 1);
      }
    PH_END
    PH_BEGIN
      TASK_LOOP(c, 258 * 4, glu_tile(p, l, t))
    PH_END
    PH_BEGIN
      TASK_LOOP(c, 258 * 8, out_tile(p, l, t))
    PH_END
    PH_BEGIN
      for (int t = blockIdx.x; t < NTOK / 4; t += gridDim.x) { post_task(p, (const u16*)(arena + 1 * SLOT), p.mix_post + l * 1024, t, false); }
    PH_END
    PH_BEGIN
      TASK_LOOP(c, 258 * 8, cq_tile(p, l, t))
    PH_END
    PH_BEGIN
      TASK_LOOP(c, 2112, att_task(p, l, t))
    PH_END
    PH_BEGIN
      TASK_LOOP(c, 258 * 8, raw_tile(p, (const u16*)(arena + 5 * SLOT), 1024, wl + W_CO, 1024, (u16*)(arena + 1 * SLOT), t))
    PH_END
    PH_BEGIN
      for (int t = blockIdx.x; t < NTOK / 4; t += gridDim.x) { post_task(p, (const u16*)(arena + 1 * SLOT), p.xa_post + l * 1024, t, false); }
    PH_END
    PH_BEGIN
      TASK_LOOP(c, 258 * 44, gu_tile(p, l, t))
    PH_END
    PH_BEGIN
      TASK_LOOP(c, 258 * 8, raw_tile(p, (const u16*)(arena + 2 * SLOT), DFF, wl + W_DN, DFF, (u16*)(arena + 0 * SLOT), t))
    PH_END
    PH_BEGIN
      for (int t = blockIdx.x; t < NTOK / 4; t += gridDim.x) { post_task(p, (const u16*)(arena + 0 * SLOT), p.ffn_post + l * 1024, t, l == DEPTHC - 1); }
    PH_END
  }
}

#ifndef N_LAUNCH_SPLIT
#define N_LAUNCH_SPLIT 0
#endif
constexpr int N_PHASES = 1 + 13 * DEPTHC;

extern "C" void kernel_launch(void* const* d_in, const int* in_sizes, int n_in, void* d_out, int out_size, void* d_ws,
                              size_t ws_size, hipStream_t stream) {
  static int grid_blocks = 0;
  if (!grid_blocks) {
    int dev = 0, cus = 0, per_cu = 0;
    (void)hipGetDevice(&dev);
    (void)hipDeviceGetAttribute(&cus, hipDeviceAttributeMultiprocessorCount, dev);
    (void)hipOccupancyMaxActiveBlocksPerMultiprocessor(&per_cu, fwd_megakernel, NTHR, 0);
    if (per_cu > 2) per_cu = 2;
    if (per_cu < 1) per_cu = 1;
    grid_blocks = cus * per_cu;
  }
  if (ws_size < WS_NEEDED) fprintf(stderr, "workspace too small: %zu < %zu\n", ws_size, (size_t)WS_NEEDED);
  Params p{};
  const float** f = (const float**)&p;
  for (int i = 0; i < 36; ++i) f[i] = (const float*)d_in[i];
  p.out = (float*)d_out;
  p.ws = (char*)d_ws;
  p.never = 0;
  p.ph_lo = 0;
  p.ph_hi = N_PHASES;
  p.pad = 0;
  (void)hipMemsetAsync(d_ws, 0, 32768, stream);
  if (N_LAUNCH_SPLIT) {
#ifdef DUMP_AFTER
    const int nrun = DUMP_AFTER;
#else
    const int nrun = N_PHASES;
#endif
    for (int i = 0; i <= nrun; ++i) {
      if (i == nrun) {
#ifdef DUMP_AFTER
        p.ph_lo = -1; p.ph_hi = -1;
#else
        break;
#endif
      } else { p.ph_lo = i; p.ph_hi = i + 1; }
      void* args[] = {&p};
      hipError_t e = hipLaunchCooperativeKernel((void*)fwd_megakernel, dim3(grid_blocks), dim3(NTHR), args, 0, stream);
      if (e != hipSuccess) fprintf(stderr, "launch failed: %s (grid %d)\n", hipGetErrorString(e), grid_blocks);
    }
  } else {
    void* args[] = {&p};
    hipError_t e = hipLaunchCooperativeKernel((void*)fwd_megakernel, dim3(grid_blocks), dim3(NTHR), args, 0, stream);
    if (e != hipSuccess) fprintf(stderr, "cooperative launch failed: %s (grid %d)\n", hipGetErrorString(e), grid_blocks);
  }
}
```

```cpp
#include <hip/hip_runtime.h>
#include <hip/hip_bf16.h>
#include <hip/hip_cooperative_groups.h>
#include <stdint.h>
#include <stdio.h>
namespace cg = cooperative_groups;

typedef __attribute__((ext_vector_type(8))) short bf16x8;
typedef __attribute__((ext_vector_type(4))) float f32x4;
typedef unsigned short u16;
typedef __attribute__((ext_vector_type(4))) unsigned u32x4;
typedef __attribute__((ext_vector_type(2))) unsigned u32x2;
#define DI __device__ __forceinline__
#define MFMA16(a, b, c) __builtin_amdgcn_mfma_f32_16x16x32_bf16((a), (b), (c), 0, 0, 0)
#define MFMA_FENCE() do { __builtin_amdgcn_sched_barrier(0); asm volatile("s_nop 15\n\ts_nop 15" ::: "memory"); __builtin_amdgcn_sched_barrier(0); } while (0)

constexpr int NTOK = 33024, PROWS = 32768, DM = 1024, DFF = 2816, DEPTHC = 4;
constexpr int SEQ = 8192;
constexpr float EPSF = 1e-6f;
constexpr int NTHR = 256;
constexpr int LDS_STRIDE = 80;
constexpr int SMEM_BYTES = 76800;

constexpr size_t SLOT = (size_t)NTOK * 512 * 2;
constexpr size_t OFF_BAR = 0;
constexpr size_t OFF_CTR = 16384;
constexpr size_t OFF_W = 32768;
constexpr size_t W_IN = 0, W_GLU = W_IN + 2560 * 1024, W_OUT = W_GLU + 512 * 512, W_CQ = W_OUT + 1024 * 1024,
                 W_CK = W_CQ + 1024 * 1024, W_CV = W_CK + 1024 * 1024, W_CO = W_CV + 1024 * 1024,
                 W_GU = W_CO + 1024 * 1024, W_DN = W_GU + 5632 * 1024, W_LAYER = W_DN + 1024 * 2816;
constexpr size_t OFF_S5P = OFF_W + 4 * W_LAYER * 2;
constexpr size_t S5P_BBT = 0, S5P_CM = 131072, S5P_ABAR = 262144, S5P_LAYER = 278528;
constexpr size_t OFF_HB = OFF_S5P + 4 * S5P_LAYER;
constexpr size_t OFF_MEMB = OFF_HB + (size_t)NTOK * 1024 * 2;
constexpr size_t OFF_KXP = OFF_MEMB + 1024 * 1024 * 2;
constexpr size_t OFF_VTXP = OFF_KXP + 4 * 4 * 256 * 1024 * 2;
constexpr size_t OFF_KXS = OFF_VTXP + 4 * 4 * 256 * 1024 * 2;
constexpr size_t OFF_VTXS = OFF_KXS + 16 * 256 * 1024 * 2;
constexpr size_t OFF_SLOC = OFF_VTXS + 16 * 256 * 1024 * 2;
constexpr size_t OFF_ELOC = OFF_SLOC + 16 * 16 * 128 * 128 * 4;
constexpr size_t OFF_ZSQ = OFF_ELOC + 4 * 16 * 32 * 64 * 2 * 4;
constexpr size_t OFF_RSQ = OFF_ZSQ + (size_t)NTOK * 8 * 4;
constexpr size_t OFF_ARENA = OFF_RSQ + (size_t)NTOK * 16 * 4;
constexpr size_t WS_NEEDED = OFF_ARENA + 8 * SLOT;

constexpr size_t O_Y = 0, O_S5RE_P = 33816576, O_S5IM_P = 33849344, O_RET_P = 33882112, O_MK_P = 34930688,
                 O_MV_P = 39124992, O_S5RE_S = 43319296, O_S5IM_S = 43450368, O_RET_S = 43581440;

struct Params {
  const float *x_prompt, *x_sample, *mem_prompt, *s5re0, *s5im0, *ret0, *cmk, *cmv;
  const float *mix_pre, *mix_post, *w_in, *lam_re, *lam_im, *log_step, *b_re, *b_im, *c_re, *c_im, *s5_d, *w_glu,
      *b_glu, *s5_onorm, *ret_onorm, *w_out, *xa_pre, *xa_post, *mem_norm, *w_cq, *w_ck, *w_cv, *w_co, *ffn_pre,
      *ffn_post, *w_gate, *w_up, *w_down;
  float* out;
  char* ws;
  int never;
  int ph_lo;
  int ph_hi;
  int pad;
};

DI u16 f2bf(float f) {
  unsigned u = __float_as_uint(f);
  u += 0x7fffu + ((u >> 16) & 1u);
  return (u16)(u >> 16);
}
DI float bf2f(u16 h) { return __uint_as_float(((unsigned)h) << 16); }
DI unsigned pack2(float a, float b) { return (unsigned)f2bf(a) | ((unsigned)f2bf(b) << 16); }
DI float sigmoidf_(float x) { return 1.0f / (1.0f + __expf(-x)); }
DI float siluf_(float x) { return x * sigmoidf_(x); }
DI float geluf_(float x) {
  float t = 0.7978845608028654f * (x + 0.044715f * x * x * x);
  return 0.5f * x * (1.0f + tanhf(t));
}
DI float red16(float v) {
  v += __shfl_xor(v, 1); v += __shfl_xor(v, 2); v += __shfl_xor(v, 4); v += __shfl_xor(v, 8);
  return v;
}
DI float max16(float v) {
  v = fmaxf(v, __shfl_xor(v, 1)); v = fmaxf(v, __shfl_xor(v, 2)); v = fmaxf(v, __shfl_xor(v, 4)); v = fmaxf(v, __shfl_xor(v, 8));
  return v;
}
DI float red64(float v) {
  v = red16(v); v += __shfl_xor(v, 16); v += __shfl_xor(v, 32);
  return v;
}
DI void sincos_cw(float x, float* sn, float* cs) {
  const float k = rintf(x * 0.15915494309189535f);
  float r = fmaf(-k, 6.2831854820251465f, x);
  r = fmaf(-k, -1.7484555e-07f, r);
  *sn = __sinf(r); *cs = __cosf(r);
}
DI int ltid() { int x = threadIdx.x; asm volatile("" : "+v"(x)); return x; }
DI int lsgpr(int x) { asm volatile("" : "+s"(x)); return x; }
DI u32x4 ld_sc1_16(const void* p) {
  const unsigned long long* q = (const unsigned long long*)p;
  const unsigned long long a = __hip_atomic_load(q, __ATOMIC_RELAXED, __HIP_MEMORY_SCOPE_AGENT);
  const unsigned long long b = __hip_atomic_load(q + 1, __ATOMIC_RELAXED, __HIP_MEMORY_SCOPE_AGENT);
  return (u32x4){(unsigned)a, (unsigned)(a >> 32), (unsigned)b, (unsigned)(b >> 32)};
}
DI __amdgpu_buffer_rsrc_t mk_rsrc(const void* p) {
  const unsigned long long a = (unsigned long long)p;
  const unsigned lo = __builtin_amdgcn_readfirstlane((unsigned)a), hi = __builtin_amdgcn_readfirstlane((unsigned)(a >> 32));
  return __builtin_amdgcn_make_buffer_rsrc((void*)(((unsigned long long)hi << 32) | lo), 0, 0x7fffffff, 0x00020000);
}
DI u32x4 bld16(__amdgpu_buffer_rsrc_t r, unsigned voff, unsigned soff) { return __builtin_amdgcn_raw_buffer_load_b128(r, voff, soff, 16); }
DI u32x2 ld_sc1_8(const void* p) {
  const unsigned long long a = __hip_atomic_load((const unsigned long long*)p, __ATOMIC_RELAXED, __HIP_MEMORY_SCOPE_AGENT);
  return (u32x2){(unsigned)a, (unsigned)(a >> 32)};
}
DI u16 ld_sc1_2(const u16* p) { return __hip_atomic_load(p, __ATOMIC_RELAXED, __HIP_MEMORY_SCOPE_AGENT); }
DI float ld_sc1_f(const float* p) { return __hip_atomic_load(p, __ATOMIC_RELAXED, __HIP_MEMORY_SCOPE_AGENT); }
DI float gamma_l2(int h) { return log2f(1.0f - exp2f(-5.0f - (float)h)); }

#define XB_TMO 128
#define XB_XCNT(j) (256 + 64 * (j))
#define XB_XSUB(j) (1280 + 64 * (j))
#define XB_XGEN(j) (2304 + 64 * (j))
#define XB_TOP 3328
#define XB_TOPGEN 3392
#define XB_SPIN_CAP (1u << 26)
DI unsigned xb_ld(unsigned* p) { return __hip_atomic_load(p, __ATOMIC_RELAXED, __HIP_MEMORY_SCOPE_AGENT); }
DI unsigned xb_add(unsigned* p, unsigned v) { return __hip_atomic_fetch_add(p, v, __ATOMIC_RELAXED, __HIP_MEMORY_SCOPE_AGENT); }
DI unsigned xb_xcc_id() { return (unsigned)__builtin_amdgcn_s_getreg((3 << 11) | 20) & 0xFu; }
#define XB_SPIN(cond, bar) do { unsigned _sp = 0; while (cond) { __builtin_amdgcn_s_sleep(1); \
    if ((++_sp & 255u) == 0u) { if (xb_ld(&(bar)[XB_TMO])) break; if (_sp > XB_SPIN_CAP) { atomicAdd(&(bar)[XB_TMO], 1u); break; } } } } while (0)

__shared__ unsigned g_xb[4];
__shared__ __attribute__((aligned(16))) char smem[SMEM_BYTES];

DI void xcd_complete(unsigned* bar, unsigned x, unsigned& nloc, unsigned& nx) {
  const unsigned G = gridDim.x;
  unsigned sum, cnt, mine, sp = 0u;
  for (;;) {
    sum = 0u; cnt = 0u; mine = 0u;
#pragma unroll
    for (unsigned j = 0; j < 16; ++j) { const unsigned c = xb_ld(&bar[XB_XCNT(j)]); sum += c; cnt += (c > 0u) ? 1u : 0u; mine = (j == x) ? c : mine; }
    if (sum == G) break;
    __builtin_amdgcn_s_sleep(1);
    if ((++sp & 255u) == 0u) { if (xb_ld(&bar[XB_TMO])) break; if (sp > XB_SPIN_CAP) { atomicAdd(&bar[XB_TMO], 1u); break; } }
  }
  nloc = mine > 0u ? mine : 1u; nx = cnt > 0u ? cnt : 1u;
}
#ifndef USE_XCD_BARRIER
#define USE_XCD_BARRIER 1
#endif
DI void grid_barrier(unsigned* bar) {
  if (!USE_XCD_BARRIER) {
    asm volatile("s_waitcnt vmcnt(0)" ::: "memory");
    __syncthreads();
    if (threadIdx.x == 0) asm volatile("buffer_wbl2 sc0 sc1\n\ts_waitcnt vmcnt(0)" ::: "memory");
    cg::this_grid().sync();
    if (threadIdx.x == 0) asm volatile("buffer_inv sc0 sc1\n\ts_waitcnt vmcnt(0)" ::: "memory");
    __syncthreads();
    return;
  }
  asm volatile("s_waitcnt vmcnt(0)" ::: "memory");
  __syncthreads();
  if (threadIdx.x == 0) {
    __builtin_amdgcn_s_waitcnt(0);
    const unsigned xcc = xb_xcc_id();
    unsigned nloc = g_xb[0], nx = g_xb[1];
    if (nloc == 0u) { xcd_complete(bar, xcc, nloc, nx); g_xb[0] = nloc; g_xb[1] = nx; }
    const unsigned old = xb_add(&bar[XB_XSUB(xcc)], 1u);
    const unsigned gen = old / nloc;
    if (old + 1u == (gen + 1u) * nloc) {
      __builtin_amdgcn_fence(__ATOMIC_RELEASE, "agent");
      asm volatile("s_waitcnt vmcnt(0)" ::: "memory");
      const unsigned og = xb_add(&bar[XB_TOP], 1u);
      const unsigned tg = og / nx;
      if (og + 1u == (tg + 1u) * nx) xb_add(&bar[XB_TOPGEN], 1u);
      else XB_SPIN(xb_ld(&bar[XB_TOPGEN]) == tg, bar);
      __builtin_amdgcn_fence(__ATOMIC_ACQUIRE, "agent");
      xb_add(&bar[XB_XGEN(xcc)], 1u);
      asm volatile("s_waitcnt vmcnt(0)" ::: "memory");
    } else {
      XB_SPIN(xb_ld(&bar[XB_XGEN(xcc)]) == gen, bar);
      __builtin_amdgcn_fence(__ATOMIC_ACQUIRE, "agent");
      asm volatile("s_waitcnt vmcnt(0)" ::: "memory");
    }
  }
  __syncthreads();
}

#define DUMP_OFF (OFF_ELOC)
#define DUMP_N ((size_t)524288)
#define DUMP_F32 0
#ifndef MAXPH
#define MAXPH 10
#endif
#ifndef STATIC_SCHED
#define STATIC_SCHED 0
#endif
#ifndef ONE_XCD
#define ONE_XCD 0
#endif
DI int next_task(unsigned* ctr) {
  __syncthreads();
#ifdef LDS_NAN_PER_TASK
  __syncthreads();
#endif
  if (ONE_XCD) {
    if (threadIdx.x == 0) g_xb[2] = (xb_xcc_id() == 0u) ? atomicAdd(ctr, 1u) : 0x7fffffffu;
    __syncthreads();
    return (int)g_xb[2];
  }
  if (STATIC_SCHED) {
    if (threadIdx.x == 0) { unsigned it = g_xb[3]; g_xb[3] = it + 1u; g_xb[2] = blockIdx.x + it * gridDim.x; }
  } else {
    if (threadIdx.x == 0) g_xb[2] = atomicAdd(ctr, 1u);
  }
  __syncthreads();
  return (int)g_xb[2];
}
DI unsigned task_prefetch(unsigned* ctr) { unsigned v = 0u; if (threadIdx.x == 0) v = atomicAdd(ctr, 1u); return v; }
DI int task_commit(unsigned v) {
  __syncthreads();
  if (threadIdx.x == 0) g_xb[2] = v;
  __syncthreads();
  return (int)g_xb[2];
}
#define TASK_LOOP(ctr, N, BODY) { int t = next_task(ctr); while (t < (N)) { const unsigned tn_ = task_prefetch(ctr); BODY; t = task_commit(tn_); } }
DI void phase_begin() { __syncthreads(); if (threadIdx.x == 0) g_xb[3] = 0u; __syncthreads(); }

template <int BM, int BN, int WGM, int WGN, class Hook>
DI void gemm_mainloop(const u16* A, int lda, const u16* B, int ldb, int K, int kvalid,
                      f32x4 (&acc)[BM / WGM / 16][BN / WGN / 16], u16* sA, u16* sB, Hook hook) {
  constexpr int MT = BM / WGM / 16, NTL = BN / WGN / 16, CA = BM / 32, CB = BN / 32;
  const int tid = ltid(), lane = tid & 63, wid = tid >> 6, wm = wid / WGN, wn = wid % WGN;
  const __amdgpu_buffer_rsrc_t ra_ = mk_rsrc(A), rb_ = mk_rsrc(B);
  u32x4 ra0[CA], rb0[CB], ra1[CA], rb1[CB];
  unsigned va[CA], vb[CB];
  const u32x4 z4 = (u32x4){0u, 0u, 0u, 0u};
  const int cc0 = (tid & 7) * 8;
#pragma unroll
  for (int i = 0; i < CA; ++i) { const int r = (tid + i * NTHR) >> 3; va[i] = (unsigned)(r * lda + cc0) * 2u; }
#pragma unroll
  for (int i = 0; i < CB; ++i) { const int r = (tid + i * NTHR) >> 3; vb[i] = (unsigned)(r * ldb + cc0) * 2u; }
#define GM_LOAD(RA, RB, kn)                                                                          \
  {                                                                                                  \
    const bool kok = ((kn) + cc0) < kvalid;                                                          \
    _Pragma("unroll") for (int i = 0; i < CA; ++i) RA[i] = kok ? bld16(ra_, va[i], (unsigned)(kn) * 2u) : z4; \
    _Pragma("unroll") for (int i = 0; i < CB; ++i) RB[i] = kok ? bld16(rb_, vb[i], (unsigned)(kn) * 2u) : z4; \
  }
#define GM_STEP(RA, RB, kcur)                                                                        \
  {                                                                                                  \
    __syncthreads();                                                                                 \
    _Pragma("unroll") for (int i = 0; i < CA; ++i) { const int r = (tid + i * NTHR) >> 3; *(u32x4*)(sA + r * LDS_STRIDE + cc0) = RA[i]; } \
    _Pragma("unroll") for (int i = 0; i < CB; ++i) { const int r = (tid + i * NTHR) >> 3; *(u32x4*)(sB + r * LDS_STRIDE + cc0) = RB[i]; } \
    __syncthreads();                                                                                 \
    if ((kcur) + 128 < K) GM_LOAD(RA, RB, (kcur) + 128)                                              \
    _Pragma("unroll") for (int kk = 0; kk < 2; ++kk) {                                               \
      bf16x8 af[MT], bfr[NTL];                                                                       \
      _Pragma("unroll") for (int m = 0; m < MT; ++m) af[m] = *(const bf16x8*)(sA + (wm * (BM / WGM) + m * 16 + (lane & 15)) * LDS_STRIDE + kk * 32 + (lane >> 4) * 8); \
      _Pragma("unroll") for (int n = 0; n < NTL; ++n) bfr[n] = *(const bf16x8*)(sB + (wn * (BN / WGN) + n * 16 + (lane & 15)) * LDS_STRIDE + kk * 32 + (lane >> 4) * 8); \
      _Pragma("unroll") for (int m = 0; m < MT; ++m)                                                 \
        _Pragma("unroll") for (int n = 0; n < NTL; ++n) acc[m][n] = MFMA16(af[m], bfr[n], acc[m][n]); \
    }                                                                                                \
    hook((kcur), acc);                                                                               \
  }
  GM_LOAD(ra0, rb0, 0)
  if (64 < K) GM_LOAD(ra1, rb1, 64)
#pragma unroll 1
  for (int k0 = 0; k0 < K; k0 += 128) {
    GM_STEP(ra0, rb0, k0)
    GM_STEP(ra1, rb1, k0 + 64)
  }
  MFMA_FENCE();
#undef GM_LOAD
#undef GM_STEP
}
struct NoHook { template <class T> DI void operator()(int, T&) const {} };

template <int BM, int BN, int WGM, int WGN>
DI void gemm_mainloop_alds(const u16* sAimg, int lda_s, const u16* B, int ldb, int K,
                           f32x4 (&acc)[BM / WGM / 16][BN / WGN / 16], u16* sB) {
  constexpr int MT = BM / WGM / 16, NTL = BN / WGN / 16, CB = BN / 32;
  const int tid = ltid(), lane = tid & 63, wid = tid >> 6, wm = wid / WGN, wn = wid % WGN;
  const __amdgpu_buffer_rsrc_t rb_ = mk_rsrc(B);
  u32x4 rb0[CB], rb1[CB];
  unsigned vb[CB];
  const int cc0 = (tid & 7) * 8;
#pragma unroll
  for (int i = 0; i < CB; ++i) { const int r = (tid + i * NTHR) >> 3; vb[i] = (unsigned)(r * ldb + cc0) * 2u; }
#define GA_STEP(RB, kcur)                                                                            \
  {                                                                                                  \
    __syncthreads();                                                                                 \
    _Pragma("unroll") for (int i = 0; i < CB; ++i) { const int r = (tid + i * NTHR) >> 3; *(u32x4*)(sB + r * LDS_STRIDE + cc0) = RB[i]; } \
    __syncthreads();                                                                                 \
    if ((kcur) + 128 < K) { _Pragma("unroll") for (int i = 0; i < CB; ++i) RB[i] = bld16(rb_, vb[i], (unsigned)((kcur) + 128) * 2u); } \
    _Pragma("unroll") for (int kk = 0; kk < 2; ++kk) {                                               \
      bf16x8 af[MT], bfr[NTL];                                                                       \
      _Pragma("unroll") for (int m = 0; m < MT; ++m) af[m] = *(const bf16x8*)(sAimg + (wm * (BM / WGM) + m * 16 + (lane & 15)) * lda_s + (kcur) + kk * 32 + (lane >> 4) * 8); \
      _Pragma("unroll") for (int n = 0; n < NTL; ++n) bfr[n] = *(const bf16x8*)(sB + (wn * (BN / WGN) + n * 16 + (lane & 15)) * LDS_STRIDE + kk * 32 + (lane >> 4) * 8); \
      _Pragma("unroll") for (int m = 0; m < MT; ++m)                                                 \
        _Pragma("unroll") for (int n = 0; n < NTL; ++n) acc[m][n] = MFMA16(af[m], bfr[n], acc[m][n]); \
    }                                                                                                \
  }
#pragma unroll
  for (int i = 0; i < CB; ++i) rb0[i] = bld16(rb_, vb[i], 0u);
#pragma unroll
  for (int i = 0; i < CB; ++i) rb1[i] = bld16(rb_, vb[i], 128u);
#pragma unroll 1
  for (int k0 = 0; k0 < K; k0 += 128) {
    GA_STEP(rb0, k0)
    GA_STEP(rb1, k0 + 64)
  }
  MFMA_FENCE();
#undef GA_STEP
}

template <int MT, int NTL>
DI void zero_acc(f32x4 (&acc)[MT][NTL]) {
#pragma unroll
  for (int m = 0; m < MT; ++m)
#pragma unroll
    for (int n = 0; n < NTL; ++n) acc[m][n] = (f32x4){0.f, 0.f, 0.f, 0.f};
}

DI void tile_put(u16* sT, int stride, int r, int c, float v) { sT[r * stride + c] = f2bf(v); }
DI void tile_flush128(const u16* sT, u16* dst, int ld, int row0, int col0) {
  const int tid = ltid();
#pragma unroll
  for (int i = 0; i < 8; ++i) {
    const int id = tid + i * NTHR, r = id >> 4, c = (id & 15) * 8;
    *(u32x4*)(dst + (size_t)(row0 + r) * ld + col0 + c) = *(const u32x4*)(sT + r * 136 + c);
  }
}
DI void tile_out_128(const f32x4 (&v)[4][4], u16* dst, int ld, int row0, int col0) {
  u16* sT = (u16*)smem;
  const int lane = ltid() & 63, wid = ltid() >> 6, wm = wid >> 1, wn = wid & 1;
  __syncthreads();
#pragma unroll
  for (int m = 0; m < 4; ++m)
#pragma unroll
    for (int n = 0; n < 4; ++n)
#pragma unroll
      for (int j = 0; j < 4; ++j) tile_put(sT, 136, wm * 64 + m * 16 + (lane >> 4) * 4 + j, wn * 64 + n * 16 + (lane & 15), v[m][n][j]);
  __syncthreads();
  tile_flush128(sT, dst, ld, row0, col0);
}

DI int dst_row_map(int n, int mode) {
  if (mode == 0) return n;
  if (mode == 1) {
    if (n < 512 || n >= 1536) return n;
    int sec = n & ~127, d = n & 127;
    int xh = d >> 6, idx = d & 63;
    return sec + (((idx >> 4) * 2 + xh) << 4) + (idx & 15);
  }
  if (mode == 2) return (n >> 4) * 32 + (n & 15);
  return (n >> 4) * 32 + 16 + (n & 15);
}
DI void transpose_tile(const float* src, int lds_, int k0, int n0, u16* dst, int ldd,
                       const float* gain, int mode, float scale) {
  float* t = (float*)smem;
  const int tid = ltid(), ty = tid >> 4, tx = tid & 15;
  __syncthreads();
#pragma unroll
  for (int i = 0; i < 4; ++i) {
    int k = ty + 16 * i;
    float4 v = *(const float4*)(src + (size_t)(k0 + k) * lds_ + n0 + tx * 4);
    float g = gain ? gain[k0 + k] : 1.0f;
    t[k * 65 + tx * 4 + 0] = v.x * g; t[k * 65 + tx * 4 + 1] = v.y * g;
    t[k * 65 + tx * 4 + 2] = v.z * g; t[k * 65 + tx * 4 + 3] = v.w * g;
  }
  __syncthreads();
  const int nl = tid >> 2, ks = (tid & 3) * 16;
  const int n = n0 + nl;
  float sc = scale;
  if (mode == 1) sc = (n >= 512 && n < 1024) ? 0.08838834764831845f : 1.0f;
  unsigned w[8];
#pragma unroll
  for (int i = 0; i < 8; ++i) w[i] = pack2(t[(ks + 2 * i) * 65 + nl] * sc, t[(ks + 2 * i + 1) * 65 + nl] * sc);
  u16* d = dst + (size_t)dst_row_map(n, mode) * ldd + k0 + ks;
  *(u32x4*)d = (u32x4){w[0], w[1], w[2], w[3]};
  *(u32x4*)(d + 8) = (u32x4){w[4], w[5], w[6], w[7]};
}

DI void rownorm_task(const float* src, float* xs_out, u16* dst) {
  const int lane = ltid() & 63;
  float4 v[4];
  float ss = 0.f;
#pragma unroll
  for (int i = 0; i < 4; ++i) {
    v[i] = *(const float4*)(src + i * 256 + lane * 4);
    ss += v[i].x * v[i].x + v[i].y * v[i].y + v[i].z * v[i].z + v[i].w * v[i].w;
  }
  ss = red64(ss);
  const float r = rsqrtf(ss * (1.0f / 1024.0f) + EPSF);
  if (xs_out && lane == 0) *xs_out = 1.0f / r;
#pragma unroll
  for (int i = 0; i < 4; ++i) {
    u32x2 o; o.x = pack2(v[i].x * r, v[i].y * r); o.y = pack2(v[i].z * r, v[i].w * r);
    *(u32x2*)(dst + i * 256 + lane * 4) = o;
  }
}

DI void phase_prep(const Params& p, unsigned* ctr) {
  char* ws = p.ws;
  const int tid = ltid();
  constexpr int T_W = 16384, T_X = NTOK / 4, T_M = 256, T_S = 128;
  constexpr int TOT = T_W + T_X + T_M + T_S;
  for (int t = blockIdx.x; t < TOT; t += gridDim.x) {
    if (t < T_W) {
      const int l = t >> 12; int q = t & 4095;
      u16* wl = (u16*)(ws + OFF_W) + (size_t)l * W_LAYER;
      if (q < 640) {
        transpose_tile(p.w_in + (size_t)l * 1024 * 2560, 2560, (q / 40) * 64, (q % 40) * 64, wl + W_IN, 1024, p.mix_pre + l * 1024, 1, 1.0f);
      } else if ((q -= 640) < 64) {
        transpose_tile(p.w_glu + (size_t)l * 512 * 512, 512, (q / 8) * 64, (q % 8) * 64, wl + W_GLU, 512, nullptr, 0, 1.0f);
      } else if ((q -= 64) < 256) {
        const int k0 = (q / 16) * 64;
        const float* gain = (k0 < 512) ? (p.s5_onorm + l * 512) : (p.ret_onorm + l * 512 - 512);
        transpose_tile(p.w_out + (size_t)l * 1024 * 1024, 1024, k0, (q % 16) * 64, wl + W_OUT, 1024, gain, 0, 1.0f);
      } else if ((q -= 256) < 256) {
        transpose_tile(p.w_cq + (size_t)l * 1024 * 1024, 1024, (q / 16) * 64, (q % 16) * 64, wl + W_CQ, 1024, p.xa_pre + l * 1024, 0, 0.0625f);
      } else if ((q -= 256) < 256) {
        transpose_tile(p.w_ck + (size_t)l * 1024 * 1024, 1024, (q / 16) * 64, (q % 16) * 64, wl + W_CK, 1024, p.mem_norm + l * 1024, 0, 1.0f);
      } else if ((q -= 256) < 256) {
        transpose_tile(p.w_cv + (size_t)l * 1024 * 1024, 1024, (q / 16) * 64, (q % 16) * 64, wl + W_CV, 1024, p.mem_norm + l * 1024, 0, 1.0f);
      } else if ((q -= 256) < 256) {
        transpose_tile(p.w_co + (size_t)l * 1024 * 1024, 1024, (q / 16) * 64, (q % 16) * 64, wl + W_CO, 1024, nullptr, 0, 1.0f);
      } else if ((q -= 256) < 704) {
        transpose_tile(p.w_gate + (size_t)l * 1024 * 2816, 2816, (q / 44) * 64, (q % 44) * 64, wl + W_GU, 1024, p.ffn_pre + l * 1024, 2, 1.0f);
      } else if ((q -= 704) < 704) {
        transpose_tile(p.w_up + (size_t)l * 1024 * 2816, 2816, (q / 44) * 64, (q % 44) * 64, wl + W_GU, 1024, p.ffn_pre + l * 1024, 3, 1.0f);
      } else {
        q -= 704;
        transpose_tile(p.w_down + (size_t)l * 2816 * 1024, 1024, (q / 16) * 64, (q % 16) * 64, wl + W_DN, 2816, nullptr, 0, 1.0f);
      }
    } else if (t < T_W + T_X) {
      const int row = (t - T_W) * 4 + (tid >> 6);
      const float* src = (row < PROWS) ? p.x_prompt + (size_t)row * 1024 : p.x_sample + (size_t)(row - PROWS) * 1024;
      rownorm_task(src, (float*)(ws + OFF_RSQ) + row, (u16*)(ws + OFF_HB) + (size_t)row * 1024);
    } else if (t < T_W + T_X + T_M) {
      const int row = (t - T_W - T_X) * 4 + (tid >> 6);
      rownorm_task(p.mem_prompt + (size_t)row * 1024, nullptr, (u16*)(ws + OFF_MEMB) + (size_t)row * 1024);
    } else {
      const int lg = t - T_W - T_X - T_M, l = lg >> 5, g = lg & 31;
      char* sp = ws + OFF_S5P + (size_t)l * S5P_LAYER;
      u16* bbt = (u16*)(sp + S5P_BBT) + g * 2048;
      u16* cm = (u16*)(sp + S5P_CM) + g * 2048;
      float* ab = (float*)(sp + S5P_ABAR) + g * 128;
      const float dt = __expf(p.log_step[l * 32 + g]);
      for (int e = tid; e < 1024; e += NTHR) {
        const int pp = e >> 4, h = e & 15;
        const float lr = p.lam_re[(l * 32 + g) * 64 + pp], li = p.lam_im[(l * 32 + g) * 64 + pp];
        const float ar = lr * dt, ai = li * dt, mag = expf(ar);
        float sn_, cs_; sincos_cw(ai, &sn_, &cs_);
        const float abr = mag * cs_, abi = mag * sn_;
        const float den = lr * lr + li * li, nr = abr - 1.0f, ni = abi;
        const float fr = (nr * lr + ni * li) / den, fi = (ni * lr - nr * li) / den;
        const float br = p.b_re[((size_t)(l * 32 + g) * 64 + pp) * 16 + h], bi = p.b_im[((size_t)(l * 32 + g) * 64 + pp) * 16 + h];
        bbt[pp * 16 + h] = f2bf(fr * br - fi * bi);
        bbt[(64 + pp) * 16 + h] = f2bf(fr * bi + fi * br);
        if (h == 0) { ab[pp * 2] = abr; ab[pp * 2 + 1] = abi; }
        const int hh = e >> 6, kk = e & 63;
        cm[hh * 128 + kk] = f2bf(p.c_re[((size_t)(l * 32 + g) * 16 + hh) * 64 + kk]);
        cm[hh * 128 + 64 + kk] = f2bf(-p.c_im[((size_t)(l * 32 + g) * 16 + hh) * 64 + kk]);
      }
    }
  }
}

DI void memkv_tile(const Params& p, int t) {
  char* ws = p.ws;
  const int l = t >> 7, rt = (t >> 4) & 7, ct = t & 15;
  const int isv = ct >> 3, col0 = (ct & 7) * 128, row0 = rt * 128;
  const u16* A = (const u16*)(ws + OFF_MEMB) + (size_t)row0 * 1024;
  const u16* B = (const u16*)(ws + OFF_W) + (size_t)l * W_LAYER + (isv ? W_CV : W_CK) + (size_t)col0 * 1024;
  f32x4 acc[4][4];
  zero_acc(acc);
  u16* sA = (u16*)smem; u16* sB = sA + 128 * LDS_STRIDE;
  gemm_mainloop<128, 128, 2, 2>(A, 1024, B, 1024, 1024, 1 << 30, acc, sA, sB, NoHook());
  const int lane = ltid() & 63, wid = ltid() >> 6, wm = wid >> 1, wn = wid & 1;
  float* of = p.out + (isv ? O_MV_P : O_MK_P) + (size_t)l * 1024 * 1024;
  u16* kx = (u16*)(ws + OFF_KXP) + (size_t)l * 1024 * 1024;
  u16* vx = (u16*)(ws + OFF_VTXP) + (size_t)l * 1024 * 1024;
#pragma unroll
  for (int m = 0; m < 4; ++m)
#pragma unroll
    for (int n = 0; n < 4; ++n) {
      const int r = row0 + wm * 64 + m * 16 + (lane >> 4) * 4, c = col0 + wn * 64 + n * 16 + (lane & 15);
#pragma unroll
      for (int j = 0; j < 4; ++j) of[(size_t)(r + j) * 1024 + c] = acc[m][n][j];
      if (!isv) {
#pragma unroll
        for (int j = 0; j < 4; ++j) kx[(size_t)(r + j) * 1024 + c] = f2bf(acc[m][n][j]);
      } else {
        const int b = r >> 8, mm = r & 255, h = c >> 8, d = c & 255;
        u32x2 o; o.x = pack2(acc[m][n][0], acc[m][n][1]); o.y = pack2(acc[m][n][2], acc[m][n][3]);
        *(u32x2*)(vx + ((size_t)((b * 4 + h) * 256 + d)) * 256 + mm) = o;
      }
    }
}
DI void cache_task(const Params& p, int l, int t) {
  char* ws = p.ws;
  if (t < 1024) {
    const float* src = p.cmk + (size_t)l * 16 * 256 * 1024 + (size_t)t * 4096 + ltid() * 16;
    u16* dst = (u16*)(ws + OFF_KXS) + (size_t)t * 4096 + ltid() * 16;
    float4 a = *(const float4*)src, b = *(const float4*)(src + 4), c = *(const float4*)(src + 8), d = *(const float4*)(src + 12);
    *(u32x4*)dst = (u32x4){pack2(a.x, a.y), pack2(a.z, a.w), pack2(b.x, b.y), pack2(b.z, b.w)};
    *(u32x4*)(dst + 8) = (u32x4){pack2(c.x, c.y), pack2(c.z, c.w), pack2(d.x, d.y), pack2(d.z, d.w)};
  } else {
    t -= 1024;
    const int bh = t >> 4, q = t & 15, b = bh >> 2, h = bh & 3;
    const float* src = p.cmv + ((size_t)(l * 16 + b) * 256) * 1024 + h * 256;
    u16* dst = (u16*)(ws + OFF_VTXS) + (size_t)bh * 256 * 256;
    transpose_tile(src, 1024, (q >> 2) * 64, (q & 3) * 64, dst, 256, nullptr, 0, 1.0f);
  }
}

DI void g1_tile(const Params& p, int l, int t) {
  char* ws = p.ws;
  const int rt = t / 20, ct = t % 20;
  const int row0 = rt * 128, col0 = ct * 128;
  const u16* A = (const u16*)(ws + OFF_HB) + (size_t)row0 * 1024;
  const u16* B = (const u16*)(ws + OFF_W) + (size_t)l * W_LAYER + W_IN + (size_t)col0 * 1024;
  f32x4 acc[4][4];
  zero_acc(acc);
  u16* sA = (u16*)smem; u16* sB = sA + 128 * LDS_STRIDE;
  gemm_mainloop<128, 128, 2, 2>(A, 1024, B, 1024, 1024, 1 << 30, acc, sA, sB, NoHook());
  const int lane = ltid() & 63, wid = ltid() >> 6, wm = wid >> 1, wn = wid & 1;
  char* arena = ws + OFF_ARENA;
  const int sec = ct >> 2, hd = ct & 3;
  const bool samp = row0 >= PROWS;
  if (sec == 0 || sec == 4) {
    tile_out_128(acc, (u16*)(arena + (sec == 0 ? 0 : 3) * SLOT), 512, row0, hd * 128);
  } else if (sec == 3) {
    u16* vt = (u16*)(arena + 4 * SLOT);
#pragma unroll
    for (int m = 0; m < 4; ++m)
#pragma unroll
      for (int n = 0; n < 4; ++n) {
        const int r = row0 + wm * 64 + m * 16 + (lane >> 4) * 4, e = wn * 64 + n * 16 + (lane & 15);
        u32x2 o; o.x = pack2(acc[m][n][0], acc[m][n][1]); o.y = pack2(acc[m][n][2], acc[m][n][3]);
        size_t off;
        if (!samp) { const int b = r >> 13, tt = r & 8191; off = ((size_t)((b * 4 + hd) * 128 + e)) * SEQ + tt; }
        else { const int sr = r - PROWS, b = sr >> 4, tt = sr & 15; off = (size_t)16 * 128 * SEQ + ((size_t)((b * 4 + hd) * 128 + e)) * 16 + tt; }
        *(u32x2*)(vt + off) = o;
      }
  } else {
    u16* dst = (u16*)(arena + (sec == 1 ? 1 : 2) * SLOT);
    u16* ktd = (u16*)(arena + 5 * SLOT);
    const float gl2 = gamma_l2(hd);
    u16* sT = (u16*)smem;
    __syncthreads();
#pragma unroll
    for (int m = 0; m < 4; ++m)
#pragma unroll
      for (int np = 0; np < 2; ++np) {
        const int r = row0 + wm * 64 + m * 16 + (lane >> 4) * 4;
        const int idx = (wn * 2 + np) * 16 + (lane & 15);
        const float inv = exp2f(-(float)idx * (13.287712379549449f / 64.0f));
        float o1[4], o2[4];
#pragma unroll
        for (int j = 0; j < 4; ++j) {
          const int rr = r + j;
          const int pos = samp ? (1024 + ((rr - PROWS) & 15)) : (rr & 8191);
          float sn, cs;
          sincos_cw((float)pos * inv, &sn, &cs);
          const float x1 = acc[m][2 * np][j], x2 = acc[m][2 * np + 1][j];
          o1[j] = x1 * cs - x2 * sn; o2[j] = x1 * sn + x2 * cs;
          tile_put(sT, 136, rr - row0, idx, o1[j]);
          tile_put(sT, 136, rr - row0, 64 + idx, o2[j]);
        }
        if (sec == 2) {
          size_t off1; int tloc;
          if (!samp) { const int b = r >> 13, tt = r & 8191; off1 = ((size_t)((b * 4 + hd) * 128 + idx)) * SEQ + tt; tloc = 63 - (tt & 63); }
          else { const int sr = r - PROWS, b = sr >> 4, tt = sr & 15; off1 = (size_t)16 * 128 * SEQ + ((size_t)((b * 4 + hd) * 128 + idx)) * 16 + tt; tloc = 15 - tt; }
          const size_t off2 = off1 + (size_t)64 * (samp ? 16 : SEQ);
          float dc[4];
#pragma unroll
          for (int j = 0; j < 4; ++j) dc[j] = exp2f(gl2 * (float)(tloc - j));
          u32x2 a, b2;
          a.x = pack2(o1[0] * dc[0], o1[1] * dc[1]); a.y = pack2(o1[2] * dc[2], o1[3] * dc[3]);
          b2.x = pack2(o2[0] * dc[0], o2[1] * dc[1]); b2.y = pack2(o2[2] * dc[2], o2[3] * dc[3]);
          *(u32x2*)(ktd + off1) = a;
          *(u32x2*)(ktd + off2) = b2;
        }
      }
    __syncthreads();
    tile_flush128(sT, dst, 512, row0, hd * 128);
  }
}

struct DecayHook {
  float g64;
  template <class T> DI void operator()(int k0, T& acc) const {
    if (k0 + 64 < 512) {
#pragma unroll
      for (int m = 0; m < 4; ++m)
#pragma unroll
        for (int n = 0; n < 4; ++n) acc[m][n] *= g64;
    }
  }
};
DI void ret_local_task(const Params& p, int t) {
  char* ws = p.ws;
  char* arena = ws + OFF_ARENA;
  const int bh = t >> 4, sc = t & 15, h = bh & 3;
  const u16* A = (const u16*)(arena + 5 * SLOT) + (size_t)bh * 128 * SEQ + sc * 512;
  const u16* B = (const u16*)(arena + 4 * SLOT) + (size_t)bh * 128 * SEQ + sc * 512;
  f32x4 acc[4][4];
  zero_acc(acc);
  u16* sA = (u16*)smem; u16* sB = sA + 128 * LDS_STRIDE;
  DecayHook hk; hk.g64 = exp2f(gamma_l2(h) * 64.0f);
  gemm_mainloop<128, 128, 2, 2>(A, SEQ, B, SEQ, 512, 1 << 30, acc, sA, sB, hk);
  const int lane = ltid() & 63, wid = ltid() >> 6, wm = wid >> 1, wn = wid & 1;
  float* dst = (float*)(ws + OFF_SLOC) + (size_t)t * 16384;
#pragma unroll
  for (int m = 0; m < 4; ++m)
#pragma unroll
    for (int n = 0; n < 4; ++n) {
      const int r = wm * 64 + m * 16 + (lane >> 4) * 4, c = wn * 64 + n * 16 + (lane & 15);
#pragma unroll
      for (int j = 0; j < 4; ++j) dst[(r + j) * 128 + c] = acc[m][n][j];
    }
}

DI void ret_final_task(const Params& p, int l, int t) {
  char* ws = p.ws;
  char* arena = ws + OFF_ARENA;
  const int tid = ltid(), lane = tid & 63, w = tid >> 6;
  const bool samp = t >= 256;
  int bh, sc, nchunk, C, row_base;
  size_t tr_base; int tr_ld;
  if (!samp) { bh = t >> 4; sc = t & 15; nchunk = 8; C = 64; row_base = (bh >> 2) * SEQ + sc * 512; tr_base = (size_t)bh * 128 * SEQ + sc * 512; tr_ld = SEQ; }
  else { bh = t - 256; sc = 0; nchunk = 1; C = 16; row_base = PROWS + (bh >> 2) * 16; tr_base = (size_t)16 * 128 * SEQ + (size_t)bh * 128 * 16; tr_ld = 16; }
  const int h = bh & 3;
  const float gl2 = gamma_l2(h);
  const float gC = exp2f(gl2 * (float)C);
  const u16* Qg = (const u16*)(arena + 1 * SLOT);
  const u16* Kg = (const u16*)(arena + 2 * SLOT);
  const u16* Gg = (const u16*)(arena + 3 * SLOT);
  const u16* Vt = (const u16*)(arena + 4 * SLOT) + tr_base;
  const u16* Ktd = (const u16*)(arena + 5 * SLOT) + tr_base;
  u16* reto = (u16*)(arena + 7 * SLOT);
  u16* sQ = (u16*)smem;
  u16* sK = sQ + 64 * 144;
  u16* sV = sK + 128 * LDS_STRIDE;
  u16* sS = sV + 128 * LDS_STRIDE;
  float* sR = (float*)(sS + 64 * LDS_STRIDE);

  f32x4 S[8][2];
  if (samp) {
    const float* s0 = p.ret0 + ((size_t)(l * 64 + bh)) * 16384;
#pragma unroll
    for (int mt = 0; mt < 8; ++mt)
#pragma unroll
      for (int nt = 0; nt < 2; ++nt)
#pragma unroll
        for (int j = 0; j < 4; ++j) S[mt][nt][j] = s0[(mt * 16 + (lane >> 4) * 4 + j) * 128 + 32 * w + nt * 16 + (lane & 15)];
  } else {
#pragma unroll
    for (int mt = 0; mt < 8; ++mt)
#pragma unroll
      for (int nt = 0; nt < 2; ++nt) S[mt][nt] = (f32x4){0.f, 0.f, 0.f, 0.f};
    const float g512 = exp2f(gl2 * 512.0f);
    for (int s2 = 0; s2 < sc; ++s2) {
      const float* sl = (const float*)(ws + OFF_SLOC) + ((size_t)(bh * 16 + s2)) * 16384;
#pragma unroll
      for (int mt = 0; mt < 8; ++mt)
#pragma unroll
        for (int nt = 0; nt < 2; ++nt)
#pragma unroll
          for (int j = 0; j < 4; ++j)
            S[mt][nt][j] = S[mt][nt][j] * g512 + ld_sc1_f(sl + (mt * 16 + (lane >> 4) * 4 + j) * 128 + 32 * w + nt * 16 + (lane & 15));
    }
  }
  const u32x4 z4 = (u32x4){0, 0, 0, 0};
  for (int c = 0; c < nchunk; ++c) {
    const int r0 = row_base + c * 64;
    __syncthreads();
#pragma unroll
    for (int i = 0; i < 4; ++i) {
      const int id = tid + i * NTHR, r = id >> 4, cc = (id & 15) * 8;
      u32x4 q4 = z4, k4 = z4;
      if (r < C) {
        q4 = ld_sc1_16(Qg + (size_t)(r0 + r) * 512 + h * 128 + cc);
        k4 = ld_sc1_16(Kg + (size_t)(r0 + r) * 512 + h * 128 + cc);
      }
      *(u32x4*)(sQ + r * 144 + cc) = q4;
      *(u32x4*)(sK + r * 144 + cc) = k4;
    }
#pragma unroll
    for (int i = 0; i < 4; ++i) {
      const int id = tid + i * NTHR, r = id >> 3, cc = (id & 7) * 8;
      u32x4 v4 = z4;
      if (cc < C) v4 = ld_sc1_16(Vt + (size_t)r * tr_ld + c * 64 + cc);
      *(u32x4*)(sV + r * LDS_STRIDE + cc) = v4;
    }
    __syncthreads();
    {
      f32x4 sc4[4];
#pragma unroll
      for (int m = 0; m < 4; ++m) sc4[m] = (f32x4){0.f, 0.f, 0.f, 0.f};
#pragma unroll
      for (int ks = 0; ks < 4; ++ks) {
        const bf16x8 bk = *(const bf16x8*)(sK + (16 * w + (lane & 15)) * 144 + ks * 32 + (lane >> 4) * 8);
#pragma unroll
        for (int m = 0; m < 4; ++m) {
          const bf16x8 aq = *(const bf16x8*)(sQ + (m * 16 + (lane & 15)) * 144 + ks * 32 + (lane >> 4) * 8);
          sc4[m] = MFMA16(aq, bk, sc4[m]);
        }
      }
      MFMA_FENCE();
      const int jc = 16 * w + (lane & 15);
#pragma unroll
      for (int m = 0; m < 4; ++m)
#pragma unroll
        for (int j = 0; j < 4; ++j) {
          const int i = m * 16 + (lane >> 4) * 4 + j;
          const int dd = i > jc ? i - jc : jc - i;
          sS[i * LDS_STRIDE + jc] = f2bf(sc4[m][j] * exp2f(gl2 * (float)dd));
        }
    }
    __syncthreads();
#pragma unroll
    for (int i = 0; i < 4; ++i) {
      const int id = tid + i * NTHR, r = id >> 3, cc = (id & 7) * 8;
      u32x4 v4 = z4;
      if (cc < C) v4 = ld_sc1_16(Ktd + (size_t)r * tr_ld + c * 64 + cc);
      *(u32x4*)(sK + r * LDS_STRIDE + cc) = v4;
    }
    f32x4 o[4][2];
#pragma unroll
    for (int m = 0; m < 4; ++m) { o[m][0] = (f32x4){0.f, 0.f, 0.f, 0.f}; o[m][1] = o[m][0]; }
#pragma unroll
    for (int a = 0; a < 4; ++a) {
      bf16x8 bs[2];
#pragma unroll
      for (int nt = 0; nt < 2; ++nt) {
        u32x4 u;
        u.x = pack2(S[2 * a][nt][0], S[2 * a][nt][1]); u.y = pack2(S[2 * a][nt][2], S[2 * a][nt][3]);
        u.z = pack2(S[2 * a + 1][nt][0], S[2 * a + 1][nt][1]); u.w = pack2(S[2 * a + 1][nt][2], S[2 * a + 1][nt][3]);
        bs[nt] = __builtin_bit_cast(bf16x8, u);
      }
#pragma unroll
      for (int m = 0; m < 4; ++m) {
        const u16* qp = sQ + (m * 16 + (lane & 15)) * 144 + (lane >> 4) * 4;
        const u32x2 lo = *(const u32x2*)(qp + (2 * a) * 16);
        const u32x2 hi = *(const u32x2*)(qp + (2 * a + 1) * 16);
        const bf16x8 aq = __builtin_bit_cast(bf16x8, ((u32x4){lo.x, lo.y, hi.x, hi.y}));
        o[m][0] = MFMA16(aq, bs[0], o[m][0]);
        o[m][1] = MFMA16(aq, bs[1], o[m][1]);
      }
      __builtin_amdgcn_sched_barrier(0);
    }
    MFMA_FENCE();
#pragma unroll
    for (int m = 0; m < 4; ++m)
#pragma unroll
      for (int j = 0; j < 4; ++j) {
        const int i = m * 16 + (lane >> 4) * 4 + j;
        const float f = exp2f(gl2 * (float)(i + 1));
        o[m][0][j] *= f;
        o[m][1][j] *= f;
      }
#pragma unroll
    for (int ks = 0; ks < 2; ++ks) {
      bf16x8 bv[2];
#pragma unroll
      for (int nt = 0; nt < 2; ++nt) bv[nt] = *(const bf16x8*)(sV + (32 * w + nt * 16 + (lane & 15)) * LDS_STRIDE + ks * 32 + (lane >> 4) * 8);
#pragma unroll
      for (int m = 0; m < 4; ++m) {
        const bf16x8 as = *(const bf16x8*)(sS + (m * 16 + (lane & 15)) * LDS_STRIDE + ks * 32 + (lane >> 4) * 8);
        o[m][0] = MFMA16(as, bv[0], o[m][0]);
        o[m][1] = MFMA16(as, bv[1], o[m][1]);
      }
      __builtin_amdgcn_sched_barrier(0);
    }
    MFMA_FENCE();
#pragma unroll
    for (int m = 0; m < 4; ++m)
#pragma unroll
      for (int j = 0; j < 4; ++j) {
        float v = o[m][0][j] * o[m][0][j] + o[m][1][j] * o[m][1][j];
        v = red16(v);
        if ((lane & 15) == 0) sR[w * 64 + m * 16 + (lane >> 4) * 4 + j] = v;
      }
    __syncthreads();
#pragma unroll
    for (int m = 0; m < 4; ++m)
#pragma unroll
      for (int j = 0; j < 4; ++j) {
        const int i = m * 16 + (lane >> 4) * 4 + j;
        if (i < C) {
          const float ss = sR[i] + sR[64 + i] + sR[128 + i] + sR[192 + i];
          const float rs = rsqrtf(ss * (1.0f / 128.0f) + EPSF);
#pragma unroll
          for (int nt = 0; nt < 2; ++nt) {
            const int e = 32 * w + nt * 16 + (lane & 15);
            const float g = bf2f(ld_sc1_2(Gg + (size_t)(r0 + i) * 512 + h * 128 + e));
            reto[(size_t)(r0 + i) * 512 + h * 128 + e] = f2bf(o[m][nt][j] * rs * siluf_(g));
          }
        }
      }
#pragma unroll
    for (int mt = 0; mt < 8; ++mt) { S[mt][0] *= gC; S[mt][1] *= gC; }
#pragma unroll 1
    for (int ks = 0; ks < 2; ++ks) {
      bf16x8 bv[2];
#pragma unroll
      for (int nt = 0; nt < 2; ++nt) bv[nt] = *(const bf16x8*)(sV + (32 * w + nt * 16 + (lane & 15)) * LDS_STRIDE + ks * 32 + (lane >> 4) * 8);
#pragma unroll
      for (int mt = 0; mt < 8; ++mt) {
        const bf16x8 ak = *(const bf16x8*)(sK + (mt * 16 + (lane & 15)) * LDS_STRIDE + ks * 32 + (lane >> 4) * 8);
        S[mt][0] = MFMA16(ak, bv[0], S[mt][0]);
        S[mt][1] = MFMA16(ak, bv[1], S[mt][1]);
      }
    }
    MFMA_FENCE();
  }
  if (samp || sc == 15) {
    float* so = samp ? (p.out + O_RET_S + ((size_t)(l * 64 + bh)) * 16384) : (p.out + O_RET_P + ((size_t)(l * 16 + bh)) * 16384);
#pragma unroll
    for (int mt = 0; mt < 8; ++mt)
#pragma unroll
      for (int nt = 0; nt < 2; ++nt)
#pragma unroll
        for (int j = 0; j < 4; ++j) so[(mt * 16 + (lane >> 4) * 4 + j) * 128 + 32 * w + nt * 16 + (lane & 15)] = S[mt][nt][j];
  }
}

DI void s5_task(const Params& p, int l, int t, int mode) {
  char* ws = p.ws;
  char* arena = ws + OFF_ARENA;
  const int tid = ltid(), lane = tid & 63, w = tid >> 6;
  const bool samp = t >= 512;
  int b, lc, g, row_base, nsub;
  if (!samp) { b = t >> 7; lc = (t >> 3) & 15; g = (t & 7) * 4 + w; row_base = b * SEQ + lc * 512; nsub = 32; }
  else { const int q = t - 512; b = q >> 3; lc = 0; g = (q & 7) * 4 + w; row_base = PROWS + b * 16; nsub = 1; }
  const char* sp = ws + OFF_S5P + (size_t)l * S5P_LAYER;
  const u16* bbt = (const u16*)(sp + S5P_BBT) + g * 2048;
  const u16* cm = (const u16*)(sp + S5P_CM) + g * 2048;
  const float* ab = (const float*)(sp + S5P_ABAR) + g * 128;
  const u16* U = (const u16*)(arena + 0 * SLOT);
  u16* Z = (u16*)(arena + 6 * SLOT);
  float* bu = (float*)(smem + w * 13056);
  u16* xs = (u16*)(smem + w * 13056 + 8448);
  const float ar = ld_sc1_f(ab + lane * 2), ai = ld_sc1_f(ab + lane * 2 + 1);
  const int slab = lane >> 4;
  const u32x4 z4 = (u32x4){0, 0, 0, 0};
  bf16x8 Bf[8], Cf[4];
#pragma unroll
  for (int nt = 0; nt < 8; ++nt) {
    u32x4 u = z4;
    if (slab < 2) u = ld_sc1_16(bbt + (nt * 16 + (lane & 15)) * 16 + slab * 8);
    Bf[nt] = __builtin_bit_cast(bf16x8, u);
  }
#pragma unroll
  for (int ks = 0; ks < 4; ++ks) Cf[ks] = __builtin_bit_cast(bf16x8, ld_sc1_16(cm + (lane & 15) * 128 + ks * 32 + slab * 8));
  const float Dh = p.s5_d[(l * 32 + g) * 16 + (lane & 15)];
  float xr = 0.f, xi = 0.f;
  if (samp) {
    xr = p.s5re0[((size_t)(l * 16 + b) * 32 + g) * 64 + lane];
    xi = p.s5im0[((size_t)(l * 16 + b) * 32 + g) * 64 + lane];
  } else if (mode == 1 && lc > 0) {
    float pr = ar, pi = ai;
#pragma unroll
    for (int s = 0; s < 9; ++s) { const float nr = pr * pr - pi * pi, ni = 2.f * pr * pi; pr = nr; pi = ni; }
    const float* el = (const float*)(ws + OFF_ELOC);
    for (int c2 = 0; c2 < lc; ++c2) {
      const float er = ld_sc1_f(el + (((size_t)(b * 16 + c2) * 32 + g) * 64 + lane) * 2), ei = ld_sc1_f(el + (((size_t)(b * 16 + c2) * 32 + g) * 64 + lane) * 2 + 1);
      const float nr = pr * xr - pi * xi + er, ni = pr * xi + pi * xr + ei;
      xr = nr; xi = ni;
    }
  }
  u16* usm = (u16*)(smem + 52224 + w * 512);
  const u16* up = U + (size_t)(row_base + (lane & 15)) * 512 + g * 16 + (slab & 1) * 8;
  u32x4 ua = ld_sc1_16(up);
  for (int sub = 0; sub < nsub; ++sub) {
    const int r0 = row_base + sub * 16;
    u32x4 un = z4;
    if (sub + 1 < nsub) un = ld_sc1_16(up + (size_t)(sub + 1) * 16 * 512);
    if (slab >= 2) ua = z4;
    const bf16x8 Af = __builtin_bit_cast(bf16x8, ua);
    __syncthreads();
    if (mode == 1 && slab < 2) *(u32x4*)(usm + (lane & 15) * 16 + slab * 8) = ua;
    f32x4 a8[8];
#pragma unroll
    for (int nt = 0; nt < 8; ++nt) a8[nt] = MFMA16(Af, Bf[nt], ((f32x4){0.f, 0.f, 0.f, 0.f}));
    __builtin_amdgcn_sched_barrier(0);
    asm volatile("s_nop 15\n\ts_nop 15\n\ts_nop 15" ::: "memory");
    __builtin_amdgcn_sched_barrier(0);
#pragma unroll
    for (int nt = 0; nt < 8; ++nt) {
#pragma unroll
      for (int j = 0; j < 4; ++j) bu[(slab * 4 + j) * 132 + nt * 16 + (lane & 15)] = a8[nt][j];
    }
    __syncthreads();
#pragma unroll
    for (int tt = 0; tt < 16; ++tt) {
      const float br = bu[tt * 132 + lane], bi = bu[tt * 132 + 64 + lane];
      const float nr = ar * xr - ai * xi + br, ni = ar * xi + ai * xr + bi;
      xr = nr; xi = ni;
      if (mode == 1) { xs[tt * 144 + lane] = f2bf(xr); xs[tt * 144 + 64 + lane] = f2bf(xi); }
    }
    if (mode == 1) {
      __syncthreads();
      f32x4 y = (f32x4){0.f, 0.f, 0.f, 0.f};
#pragma unroll
      for (int ks = 0; ks < 4; ++ks) {
        const bf16x8 ax = *(const bf16x8*)(xs + (lane & 15) * 144 + ks * 32 + slab * 8);
        y = MFMA16(ax, Cf[ks], y);
      }
      __builtin_amdgcn_sched_barrier(0);
      asm volatile("s_nop 15\n\ts_nop 15" ::: "memory");
      __builtin_amdgcn_sched_barrier(0);
#pragma unroll
      for (int j = 0; j < 4; ++j) {
        const int rr = r0 + slab * 4 + j, cc = g * 16 + (lane & 15);
        const float u = bf2f(usm[(slab * 4 + j) * 16 + (lane & 15)]);
        Z[(size_t)rr * 512 + cc] = f2bf(geluf_(y[j] + Dh * u));
      }
    }
    ua = un;
  }
  if (mode == 0) {
    float* el = (float*)(ws + OFF_ELOC);
    el[(((size_t)(b * 16 + lc) * 32 + g) * 64 + lane) * 2] = xr;
    el[(((size_t)(b * 16 + lc) * 32 + g) * 64 + lane) * 2 + 1] = xi;
  } else if (samp) {
    p.out[O_S5RE_S + ((size_t)(l * 16 + b) * 32 + g) * 64 + lane] = xr;
    p.out[O_S5IM_S + ((size_t)(l * 16 + b) * 32 + g) * 64 + lane] = xi;
  } else if (lc == 15) {
    p.out[O_S5RE_P + ((size_t)(l * 4 + b) * 32 + g) * 64 + lane] = xr;
    p.out[O_S5IM_P + ((size_t)(l * 4 + b) * 32 + g) * 64 + lane] = xi;
  }
}

DI void glu_tile(const Params& p, int l, int t) {
  char* ws = p.ws;
  char* arena = ws + OFF_ARENA;
  const int rt = t >> 2, ct = t & 3, row0 = rt * 128, col0 = ct * 128;
  const u16* Zb = (const u16*)(arena + 6 * SLOT);
  const u16* A = Zb + (size_t)row0 * 512;
  const u16* B = (const u16*)(ws + OFF_W) + (size_t)l * W_LAYER + W_GLU + (size_t)col0 * 512;
  f32x4 acc[4][4];
  zero_acc(acc);
  u16* sA = (u16*)smem; u16* sB = sA + 128 * LDS_STRIDE;
  gemm_mainloop<128, 128, 2, 2>(A, 512, B, 512, 512, 1 << 30, acc, sA, sB, NoHook());
  const int lane = ltid() & 63, wid = ltid() >> 6, wm = wid >> 1, wn = wid & 1;
  u16* Z2 = (u16*)(arena + 0 * SLOT);
  float* zsq = (float*)(ws + OFF_ZSQ);
  const float* bg = p.b_glu + l * 512;
  u16* sT = (u16*)smem;
  __syncthreads();
  {
    const int tq = ltid();
#pragma unroll
    for (int i = 0; i < 8; ++i) {
      const int id = tq + i * NTHR, rr = id >> 4, cc = (id & 15) * 8;
      *(u32x4*)(sT + rr * 136 + cc) = ld_sc1_16(Zb + (size_t)(row0 + rr) * 512 + col0 + cc);
    }
  }
  __syncthreads();
#pragma unroll
  for (int m = 0; m < 4; ++m) {
    float ss[4] = {0.f, 0.f, 0.f, 0.f};
    const int rl = wm * 64 + m * 16 + (lane >> 4) * 4;
#pragma unroll
    for (int n = 0; n < 4; ++n) {
      const int cl = wn * 64 + n * 16 + (lane & 15);
      const float bb = bg[col0 + cl];
#pragma unroll
      for (int j = 0; j < 4; ++j) {
        const float z = bf2f(sT[(rl + j) * 136 + cl]);
        const float z2 = z * sigmoidf_(acc[m][n][j] + bb);
        ss[j] += z2 * z2;
        sT[(rl + j) * 136 + cl] = f2bf(z2);
      }
    }
#pragma unroll
    for (int j = 0; j < 4; ++j) {
      const float v = red16(ss[j]);
      if ((lane & 15) == 0) zsq[(size_t)(ct * 2 + wn) * NTOK + row0 + rl + j] = v;
    }
  }
  __syncthreads();
  tile_flush128(sT, Z2, 512, row0, col0);
}

DI void store_raw_rsq(const f32x4 (&acc)[4][4], u16* raw, float* rsq, int row0, int col0, int ct) {
  tile_out_128(acc, raw, 1024, row0, col0);
}

DI void out_tile(const Params& p, int l, int t) {
  char* ws = p.ws;
  char* arena = ws + OFF_ARENA;
  const int rt = t >> 3, ct = t & 7, row0 = rt * 128, col0 = ct * 128;
  const u16* B = (const u16*)(ws + OFF_W) + (size_t)l * W_LAYER + W_OUT + (size_t)col0 * 1024;
  f32x4 acc[4][4];
  zero_acc(acc);
  u16* sA = (u16*)smem; u16* sB = sA + 128 * LDS_STRIDE;
  float* rsl = (float*)(smem + 40960);
  const float* zsq = (const float*)(ws + OFF_ZSQ);
  {
    const int tq = ltid();
    if (tq < 128) {
      float zs = 0.f;
#pragma unroll
      for (int q = 0; q < 8; ++q) zs += ld_sc1_f(zsq + (size_t)q * NTOK + row0 + tq);
      rsl[tq] = rsqrtf(zs * (1.0f / 512.0f) + EPSF);
    }
  }
  gemm_mainloop<128, 128, 2, 2>((const u16*)(arena + 0 * SLOT) + (size_t)row0 * 512, 512, B, 1024, 512, 1 << 30, acc, sA, sB, NoHook());
  const int lane = ltid() & 63, wid = ltid() >> 6, wm = wid >> 1;
#pragma unroll
  for (int m = 0; m < 4; ++m)
#pragma unroll
    for (int j = 0; j < 4; ++j) {
      const float rs = rsl[wm * 64 + m * 16 + (lane >> 4) * 4 + j];
#pragma unroll
      for (int n = 0; n < 4; ++n) acc[m][n][j] *= rs;
    }
  gemm_mainloop<128, 128, 2, 2>((const u16*)(arena + 7 * SLOT) + (size_t)row0 * 512, 512, B + 512, 1024, 512, 1 << 30, acc, sA, sB, NoHook());
  store_raw_rsq(acc, (u16*)(arena + 1 * SLOT), (float*)(ws + OFF_RSQ), row0, col0, ct);
}

DI void raw_tile(const Params& p, const u16* Abase, int lda, const u16* Bbase, int K, u16* raw, int t) {
  char* ws = p.ws;
  const int rt = t >> 3, ct = t & 7, row0 = rt * 128, col0 = ct * 128;
  f32x4 acc[4][4];
  zero_acc(acc);
  u16* sA = (u16*)smem; u16* sB = sA + 128 * LDS_STRIDE;
  gemm_mainloop<128, 128, 2, 2>(Abase + (size_t)row0 * lda, lda, Bbase + (size_t)col0 * K, K, K, 1 << 30, acc, sA, sB, NoHook());
  store_raw_rsq(acc, raw, (float*)(ws + OFF_RSQ), row0, col0, ct);
}

DI void post_task(const Params& p, const u16* raw, const float* gpost, int t, bool last) {
  char* ws = p.ws;
  const int lane = ltid() & 63;
  const int row = t * 4 + (ltid() >> 6);
  const u16* rw = raw + (size_t)row * 1024;
  u16* hb = (u16*)(ws + OFF_HB) + (size_t)row * 1024;
  float* xsp = (float*)(ws + OFF_RSQ) + row;
  const float xscale = ld_sc1_f(xsp);
  float4 rv[4];
  float s = 0.f;
#pragma unroll
  for (int i = 0; i < 4; ++i) {
    const int c = i * 256 + lane * 4;
    const u32x2 r2 = ld_sc1_8(rw + c);
    rv[i].x = bf2f((u16)(r2.x & 0xffff)); rv[i].y = bf2f((u16)(r2.x >> 16));
    rv[i].z = bf2f((u16)(r2.y & 0xffff)); rv[i].w = bf2f((u16)(r2.y >> 16));
    s += rv[i].x * rv[i].x + rv[i].y * rv[i].y + rv[i].z * rv[i].z + rv[i].w * rv[i].w;
  }
  s = red64(s);
  const float rr = rsqrtf(s * (1.0f / 1024.0f) + EPSF);
  float4 v[4];
  float ss = 0.f;
#pragma unroll
  for (int i = 0; i < 4; ++i) {
    const int c = i * 256 + lane * 4;
    const u32x2 h2 = ld_sc1_8(hb + c);
    const float4 g = *(const float4*)(gpost + c);
    v[i].x = bf2f((u16)(h2.x & 0xffff)) * xscale + rv[i].x * rr * g.x;
    v[i].y = bf2f((u16)(h2.x >> 16)) * xscale + rv[i].y * rr * g.y;
    v[i].z = bf2f((u16)(h2.y & 0xffff)) * xscale + rv[i].z * rr * g.z;
    v[i].w = bf2f((u16)(h2.y >> 16)) * xscale + rv[i].w * rr * g.w;
    ss += v[i].x * v[i].x + v[i].y * v[i].y + v[i].z * v[i].z + v[i].w * v[i].w;
  }
  ss = red64(ss);
  const float r = rsqrtf(ss * (1.0f / 1024.0f) + EPSF);
  if (lane == 0) *xsp = 1.0f / r;
  float* y = p.out + O_Y + (size_t)row * 1024;
#pragma unroll
  for (int i = 0; i < 4; ++i) {
    const int c = i * 256 + lane * 4;
    if (last) *(float4*)(y + c) = v[i];
    u32x2 o; o.x = pack2(v[i].x * r, v[i].y * r); o.y = pack2(v[i].z * r, v[i].w * r);
    *(u32x2*)(hb + c) = o;
  }
}

DI void cq_tile(const Params& p, int l, int t) {
  char* ws = p.ws;
  char* arena = ws + OFF_ARENA;
  const int rt = t >> 3, ct = t & 7, row0 = rt * 128, col0 = ct * 128;
  f32x4 acc[4][4];
  zero_acc(acc);
  u16* sA = (u16*)smem; u16* sB = sA + 128 * LDS_STRIDE;
  gemm_mainloop<128, 128, 2, 2>((const u16*)(ws + OFF_HB) + (size_t)row0 * 1024, 1024,
                                (const u16*)(ws + OFF_W) + (size_t)l * W_LAYER + W_CQ + (size_t)col0 * 1024, 1024, 1024, 1 << 30, acc, sA, sB, NoHook());
  tile_out_128(acc, (u16*)(arena + 3 * SLOT), 1024, row0, col0);
}

DI void att_task(const Params& p, int l, int t) {
  char* ws = p.ws;
  char* arena = ws + OFF_ARENA;
  const int tid = ltid(), lane = tid & 63, w = tid >> 6;
  int row0, h, nvalid;
  const u16 *KX, *VTX;
  if (t < 2048) {
    const int rt = t >> 2; h = t & 3; row0 = rt * 64; nvalid = 64;
    const int b = row0 >> 13;
    KX = (const u16*)(ws + OFF_KXP) + ((size_t)(l * 4 + b)) * 256 * 1024 + h * 256;
    VTX = (const u16*)(ws + OFF_VTXP) + ((size_t)((l * 4 + b) * 4 + h)) * 65536;
  } else {
    const int q = t - 2048, b = q >> 2; h = q & 3; row0 = PROWS + b * 16; nvalid = 16;
    KX = (const u16*)(ws + OFF_KXS) + (size_t)b * 256 * 1024 + h * 256;
    VTX = (const u16*)(ws + OFF_VTXS) + ((size_t)(b * 4 + h)) * 65536;
  }
  const u16* QX = (const u16*)(arena + 3 * SLOT);
  u16* OX = (u16*)(arena + 5 * SLOT);
#ifdef EXP_ATT_COPY
  for (int e = tid; e < nvalid * 256; e += NTHR) { const int r = e >> 8, c = e & 255; OX[(size_t)(row0 + r) * 1024 + h * 256 + c] = QX[(size_t)(row0 + r) * 1024 + h * 256 + c]; }
  return;
#endif
  const int arow0 = (row0 + 64 <= NTOK) ? row0 : (NTOK - 64);
  const int shift = row0 - arow0;
  u16* sA = (u16*)smem;
  u16* sB = (u16*)(smem + 34816);
  f32x4 acc[1][16];
  zero_acc(acc);
  gemm_mainloop<64, 256, 4, 1>(QX + (size_t)arow0 * 1024 + h * 256, 1024, KX, 1024, 256, 1 << 30, acc, sA, sB, NoHook());
  float inv[4];
#pragma unroll
  for (int j = 0; j < 4; ++j) {
    float mx = -3.0e38f;
#pragma unroll
    for (int n = 0; n < 16; ++n) mx = fmaxf(mx, acc[0][n][j]);
    mx = max16(mx);
    float s = 0.f;
#pragma unroll
    for (int n = 0; n < 16; ++n) { const float e = __expf(acc[0][n][j] - mx); acc[0][n][j] = e; s += e; }
    s = red16(s);
    inv[j] = 1.0f / s;
  }
  __syncthreads();
  u16* sP = (u16*)smem;
#pragma unroll
  for (int n = 0; n < 16; ++n)
#pragma unroll
    for (int j = 0; j < 4; ++j) sP[(w * 16 + (lane >> 4) * 4 + j) * 272 + n * 16 + (lane & 15)] = f2bf(acc[0][n][j] * inv[j]);
  zero_acc(acc);
  gemm_mainloop_alds<64, 256, 4, 1>(sP, 272, VTX, 256, 256, acc, sB);
#pragma unroll
  for (int n = 0; n < 16; ++n)
#pragma unroll
    for (int j = 0; j < 4; ++j) {
      const int rl = w * 16 + (lane >> 4) * 4 + j - shift;
      if (rl >= 0 && rl < nvalid) OX[(size_t)(row0 + rl) * 1024 + h * 256 + n * 16 + (lane & 15)] = f2bf(acc[0][n][j]);
    }
}

DI void gu_tile(const Params& p, int l, int t) {
  char* ws = p.ws;
  char* arena = ws + OFF_ARENA;
  const int rt = t / 44, ct = t % 44, row0 = rt * 128, col0 = ct * 128;
  f32x4 acc[4][4];
  zero_acc(acc);
  u16* sA = (u16*)smem; u16* sB = sA + 128 * LDS_STRIDE;
  gemm_mainloop<128, 128, 2, 2>((const u16*)(ws + OFF_HB) + (size_t)row0 * 1024, 1024,
                                (const u16*)(ws + OFF_W) + (size_t)l * W_LAYER + W_GU + (size_t)col0 * 1024, 1024, 1024, 1 << 30, acc, sA, sB, NoHook());
  const int tid = ltid(), lane = tid & 63, wid = tid >> 6, wm = wid >> 1, wn = wid & 1;
  u16* act = (u16*)(arena + 2 * SLOT);
  u16* sT = (u16*)smem;
  __syncthreads();
#pragma unroll
  for (int m = 0; m < 4; ++m)
#pragma unroll
    for (int np = 0; np < 2; ++np)
#pragma unroll
      for (int j = 0; j < 4; ++j)
        tile_put(sT, 72, wm * 64 + m * 16 + (lane >> 4) * 4 + j, wn * 32 + np * 16 + (lane & 15), siluf_(acc[m][2 * np][j]) * acc[m][2 * np + 1][j]);
  __syncthreads();
#pragma unroll
  for (int i = 0; i < 4; ++i) {
    const int id = tid + i * NTHR, r = id >> 3, c = (id & 7) * 8;
    *(u32x4*)(act + (size_t)(row0 + r) * DFF + (col0 >> 1) + c) = *(const u32x4*)(sT + r * 72 + c);
  }
}

DI void dbg_dump(const Params& p) {
#ifdef DUMP_SLOT
  const u16* src = (const u16*)(p.ws + OFF_ARENA + (size_t)DUMP_SLOT * SLOT);
  float* dst = p.out + O_Y;
  for (size_t i = (size_t)blockIdx.x * NTHR + threadIdx.x; i < (size_t)NTOK * 1024; i += (size_t)gridDim.x * NTHR) dst[i] = bf2f(src[i]);
#endif
#ifdef DUMP_HB
  const u16* src = (const u16*)(p.ws + OFF_HB);
  float* dst = p.out + O_Y;
  for (size_t i = (size_t)blockIdx.x * NTHR + threadIdx.x; i < (size_t)NTOK * 1024; i += (size_t)gridDim.x * NTHR) dst[i] = bf2f(src[i]);
#endif
}
#define PH_BEGIN { const int myph = ph++; const bool act_ = (myph >= p.ph_lo && myph < p.ph_hi); if (act_) { unsigned* c = &ctr[myph]; (void)c; phase_begin();
#define PH_END } if (act_ && myph + 1 < p.ph_hi) grid_barrier(bar); }

__global__ void __launch_bounds__(NTHR, 2) fwd_megakernel(Params p) {
  unsigned* bar = (unsigned*)(p.ws + OFF_BAR);
  unsigned* ctr = (unsigned*)(p.ws + OFF_CTR);
  if (threadIdx.x == 0) { g_xb[0] = 0u; g_xb[1] = 0u; g_xb[2] = 0u; g_xb[3] = 0u; }
  __syncthreads();
  if (USE_XCD_BARRIER) { if (threadIdx.x == 0) (void)xb_add(&bar[XB_XCNT(xb_xcc_id())], 1u); }
  if (p.never) cg::this_grid().sync();
  int ph = 0;
  char* ws = p.ws;
  char* arena = ws + OFF_ARENA;
#ifdef DUMP_AFTER
  if (p.ph_lo < 0) {
    const u16* src = (const u16*)(ws + DUMP_OFF);
    for (size_t j = (size_t)blockIdx.x * NTHR + threadIdx.x; j < (size_t)1048576; j += (size_t)gridDim.x * NTHR) {
      float acc = 0.f;
      size_t idx = (j * 131u) % DUMP_N;
      for (int k = 0; k < 512; ++k) {
        const float e = bf2f((u16)(src[idx] & 0xBFFF));
        acc = acc * 0.75f + e * (1.0f + 0.001f * (float)(k & 15));
        idx += 65537u; if (idx >= DUMP_N) idx -= DUMP_N;
      }
      float v = acc;
      for (int k = 0; k < 200; ++k) { v = bf2f(f2bf(v * 1.37f + 0.11f)); if (fabsf(v) > 4.f) v *= 0.125f; }
      p.out[O_Y + j] = v;
    }
    return;
  }
#endif
#ifdef EXP_CHAOS
  if (p.ph_lo == 0) {
    for (size_t i = (size_t)blockIdx.x * NTHR + threadIdx.x; i < (size_t)NTOK * 1024; i += (size_t)gridDim.x * NTHR) {
      float v = (i < (size_t)PROWS * 1024) ? p.x_prompt[i] : p.x_sample[i - (size_t)PROWS * 1024];
      float w = p.w_in[i % (4u * 1024u * 2560u)];
      for (int k = 0; k < 200; ++k) { v = bf2f(f2bf(v * 1.37f + w)); if (fabsf(v) > 4.f) v *= 0.125f; }
      p.out[O_Y + i] = v;
    }
  }
  return;
#endif

  PH_BEGIN
    phase_prep(p, c);
  PH_END

  for (int l_ = 0; l_ < DEPTHC; ++l_) {
    const int l = lsgpr(l_);
    const u16* wl = (const u16*)(ws + OFF_W) + (size_t)l * W_LAYER;
    PH_BEGIN
      const int n_g1 = 258 * 20, n_mk = (l == 0) ? 512 : 0, n_cc = 2048;
      for (;;) {
        int t = next_task(c);
        if (t >= n_g1 + n_mk + n_cc) break;
        if (t < n_g1) g1_tile(p, l, t);
        else if (t < n_g1 + n_mk) memkv_tile(p, t - n_g1);
        else cache_task(p, l, t - n_g1 - n_mk);
      }
    PH_END
    PH_BEGIN
      for (;;) {
        int t = next_task(c);
        if (t >= 256 + 512) break;
        if (t < 256) ret_local_task(p, t);
        else s5_task(p, l, t - 256, 0);
      }
    PH_END
    PH_BEGIN
      for (;;) {
        int t = next_task(c);
        if (t >= 320 + 640) break;
        if (t < 320) ret_final_task(p, l, t);
        else s5_task(p, l, t - 320, 1);
      }
    PH_END
    PH_BEGIN
      TASK_LOOP(c, 258 * 4, glu_tile(p, l, t))
    PH_END
    PH_BEGIN
      TASK_LOOP(c, 258 * 8, out_tile(p, l, t))
    PH_END
    PH_BEGIN
      for (int t = blockIdx.x; t < NTOK / 4; t += gridDim.x) { post_task(p, (const u16*)(arena + 1 * SLOT), p.mix_post + l * 1024, t, false); }
    PH_END
    PH_BEGIN
      TASK_LOOP(c, 258 * 8, cq_tile(p, l, t))
    PH_END
    PH_BEGIN
      TASK_LOOP(c, 2112, att_task(p, l, t))
    PH_END
    PH_BEGIN
      TASK_LOOP(c, 258 * 8, raw_tile(p, (const u16*)(arena + 5 * SLOT), 1024, wl + W_CO, 1024, (u16*)(arena + 1 * SLOT), t))
    PH_END
    PH_BEGIN
      for (int t = blockIdx.x; t < NTOK / 4; t += gridDim.x) { post_task(p, (const u16*)(arena + 1 * SLOT), p.xa_post + l * 1024, t, false); }
    PH_END
    PH_BEGIN
      TASK_LOOP(c, 258 * 44, gu_tile(p, l, t))
    PH_END
    PH_BEGIN
      TASK_LOOP(c, 258 * 8, raw_tile(p, (const u16*)(arena + 2 * SLOT), DFF, wl + W_DN, DFF, (u16*)(arena + 0 * SLOT), t))
    PH_END
    PH_BEGIN
      for (int t = blockIdx.x; t < NTOK / 4; t += gridDim.x) { post_task(p, (const u16*)(arena + 0 * SLOT), p.ffn_post + l * 1024, t, l == DEPTHC - 1); }
    PH_END
  }
}

#ifndef N_LAUNCH_SPLIT
#define N_LAUNCH_SPLIT 0
#endif
constexpr int N_PHASES = 1 + 13 * DEPTHC;

extern "C" void kernel_launch(void* const* d_in, const int* in_sizes, int n_in, void* d_out, int out_size, void* d_ws,
                              size_t ws_size, hipStream_t stream) {
  static int grid_blocks = 0;
  if (!grid_blocks) {
    int dev = 0, cus = 0, per_cu = 0;
    (void)hipGetDevice(&dev);
    (void)hipDeviceGetAttribute(&cus, hipDeviceAttributeMultiprocessorCount, dev);
    (void)hipOccupancyMaxActiveBlocksPerMultiprocessor(&per_cu, fwd_megakernel, NTHR, 0);
    if (per_cu > 2) per_cu = 2;
    if (per_cu < 1) per_cu = 1;
    grid_blocks = cus * per_cu;
  }
  if (ws_size < WS_NEEDED) fprintf(stderr, "workspace too small: %zu < %zu\n", ws_size, (size_t)WS_NEEDED);
  Params p{};
  const float** f = (const float**)&p;
  for (int i = 0; i < 36; ++i) f[i] = (const float*)d_in[i];
  p.out = (float*)d_out;
  p.ws = (char*)d_ws;
  p.never = 0;
  p.ph_lo = 0;
  p.ph_hi = N_PHASES;
  p.pad = 0;
  (void)hipMemsetAsync(d_ws, 0, 32768, stream);
  if (N_LAUNCH_SPLIT) {
#ifdef DUMP_AFTER
    const int nrun = DUMP_AFTER;
#else
    const int nrun = N_PHASES;
#endif
    for (int i = 0; i <= nrun; ++i) {
      if (i == nrun) {
#ifdef DUMP_AFTER
        p.ph_lo = -1; p.ph_hi = -1;
#else
        break;
#endif
      } else { p.ph_lo = i; p.ph_hi = i + 1; }
      void* args[] = {&p};
      hipError_t e = hipLaunchCooperativeKernel((void*)fwd_megakernel, dim3(grid_blocks), dim3(NTHR), args, 0, stream);
      if (e != hipSuccess) fprintf(stderr, "launch failed: %s (grid %d)\n", hipGetErrorString(e), grid_blocks);
    }
  } else {
    void* args[] = {&p};
    hipError_t e = hipLaunchCooperativeKernel((void*)fwd_megakernel, dim3(grid_blocks), dim3(NTHR), args, 0, stream);
    if (e != hipSuccess) fprintf(stderr, "cooperative launch failed: %s (grid %d)\n", hipGetErrorString(e), grid_blocks);
  }
}
```

```cpp
#include <hip/hip_runtime.h>
#include <hip/hip_bf16.h>
#include <hip/hip_cooperative_groups.h>
#include <stdint.h>
#include <stdio.h>
namespace cg = cooperative_groups;

typedef __attribute__((ext_vector_type(8))) short bf16x8;
typedef __attribute__((ext_vector_type(4))) float f32x4;
typedef unsigned short u16;
typedef __attribute__((ext_vector_type(4))) unsigned u32x4;
typedef __attribute__((ext_vector_type(2))) unsigned u32x2;
#define DI __device__ __forceinline__
#define MFMA16(a, b, c) __builtin_amdgcn_mfma_f32_16x16x32_bf16((a), (b), (c), 0, 0, 0)
#define MFMA_FENCE() do { __builtin_amdgcn_sched_barrier(0); asm volatile("s_nop 15\n\ts_nop 15" ::: "memory"); __builtin_amdgcn_sched_barrier(0); } while (0)

constexpr int NTOK = 33024, PROWS = 32768, DM = 1024, DFF = 2816, DEPTHC = 4;
constexpr int SEQ = 8192;
constexpr float EPSF = 1e-6f;
constexpr int NTHR = 256;
constexpr int LDS_STRIDE = 80;
constexpr int SMEM_BYTES = 76800;

constexpr size_t SLOT = (size_t)NTOK * 512 * 2;
constexpr size_t OFF_BAR = 0;
constexpr size_t OFF_CTR = 16384;
constexpr size_t OFF_W = 32768;
constexpr size_t W_IN = 0, W_GLU = W_IN + 2560 * 1024, W_OUT = W_GLU + 512 * 512, W_CQ = W_OUT + 1024 * 1024,
                 W_CK = W_CQ + 1024 * 1024, W_CV = W_CK + 1024 * 1024, W_CO = W_CV + 1024 * 1024,
                 W_GU = W_CO + 1024 * 1024, W_DN = W_GU + 5632 * 1024, W_LAYER = W_DN + 1024 * 2816;
constexpr size_t OFF_S5P = OFF_W + 4 * W_LAYER * 2;
constexpr size_t S5P_BBT = 0, S5P_CM = 131072, S5P_ABAR = 262144, S5P_LAYER = 278528;
constexpr size_t OFF_HB = OFF_S5P + 4 * S5P_LAYER;
constexpr size_t OFF_MEMB = OFF_HB + (size_t)NTOK * 1024 * 2;
constexpr size_t OFF_KXP = OFF_MEMB + 1024 * 1024 * 2;
constexpr size_t OFF_VTXP = OFF_KXP + 4 * 4 * 256 * 1024 * 2;
constexpr size_t OFF_KXS = OFF_VTXP + 4 * 4 * 256 * 1024 * 2;
constexpr size_t OFF_VTXS = OFF_KXS + 16 * 256 * 1024 * 2;
constexpr size_t OFF_SLOC = OFF_VTXS + 16 * 256 * 1024 * 2;
constexpr size_t OFF_ELOC = OFF_SLOC + 16 * 16 * 128 * 128 * 4;
constexpr size_t OFF_ZSQ = OFF_ELOC + 4 * 16 * 32 * 64 * 2 * 4;
constexpr size_t OFF_RSQ = OFF_ZSQ + (size_t)NTOK * 8 * 4;
constexpr size_t OFF_ARENA = OFF_RSQ + (size_t)NTOK * 16 * 4;
constexpr size_t WS_NEEDED = OFF_ARENA + 8 * SLOT;

constexpr size_t O_Y = 0, O_S5RE_P = 33816576, O_S5IM_P = 33849344, O_RET_P = 33882112, O_MK_P = 34930688,
                 O_MV_P = 39124992, O_S5RE_S = 43319296, O_S5IM_S = 43450368, O_RET_S = 43581440;

struct Params {
  const float *x_prompt, *x_sample, *mem_prompt, *s5re0, *s5im0, *ret0, *cmk, *cmv;
  const float *mix_pre, *mix_post, *w_in, *lam_re, *lam_im, *log_step, *b_re, *b_im, *c_re, *c_im, *s5_d, *w_glu,
      *b_glu, *s5_onorm, *ret_onorm, *w_out, *xa_pre, *xa_post, *mem_norm, *w_cq, *w_ck, *w_cv, *w_co, *ffn_pre,
      *ffn_post, *w_gate, *w_up, *w_down;
  float* out;
  char* ws;
  int never;
  int ph_lo;
  int ph_hi;
  int pad;
};

DI u16 f2bf(float f) {
  unsigned u = __float_as_uint(f);
  u += 0x7fffu + ((u >> 16) & 1u);
  return (u16)(u >> 16);
}
DI float bf2f(u16 h) { return __uint_as_float(((unsigned)h) << 16); }
DI unsigned pack2(float a, float b) { return (unsigned)f2bf(a) | ((unsigned)f2bf(b) << 16); }
DI float sigmoidf_(float x) { return 1.0f / (1.0f + __expf(-x)); }
DI float siluf_(float x) { return x * sigmoidf_(x); }
DI float geluf_(float x) {
  float t = 0.7978845608028654f * (x + 0.044715f * x * x * x);
  return 0.5f * x * (1.0f + tanhf(t));
}
DI float red16(float v) {
  v += __shfl_xor(v, 1); v += __shfl_xor(v, 2); v += __shfl_xor(v, 4); v += __shfl_xor(v, 8);
  return v;
}
DI float max16(float v) {
  v = fmaxf(v, __shfl_xor(v, 1)); v = fmaxf(v, __shfl_xor(v, 2)); v = fmaxf(v, __shfl_xor(v, 4)); v = fmaxf(v, __shfl_xor(v, 8));
  return v;
}
DI float red64(float v) {
  v = red16(v); v += __shfl_xor(v, 16); v += __shfl_xor(v, 32);
  return v;
}
DI void sincos_cw(float x, float* sn, float* cs) {
  const float k = rintf(x * 0.15915494309189535f);
  float r = fmaf(-k, 6.2831854820251465f, x);
  r = fmaf(-k, -1.7484555e-07f, r);
  *sn = __sinf(r); *cs = __cosf(r);
}
DI int ltid() { int x = threadIdx.x; asm volatile("" : "+v"(x)); return x; }
DI int lsgpr(int x) { asm volatile("" : "+s"(x)); return x; }
DI u32x4 ld_sc1_16(const void* p) {
  const unsigned long long* q = (const unsigned long long*)p;
  const unsigned long long a = __hip_atomic_load(q, __ATOMIC_RELAXED, __HIP_MEMORY_SCOPE_AGENT);
  const unsigned long long b = __hip_atomic_load(q + 1, __ATOMIC_RELAXED, __HIP_MEMORY_SCOPE_AGENT);
  return (u32x4){(unsigned)a, (unsigned)(a >> 32), (unsigned)b, (unsigned)(b >> 32)};
}
DI __amdgpu_buffer_rsrc_t mk_rsrc(const void* p) {
  const unsigned long long a = (unsigned long long)p;
  const unsigned lo = __builtin_amdgcn_readfirstlane((unsigned)a), hi = __builtin_amdgcn_readfirstlane((unsigned)(a >> 32));
  return __builtin_amdgcn_make_buffer_rsrc((void*)(((unsigned long long)hi << 32) | lo), 0, 0x7fffffff, 0x00020000);
}
DI u32x4 bld16(__amdgpu_buffer_rsrc_t r, unsigned voff, unsigned soff) { return __builtin_amdgcn_raw_buffer_load_b128(r, voff, soff, 16); }
DI u32x4 ld_ws16(const char* ws, const void* p) {
  const __amdgpu_buffer_rsrc_t r = __builtin_amdgcn_make_buffer_rsrc((void*)ws, 0, 0x7fffffff, 0x00020000);
  return __builtin_amdgcn_raw_buffer_load_b128(r, (unsigned)((const char*)p - ws), 0, 16);
}
DI u32x2 ld_sc1_8(const void* p) {
  const unsigned long long a = __hip_atomic_load((const unsigned long long*)p, __ATOMIC_RELAXED, __HIP_MEMORY_SCOPE_AGENT);
  return (u32x2){(unsigned)a, (unsigned)(a >> 32)};
}
DI u16 ld_sc1_2(const u16* p) { return __hip_atomic_load(p, __ATOMIC_RELAXED, __HIP_MEMORY_SCOPE_AGENT); }
DI float ld_sc1_f(const float* p) { return __hip_atomic_load(p, __ATOMIC_RELAXED, __HIP_MEMORY_SCOPE_AGENT); }
DI float gamma_l2(int h) { return log2f(1.0f - exp2f(-5.0f - (float)h)); }

#define XB_TMO 128
#define XB_XCNT(j) (256 + 64 * (j))
#define XB_XSUB(j) (1280 + 64 * (j))
#define XB_XGEN(j) (2304 + 64 * (j))
#define XB_TOP 3328
#define XB_TOPGEN 3392
#define XB_SPIN_CAP (1u << 26)
DI unsigned xb_ld(unsigned* p) { return __hip_atomic_load(p, __ATOMIC_RELAXED, __HIP_MEMORY_SCOPE_AGENT); }
DI unsigned xb_add(unsigned* p, unsigned v) { return __hip_atomic_fetch_add(p, v, __ATOMIC_RELAXED, __HIP_MEMORY_SCOPE_AGENT); }
DI unsigned xb_xcc_id() { return (unsigned)__builtin_amdgcn_s_getreg((3 << 11) | 20) & 0xFu; }
#define XB_SPIN(cond, bar) do { unsigned _sp = 0; while (cond) { __builtin_amdgcn_s_sleep(1); \
    if ((++_sp & 255u) == 0u) { if (xb_ld(&(bar)[XB_TMO])) break; if (_sp > XB_SPIN_CAP) { atomicAdd(&(bar)[XB_TMO], 1u); break; } } } } while (0)

__shared__ unsigned g_xb[4];
__shared__ __attribute__((aligned(16))) char smem[SMEM_BYTES];

DI void xcd_complete(unsigned* bar, unsigned x, unsigned& nloc, unsigned& nx) {
  const unsigned G = gridDim.x;
  unsigned sum, cnt, mine, sp = 0u;
  for (;;) {
    sum = 0u; cnt = 0u; mine = 0u;
#pragma unroll
    for (unsigned j = 0; j < 16; ++j) { const unsigned c = xb_ld(&bar[XB_XCNT(j)]); sum += c; cnt += (c > 0u) ? 1u : 0u; mine = (j == x) ? c : mine; }
    if (sum == G) break;
    __builtin_amdgcn_s_sleep(1);
    if ((++sp & 255u) == 0u) { if (xb_ld(&bar[XB_TMO])) break; if (sp > XB_SPIN_CAP) { atomicAdd(&bar[XB_TMO], 1u); break; } }
  }
  nloc = mine > 0u ? mine : 1u; nx = cnt > 0u ? cnt : 1u;
}
#ifndef USE_XCD_BARRIER
#define USE_XCD_BARRIER 1
#endif
DI void grid_barrier(unsigned* bar) {
  if (!USE_XCD_BARRIER) {
    asm volatile("s_waitcnt vmcnt(0)" ::: "memory");
    __syncthreads();
    if (threadIdx.x == 0) asm volatile("buffer_wbl2 sc0 sc1\n\ts_waitcnt vmcnt(0)" ::: "memory");
    cg::this_grid().sync();
    if (threadIdx.x == 0) asm volatile("buffer_inv sc0 sc1\n\ts_waitcnt vmcnt(0)" ::: "memory");
    __syncthreads();
    return;
  }
  asm volatile("s_waitcnt vmcnt(0)" ::: "memory");
  __syncthreads();
  if (threadIdx.x == 0) {
    __builtin_amdgcn_s_waitcnt(0);
    const unsigned xcc = xb_xcc_id();
    unsigned nloc = g_xb[0], nx = g_xb[1];
    if (nloc == 0u) { xcd_complete(bar, xcc, nloc, nx); g_xb[0] = nloc; g_xb[1] = nx; }
    const unsigned old = xb_add(&bar[XB_XSUB(xcc)], 1u);
    const unsigned gen = old / nloc;
    if (old + 1u == (gen + 1u) * nloc) {
      __builtin_amdgcn_fence(__ATOMIC_RELEASE, "agent");
      asm volatile("s_waitcnt vmcnt(0)" ::: "memory");
      const unsigned og = xb_add(&bar[XB_TOP], 1u);
      const unsigned tg = og / nx;
      if (og + 1u == (tg + 1u) * nx) xb_add(&bar[XB_TOPGEN], 1u);
      else XB_SPIN(xb_ld(&bar[XB_TOPGEN]) == tg, bar);
      __builtin_amdgcn_fence(__ATOMIC_ACQUIRE, "agent");
      xb_add(&bar[XB_XGEN(xcc)], 1u);
      asm volatile("s_waitcnt vmcnt(0)" ::: "memory");
    } else {
      XB_SPIN(xb_ld(&bar[XB_XGEN(xcc)]) == gen, bar);
      __builtin_amdgcn_fence(__ATOMIC_ACQUIRE, "agent");
      asm volatile("s_waitcnt vmcnt(0)" ::: "memory");
    }
  }
  __syncthreads();
}

#define DUMP_OFF (OFF_ELOC)
#define DUMP_N ((size_t)524288)
#define DUMP_F32 0
#ifndef MAXPH
#define MAXPH 10
#endif
#ifndef STATIC_SCHED
#define STATIC_SCHED 0
#endif
#ifndef ONE_XCD
#define ONE_XCD 0
#endif
DI int next_task(unsigned* ctr) {
  __syncthreads();
#ifdef LDS_NAN_PER_TASK
  __syncthreads();
#endif
  if (ONE_XCD) {
    if (threadIdx.x == 0) g_xb[2] = (xb_xcc_id() == 0u) ? atomicAdd(ctr, 1u) : 0x7fffffffu;
    __syncthreads();
    return (int)g_xb[2];
  }
  if (STATIC_SCHED) {
    if (threadIdx.x == 0) { unsigned it = g_xb[3]; g_xb[3] = it + 1u; g_xb[2] = blockIdx.x + it * gridDim.x; }
  } else {
    if (threadIdx.x == 0) g_xb[2] = atomicAdd(ctr, 1u);
  }
  __syncthreads();
  return (int)g_xb[2];
}
DI unsigned task_prefetch(unsigned* ctr) { unsigned v = 0u; if (threadIdx.x == 0) v = atomicAdd(ctr, 1u); return v; }
DI int task_commit(unsigned v) {
  __syncthreads();
  if (threadIdx.x == 0) g_xb[2] = v;
  __syncthreads();
  return (int)g_xb[2];
}
#define TASK_LOOP(ctr, N, BODY) { int t = next_task(ctr); while (t < (N)) { const unsigned tn_ = task_prefetch(ctr); BODY; t = task_commit(tn_); } }
DI void phase_begin() { __syncthreads(); if (threadIdx.x == 0) g_xb[3] = 0u; __syncthreads(); }

template <int BM, int BN, int WGM, int WGN, class Hook>
DI void gemm_mainloop(const u16* A, int lda, const u16* B, int ldb, int K, int kvalid,
                      f32x4 (&acc)[BM / WGM / 16][BN / WGN / 16], u16* sA, u16* sB, Hook hook) {
  constexpr int MT = BM / WGM / 16, NTL = BN / WGN / 16, CA = BM / 32, CB = BN / 32;
  const int tid = ltid(), lane = tid & 63, wid = tid >> 6, wm = wid / WGN, wn = wid % WGN;
  const __amdgpu_buffer_rsrc_t ra_ = mk_rsrc(A), rb_ = mk_rsrc(B);
  u32x4 ra0[CA], rb0[CB], ra1[CA], rb1[CB];
  unsigned va[CA], vb[CB];
  const u32x4 z4 = (u32x4){0u, 0u, 0u, 0u};
  const int cc0 = (tid & 7) * 8;
#pragma unroll
  for (int i = 0; i < CA; ++i) { const int r = (tid + i * NTHR) >> 3; va[i] = (unsigned)(r * lda + cc0) * 2u; }
#pragma unroll
  for (int i = 0; i < CB; ++i) { const int r = (tid + i * NTHR) >> 3; vb[i] = (unsigned)(r * ldb + cc0) * 2u; }
#define GM_LOAD(RA, RB, kn)                                                                          \
  {                                                                                                  \
    const bool kok = ((kn) + cc0) < kvalid;                                                          \
    _Pragma("unroll") for (int i = 0; i < CA; ++i) RA[i] = kok ? bld16(ra_, va[i], (unsigned)(kn) * 2u) : z4; \
    _Pragma("unroll") for (int i = 0; i < CB; ++i) RB[i] = kok ? bld16(rb_, vb[i], (unsigned)(kn) * 2u) : z4; \
  }
#define GM_STEP(RA, RB, kcur)                                                                        \
  {                                                                                                  \
    __syncthreads();                                                                                 \
    _Pragma("unroll") for (int i = 0; i < CA; ++i) { const int r = (tid + i * NTHR) >> 3; *(u32x4*)(sA + r * LDS_STRIDE + cc0) = RA[i]; } \
    _Pragma("unroll") for (int i = 0; i < CB; ++i) { const int r = (tid + i * NTHR) >> 3; *(u32x4*)(sB + r * LDS_STRIDE + cc0) = RB[i]; } \
    __syncthreads();                                                                                 \
    if ((kcur) + 128 < K) GM_LOAD(RA, RB, (kcur) + 128)                                              \
    _Pragma("unroll") for (int kk = 0; kk < 2; ++kk) {                                               \
      bf16x8 af[MT], bfr[NTL];                                                                       \
      _Pragma("unroll") for (int m = 0; m < MT; ++m) af[m] = *(const bf16x8*)(sA + (wm * (BM / WGM) + m * 16 + (lane & 15)) * LDS_STRIDE + kk * 32 + (lane >> 4) * 8); \
      _Pragma("unroll") for (int n = 0; n < NTL; ++n) bfr[n] = *(const bf16x8*)(sB + (wn * (BN / WGN) + n * 16 + (lane & 15)) * LDS_STRIDE + kk * 32 + (lane >> 4) * 8); \
      _Pragma("unroll") for (int m = 0; m < MT; ++m)                                                 \
        _Pragma("unroll") for (int n = 0; n < NTL; ++n) acc[m][n] = MFMA16(af[m], bfr[n], acc[m][n]); \
    }                                                                                                \
    hook((kcur), acc);                                                                               \
  }
  GM_LOAD(ra0, rb0, 0)
  if (64 < K) GM_LOAD(ra1, rb1, 64)
#pragma unroll 1
  for (int k0 = 0; k0 < K; k0 += 128) {
    GM_STEP(ra0, rb0, k0)
    GM_STEP(ra1, rb1, k0 + 64)
  }
  MFMA_FENCE();
#undef GM_LOAD
#undef GM_STEP
}
struct NoHook { template <class T> DI void operator()(int, T&) const {} };

template <int BM, int BN, int WGM, int WGN>
DI void gemm_mainloop_alds(const u16* sAimg, int lda_s, const u16* B, int ldb, int K,
                           f32x4 (&acc)[BM / WGM / 16][BN / WGN / 16], u16* sB) {
  constexpr int MT = BM / WGM / 16, NTL = BN / WGN / 16, CB = BN / 32;
  const int tid = ltid(), lane = tid & 63, wid = tid >> 6, wm = wid / WGN, wn = wid % WGN;
  const __amdgpu_buffer_rsrc_t rb_ = mk_rsrc(B);
  u32x4 rb0[CB], rb1[CB];
  unsigned vb[CB];
  const int cc0 = (tid & 7) * 8;
#pragma unroll
  for (int i = 0; i < CB; ++i) { const int r = (tid + i * NTHR) >> 3; vb[i] = (unsigned)(r * ldb + cc0) * 2u; }
#define GA_STEP(RB, kcur)                                                                            \
  {                                                                                                  \
    __syncthreads();                                                                                 \
    _Pragma("unroll") for (int i = 0; i < CB; ++i) { const int r = (tid + i * NTHR) >> 3; *(u32x4*)(sB + r * LDS_STRIDE + cc0) = RB[i]; } \
    __syncthreads();                                                                                 \
    if ((kcur) + 128 < K) { _Pragma("unroll") for (int i = 0; i < CB; ++i) RB[i] = bld16(rb_, vb[i], (unsigned)((kcur) + 128) * 2u); } \
    _Pragma("unroll") for (int kk = 0; kk < 2; ++kk) {                                               \
      bf16x8 af[MT], bfr[NTL];                                                                       \
      _Pragma("unroll") for (int m = 0; m < MT; ++m) af[m] = *(const bf16x8*)(sAimg + (wm * (BM / WGM) + m * 16 + (lane & 15)) * lda_s + (kcur) + kk * 32 + (lane >> 4) * 8); \
      _Pragma("unroll") for (int n = 0; n < NTL; ++n) bfr[n] = *(const bf16x8*)(sB + (wn * (BN / WGN) + n * 16 + (lane & 15)) * LDS_STRIDE + kk * 32 + (lane >> 4) * 8); \
      _Pragma("unroll") for (int m = 0; m < MT; ++m)                                                 \
        _Pragma("unroll") for (int n = 0; n < NTL; ++n) acc[m][n] = MFMA16(af[m], bfr[n], acc[m][n]); \
    }                                                                                                \
  }
#pragma unroll
  for (int i = 0; i < CB; ++i) rb0[i] = bld16(rb_, vb[i], 0u);
#pragma unroll
  for (int i = 0; i < CB; ++i) rb1[i] = bld16(rb_, vb[i], 128u);
#pragma unroll 1
  for (int k0 = 0; k0 < K; k0 += 128) {
    GA_STEP(rb0, k0)
    GA_STEP(rb1, k0 + 64)
  }
  MFMA_FENCE();
#undef GA_STEP
}

template <int MT, int NTL>
DI void zero_acc(f32x4 (&acc)[MT][NTL]) {
#pragma unroll
  for (int m = 0; m < MT; ++m)
#pragma unroll
    for (int n = 0; n < NTL; ++n) acc[m][n] = (f32x4){0.f, 0.f, 0.f, 0.f};
}

DI void tile_put(u16* sT, int stride, int r, int c, float v) { sT[r * stride + c] = f2bf(v); }
DI void tile_flush128(const u16* sT, u16* dst, int ld, int row0, int col0) {
  const int tid = ltid();
#pragma unroll
  for (int i = 0; i < 8; ++i) {
    const int id = tid + i * NTHR, r = id >> 4, c = (id & 15) * 8;
    *(u32x4*)(dst + (size_t)(row0 + r) * ld + col0 + c) = *(const u32x4*)(sT + r * 136 + c);
  }
}
DI void tile_out_128(const f32x4 (&v)[4][4], u16* dst, int ld, int row0, int col0) {
  u16* sT = (u16*)smem;
  const int lane = ltid() & 63, wid = ltid() >> 6, wm = wid >> 1, wn = wid & 1;
  __syncthreads();
#pragma unroll
  for (int m = 0; m < 4; ++m)
#pragma unroll
    for (int n = 0; n < 4; ++n)
#pragma unroll
      for (int j = 0; j < 4; ++j) tile_put(sT, 136, wm * 64 + m * 16 + (lane >> 4) * 4 + j, wn * 64 + n * 16 + (lane & 15), v[m][n][j]);
  __syncthreads();
  tile_flush128(sT, dst, ld, row0, col0);
}

DI int dst_row_map(int n, int mode) {
  if (mode == 0) return n;
  if (mode == 1) {
    if (n < 512 || n >= 1536) return n;
    int sec = n & ~127, d = n & 127;
    int xh = d >> 6, idx = d & 63;
    return sec + (((idx >> 4) * 2 + xh) << 4) + (idx & 15);
  }
  if (mode == 2) return (n >> 4) * 32 + (n & 15);
  return (n >> 4) * 32 + 16 + (n & 15);
}
DI void transpose_tile(const float* src, int lds_, int k0, int n0, u16* dst, int ldd,
                       const float* gain, int mode, float scale) {
  float* t = (float*)smem;
  const int tid = ltid(), ty = tid >> 4, tx = tid & 15;
  __syncthreads();
#pragma unroll
  for (int i = 0; i < 4; ++i) {
    int k = ty + 16 * i;
    float4 v = *(const float4*)(src + (size_t)(k0 + k) * lds_ + n0 + tx * 4);
    float g = gain ? gain[k0 + k] : 1.0f;
    t[k * 65 + tx * 4 + 0] = v.x * g; t[k * 65 + tx * 4 + 1] = v.y * g;
    t[k * 65 + tx * 4 + 2] = v.z * g; t[k * 65 + tx * 4 + 3] = v.w * g;
  }
  __syncthreads();
  const int nl = tid >> 2, ks = (tid & 3) * 16;
  const int n = n0 + nl;
  float sc = scale;
  if (mode == 1) sc = (n >= 512 && n < 1024) ? 0.08838834764831845f : 1.0f;
  unsigned w[8];
#pragma unroll
  for (int i = 0; i < 8; ++i) w[i] = pack2(t[(ks + 2 * i) * 65 + nl] * sc, t[(ks + 2 * i + 1) * 65 + nl] * sc);
  u16* d = dst + (size_t)dst_row_map(n, mode) * ldd + k0 + ks;
  *(u32x4*)d = (u32x4){w[0], w[1], w[2], w[3]};
  *(u32x4*)(d + 8) = (u32x4){w[4], w[5], w[6], w[7]};
}

DI void rownorm_task(const float* src, float* xs_out, u16* dst) {
  const int lane = ltid() & 63;
  float4 v[4];
  float ss = 0.f;
#pragma unroll
  for (int i = 0; i < 4; ++i) {
    v[i] = *(const float4*)(src + i * 256 + lane * 4);
    ss += v[i].x * v[i].x + v[i].y * v[i].y + v[i].z * v[i].z + v[i].w * v[i].w;
  }
  ss = red64(ss);
  const float r = rsqrtf(ss * (1.0f / 1024.0f) + EPSF);
  if (xs_out && lane == 0) *xs_out = 1.0f / r;
#pragma unroll
  for (int i = 0; i < 4; ++i) {
    u32x2 o; o.x = pack2(v[i].x * r, v[i].y * r); o.y = pack2(v[i].z * r, v[i].w * r);
    *(u32x2*)(dst + i * 256 + lane * 4) = o;
  }
}

DI void phase_prep(const Params& p, unsigned* ctr) {
  char* ws = p.ws;
  const int tid = ltid();
  constexpr int T_W = 16384, T_X = NTOK / 4, T_M = 256, T_S = 128;
  constexpr int TOT = T_W + T_X + T_M + T_S;
  for (int t = blockIdx.x; t < TOT; t += gridDim.x) {
    if (t < T_W) {
      const int l = t >> 12; int q = t & 4095;
      u16* wl = (u16*)(ws + OFF_W) + (size_t)l * W_LAYER;
      if (q < 640) {
        transpose_tile(p.w_in + (size_t)l * 1024 * 2560, 2560, (q / 40) * 64, (q % 40) * 64, wl + W_IN, 1024, p.mix_pre + l * 1024, 1, 1.0f);
      } else if ((q -= 640) < 64) {
        transpose_tile(p.w_glu + (size_t)l * 512 * 512, 512, (q / 8) * 64, (q % 8) * 64, wl + W_GLU, 512, nullptr, 0, 1.0f);
      } else if ((q -= 64) < 256) {
        const int k0 = (q / 16) * 64;
        const float* gain = (k0 < 512) ? (p.s5_onorm + l * 512) : (p.ret_onorm + l * 512 - 512);
        transpose_tile(p.w_out + (size_t)l * 1024 * 1024, 1024, k0, (q % 16) * 64, wl + W_OUT, 1024, gain, 0, 1.0f);
      } else if ((q -= 256) < 256) {
        transpose_tile(p.w_cq + (size_t)l * 1024 * 1024, 1024, (q / 16) * 64, (q % 16) * 64, wl + W_CQ, 1024, p.xa_pre + l * 1024, 0, 0.0625f);
      } else if ((q -= 256) < 256) {
        transpose_tile(p.w_ck + (size_t)l * 1024 * 1024, 1024, (q / 16) * 64, (q % 16) * 64, wl + W_CK, 1024, p.mem_norm + l * 1024, 0, 1.0f);
      } else if ((q -= 256) < 256) {
        transpose_tile(p.w_cv + (size_t)l * 1024 * 1024, 1024, (q / 16) * 64, (q % 16) * 64, wl + W_CV, 1024, p.mem_norm + l * 1024, 0, 1.0f);
      } else if ((q -= 256) < 256) {
        transpose_tile(p.w_co + (size_t)l * 1024 * 1024, 1024, (q / 16) * 64, (q % 16) * 64, wl + W_CO, 1024, nullptr, 0, 1.0f);
      } else if ((q -= 256) < 704) {
        transpose_tile(p.w_gate + (size_t)l * 1024 * 2816, 2816, (q / 44) * 64, (q % 44) * 64, wl + W_GU, 1024, p.ffn_pre + l * 1024, 2, 1.0f);
      } else if ((q -= 704) < 704) {
        transpose_tile(p.w_up + (size_t)l * 1024 * 2816, 2816, (q / 44) * 64, (q % 44) * 64, wl + W_GU, 1024, p.ffn_pre + l * 1024, 3, 1.0f);
      } else {
        q -= 704;
        transpose_tile(p.w_down + (size_t)l * 2816 * 1024, 1024, (q / 16) * 64, (q % 16) * 64, wl + W_DN, 2816, nullptr, 0, 1.0f);
      }
    } else if (t < T_W + T_X) {
      const int row = (t - T_W) * 4 + (tid >> 6);
      const float* src = (row < PROWS) ? p.x_prompt + (size_t)row * 1024 : p.x_sample + (size_t)(row - PROWS) * 1024;
      rownorm_task(src, (float*)(ws + OFF_RSQ) + row, (u16*)(ws + OFF_HB) + (size_t)row * 1024);
    } else if (t < T_W + T_X + T_M) {
      const int row = (t - T_W - T_X) * 4 + (tid >> 6);
      rownorm_task(p.mem_prompt + (size_t)row * 1024, nullptr, (u16*)(ws + OFF_MEMB) + (size_t)row * 1024);
    } else {
      const int lg = t - T_W - T_X - T_M, l = lg >> 5, g = lg & 31;
      char* sp = ws + OFF_S5P + (size_t)l * S5P_LAYER;
      u16* bbt = (u16*)(sp + S5P_BBT) + g * 2048;
      u16* cm = (u16*)(sp + S5P_CM) + g * 2048;
      float* ab = (float*)(sp + S5P_ABAR) + g * 128;
      const float dt = __expf(p.log_step[l * 32 + g]);
      for (int e = tid; e < 1024; e += NTHR) {
        const int pp = e >> 4, h = e & 15;
        const float lr = p.lam_re[(l * 32 + g) * 64 + pp], li = p.lam_im[(l * 32 + g) * 64 + pp];
        const float ar = lr * dt, ai = li * dt, mag = expf(ar);
        float sn_, cs_; sincos_cw(ai, &sn_, &cs_);
        const float abr = mag * cs_, abi = mag * sn_;
        const float den = lr * lr + li * li, nr = abr - 1.0f, ni = abi;
        const float fr = (nr * lr + ni * li) / den, fi = (ni * lr - nr * li) / den;
        const float br = p.b_re[((size_t)(l * 32 + g) * 64 + pp) * 16 + h], bi = p.b_im[((size_t)(l * 32 + g) * 64 + pp) * 16 + h];
        bbt[pp * 16 + h] = f2bf(fr * br - fi * bi);
        bbt[(64 + pp) * 16 + h] = f2bf(fr * bi + fi * br);
        if (h == 0) { ab[pp * 2] = abr; ab[pp * 2 + 1] = abi; }
        const int hh = e >> 6, kk = e & 63;
        cm[hh * 128 + kk] = f2bf(p.c_re[((size_t)(l * 32 + g) * 16 + hh) * 64 + kk]);
        cm[hh * 128 + 64 + kk] = f2bf(-p.c_im[((size_t)(l * 32 + g) * 16 + hh) * 64 + kk]);
      }
    }
  }
}

DI void memkv_tile(const Params& p, int t) {
  char* ws = p.ws;
  const int l = t >> 7, rt = (t >> 4) & 7, ct = t & 15;
  const int isv = ct >> 3, col0 = (ct & 7) * 128, row0 = rt * 128;
  const u16* A = (const u16*)(ws + OFF_MEMB) + (size_t)row0 * 1024;
  const u16* B = (const u16*)(ws + OFF_W) + (size_t)l * W_LAYER + (isv ? W_CV : W_CK) + (size_t)col0 * 1024;
  f32x4 acc[4][4];
  zero_acc(acc);
  u16* sA = (u16*)smem; u16* sB = sA + 128 * LDS_STRIDE;
  gemm_mainloop<128, 128, 2, 2>(A, 1024, B, 1024, 1024, 1 << 30, acc, sA, sB, NoHook());
  const int lane = ltid() & 63, wid = ltid() >> 6, wm = wid >> 1, wn = wid & 1;
  float* of = p.out + (isv ? O_MV_P : O_MK_P) + (size_t)l * 1024 * 1024;
  u16* kx = (u16*)(ws + OFF_KXP) + (size_t)l * 1024 * 1024;
  u16* vx = (u16*)(ws + OFF_VTXP) + (size_t)l * 1024 * 1024;
#pragma unroll
  for (int m = 0; m < 4; ++m)
#pragma unroll
    for (int n = 0; n < 4; ++n) {
      const int r = row0 + wm * 64 + m * 16 + (lane >> 4) * 4, c = col0 + wn * 64 + n * 16 + (lane & 15);
#pragma unroll
      for (int j = 0; j < 4; ++j) of[(size_t)(r + j) * 1024 + c] = acc[m][n][j];
      if (!isv) {
#pragma unroll
        for (int j = 0; j < 4; ++j) kx[(size_t)(r + j) * 1024 + c] = f2bf(acc[m][n][j]);
      } else {
        const int b = r >> 8, mm = r & 255, h = c >> 8, d = c & 255;
        u32x2 o; o.x = pack2(acc[m][n][0], acc[m][n][1]); o.y = pack2(acc[m][n][2], acc[m][n][3]);
        *(u32x2*)(vx + ((size_t)((b * 4 + h) * 256 + d)) * 256 + mm) = o;
      }
    }
}
DI void cache_task(const Params& p, int l, int t) {
  char* ws = p.ws;
  if (t < 1024) {
    const float* src = p.cmk + (size_t)l * 16 * 256 * 1024 + (size_t)t * 4096 + ltid() * 16;
    u16* dst = (u16*)(ws + OFF_KXS) + (size_t)t * 4096 + ltid() * 16;
    float4 a = *(const float4*)src, b = *(const float4*)(src + 4), c = *(const float4*)(src + 8), d = *(const float4*)(src + 12);
    *(u32x4*)dst = (u32x4){pack2(a.x, a.y), pack2(a.z, a.w), pack2(b.x, b.y), pack2(b.z, b.w)};
    *(u32x4*)(dst + 8) = (u32x4){pack2(c.x, c.y), pack2(c.z, c.w), pack2(d.x, d.y), pack2(d.z, d.w)};
  } else {
    t -= 1024;
    const int bh = t >> 4, q = t & 15, b = bh >> 2, h = bh & 3;
    const float* src = p.cmv + ((size_t)(l * 16 + b) * 256) * 1024 + h * 256;
    u16* dst = (u16*)(ws + OFF_VTXS) + (size_t)bh * 256 * 256;
    transpose_tile(src, 1024, (q >> 2) * 64, (q & 3) * 64, dst, 256, nullptr, 0, 1.0f);
  }
}

DI void g1_tile(const Params& p, int l, int t) {
  char* ws = p.ws;
  const int rt = t / 20, ct = t % 20;
  const int row0 = rt * 128, col0 = ct * 128;
  const u16* A = (const u16*)(ws + OFF_HB) + (size_t)row0 * 1024;
  const u16* B = (const u16*)(ws + OFF_W) + (size_t)l * W_LAYER + W_IN + (size_t)col0 * 1024;
  f32x4 acc[4][4];
  zero_acc(acc);
  u16* sA = (u16*)smem; u16* sB = sA + 128 * LDS_STRIDE;
  gemm_mainloop<128, 128, 2, 2>(A, 1024, B, 1024, 1024, 1 << 30, acc, sA, sB, NoHook());
  const int lane = ltid() & 63, wid = ltid() >> 6, wm = wid >> 1, wn = wid & 1;
  char* arena = ws + OFF_ARENA;
  const int sec = ct >> 2, hd = ct & 3;
  const bool samp = row0 >= PROWS;
  if (sec == 0 || sec == 4) {
    tile_out_128(acc, (u16*)(arena + (sec == 0 ? 0 : 3) * SLOT), 512, row0, hd * 128);
  } else if (sec == 3) {
    u16* vt = (u16*)(arena + 4 * SLOT);
#pragma unroll
    for (int m = 0; m < 4; ++m)
#pragma unroll
      for (int n = 0; n < 4; ++n) {
        const int r = row0 + wm * 64 + m * 16 + (lane >> 4) * 4, e = wn * 64 + n * 16 + (lane & 15);
        u32x2 o; o.x = pack2(acc[m][n][0], acc[m][n][1]); o.y = pack2(acc[m][n][2], acc[m][n][3]);
        size_t off;
        if (!samp) { const int b = r >> 13, tt = r & 8191; off = ((size_t)((b * 4 + hd) * 128 + e)) * SEQ + tt; }
        else { const int sr = r - PROWS, b = sr >> 4, tt = sr & 15; off = (size_t)16 * 128 * SEQ + ((size_t)((b * 4 + hd) * 128 + e)) * 16 + tt; }
        *(u32x2*)(vt + off) = o;
      }
  } else {
    u16* dst = (u16*)(arena + (sec == 1 ? 1 : 2) * SLOT);
    u16* ktd = (u16*)(arena + 5 * SLOT);
    const float gl2 = gamma_l2(hd);
    u16* sT = (u16*)smem;
    __syncthreads();
#pragma unroll
    for (int m = 0; m < 4; ++m)
#pragma unroll
      for (int np = 0; np < 2; ++np) {
        const int r = row0 + wm * 64 + m * 16 + (lane >> 4) * 4;
        const int idx = (wn * 2 + np) * 16 + (lane & 15);
        const float inv = exp2f(-(float)idx * (13.287712379549449f / 64.0f));
        float o1[4], o2[4];
#pragma unroll
        for (int j = 0; j < 4; ++j) {
          const int rr = r + j;
          const int pos = samp ? (1024 + ((rr - PROWS) & 15)) : (rr & 8191);
          float sn, cs;
          sincos_cw((float)pos * inv, &sn, &cs);
          const float x1 = acc[m][2 * np][j], x2 = acc[m][2 * np + 1][j];
          o1[j] = x1 * cs - x2 * sn; o2[j] = x1 * sn + x2 * cs;
          tile_put(sT, 136, rr - row0, idx, o1[j]);
          tile_put(sT, 136, rr - row0, 64 + idx, o2[j]);
        }
        if (sec == 2) {
          size_t off1; int tloc;
          if (!samp) { const int b = r >> 13, tt = r & 8191; off1 = ((size_t)((b * 4 + hd) * 128 + idx)) * SEQ + tt; tloc = 63 - (tt & 63); }
          else { const int sr = r - PROWS, b = sr >> 4, tt = sr & 15; off1 = (size_t)16 * 128 * SEQ + ((size_t)((b * 4 + hd) * 128 + idx)) * 16 + tt; tloc = 15 - tt; }
          const size_t off2 = off1 + (size_t)64 * (samp ? 16 : SEQ);
          float dc[4];
#pragma unroll
          for (int j = 0; j < 4; ++j) dc[j] = exp2f(gl2 * (float)(tloc - j));
          u32x2 a, b2;
          a.x = pack2(o1[0] * dc[0], o1[1] * dc[1]); a.y = pack2(o1[2] * dc[2], o1[3] * dc[3]);
          b2.x = pack2(o2[0] * dc[0], o2[1] * dc[1]); b2.y = pack2(o2[2] * dc[2], o2[3] * dc[3]);
          *(u32x2*)(ktd + off1) = a;
          *(u32x2*)(ktd + off2) = b2;
        }
      }
    __syncthreads();
    tile_flush128(sT, dst, 512, row0, hd * 128);
  }
}

struct DecayHook {
  float g64;
  template <class T> DI void operator()(int k0, T& acc) const {
    if (k0 + 64 < 512) {
#pragma unroll
      for (int m = 0; m < 4; ++m)
#pragma unroll
        for (int n = 0; n < 4; ++n) acc[m][n] *= g64;
    }
  }
};
DI void ret_local_task(const Params& p, int t) {
  char* ws = p.ws;
  char* arena = ws + OFF_ARENA;
  const int bh = t >> 4, sc = t & 15, h = bh & 3;
  const u16* A = (const u16*)(arena + 5 * SLOT) + (size_t)bh * 128 * SEQ + sc * 512;
  const u16* B = (const u16*)(arena + 4 * SLOT) + (size_t)bh * 128 * SEQ + sc * 512;
  f32x4 acc[4][4];
  zero_acc(acc);
  u16* sA = (u16*)smem; u16* sB = sA + 128 * LDS_STRIDE;
  DecayHook hk; hk.g64 = exp2f(gamma_l2(h) * 64.0f);
  gemm_mainloop<128, 128, 2, 2>(A, SEQ, B, SEQ, 512, 1 << 30, acc, sA, sB, hk);
  const int lane = ltid() & 63, wid = ltid() >> 6, wm = wid >> 1, wn = wid & 1;
  float* dst = (float*)(ws + OFF_SLOC) + (size_t)t * 16384;
#pragma unroll
  for (int m = 0; m < 4; ++m)
#pragma unroll
    for (int n = 0; n < 4; ++n) {
      const int r = wm * 64 + m * 16 + (lane >> 4) * 4, c = wn * 64 + n * 16 + (lane & 15);
#pragma unroll
      for (int j = 0; j < 4; ++j) dst[(r + j) * 128 + c] = acc[m][n][j];
    }
}

DI void ret_final_task(const Params& p, int l, int t) {
  char* ws = p.ws;
  char* arena = ws + OFF_ARENA;
  const int tid = ltid(), lane = tid & 63, w = tid >> 6;
  const bool samp = t >= 256;
  int bh, sc, nchunk, C, row_base;
  size_t tr_base; int tr_ld;
  if (!samp) { bh = t >> 4; sc = t & 15; nchunk = 8; C = 64; row_base = (bh >> 2) * SEQ + sc * 512; tr_base = (size_t)bh * 128 * SEQ + sc * 512; tr_ld = SEQ; }
  else { bh = t - 256; sc = 0; nchunk = 1; C = 16; row_base = PROWS + (bh >> 2) * 16; tr_base = (size_t)16 * 128 * SEQ + (size_t)bh * 128 * 16; tr_ld = 16; }
  const int h = bh & 3;
  const float gl2 = gamma_l2(h);
  const float gC = exp2f(gl2 * (float)C);
  const u16* Qg = (const u16*)(arena + 1 * SLOT);
  const u16* Kg = (const u16*)(arena + 2 * SLOT);
  const u16* Gg = (const u16*)(arena + 3 * SLOT);
  const u16* Vt = (const u16*)(arena + 4 * SLOT) + tr_base;
  const u16* Ktd = (const u16*)(arena + 5 * SLOT) + tr_base;
  u16* reto = (u16*)(arena + 7 * SLOT);
  u16* sQ = (u16*)smem;
  u16* sK = sQ + 64 * 144;
  u16* sV = sK + 128 * LDS_STRIDE;
  u16* sS = sV + 128 * LDS_STRIDE;
  float* sR = (float*)(sS + 64 * LDS_STRIDE);

  f32x4 S[8][2];
  if (samp) {
    const float* s0 = p.ret0 + ((size_t)(l * 64 + bh)) * 16384;
#pragma unroll
    for (int mt = 0; mt < 8; ++mt)
#pragma unroll
      for (int nt = 0; nt < 2; ++nt)
#pragma unroll
        for (int j = 0; j < 4; ++j) S[mt][nt][j] = s0[(mt * 16 + (lane >> 4) * 4 + j) * 128 + 32 * w + nt * 16 + (lane & 15)];
  } else {
#pragma unroll
    for (int mt = 0; mt < 8; ++mt)
#pragma unroll
      for (int nt = 0; nt < 2; ++nt) S[mt][nt] = (f32x4){0.f, 0.f, 0.f, 0.f};
    const float g512 = exp2f(gl2 * 512.0f);
    for (int s2 = 0; s2 < sc; ++s2) {
      const float* sl = (const float*)(ws + OFF_SLOC) + ((size_t)(bh * 16 + s2)) * 16384;
#pragma unroll
      for (int mt = 0; mt < 8; ++mt)
#pragma unroll
        for (int nt = 0; nt < 2; ++nt)
#pragma unroll
          for (int j = 0; j < 4; ++j)
            S[mt][nt][j] = S[mt][nt][j] * g512 + ld_sc1_f(sl + (mt * 16 + (lane >> 4) * 4 + j) * 128 + 32 * w + nt * 16 + (lane & 15));
    }
  }
  const u32x4 z4 = (u32x4){0, 0, 0, 0};
  for (int c = 0; c < nchunk; ++c) {
    const int r0 = row_base + c * 64;
    __syncthreads();
#pragma unroll
    for (int i = 0; i < 4; ++i) {
      const int id = tid + i * NTHR, r = id >> 4, cc = (id & 15) * 8;
      u32x4 q4 = z4, k4 = z4;
      if (r < C) {
        q4 = ld_ws16(ws, Qg + (size_t)(r0 + r) * 512 + h * 128 + cc);
        k4 = ld_ws16(ws, Kg + (size_t)(r0 + r) * 512 + h * 128 + cc);
      }
      *(u32x4*)(sQ + r * 144 + cc) = q4;
      *(u32x4*)(sK + r * 144 + cc) = k4;
    }
#pragma unroll
    for (int i = 0; i < 4; ++i) {
      const int id = tid + i * NTHR, r = id >> 3, cc = (id & 7) * 8;
      u32x4 v4 = z4;
      if (cc < C) v4 = ld_ws16(ws, Vt + (size_t)r * tr_ld + c * 64 + cc);
      *(u32x4*)(sV + r * LDS_STRIDE + cc) = v4;
    }
    __syncthreads();
    {
      f32x4 sc4[4];
#pragma unroll
      for (int m = 0; m < 4; ++m) sc4[m] = (f32x4){0.f, 0.f, 0.f, 0.f};
#pragma unroll
      for (int ks = 0; ks < 4; ++ks) {
        const bf16x8 bk = *(const bf16x8*)(sK + (16 * w + (lane & 15)) * 144 + ks * 32 + (lane >> 4) * 8);
#pragma unroll
        for (int m = 0; m < 4; ++m) {
          const bf16x8 aq = *(const bf16x8*)(sQ + (m * 16 + (lane & 15)) * 144 + ks * 32 + (lane >> 4) * 8);
          sc4[m] = MFMA16(aq, bk, sc4[m]);
        }
      }
      MFMA_FENCE();
      const int jc = 16 * w + (lane & 15);
#pragma unroll
      for (int m = 0; m < 4; ++m)
#pragma unroll
        for (int j = 0; j < 4; ++j) {
          const int i = m * 16 + (lane >> 4) * 4 + j;
          const int dd = i > jc ? i - jc : jc - i;
          sS[i * LDS_STRIDE + jc] = f2bf(sc4[m][j] * exp2f(gl2 * (float)dd));
        }
    }
    __syncthreads();
#pragma unroll
    for (int i = 0; i < 4; ++i) {
      const int id = tid + i * NTHR, r = id >> 3, cc = (id & 7) * 8;
      u32x4 v4 = z4;
      if (cc < C) v4 = ld_ws16(ws, Ktd + (size_t)r * tr_ld + c * 64 + cc);
      *(u32x4*)(sK + r * LDS_STRIDE + cc) = v4;
    }
    f32x4 o[4][2];
#pragma unroll
    for (int m = 0; m < 4; ++m) { o[m][0] = (f32x4){0.f, 0.f, 0.f, 0.f}; o[m][1] = o[m][0]; }
#pragma unroll
    for (int a = 0; a < 4; ++a) {
      bf16x8 bs[2];
#pragma unroll
      for (int nt = 0; nt < 2; ++nt) {
        u32x4 u;
        u.x = pack2(S[2 * a][nt][0], S[2 * a][nt][1]); u.y = pack2(S[2 * a][nt][2], S[2 * a][nt][3]);
        u.z = pack2(S[2 * a + 1][nt][0], S[2 * a + 1][nt][1]); u.w = pack2(S[2 * a + 1][nt][2], S[2 * a + 1][nt][3]);
        bs[nt] = __builtin_bit_cast(bf16x8, u);
      }
#pragma unroll
      for (int m = 0; m < 4; ++m) {
        const u16* qp = sQ + (m * 16 + (lane & 15)) * 144 + (lane >> 4) * 4;
        const u32x2 lo = *(const u32x2*)(qp + (2 * a) * 16);
        const u32x2 hi = *(const u32x2*)(qp + (2 * a + 1) * 16);
        const bf16x8 aq = __builtin_bit_cast(bf16x8, ((u32x4){lo.x, lo.y, hi.x, hi.y}));
        o[m][0] = MFMA16(aq, bs[0], o[m][0]);
        o[m][1] = MFMA16(aq, bs[1], o[m][1]);
      }
      __builtin_amdgcn_sched_barrier(0);
    }
    MFMA_FENCE();
#pragma unroll
    for (int m = 0; m < 4; ++m)
#pragma unroll
      for (int j = 0; j < 4; ++j) {
        const int i = m * 16 + (lane >> 4) * 4 + j;
        const float f = exp2f(gl2 * (float)(i + 1));
        o[m][0][j] *= f;
        o[m][1][j] *= f;
      }
#pragma unroll
    for (int ks = 0; ks < 2; ++ks) {
      bf16x8 bv[2];
#pragma unroll
      for (int nt = 0; nt < 2; ++nt) bv[nt] = *(const bf16x8*)(sV + (32 * w + nt * 16 + (lane & 15)) * LDS_STRIDE + ks * 32 + (lane >> 4) * 8);
#pragma unroll
      for (int m = 0; m < 4; ++m) {
        const bf16x8 as = *(const bf16x8*)(sS + (m * 16 + (lane & 15)) * LDS_STRIDE + ks * 32 + (lane >> 4) * 8);
        o[m][0] = MFMA16(as, bv[0], o[m][0]);
        o[m][1] = MFMA16(as, bv[1], o[m][1]);
      }
      __builtin_amdgcn_sched_barrier(0);
    }
    MFMA_FENCE();
#pragma unroll
    for (int m = 0; m < 4; ++m)
#pragma unroll
      for (int j = 0; j < 4; ++j) {
        float v = o[m][0][j] * o[m][0][j] + o[m][1][j] * o[m][1][j];
        v = red16(v);
        if ((lane & 15) == 0) sR[w * 64 + m * 16 + (lane >> 4) * 4 + j] = v;
      }
    __syncthreads();
#pragma unroll
    for (int m = 0; m < 4; ++m)
#pragma unroll
      for (int j = 0; j < 4; ++j) {
        const int i = m * 16 + (lane >> 4) * 4 + j;
        if (i < C) {
          const float ss = sR[i] + sR[64 + i] + sR[128 + i] + sR[192 + i];
          const float rs = rsqrtf(ss * (1.0f / 128.0f) + EPSF);
#pragma unroll
          for (int nt = 0; nt < 2; ++nt) {
            const int e = 32 * w + nt * 16 + (lane & 15);
            const float g = bf2f(ld_sc1_2(Gg + (size_t)(r0 + i) * 512 + h * 128 + e));
            reto[(size_t)(r0 + i) * 512 + h * 128 + e] = f2bf(o[m][nt][j] * rs * siluf_(g));
          }
        }
      }
#pragma unroll
    for (int mt = 0; mt < 8; ++mt) { S[mt][0] *= gC; S[mt][1] *= gC; }
#pragma unroll 1
    for (int ks = 0; ks < 2; ++ks) {
      bf16x8 bv[2];
#pragma unroll
      for (int nt = 0; nt < 2; ++nt) bv[nt] = *(const bf16x8*)(sV + (32 * w + nt * 16 + (lane & 15)) * LDS_STRIDE + ks * 32 + (lane >> 4) * 8);
#pragma unroll
      for (int mt = 0; mt < 8; ++mt) {
        const bf16x8 ak = *(const bf16x8*)(sK + (mt * 16 + (lane & 15)) * LDS_STRIDE + ks * 32 + (lane >> 4) * 8);
        S[mt][0] = MFMA16(ak, bv[0], S[mt][0]);
        S[mt][1] = MFMA16(ak, bv[1], S[mt][1]);
      }
    }
    MFMA_FENCE();
  }
  if (samp || sc == 15) {
    float* so = samp ? (p.out + O_RET_S + ((size_t)(l * 64 + bh)) * 16384) : (p.out + O_RET_P + ((size_t)(l * 16 + bh)) * 16384);
#pragma unroll
    for (int mt = 0; mt < 8; ++mt)
#pragma unroll
      for (int nt = 0; nt < 2; ++nt)
#pragma unroll
        for (int j = 0; j < 4; ++j) so[(mt * 16 + (lane >> 4) * 4 + j) * 128 + 32 * w + nt * 16 + (lane & 15)] = S[mt][nt][j];
  }
}

DI void s5_task(const Params& p, int l, int t, int mode) {
  char* ws = p.ws;
  char* arena = ws + OFF_ARENA;
  const int tid = ltid(), lane = tid & 63, w = tid >> 6;
  const bool samp = t >= 512;
  int b, lc, g, row_base, nsub;
  if (!samp) { b = t >> 7; lc = (t >> 3) & 15; g = (t & 7) * 4 + w; row_base = b * SEQ + lc * 512; nsub = 32; }
  else { const int q = t - 512; b = q >> 3; lc = 0; g = (q & 7) * 4 + w; row_base = PROWS + b * 16; nsub = 1; }
  const char* sp = ws + OFF_S5P + (size_t)l * S5P_LAYER;
  const u16* bbt = (const u16*)(sp + S5P_BBT) + g * 2048;
  const u16* cm = (const u16*)(sp + S5P_CM) + g * 2048;
  const float* ab = (const float*)(sp + S5P_ABAR) + g * 128;
  const u16* U = (const u16*)(arena + 0 * SLOT);
  u16* Z = (u16*)(arena + 6 * SLOT);
  float* bu = (float*)(smem + w * 13056);
  u16* xs = (u16*)(smem + w * 13056 + 8448);
  const float ar = ld_sc1_f(ab + lane * 2), ai = ld_sc1_f(ab + lane * 2 + 1);
  const int slab = lane >> 4;
  const u32x4 z4 = (u32x4){0, 0, 0, 0};
  bf16x8 Bf[8], Cf[4];
#pragma unroll
  for (int nt = 0; nt < 8; ++nt) {
    u32x4 u = z4;
    if (slab < 2) u = ld_ws16(ws, bbt + (nt * 16 + (lane & 15)) * 16 + slab * 8);
    Bf[nt] = __builtin_bit_cast(bf16x8, u);
  }
#pragma unroll
  for (int ks = 0; ks < 4; ++ks) Cf[ks] = __builtin_bit_cast(bf16x8, ld_ws16(ws, cm + (lane & 15) * 128 + ks * 32 + slab * 8));
  const float Dh = p.s5_d[(l * 32 + g) * 16 + (lane & 15)];
  float xr = 0.f, xi = 0.f;
  if (samp) {
    xr = p.s5re0[((size_t)(l * 16 + b) * 32 + g) * 64 + lane];
    xi = p.s5im0[((size_t)(l * 16 + b) * 32 + g) * 64 + lane];
  } else if (mode == 1 && lc > 0) {
    float pr = ar, pi = ai;
#pragma unroll
    for (int s = 0; s < 9; ++s) { const float nr = pr * pr - pi * pi, ni = 2.f * pr * pi; pr = nr; pi = ni; }
    const float* el = (const float*)(ws + OFF_ELOC);
    for (int c2 = 0; c2 < lc; ++c2) {
      const float er = ld_sc1_f(el + (((size_t)(b * 16 + c2) * 32 + g) * 64 + lane) * 2), ei = ld_sc1_f(el + (((size_t)(b * 16 + c2) * 32 + g) * 64 + lane) * 2 + 1);
      const float nr = pr * xr - pi * xi + er, ni = pr * xi + pi * xr + ei;
      xr = nr; xi = ni;
    }
  }
  u16* usm = (u16*)(smem + 52224 + w * 512);
  const u16* up = U + (size_t)(row_base + (lane & 15)) * 512 + g * 16 + (slab & 1) * 8;
  u32x4 ua = ld_ws16(ws, up);
  for (int sub = 0; sub < nsub; ++sub) {
    const int r0 = row_base + sub * 16;
    u32x4 un = z4;
    if (sub + 1 < nsub) un = ld_ws16(ws, up + (size_t)(sub + 1) * 16 * 512);
    if (slab >= 2) ua = z4;
    const bf16x8 Af = __builtin_bit_cast(bf16x8, ua);
    __syncthreads();
    if (mode == 1 && slab < 2) *(u32x4*)(usm + (lane & 15) * 16 + slab * 8) = ua;
    f32x4 a8[8];
#pragma unroll
    for (int nt = 0; nt < 8; ++nt) a8[nt] = MFMA16(Af, Bf[nt], ((f32x4){0.f, 0.f, 0.f, 0.f}));
    __builtin_amdgcn_sched_barrier(0);
    asm volatile("s_nop 15\n\ts_nop 15\n\ts_nop 15" ::: "memory");
    __builtin_amdgcn_sched_barrier(0);
#pragma unroll
    for (int nt = 0; nt < 8; ++nt) {
#pragma unroll
      for (int j = 0; j < 4; ++j) bu[(slab * 4 + j) * 132 + nt * 16 + (lane & 15)] = a8[nt][j];
    }
    __syncthreads();
#pragma unroll
    for (int tt = 0; tt < 16; ++tt) {
      const float br = bu[tt * 132 + lane], bi = bu[tt * 132 + 64 + lane];
      const float nr = ar * xr - ai * xi + br, ni = ar * xi + ai * xr + bi;
      xr = nr; xi = ni;
      if (mode == 1) { xs[tt * 144 + lane] = f2bf(xr); xs[tt * 144 + 64 + lane] = f2bf(xi); }
    }
    if (mode == 1) {
      __syncthreads();
      f32x4 y = (f32x4){0.f, 0.f, 0.f, 0.f};
#pragma unroll
      for (int ks = 0; ks < 4; ++ks) {
        const bf16x8 ax = *(const bf16x8*)(xs + (lane & 15) * 144 + ks * 32 + slab * 8);
        y = MFMA16(ax, Cf[ks], y);
      }
      __builtin_amdgcn_sched_barrier(0);
      asm volatile("s_nop 15\n\ts_nop 15" ::: "memory");
      __builtin_amdgcn_sched_barrier(0);
#pragma unroll
      for (int j = 0; j < 4; ++j) {
        const int rr = r0 + slab * 4 + j, cc = g * 16 + (lane & 15);
        const float u = bf2f(usm[(slab * 4 + j) * 16 + (lane & 15)]);
        Z[(size_t)rr * 512 + cc] = f2bf(geluf_(y[j] + Dh * u));
      }
    }
    ua = un;
  }
  if (mode == 0) {
    float* el = (float*)(ws + OFF_ELOC);
    el[(((size_t)(b * 16 + lc) * 32 + g) * 64 + lane) * 2] = xr;
    el[(((size_t)(b * 16 + lc) * 32 + g) * 64 + lane) * 2 + 1] = xi;
  } else if (samp) {
    p.out[O_S5RE_S + ((size_t)(l * 16 + b) * 32 + g) * 64 + lane] = xr;
    p.out[O_S5IM_S + ((size_t)(l * 16 + b) * 32 + g) * 64 + lane] = xi;
  } else if (lc == 15) {
    p.out[O_S5RE_P + ((size_t)(l * 4 + b) * 32 + g) * 64 + lane] = xr;
    p.out[O_S5IM_P + ((size_t)(l * 4 + b) * 32 + g) * 64 + lane] = xi;
  }
}

DI void glu_tile(const Params& p, int l, int t) {
  char* ws = p.ws;
  char* arena = ws + OFF_ARENA;
  const int rt = t >> 2, ct = t & 3, row0 = rt * 128, col0 = ct * 128;
  const u16* Zb = (const u16*)(arena + 6 * SLOT);
  const u16* A = Zb + (size_t)row0 * 512;
  const u16* B = (const u16*)(ws + OFF_W) + (size_t)l * W_LAYER + W_GLU + (size_t)col0 * 512;
  f32x4 acc[4][4];
  zero_acc(acc);
  u16* sA = (u16*)smem; u16* sB = sA + 128 * LDS_STRIDE;
  gemm_mainloop<128, 128, 2, 2>(A, 512, B, 512, 512, 1 << 30, acc, sA, sB, NoHook());
  const int lane = ltid() & 63, wid = ltid() >> 6, wm = wid >> 1, wn = wid & 1;
  u16* Z2 = (u16*)(arena + 0 * SLOT);
  float* zsq = (float*)(ws + OFF_ZSQ);
  const float* bg = p.b_glu + l * 512;
  u16* sT = (u16*)smem;
  __syncthreads();
  {
    const int tq = ltid();
#pragma unroll
    for (int i = 0; i < 8; ++i) {
      const int id = tq + i * NTHR, rr = id >> 4, cc = (id & 15) * 8;
      *(u32x4*)(sT + rr * 136 + cc) = ld_ws16(ws, Zb + (size_t)(row0 + rr) * 512 + col0 + cc);
    }
  }
  __syncthreads();
#pragma unroll
  for (int m = 0; m < 4; ++m) {
    float ss[4] = {0.f, 0.f, 0.f, 0.f};
    const int rl = wm * 64 + m * 16 + (lane >> 4) * 4;
#pragma unroll
    for (int n = 0; n < 4; ++n) {
      const int cl = wn * 64 + n * 16 + (lane & 15);
      const float bb = bg[col0 + cl];
#pragma unroll
      for (int j = 0; j < 4; ++j) {
        const float z = bf2f(sT[(rl + j) * 136 + cl]);
        const float z2 = z * sigmoidf_(acc[m][n][j] + bb);
        ss[j] += z2 * z2;
        sT[(rl + j) * 136 + cl] = f2bf(z2);
      }
    }
#pragma unroll
    for (int j = 0; j < 4; ++j) {
      const float v = red16(ss[j]);
      if ((lane & 15) == 0) zsq[(size_t)(ct * 2 + wn) * NTOK + row0 + rl + j] = v;
    }
  }
  __syncthreads();
  tile_flush128(sT, Z2, 512, row0, col0);
}

DI void store_raw_rsq(const f32x4 (&acc)[4][4], u16* raw, float* rsq, int row0, int col0, int ct) {
  tile_out_128(acc, raw, 1024, row0, col0);
}

DI void out_tile(const Params& p, int l, int t) {
  char* ws = p.ws;
  char* arena = ws + OFF_ARENA;
  const int rt = t >> 3, ct = t & 7, row0 = rt * 128, col0 = ct * 128;
  const u16* B = (const u16*)(ws + OFF_W) + (size_t)l * W_LAYER + W_OUT + (size_t)col0 * 1024;
  f32x4 acc[4][4];
  zero_acc(acc);
  u16* sA = (u16*)smem; u16* sB = sA + 128 * LDS_STRIDE;
  float* rsl = (float*)(smem + 40960);
  const float* zsq = (const float*)(ws + OFF_ZSQ);
  {
    const int tq = ltid();
    if (tq < 128) {
      float zs = 0.f;
#pragma unroll
      for (int q = 0; q < 8; ++q) zs += ld_sc1_f(zsq + (size_t)q * NTOK + row0 + tq);
      rsl[tq] = rsqrtf(zs * (1.0f / 512.0f) + EPSF);
    }
  }
  gemm_mainloop<128, 128, 2, 2>((const u16*)(arena + 0 * SLOT) + (size_t)row0 * 512, 512, B, 1024, 512, 1 << 30, acc, sA, sB, NoHook());
  const int lane = ltid() & 63, wid = ltid() >> 6, wm = wid >> 1;
#pragma unroll
  for (int m = 0; m < 4; ++m)
#pragma unroll
    for (int j = 0; j < 4; ++j) {
      const float rs = rsl[wm * 64 + m * 16 + (lane >> 4) * 4 + j];
#pragma unroll
      for (int n = 0; n < 4; ++n) acc[m][n][j] *= rs;
    }
  gemm_mainloop<128, 128, 2, 2>((const u16*)(arena + 7 * SLOT) + (size_t)row0 * 512, 512, B + 512, 1024, 512, 1 << 30, acc, sA, sB, NoHook());
  store_raw_rsq(acc, (u16*)(arena + 1 * SLOT), (float*)(ws + OFF_RSQ), row0, col0, ct);
}

DI void raw_tile(const Params& p, const u16* Abase, int lda, const u16* Bbase, int K, u16* raw, int t) {
  char* ws = p.ws;
  const int rt = t >> 3, ct = t & 7, row0 = rt * 128, col0 = ct * 128;
  f32x4 acc[4][4];
  zero_acc(acc);
  u16* sA = (u16*)smem; u16* sB = sA + 128 * LDS_STRIDE;
  gemm_mainloop<128, 128, 2, 2>(Abase + (size_t)row0 * lda, lda, Bbase + (size_t)col0 * K, K, K, 1 << 30, acc, sA, sB, NoHook());
  store_raw_rsq(acc, raw, (float*)(ws + OFF_RSQ), row0, col0, ct);
}

DI void post_task(const Params& p, const u16* raw, const float* gpost, int t, bool last) {
  char* ws = p.ws;
  const int lane = ltid() & 63;
  const int row = t * 4 + (ltid() >> 6);
  const u16* rw = raw + (size_t)row * 1024;
  u16* hb = (u16*)(ws + OFF_HB) + (size_t)row * 1024;
  float* xsp = (float*)(ws + OFF_RSQ) + row;
  const float xscale = ld_sc1_f(xsp);
  float4 rv[4];
  float s = 0.f;
#pragma unroll
  for (int i = 0; i < 4; ++i) {
    const int c = i * 256 + lane * 4;
    const u32x2 r2 = ld_sc1_8(rw + c);
    rv[i].x = bf2f((u16)(r2.x & 0xffff)); rv[i].y = bf2f((u16)(r2.x >> 16));
    rv[i].z = bf2f((u16)(r2.y & 0xffff)); rv[i].w = bf2f((u16)(r2.y >> 16));
    s += rv[i].x * rv[i].x + rv[i].y * rv[i].y + rv[i].z * rv[i].z + rv[i].w * rv[i].w;
  }
  s = red64(s);
  const float rr = rsqrtf(s * (1.0f / 1024.0f) + EPSF);
  float4 v[4];
  float ss = 0.f;
#pragma unroll
  for (int i = 0; i < 4; ++i) {
    const int c = i * 256 + lane * 4;
    const u32x2 h2 = ld_sc1_8(hb + c);
    const float4 g = *(const float4*)(gpost + c);
    v[i].x = bf2f((u16)(h2.x & 0xffff)) * xscale + rv[i].x * rr * g.x;
    v[i].y = bf2f((u16)(h2.x >> 16)) * xscale + rv[i].y * rr * g.y;
    v[i].z = bf2f((u16)(h2.y & 0xffff)) * xscale + rv[i].z * rr * g.z;
    v[i].w = bf2f((u16)(h2.y >> 16)) * xscale + rv[i].w * rr * g.w;
    ss += v[i].x * v[i].x + v[i].y * v[i].y + v[i].z * v[i].z + v[i].w * v[i].w;
  }
  ss = red64(ss);
  const float r = rsqrtf(ss * (1.0f / 1024.0f) + EPSF);
  if (lane == 0) *xsp = 1.0f / r;
  float* y = p.out + O_Y + (size_t)row * 1024;
#pragma unroll
  for (int i = 0; i < 4; ++i) {
    const int c = i * 256 + lane * 4;
    if (last) *(float4*)(y + c) = v[i];
    u32x2 o; o.x = pack2(v[i].x * r, v[i].y * r); o.y = pack2(v[i].z * r, v[i].w * r);
    *(u32x2*)(hb + c) = o;
  }
}

DI void cq_tile(const Params& p, int l, int t) {
  char* ws = p.ws;
  char* arena = ws + OFF_ARENA;
  const int rt = t >> 3, ct = t & 7, row0 = rt * 128, col0 = ct * 128;
  f32x4 acc[4][4];
  zero_acc(acc);
  u16* sA = (u16*)smem; u16* sB = sA + 128 * LDS_STRIDE;
  gemm_mainloop<128, 128, 2, 2>((const u16*)(ws + OFF_HB) + (size_t)row0 * 1024, 1024,
                                (const u16*)(ws + OFF_W) + (size_t)l * W_LAYER + W_CQ + (size_t)col0 * 1024, 1024, 1024, 1 << 30, acc, sA, sB, NoHook());
  tile_out_128(acc, (u16*)(arena + 3 * SLOT), 1024, row0, col0);
}

DI void att_task(const Params& p, int l, int t) {
  char* ws = p.ws;
  char* arena = ws + OFF_ARENA;
  const int tid = ltid(), lane = tid & 63, w = tid >> 6;
  int row0, h, nvalid;
  const u16 *KX, *VTX;
  if (t < 2048) {
    const int rt = t >> 2; h = t & 3; row0 = rt * 64; nvalid = 64;
    const int b = row0 >> 13;
    KX = (const u16*)(ws + OFF_KXP) + ((size_t)(l * 4 + b)) * 256 * 1024 + h * 256;
    VTX = (const u16*)(ws + OFF_VTXP) + ((size_t)((l * 4 + b) * 4 + h)) * 65536;
  } else {
    const int q = t - 2048, b = q >> 2; h = q & 3; row0 = PROWS + b * 16; nvalid = 16;
    KX = (const u16*)(ws + OFF_KXS) + (size_t)b * 256 * 1024 + h * 256;
    VTX = (const u16*)(ws + OFF_VTXS) + ((size_t)(b * 4 + h)) * 65536;
  }
  const u16* QX = (const u16*)(arena + 3 * SLOT);
  u16* OX = (u16*)(arena + 5 * SLOT);
#ifdef EXP_ATT_COPY
  for (int e = tid; e < nvalid * 256; e += NTHR) { const int r = e >> 8, c = e & 255; OX[(size_t)(row0 + r) * 1024 + h * 256 + c] = QX[(size_t)(row0 + r) * 1024 + h * 256 + c]; }
  return;
#endif
  const int arow0 = (row0 + 64 <= NTOK) ? row0 : (NTOK - 64);
  const int shift = row0 - arow0;
  u16* sA = (u16*)smem;
  u16* sB = (u16*)(smem + 34816);
  f32x4 acc[1][16];
  zero_acc(acc);
  gemm_mainloop<64, 256, 4, 1>(QX + (size_t)arow0 * 1024 + h * 256, 1024, KX, 1024, 256, 1 << 30, acc, sA, sB, NoHook());
  float inv[4];
#pragma unroll
  for (int j = 0; j < 4; ++j) {
    float mx = -3.0e38f;
#pragma unroll
    for (int n = 0; n < 16; ++n) mx = fmaxf(mx, acc[0][n][j]);
    mx = max16(mx);
    float s = 0.f;
#pragma unroll
    for (int n = 0; n < 16; ++n) { const float e = __expf(acc[0][n][j] - mx); acc[0][n][j] = e; s += e; }
    s = red16(s);
    inv[j] = 1.0f / s;
  }
  __syncthreads();
  u16* sP = (u16*)smem;
#pragma unroll
  for (int n = 0; n < 16; ++n)
#pragma unroll
    for (int j = 0; j < 4; ++j) sP[(w * 16 + (lane >> 4) * 4 + j) * 272 + n * 16 + (lane & 15)] = f2bf(acc[0][n][j] * inv[j]);
  zero_acc(acc);
  gemm_mainloop_alds<64, 256, 4, 1>(sP, 272, VTX, 256, 256, acc, sB);
#pragma unroll
  for (int n = 0; n < 16; ++n)
#pragma unroll
    for (int j = 0; j < 4; ++j) {
      const int rl = w * 16 + (lane >> 4) * 4 + j - shift;
      if (rl >= 0 && rl < nvalid) OX[(size_t)(row0 + rl) * 1024 + h * 256 + n * 16 + (lane & 15)] = f2bf(acc[0][n][j]);
    }
}

DI void gu_tile(const Params& p, int l, int t) {
  char* ws = p.ws;
  char* arena = ws + OFF_ARENA;
  const int rt = t / 44, ct = t % 44, row0 = rt * 128, col0 = ct * 128;
  f32x4 acc[4][4];
  zero_acc(acc);
  u16* sA = (u16*)smem; u16* sB = sA + 128 * LDS_STRIDE;
  gemm_mainloop<128, 128, 2, 2>((const u16*)(ws + OFF_HB) + (size_t)row0 * 1024, 1024,
                                (const u16*)(ws + OFF_W) + (size_t)l * W_LAYER + W_GU + (size_t)col0 * 1024, 1024, 1024, 1 << 30, acc, sA, sB, NoHook());
  const int tid = ltid(), lane = tid & 63, wid = tid >> 6, wm = wid >> 1, wn = wid & 1;
  u16* act = (u16*)(arena + 2 * SLOT);
  u16* sT = (u16*)smem;
  __syncthreads();
#pragma unroll
  for (int m = 0; m < 4; ++m)
#pragma unroll
    for (int np = 0; np < 2; ++np)
#pragma unroll
      for (int j = 0; j < 4; ++j)
        tile_put(sT, 72, wm * 64 + m * 16 + (lane >> 4) * 4 + j, wn * 32 + np * 16 + (lane & 15), siluf_(acc[m][2 * np][j]) * acc[m][2 * np + 1][j]);
  __syncthreads();
#pragma unroll
  for (int i = 0; i < 4; ++i) {
    const int id = tid + i * NTHR, r = id >> 3, c = (id & 7) * 8;
    *(u32x4*)(act + (size_t)(row0 + r) * DFF + (col0 >> 1) + c) = *(const u32x4*)(sT + r * 72 + c);
  }
}

DI void dbg_dump(const Params& p) {
#ifdef DUMP_SLOT
  const u16* src = (const u16*)(p.ws + OFF_ARENA + (size_t)DUMP_SLOT * SLOT);
  float* dst = p.out + O_Y;
  for (size_t i = (size_t)blockIdx.x * NTHR + threadIdx.x; i < (size_t)NTOK * 1024; i += (size_t)gridDim.x * NTHR) dst[i] = bf2f(src[i]);
#endif
#ifdef DUMP_HB
  const u16* src = (const u16*)(p.ws + OFF_HB);
  float* dst = p.out + O_Y;
  for (size_t i = (size_t)blockIdx.x * NTHR + threadIdx.x; i < (size_t)NTOK * 1024; i += (size_t)gridDim.x * NTHR) dst[i] = bf2f(src[i]);
#endif
}
#define PH_BEGIN { const int myph = ph++; const bool act_ = (myph >= p.ph_lo && myph < p.ph_hi); if (act_) { unsigned* c = &ctr[myph]; (void)c; phase_begin();
#define PH_END } if (act_ && myph + 1 < p.ph_hi) grid_barrier(bar); }

__global__ void __launch_bounds__(NTHR, 2) fwd_megakernel(Params p) {
  unsigned* bar = (unsigned*)(p.ws + OFF_BAR);
  unsigned* ctr = (unsigned*)(p.ws + OFF_CTR);
  if (threadIdx.x == 0) { g_xb[0] = 0u; g_xb[1] = 0u; g_xb[2] = 0u; g_xb[3] = 0u; }
  __syncthreads();
  if (USE_XCD_BARRIER) { if (threadIdx.x == 0) (void)xb_add(&bar[XB_XCNT(xb_xcc_id())], 1u); }
  if (p.never) cg::this_grid().sync();
  int ph = 0;
  char* ws = p.ws;
  char* arena = ws + OFF_ARENA;
#ifdef DUMP_AFTER
  if (p.ph_lo < 0) {
    const u16* src = (const u16*)(ws + DUMP_OFF);
    for (size_t j = (size_t)blockIdx.x * NTHR + threadIdx.x; j < (size_t)1048576; j += (size_t)gridDim.x * NTHR) {
      float acc = 0.f;
      size_t idx = (j * 131u) % DUMP_N;
      for (int k = 0; k < 512; ++k) {
        const float e = bf2f((u16)(src[idx] & 0xBFFF));
        acc = acc * 0.75f + e * (1.0f + 0.001f * (float)(k & 15));
        idx += 65537u; if (idx >= DUMP_N) idx -= DUMP_N;
      }
      float v = acc;
      for (int k = 0; k < 200; ++k) { v = bf2f(f2bf(v * 1.37f + 0.11f)); if (fabsf(v) > 4.f) v *= 0.125f; }
      p.out[O_Y + j] = v;
    }
    return;
  }
#endif
#ifdef EXP_CHAOS
  if (p.ph_lo == 0) {
    for (size_t i = (size_t)blockIdx.x * NTHR + threadIdx.x; i < (size_t)NTOK * 1024; i += (size_t)gridDim.x * NTHR) {
      float v = (i < (size_t)PROWS * 1024) ? p.x_prompt[i] : p.x_sample[i - (size_t)PROWS * 1024];
      float w = p.w_in[i % (4u * 1024u * 2560u)];
      for (int k = 0; k < 200; ++k) { v = bf2f(f2bf(v * 1.37f + w)); if (fabsf(v) > 4.f) v *= 0.125f; }
      p.out[O_Y + i] = v;
    }
  }
  return;
#endif

  PH_BEGIN
    phase_prep(p, c);
  PH_END

  for (int l_ = 0; l_ < DEPTHC; ++l_) {
    const int l = lsgpr(l_);
    const u16* wl = (const u16*)(ws + OFF_W) + (size_t)l * W_LAYER;
    PH_BEGIN
      const int n_g1 = 258 * 20, n_mk = (l == 0) ? 512 : 0, n_cc = 2048;
      for (;;) {
        int t = next_task(c);
        if (t >= n_g1 + n_mk + n_cc) break;
        if (t < n_g1) g1_tile(p, l, t);
        else if (t < n_g1 + n_mk) memkv_tile(p, t - n_g1);
        else cache_task(p, l, t - n_g1 - n_mk);
      }
    PH_END
    PH_BEGIN
      for (;;) {
        int t = next_task(c);
        if (t >= 256 + 512) break;
        if (t < 256) ret_local_task(p, t);
        else s5_task(p, l, t - 256, 0);
      }
    PH_END
    PH_BEGIN
      for (;;) {
        int t = next_task(c);
        if (t >= 320 + 640) break;
        if (t < 320) ret_final_task(p, l, t);
        else s5_task(p, l, t - 320, 1);
      }
    PH_END
    PH_BEGIN
      TASK_LOOP(c, 258 * 4, glu_tile(p, l, t))
    PH_END
    PH_BEGIN
      TASK_LOOP(c, 258 * 8, out_tile(p, l, t))
    PH_END
    PH_BEGIN
      for (int t = blockIdx.x; t < NTOK / 4; t += gridDim.x) { post_task(p, (const u16*)(arena + 1 * SLOT), p.mix_post + l * 1024, t, false); }
    PH_END
    PH_BEGIN
      TASK_LOOP(c, 258 * 8, cq_tile(p, l, t))
    PH_END
    PH_BEGIN
      TASK_LOOP(c, 2112, att_task(p, l, t))
    PH_END
    PH_BEGIN
      TASK_LOOP(c, 258 * 8, raw_tile(p, (const u16*)(arena + 5 * SLOT), 1024, wl + W_CO, 1024, (u16*)(arena + 1 * SLOT), t))
    PH_END
    PH_BEGIN
      for (int t = blockIdx.x; t < NTOK / 4; t += gridDim.x) { post_task(p, (const u16*)(arena + 1 * SLOT), p.xa_post + l * 1024, t, false); }
    PH_END
    PH_BEGIN
      TASK_LOOP(c, 258 * 44, gu_tile(p, l, t))
    PH_END
    PH_BEGIN
      TASK_LOOP(c, 258 * 8, raw_tile(p, (const u16*)(arena + 2 * SLOT), DFF, wl + W_DN, DFF, (u16*)(arena + 0 * SLOT), t))
    PH_END
    PH_BEGIN
      for (int t = blockIdx.x; t < NTOK / 4; t += gridDim.x) { post_task(p, (const u16*)(arena + 0 * SLOT), p.ffn_post + l * 1024, t, l == DEPTHC - 1); }
    PH_END
  }
}

#ifndef N_LAUNCH_SPLIT
#define N_LAUNCH_SPLIT 0
#endif
constexpr int N_PHASES = 1 + 13 * DEPTHC;

extern "C" void kernel_launch(void* const* d_in, const int* in_sizes, int n_in, void* d_out, int out_size, void* d_ws,
                              size_t ws_size, hipStream_t stream) {
  static int grid_blocks = 0;
  if (!grid_blocks) {
    int dev = 0, cus = 0, per_cu = 0;
    (void)hipGetDevice(&dev);
    (void)hipDeviceGetAttribute(&cus, hipDeviceAttributeMultiprocessorCount, dev);
    (void)hipOccupancyMaxActiveBlocksPerMultiprocessor(&per_cu, fwd_megakernel, NTHR, 0);
    if (per_cu > 2) per_cu = 2;
    if (per_cu < 1) per_cu = 1;
    grid_blocks = cus * per_cu;
  }
  if (ws_size < WS_NEEDED) fprintf(stderr, "workspace too small: %zu < %zu\n", ws_size, (size_t)WS_NEEDED);
  Params p{};
  const float** f = (const float**)&p;
  for (int i = 0; i < 36; ++i) f[i] = (const float*)d_in[i];
  p.out = (float*)d_out;
  p.ws = (char*)d_ws;
  p.never = 0;
  p.ph_lo = 0;
  p.ph_hi = N_PHASES;
  p.pad = 0;
  (void)hipMemsetAsync(d_ws, 0, 32768, stream);
  if (N_LAUNCH_SPLIT) {
#ifdef DUMP_AFTER
    const int nrun = DUMP_AFTER;
#else
    const int nrun = N_PHASES;
#endif
    for (int i = 0; i <= nrun; ++i) {
      if (i == nrun) {
#ifdef DUMP_AFTER
        p.ph_lo = -1; p.ph_hi = -1;
#else
        break;
#endif
      } else { p.ph_lo = i; p.ph_hi = i + 1; }
      void* args[] = {&p};
      hipError_t e = hipLaunchCooperativeKernel((void*)fwd_megakernel, dim3(grid_blocks), dim3(NTHR), args, 0, stream);
      if (e != hipSuccess) fprintf(stderr, "launch failed: %s (grid %d)\n", hipGetErrorString(e), grid_blocks);
    }
  } else {
    void* args[] = {&p};
    hipError_t e = hipLaunchCooperativeKernel((void*)fwd_megakernel, dim3(grid_blocks), dim3(NTHR), args, 0, stream);
    if (e != hipSuccess) fprintf(stderr, "cooperative launch failed: %s (grid %d)\n", hipGetErrorString(e), grid_blocks);
  }
}
```

```cpp
#include <hip/hip_runtime.h>
#include <hip/hip_bf16.h>
#include <hip/hip_cooperative_groups.h>
#include <stdint.h>
#include <stdio.h>
namespace cg = cooperative_groups;

typedef __attribute__((ext_vector_type(8))) short bf16x8;
typedef __attribute__((ext_vector_type(4))) float f32x4;
typedef unsigned short u16;
typedef __attribute__((ext_vector_type(4))) unsigned u32x4;
typedef __attribute__((ext_vector_type(2))) unsigned u32x2;
#define DI __device__ __forceinline__
#define MFMA16(a, b, c) __builtin_amdgcn_mfma_f32_16x16x32_bf16((a), (b), (c), 0, 0, 0)
#define MFMA_FENCE() do { __builtin_amdgcn_sched_barrier(0); asm volatile("s_nop 15\n\ts_nop 15" ::: "memory"); __builtin_amdgcn_sched_barrier(0); } while (0)

constexpr int NTOK = 33024, PROWS = 32768, DM = 1024, DFF = 2816, DEPTHC = 4;
constexpr int SEQ = 8192;
constexpr float EPSF = 1e-6f;
constexpr int NTHR = 256;
constexpr int LDS_STRIDE = 80;
constexpr int SMEM_BYTES = 76800;

constexpr size_t SLOT = (size_t)NTOK * 512 * 2;
constexpr size_t OFF_BAR = 0;
constexpr size_t OFF_CTR = 16384;
constexpr size_t OFF_W = 32768;
constexpr size_t W_IN = 0, W_GLU = W_IN + 2560 * 1024, W_OUT = W_GLU + 512 * 512, W_CQ = W_OUT + 1024 * 1024,
                 W_CK = W_CQ + 1024 * 1024, W_CV = W_CK + 1024 * 1024, W_CO = W_CV + 1024 * 1024,
                 W_GU = W_CO + 1024 * 1024, W_DN = W_GU + 5632 * 1024, W_LAYER = W_DN + 1024 * 2816;
constexpr size_t OFF_S5P = OFF_W + 4 * W_LAYER * 2;
constexpr size_t S5P_BBT = 0, S5P_CM = 131072, S5P_ABAR = 262144, S5P_LAYER = 278528;
constexpr size_t OFF_HB = OFF_S5P + 4 * S5P_LAYER;
constexpr size_t OFF_MEMB = OFF_HB + (size_t)NTOK * 1024 * 2;
constexpr size_t OFF_KXP = OFF_MEMB + 1024 * 1024 * 2;
constexpr size_t OFF_VTXP = OFF_KXP + 4 * 4 * 256 * 1024 * 2;
constexpr size_t OFF_KXS = OFF_VTXP + 4 * 4 * 256 * 1024 * 2;
constexpr size_t OFF_VTXS = OFF_KXS + 16 * 256 * 1024 * 2;
constexpr size_t OFF_SLOC = OFF_VTXS + 16 * 256 * 1024 * 2;
constexpr size_t OFF_ELOC = OFF_SLOC + 16 * 16 * 128 * 128 * 4;
constexpr size_t OFF_ZSQ = OFF_ELOC + 4 * 16 * 32 * 64 * 2 * 4;
constexpr size_t OFF_RSQ = OFF_ZSQ + (size_t)NTOK * 8 * 4;
constexpr size_t OFF_ARENA = OFF_RSQ + (size_t)NTOK * 16 * 4;
constexpr size_t WS_NEEDED = OFF_ARENA + 8 * SLOT;

constexpr size_t O_Y = 0, O_S5RE_P = 33816576, O_S5IM_P = 33849344, O_RET_P = 33882112, O_MK_P = 34930688,
                 O_MV_P = 39124992, O_S5RE_S = 43319296, O_S5IM_S = 43450368, O_RET_S = 43581440;

struct Params {
  const float *x_prompt, *x_sample, *mem_prompt, *s5re0, *s5im0, *ret0, *cmk, *cmv;
  const float *mix_pre, *mix_post, *w_in, *lam_re, *lam_im, *log_step, *b_re, *b_im, *c_re, *c_im, *s5_d, *w_glu,
      *b_glu, *s5_onorm, *ret_onorm, *w_out, *xa_pre, *xa_post, *mem_norm, *w_cq, *w_ck, *w_cv, *w_co, *ffn_pre,
      *ffn_post, *w_gate, *w_up, *w_down;
  float* out;
  char* ws;
  int never;
  int ph_lo;
  int ph_hi;
  int pad;
};

DI u16 f2bf(float f) {
  unsigned u = __float_as_uint(f);
  u += 0x7fffu + ((u >> 16) & 1u);
  return (u16)(u >> 16);
}
DI float bf2f(u16 h) { return __uint_as_float(((unsigned)h) << 16); }
DI unsigned pack2(float a, float b) { return (unsigned)f2bf(a) | ((unsigned)f2bf(b) << 16); }
DI float sigmoidf_(float x) { return 1.0f / (1.0f + __expf(-x)); }
DI float siluf_(float x) { return x * sigmoidf_(x); }
DI float geluf_(float x) {
  float t = 0.7978845608028654f * (x + 0.044715f * x * x * x);
  return 0.5f * x * (1.0f + tanhf(t));
}
DI float red16(float v) {
  v += __shfl_xor(v, 1); v += __shfl_xor(v, 2); v += __shfl_xor(v, 4); v += __shfl_xor(v, 8);
  return v;
}
DI float max16(float v) {
  v = fmaxf(v, __shfl_xor(v, 1)); v = fmaxf(v, __shfl_xor(v, 2)); v = fmaxf(v, __shfl_xor(v, 4)); v = fmaxf(v, __shfl_xor(v, 8));
  return v;
}
DI float red64(float v) {
  v = red16(v); v += __shfl_xor(v, 16); v += __shfl_xor(v, 32);
  return v;
}
DI void sincos_cw(float x, float* sn, float* cs) {
  const float k = rintf(x * 0.15915494309189535f);
  float r = fmaf(-k, 6.2831854820251465f, x);
  r = fmaf(-k, -1.7484555e-07f, r);
  *sn = __sinf(r); *cs = __cosf(r);
}
DI int ltid() { int x = threadIdx.x; asm volatile("" : "+v"(x)); return x; }
DI int lsgpr(int x) { asm volatile("" : "+s"(x)); return x; }
DI u32x4 ld_sc1_16(const void* p) {
  const unsigned long long* q = (const unsigned long long*)p;
  const unsigned long long a = __hip_atomic_load(q, __ATOMIC_RELAXED, __HIP_MEMORY_SCOPE_AGENT);
  const unsigned long long b = __hip_atomic_load(q + 1, __ATOMIC_RELAXED, __HIP_MEMORY_SCOPE_AGENT);
  return (u32x4){(unsigned)a, (unsigned)(a >> 32), (unsigned)b, (unsigned)(b >> 32)};
}
DI __amdgpu_buffer_rsrc_t mk_rsrc(const void* p) {
  const unsigned long long a = (unsigned long long)p;
  const unsigned lo = __builtin_amdgcn_readfirstlane((unsigned)a), hi = __builtin_amdgcn_readfirstlane((unsigned)(a >> 32));
  return __builtin_amdgcn_make_buffer_rsrc((void*)(((unsigned long long)hi << 32) | lo), 0, 0x7fffffff, 0x00020000);
}
DI u32x4 bld16(__amdgpu_buffer_rsrc_t r, unsigned voff, unsigned soff) { return __builtin_amdgcn_raw_buffer_load_b128(r, voff, soff, 16); }
DI u32x4 ld_ws16(const char* ws, const void* p) {
  const __amdgpu_buffer_rsrc_t r = __builtin_amdgcn_make_buffer_rsrc((void*)ws, 0, 0x7fffffff, 0x00020000);
  return __builtin_amdgcn_raw_buffer_load_b128(r, (unsigned)((const char*)p - ws), 0, 16);
}
DI u32x2 ld_sc1_8(const void* p) {
  const unsigned long long a = __hip_atomic_load((const unsigned long long*)p, __ATOMIC_RELAXED, __HIP_MEMORY_SCOPE_AGENT);
  return (u32x2){(unsigned)a, (unsigned)(a >> 32)};
}
DI u16 ld_sc1_2(const u16* p) { return __hip_atomic_load(p, __ATOMIC_RELAXED, __HIP_MEMORY_SCOPE_AGENT); }
DI float ld_sc1_f(const float* p) { return __hip_atomic_load(p, __ATOMIC_RELAXED, __HIP_MEMORY_SCOPE_AGENT); }
DI float gamma_l2(int h) { return log2f(1.0f - exp2f(-5.0f - (float)h)); }

#define XB_TMO 128
#define XB_XCNT(j) (256 + 64 * (j))
#define XB_XSUB(j) (1280 + 64 * (j))
#define XB_XGEN(j) (2304 + 64 * (j))
#define XB_TOP 3328
#define XB_TOPGEN 3392
#define XB_SPIN_CAP (1u << 26)
DI unsigned xb_ld(unsigned* p) { return __hip_atomic_load(p, __ATOMIC_RELAXED, __HIP_MEMORY_SCOPE_AGENT); }
DI unsigned xb_add(unsigned* p, unsigned v) { return __hip_atomic_fetch_add(p, v, __ATOMIC_RELAXED, __HIP_MEMORY_SCOPE_AGENT); }
DI unsigned xb_xcc_id() { return (unsigned)__builtin_amdgcn_s_getreg((3 << 11) | 20) & 0xFu; }
#define XB_SPIN(cond, bar) do { unsigned _sp = 0; while (cond) { __builtin_amdgcn_s_sleep(1); \
    if ((++_sp & 255u) == 0u) { if (xb_ld(&(bar)[XB_TMO])) break; if (_sp > XB_SPIN_CAP) { atomicAdd(&(bar)[XB_TMO], 1u); break; } } } } while (0)

__shared__ unsigned g_xb[4];
__shared__ __attribute__((aligned(16))) char smem[SMEM_BYTES];

DI void xcd_complete(unsigned* bar, unsigned x, unsigned& nloc, unsigned& nx) {
  const unsigned G = gridDim.x;
  unsigned sum, cnt, mine, sp = 0u;
  for (;;) {
    sum = 0u; cnt = 0u; mine = 0u;
#pragma unroll
    for (unsigned j = 0; j < 16; ++j) { const unsigned c = xb_ld(&bar[XB_XCNT(j)]); sum += c; cnt += (c > 0u) ? 1u : 0u; mine = (j == x) ? c : mine; }
    if (sum == G) break;
    __builtin_amdgcn_s_sleep(1);
    if ((++sp & 255u) == 0u) { if (xb_ld(&bar[XB_TMO])) break; if (sp > XB_SPIN_CAP) { atomicAdd(&bar[XB_TMO], 1u); break; } }
  }
  nloc = mine > 0u ? mine : 1u; nx = cnt > 0u ? cnt : 1u;
}
#ifndef USE_XCD_BARRIER
#define USE_XCD_BARRIER 1
#endif
DI void grid_barrier(unsigned* bar) {
  if (!USE_XCD_BARRIER) {
    asm volatile("s_waitcnt vmcnt(0)" ::: "memory");
    __syncthreads();
    if (threadIdx.x == 0) asm volatile("buffer_wbl2 sc0 sc1\n\ts_waitcnt vmcnt(0)" ::: "memory");
    cg::this_grid().sync();
    if (threadIdx.x == 0) asm volatile("buffer_inv sc0 sc1\n\ts_waitcnt vmcnt(0)" ::: "memory");
    __syncthreads();
    return;
  }
  asm volatile("s_waitcnt vmcnt(0)" ::: "memory");
  __syncthreads();
  if (threadIdx.x == 0) {
    __builtin_amdgcn_s_waitcnt(0);
    const unsigned xcc = xb_xcc_id();
    unsigned nloc = g_xb[0], nx = g_xb[1];
    if (nloc == 0u) { xcd_complete(bar, xcc, nloc, nx); g_xb[0] = nloc; g_xb[1] = nx; }
    const unsigned old = xb_add(&bar[XB_XSUB(xcc)], 1u);
    const unsigned gen = old / nloc;
    if (old + 1u == (gen + 1u) * nloc) {
      __builtin_amdgcn_fence(__ATOMIC_RELEASE, "agent");
      asm volatile("s_waitcnt vmcnt(0)" ::: "memory");
      const unsigned og = xb_add(&bar[XB_TOP], 1u);
      const unsigned tg = og / nx;
      if (og + 1u == (tg + 1u) * nx) xb_add(&bar[XB_TOPGEN], 1u);
      else XB_SPIN(xb_ld(&bar[XB_TOPGEN]) == tg, bar);
      __builtin_amdgcn_fence(__ATOMIC_ACQUIRE, "agent");
      xb_add(&bar[XB_XGEN(xcc)], 1u);
      asm volatile("s_waitcnt vmcnt(0)" ::: "memory");
    } else {
      XB_SPIN(xb_ld(&bar[XB_XGEN(xcc)]) == gen, bar);
      __builtin_amdgcn_fence(__ATOMIC_ACQUIRE, "agent");
      asm volatile("s_waitcnt vmcnt(0)" ::: "memory");
    }
  }
  __syncthreads();
}

#define DUMP_OFF (OFF_ELOC)
#define DUMP_N ((size_t)524288)
#define DUMP_F32 0
#ifndef MAXPH
#define MAXPH 10
#endif
#ifndef STATIC_SCHED
#define STATIC_SCHED 0
#endif
#ifndef ONE_XCD
#define ONE_XCD 0
#endif
DI int next_task(unsigned* ctr) {
  __syncthreads();
#ifdef LDS_NAN_PER_TASK
  __syncthreads();
#endif
  if (ONE_XCD) {
    if (threadIdx.x == 0) g_xb[2] = (xb_xcc_id() == 0u) ? atomicAdd(ctr, 1u) : 0x7fffffffu;
    __syncthreads();
    return (int)g_xb[2];
  }
  if (STATIC_SCHED) {
    if (threadIdx.x == 0) { unsigned it = g_xb[3]; g_xb[3] = it + 1u; g_xb[2] = blockIdx.x + it * gridDim.x; }
  } else {
    if (threadIdx.x == 0) g_xb[2] = atomicAdd(ctr, 1u);
  }
  __syncthreads();
  return (int)g_xb[2];
}
DI unsigned task_prefetch(unsigned* ctr) { unsigned v = 0u; if (threadIdx.x == 0) v = atomicAdd(ctr, 1u); return v; }
DI int task_commit(unsigned v) {
  __syncthreads();
  if (threadIdx.x == 0) g_xb[2] = v;
  __syncthreads();
  return (int)g_xb[2];
}
#define TASK_LOOP(ctr, N, BODY) { int t = next_task(ctr); while (t < (N)) { const unsigned tn_ = task_prefetch(ctr); BODY; t = task_commit(tn_); } }
DI void phase_begin() { __syncthreads(); if (threadIdx.x == 0) g_xb[3] = 0u; __syncthreads(); }

template <int BM, int BN, int WGM, int WGN, class Hook>
DI void gemm_mainloop(const u16* A, int lda, const u16* B, int ldb, int K, int kvalid,
                      f32x4 (&acc)[BM / WGM / 16][BN / WGN / 16], u16* sA, u16* sB, Hook hook) {
  constexpr int MT = BM / WGM / 16, NTL = BN / WGN / 16, CA = BM / 32, CB = BN / 32;
  const int tid = ltid(), lane = tid & 63, wid = tid >> 6, wm = wid / WGN, wn = wid % WGN;
  const __amdgpu_buffer_rsrc_t ra_ = mk_rsrc(A), rb_ = mk_rsrc(B);
  u32x4 ra0[CA], rb0[CB], ra1[CA], rb1[CB];
  unsigned va[CA], vb[CB];
  const u32x4 z4 = (u32x4){0u, 0u, 0u, 0u};
  const int cc0 = (tid & 7) * 8;
#pragma unroll
  for (int i = 0; i < CA; ++i) { const int r = (tid + i * NTHR) >> 3; va[i] = (unsigned)(r * lda + cc0) * 2u; }
#pragma unroll
  for (int i = 0; i < CB; ++i) { const int r = (tid + i * NTHR) >> 3; vb[i] = (unsigned)(r * ldb + cc0) * 2u; }
#define GM_LOAD(RA, RB, kn)                                                                          \
  {                                                                                                  \
    const bool kok = ((kn) + cc0) < kvalid;                                                          \
    _Pragma("unroll") for (int i = 0; i < CA; ++i) RA[i] = kok ? bld16(ra_, va[i], (unsigned)(kn) * 2u) : z4; \
    _Pragma("unroll") for (int i = 0; i < CB; ++i) RB[i] = kok ? bld16(rb_, vb[i], (unsigned)(kn) * 2u) : z4; \
  }
#define GM_STEP(RA, RB, kcur)                                                                        \
  {                                                                                                  \
    __syncthreads();                                                                                 \
    _Pragma("unroll") for (int i = 0; i < CA; ++i) { const int r = (tid + i * NTHR) >> 3; *(u32x4*)(sA + r * LDS_STRIDE + cc0) = RA[i]; } \
    _Pragma("unroll") for (int i = 0; i < CB; ++i) { const int r = (tid + i * NTHR) >> 3; *(u32x4*)(sB + r * LDS_STRIDE + cc0) = RB[i]; } \
    __syncthreads();                                                                                 \
    if ((kcur) + 128 < K) GM_LOAD(RA, RB, (kcur) + 128)                                              \
    _Pragma("unroll") for (int kk = 0; kk < 2; ++kk) {                                               \
      bf16x8 af[MT], bfr[NTL];                                                                       \
      _Pragma("unroll") for (int m = 0; m < MT; ++m) af[m] = *(const bf16x8*)(sA + (wm * (BM / WGM) + m * 16 + (lane & 15)) * LDS_STRIDE + kk * 32 + (lane >> 4) * 8); \
      _Pragma("unroll") for (int n = 0; n < NTL; ++n) bfr[n] = *(const bf16x8*)(sB + (wn * (BN / WGN) + n * 16 + (lane & 15)) * LDS_STRIDE + kk * 32 + (lane >> 4) * 8); \
      _Pragma("unroll") for (int m = 0; m < MT; ++m)                                                 \
        _Pragma("unroll") for (int n = 0; n < NTL; ++n) acc[m][n] = MFMA16(af[m], bfr[n], acc[m][n]); \
    }                                                                                                \
    hook((kcur), acc);                                                                               \
  }
  GM_LOAD(ra0, rb0, 0)
  if (64 < K) GM_LOAD(ra1, rb1, 64)
#pragma unroll
  for (int k0 = 0; k0 < K; k0 += 128) {
    GM_STEP(ra0, rb0, k0)
    GM_STEP(ra1, rb1, k0 + 64)
  }
  MFMA_FENCE();
#undef GM_LOAD
#undef GM_STEP
}
struct NoHook { template <class T> DI void operator()(int, T&) const {} };

template <int BM, int BN, int WGM, int WGN>
DI void gemm_mainloop_alds(const u16* sAimg, int lda_s, const u16* B, int ldb, int K,
                           f32x4 (&acc)[BM / WGM / 16][BN / WGN / 16], u16* sB) {
  constexpr int MT = BM / WGM / 16, NTL = BN / WGN / 16, CB = BN / 32;
  const int tid = ltid(), lane = tid & 63, wid = tid >> 6, wm = wid / WGN, wn = wid % WGN;
  const __amdgpu_buffer_rsrc_t rb_ = mk_rsrc(B);
  u32x4 rb0[CB], rb1[CB];
  unsigned vb[CB];
  const int cc0 = (tid & 7) * 8;
#pragma unroll
  for (int i = 0; i < CB; ++i) { const int r = (tid + i * NTHR) >> 3; vb[i] = (unsigned)(r * ldb + cc0) * 2u; }
#define GA_STEP(RB, kcur)                                                                            \
  {                                                                                                  \
    __syncthreads();                                                                                 \
    _Pragma("unroll") for (int i = 0; i < CB; ++i) { const int r = (tid + i * NTHR) >> 3; *(u32x4*)(sB + r * LDS_STRIDE + cc0) = RB[i]; } \
    __syncthreads();                                                                                 \
    if ((kcur) + 128 < K) { _Pragma("unroll") for (int i = 0; i < CB; ++i) RB[i] = bld16(rb_, vb[i], (unsigned)((kcur) + 128) * 2u); } \
    _Pragma("unroll") for (int kk = 0; kk < 2; ++kk) {                                               \
      bf16x8 af[MT], bfr[NTL];                                                                       \
      _Pragma("unroll") for (int m = 0; m < MT; ++m) af[m] = *(const bf16x8*)(sAimg + (wm * (BM / WGM) + m * 16 + (lane & 15)) * lda_s + (kcur) + kk * 32 + (lane >> 4) * 8); \
      _Pragma("unroll") for (int n = 0; n < NTL; ++n) bfr[n] = *(const bf16x8*)(sB + (wn * (BN / WGN) + n * 16 + (lane & 15)) * LDS_STRIDE + kk * 32 + (lane >> 4) * 8); \
      _Pragma("unroll") for (int m = 0; m < MT; ++m)                                                 \
        _Pragma("unroll") for (int n = 0; n < NTL; ++n) acc[m][n] = MFMA16(af[m], bfr[n], acc[m][n]); \
    }                                                                                                \
  }
#pragma unroll
  for (int i = 0; i < CB; ++i) rb0[i] = bld16(rb_, vb[i], 0u);
#pragma unroll
  for (int i = 0; i < CB; ++i) rb1[i] = bld16(rb_, vb[i], 128u);
#pragma unroll 1
  for (int k0 = 0; k0 < K; k0 += 128) {
    GA_STEP(rb0, k0)
    GA_STEP(rb1, k0 + 64)
  }
  MFMA_FENCE();
#undef GA_STEP
}

template <int MT, int NTL>
DI void zero_acc(f32x4 (&acc)[MT][NTL]) {
#pragma unroll
  for (int m = 0; m < MT; ++m)
#pragma unroll
    for (int n = 0; n < NTL; ++n) acc[m][n] = (f32x4){0.f, 0.f, 0.f, 0.f};
}

DI void tile_put(u16* sT, int stride, int r, int c, float v) { sT[r * stride + c] = f2bf(v); }
DI void tile_flush128(const u16* sT, u16* dst, int ld, int row0, int col0) {
  const int tid = ltid();
#pragma unroll
  for (int i = 0; i < 8; ++i) {
    const int id = tid + i * NTHR, r = id >> 4, c = (id & 15) * 8;
    *(u32x4*)(dst + (size_t)(row0 + r) * ld + col0 + c) = *(const u32x4*)(sT + r * 136 + c);
  }
}
DI void tile_out_128(const f32x4 (&v)[4][4], u16* dst, int ld, int row0, int col0) {
  u16* sT = (u16*)smem;
  const int lane = ltid() & 63, wid = ltid() >> 6, wm = wid >> 1, wn = wid & 1;
  __syncthreads();
#pragma unroll
  for (int m = 0; m < 4; ++m)
#pragma unroll
    for (int n = 0; n < 4; ++n)
#pragma unroll
      for (int j = 0; j < 4; ++j) tile_put(sT, 136, wm * 64 + m * 16 + (lane >> 4) * 4 + j, wn * 64 + n * 16 + (lane & 15), v[m][n][j]);
  __syncthreads();
  tile_flush128(sT, dst, ld, row0, col0);
}

DI int dst_row_map(int n, int mode) {
  if (mode == 0) return n;
  if (mode == 1) {
    if (n < 512 || n >= 1536) return n;
    int sec = n & ~127, d = n & 127;
    int xh = d >> 6, idx = d & 63;
    return sec + (((idx >> 4) * 2 + xh) << 4) + (idx & 15);
  }
  if (mode == 2) return (n >> 4) * 32 + (n & 15);
  return (n >> 4) * 32 + 16 + (n & 15);
}
DI void transpose_tile(const float* src, int lds_, int k0, int n0, u16* dst, int ldd,
                       const float* gain, int mode, float scale) {
  float* t = (float*)smem;
  const int tid = ltid(), ty = tid >> 4, tx = tid & 15;
  __syncthreads();
#pragma unroll
  for (int i = 0; i < 4; ++i) {
    int k = ty + 16 * i;
    float4 v = *(const float4*)(src + (size_t)(k0 + k) * lds_ + n0 + tx * 4);
    float g = gain ? gain[k0 + k] : 1.0f;
    t[k * 65 + tx * 4 + 0] = v.x * g; t[k * 65 + tx * 4 + 1] = v.y * g;
    t[k * 65 + tx * 4 + 2] = v.z * g; t[k * 65 + tx * 4 + 3] = v.w * g;
  }
  __syncthreads();
  const int nl = tid >> 2, ks = (tid & 3) * 16;
  const int n = n0 + nl;
  float sc = scale;
  if (mode == 1) sc = (n >= 512 && n < 1024) ? 0.08838834764831845f : 1.0f;
  unsigned w[8];
#pragma unroll
  for (int i = 0; i < 8; ++i) w[i] = pack2(t[(ks + 2 * i) * 65 + nl] * sc, t[(ks + 2 * i + 1) * 65 + nl] * sc);
  u16* d = dst + (size_t)dst_row_map(n, mode) * ldd + k0 + ks;
  *(u32x4*)d = (u32x4){w[0], w[1], w[2], w[3]};
  *(u32x4*)(d + 8) = (u32x4){w[4], w[5], w[6], w[7]};
}

DI void rownorm_task(const float* src, float* xs_out, u16* dst) {
  const int lane = ltid() & 63;
  float4 v[4];
  float ss = 0.f;
#pragma unroll
  for (int i = 0; i < 4; ++i) {
    v[i] = *(const float4*)(src + i * 256 + lane * 4);
    ss += v[i].x * v[i].x + v[i].y * v[i].y + v[i].z * v[i].z + v[i].w * v[i].w;
  }
  ss = red64(ss);
  const float r = rsqrtf(ss * (1.0f / 1024.0f) + EPSF);
  if (xs_out && lane == 0) *xs_out = 1.0f / r;
#pragma unroll
  for (int i = 0; i < 4; ++i) {
    u32x2 o; o.x = pack2(v[i].x * r, v[i].y * r); o.y = pack2(v[i].z * r, v[i].w * r);
    *(u32x2*)(dst + i * 256 + lane * 4) = o;
  }
}

DI void phase_prep(const Params& p, unsigned* ctr) {
  char* ws = p.ws;
  const int tid = ltid();
  constexpr int T_W = 16384, T_X = NTOK / 4, T_M = 256, T_S = 128;
  constexpr int TOT = T_W + T_X + T_M + T_S;
  for (int t = blockIdx.x; t < TOT; t += gridDim.x) {
    if (t < T_W) {
      const int l = t >> 12; int q = t & 4095;
      u16* wl = (u16*)(ws + OFF_W) + (size_t)l * W_LAYER;
      if (q < 640) {
        transpose_tile(p.w_in + (size_t)l * 1024 * 2560, 2560, (q / 40) * 64, (q % 40) * 64, wl + W_IN, 1024, p.mix_pre + l * 1024, 1, 1.0f);
      } else if ((q -= 640) < 64) {
        transpose_tile(p.w_glu + (size_t)l * 512 * 512, 512, (q / 8) * 64, (q % 8) * 64, wl + W_GLU, 512, nullptr, 0, 1.0f);
      } else if ((q -= 64) < 256) {
        const int k0 = (q / 16) * 64;
        const float* gain = (k0 < 512) ? (p.s5_onorm + l * 512) : (p.ret_onorm + l * 512 - 512);
        transpose_tile(p.w_out + (size_t)l * 1024 * 1024, 1024, k0, (q % 16) * 64, wl + W_OUT, 1024, gain, 0, 1.0f);
      } else if ((q -= 256) < 256) {
        transpose_tile(p.w_cq + (size_t)l * 1024 * 1024, 1024, (q / 16) * 64, (q % 16) * 64, wl + W_CQ, 1024, p.xa_pre + l * 1024, 0, 0.0625f);
      } else if ((q -= 256) < 256) {
        transpose_tile(p.w_ck + (size_t)l * 1024 * 1024, 1024, (q / 16) * 64, (q % 16) * 64, wl + W_CK, 1024, p.mem_norm + l * 1024, 0, 1.0f);
      } else if ((q -= 256) < 256) {
        transpose_tile(p.w_cv + (size_t)l * 1024 * 1024, 1024, (q / 16) * 64, (q % 16) * 64, wl + W_CV, 1024, p.mem_norm + l * 1024, 0, 1.0f);
      } else if ((q -= 256) < 256) {
        transpose_tile(p.w_co + (size_t)l * 1024 * 1024, 1024, (q / 16) * 64, (q % 16) * 64, wl + W_CO, 1024, nullptr, 0, 1.0f);
      } else if ((q -= 256) < 704) {
        transpose_tile(p.w_gate + (size_t)l * 1024 * 2816, 2816, (q / 44) * 64, (q % 44) * 64, wl + W_GU, 1024, p.ffn_pre + l * 1024, 2, 1.0f);
      } else if ((q -= 704) < 704) {
        transpose_tile(p.w_up + (size_t)l * 1024 * 2816, 2816, (q / 44) * 64, (q % 44) * 64, wl + W_GU, 1024, p.ffn_pre + l * 1024, 3, 1.0f);
      } else {
        q -= 704;
        transpose_tile(p.w_down + (size_t)l * 2816 * 1024, 1024, (q / 16) * 64, (q % 16) * 64, wl + W_DN, 2816, nullptr, 0, 1.0f);
      }
    } else if (t < T_W + T_X) {
      const int row = (t - T_W) * 4 + (tid >> 6);
      const float* src = (row < PROWS) ? p.x_prompt + (size_t)row * 1024 : p.x_sample + (size_t)(row - PROWS) * 1024;
      rownorm_task(src, (float*)(ws + OFF_RSQ) + row, (u16*)(ws + OFF_HB) + (size_t)row * 1024);
    } else if (t < T_W + T_X + T_M) {
      const int row = (t - T_W - T_X) * 4 + (tid >> 6);
      rownorm_task(p.mem_prompt + (size_t)row * 1024, nullptr, (u16*)(ws + OFF_MEMB) + (size_t)row * 1024);
    } else {
      const int lg = t - T_W - T_X - T_M, l = lg >> 5, g = lg & 31;
      char* sp = ws + OFF_S5P + (size_t)l * S5P_LAYER;
      u16* bbt = (u16*)(sp + S5P_BBT) + g * 2048;
      u16* cm = (u16*)(sp + S5P_CM) + g * 2048;
      float* ab = (float*)(sp + S5P_ABAR) + g * 128;
      const float dt = __expf(p.log_step[l * 32 + g]);
      for (int e = tid; e < 1024; e += NTHR) {
        const int pp = e >> 4, h = e & 15;
        const float lr = p.lam_re[(l * 32 + g) * 64 + pp], li = p.lam_im[(l * 32 + g) * 64 + pp];
        const float ar = lr * dt, ai = li * dt, mag = expf(ar);
        float sn_, cs_; sincos_cw(ai, &sn_, &cs_);
        const float abr = mag * cs_, abi = mag * sn_;
        const float den = lr * lr + li * li, nr = abr - 1.0f, ni = abi;
        const float fr = (nr * lr + ni * li) / den, fi = (ni * lr - nr * li) / den;
        const float br = p.b_re[((size_t)(l * 32 + g) * 64 + pp) * 16 + h], bi = p.b_im[((size_t)(l * 32 + g) * 64 + pp) * 16 + h];
        bbt[pp * 16 + h] = f2bf(fr * br - fi * bi);
        bbt[(64 + pp) * 16 + h] = f2bf(fr * bi + fi * br);
        if (h == 0) { ab[pp * 2] = abr; ab[pp * 2 + 1] = abi; }
        const int hh = e >> 6, kk = e & 63;
        cm[hh * 128 + kk] = f2bf(p.c_re[((size_t)(l * 32 + g) * 16 + hh) * 64 + kk]);
        cm[hh * 128 + 64 + kk] = f2bf(-p.c_im[((size_t)(l * 32 + g) * 16 + hh) * 64 + kk]);
      }
    }
  }
}

DI void memkv_tile(const Params& p, int t) {
  char* ws = p.ws;
  const int l = t >> 7, rt = (t >> 4) & 7, ct = t & 15;
  const int isv = ct >> 3, col0 = (ct & 7) * 128, row0 = rt * 128;
  const u16* A = (const u16*)(ws + OFF_MEMB) + (size_t)row0 * 1024;
  const u16* B = (const u16*)(ws + OFF_W) + (size_t)l * W_LAYER + (isv ? W_CV : W_CK) + (size_t)col0 * 1024;
  f32x4 acc[4][4];
  zero_acc(acc);
  u16* sA = (u16*)smem; u16* sB = sA + 128 * LDS_STRIDE;
  gemm_mainloop<128, 128, 2, 2>(A, 1024, B, 1024, 1024, 1 << 30, acc, sA, sB, NoHook());
  const int lane = ltid() & 63, wid = ltid() >> 6, wm = wid >> 1, wn = wid & 1;
  float* of = p.out + (isv ? O_MV_P : O_MK_P) + (size_t)l * 1024 * 1024;
  u16* kx = (u16*)(ws + OFF_KXP) + (size_t)l * 1024 * 1024;
  u16* vx = (u16*)(ws + OFF_VTXP) + (size_t)l * 1024 * 1024;
#pragma unroll
  for (int m = 0; m < 4; ++m)
#pragma unroll
    for (int n = 0; n < 4; ++n) {
      const int r = row0 + wm * 64 + m * 16 + (lane >> 4) * 4, c = col0 + wn * 64 + n * 16 + (lane & 15);
#pragma unroll
      for (int j = 0; j < 4; ++j) of[(size_t)(r + j) * 1024 + c] = acc[m][n][j];
      if (!isv) {
#pragma unroll
        for (int j = 0; j < 4; ++j) kx[(size_t)(r + j) * 1024 + c] = f2bf(acc[m][n][j]);
      } else {
        const int b = r >> 8, mm = r & 255, h = c >> 8, d = c & 255;
        u32x2 o; o.x = pack2(acc[m][n][0], acc[m][n][1]); o.y = pack2(acc[m][n][2], acc[m][n][3]);
        *(u32x2*)(vx + ((size_t)((b * 4 + h) * 256 + d)) * 256 + mm) = o;
      }
    }
}
DI void cache_task(const Params& p, int l, int t) {
  char* ws = p.ws;
  if (t < 1024) {
    const float* src = p.cmk + (size_t)l * 16 * 256 * 1024 + (size_t)t * 4096 + ltid() * 16;
    u16* dst = (u16*)(ws + OFF_KXS) + (size_t)t * 4096 + ltid() * 16;
    float4 a = *(const float4*)src, b = *(const float4*)(src + 4), c = *(const float4*)(src + 8), d = *(const float4*)(src + 12);
    *(u32x4*)dst = (u32x4){pack2(a.x, a.y), pack2(a.z, a.w), pack2(b.x, b.y), pack2(b.z, b.w)};
    *(u32x4*)(dst + 8) = (u32x4){pack2(c.x, c.y), pack2(c.z, c.w), pack2(d.x, d.y), pack2(d.z, d.w)};
  } else {
    t -= 1024;
    const int bh = t >> 4, q = t & 15, b = bh >> 2, h = bh & 3;
    const float* src = p.cmv + ((size_t)(l * 16 + b) * 256) * 1024 + h * 256;
    u16* dst = (u16*)(ws + OFF_VTXS) + (size_t)bh * 256 * 256;
    transpose_tile(src, 1024, (q >> 2) * 64, (q & 3) * 64, dst, 256, nullptr, 0, 1.0f);
  }
}

DI void g1_tile(const Params& p, int l, int t) {
  char* ws = p.ws;
  const int rt = t / 20, ct = t % 20;
  const int row0 = rt * 128, col0 = ct * 128;
  const u16* A = (const u16*)(ws + OFF_HB) + (size_t)row0 * 1024;
  const u16* B = (const u16*)(ws + OFF_W) + (size_t)l * W_LAYER + W_IN + (size_t)col0 * 1024;
  f32x4 acc[4][4];
  zero_acc(acc);
  u16* sA = (u16*)smem; u16* sB = sA + 128 * LDS_STRIDE;
  gemm_mainloop<128, 128, 2, 2>(A, 1024, B, 1024, 1024, 1 << 30, acc, sA, sB, NoHook());
  const int lane = ltid() & 63, wid = ltid() >> 6, wm = wid >> 1, wn = wid & 1;
  char* arena = ws + OFF_ARENA;
  const int sec = ct >> 2, hd = ct & 3;
  const bool samp = row0 >= PROWS;
  if (sec == 0 || sec == 4) {
    tile_out_128(acc, (u16*)(arena + (sec == 0 ? 0 : 3) * SLOT), 512, row0, hd * 128);
  } else if (sec == 3) {
    u16* vt = (u16*)(arena + 4 * SLOT);
#pragma unroll
    for (int m = 0; m < 4; ++m)
#pragma unroll
      for (int n = 0; n < 4; ++n) {
        const int r = row0 + wm * 64 + m * 16 + (lane >> 4) * 4, e = wn * 64 + n * 16 + (lane & 15);
        u32x2 o; o.x = pack2(acc[m][n][0], acc[m][n][1]); o.y = pack2(acc[m][n][2], acc[m][n][3]);
        size_t off;
        if (!samp) { const int b = r >> 13, tt = r & 8191; off = ((size_t)((b * 4 + hd) * 128 + e)) * SEQ + tt; }
        else { const int sr = r - PROWS, b = sr >> 4, tt = sr & 15; off = (size_t)16 * 128 * SEQ + ((size_t)((b * 4 + hd) * 128 + e)) * 16 + tt; }
        *(u32x2*)(vt + off) = o;
      }
  } else {
    u16* dst = (u16*)(arena + (sec == 1 ? 1 : 2) * SLOT);
    u16* ktd = (u16*)(arena + 5 * SLOT);
    const float gl2 = gamma_l2(hd);
    u16* sT = (u16*)smem;
    __syncthreads();
#pragma unroll
    for (int m = 0; m < 4; ++m)
#pragma unroll
      for (int np = 0; np < 2; ++np) {
        const int r = row0 + wm * 64 + m * 16 + (lane >> 4) * 4;
        const int idx = (wn * 2 + np) * 16 + (lane & 15);
        const float inv = exp2f(-(float)idx * (13.287712379549449f / 64.0f));
        float o1[4], o2[4];
#pragma unroll
        for (int j = 0; j < 4; ++j) {
          const int rr = r + j;
          const int pos = samp ? (1024 + ((rr - PROWS) & 15)) : (rr & 8191);
          float sn, cs;
          sincos_cw((float)pos * inv, &sn, &cs);
          const float x1 = acc[m][2 * np][j], x2 = acc[m][2 * np + 1][j];
          o1[j] = x1 * cs - x2 * sn; o2[j] = x1 * sn + x2 * cs;
          tile_put(sT, 136, rr - row0, idx, o1[j]);
          tile_put(sT, 136, rr - row0, 64 + idx, o2[j]);
        }
        if (sec == 2) {
          size_t off1; int tloc;
          if (!samp) { const int b = r >> 13, tt = r & 8191; off1 = ((size_t)((b * 4 + hd) * 128 + idx)) * SEQ + tt; tloc = 63 - (tt & 63); }
          else { const int sr = r - PROWS, b = sr >> 4, tt = sr & 15; off1 = (size_t)16 * 128 * SEQ + ((size_t)((b * 4 + hd) * 128 + idx)) * 16 + tt; tloc = 15 - tt; }
          const size_t off2 = off1 + (size_t)64 * (samp ? 16 : SEQ);
          float dc[4];
#pragma unroll
          for (int j = 0; j < 4; ++j) dc[j] = exp2f(gl2 * (float)(tloc - j));
          u32x2 a, b2;
          a.x = pack2(o1[0] * dc[0], o1[1] * dc[1]); a.y = pack2(o1[2] * dc[2], o1[3] * dc[3]);
          b2.x = pack2(o2[0] * dc[0], o2[1] * dc[1]); b2.y = pack2(o2[2] * dc[2], o2[3] * dc[3]);
          *(u32x2*)(ktd + off1) = a;
          *(u32x2*)(ktd + off2) = b2;
        }
      }
    __syncthreads();
    tile_flush128(sT, dst, 512, row0, hd * 128);
  }
}

struct DecayHook {
  float g64;
  template <class T> DI void operator()(int k0, T& acc) const {
    if (k0 + 64 < 512) {
#pragma unroll
      for (int m = 0; m < 4; ++m)
#pragma unroll
        for (int n = 0; n < 4; ++n) acc[m][n] *= g64;
    }
  }
};
DI void ret_local_task(const Params& p, int t) {
  char* ws = p.ws;
  char* arena = ws + OFF_ARENA;
  const int bh = t >> 4, sc = t & 15, h = bh & 3;
  const u16* A = (const u16*)(arena + 5 * SLOT) + (size_t)bh * 128 * SEQ + sc * 512;
  const u16* B = (const u16*)(arena + 4 * SLOT) + (size_t)bh * 128 * SEQ + sc * 512;
  f32x4 acc[4][4];
  zero_acc(acc);
  u16* sA = (u16*)smem; u16* sB = sA + 128 * LDS_STRIDE;
  DecayHook hk; hk.g64 = exp2f(gamma_l2(h) * 64.0f);
  gemm_mainloop<128, 128, 2, 2>(A, SEQ, B, SEQ, 512, 1 << 30, acc, sA, sB, hk);
  const int lane = ltid() & 63, wid = ltid() >> 6, wm = wid >> 1, wn = wid & 1;
  float* dst = (float*)(ws + OFF_SLOC) + (size_t)t * 16384;
#pragma unroll
  for (int m = 0; m < 4; ++m)
#pragma unroll
    for (int n = 0; n < 4; ++n) {
      const int r = wm * 64 + m * 16 + (lane >> 4) * 4, c = wn * 64 + n * 16 + (lane & 15);
#pragma unroll
      for (int j = 0; j < 4; ++j) dst[(r + j) * 128 + c] = acc[m][n][j];
    }
}

DI void ret_final_task(const Params& p, int l, int t) {
  char* ws = p.ws;
  char* arena = ws + OFF_ARENA;
  const int tid = ltid(), lane = tid & 63, w = tid >> 6;
  const bool samp = t >= 256;
  int bh, sc, nchunk, C, row_base;
  size_t tr_base; int tr_ld;
  if (!samp) { bh = t >> 4; sc = t & 15; nchunk = 8; C = 64; row_base = (bh >> 2) * SEQ + sc * 512; tr_base = (size_t)bh * 128 * SEQ + sc * 512; tr_ld = SEQ; }
  else { bh = t - 256; sc = 0; nchunk = 1; C = 16; row_base = PROWS + (bh >> 2) * 16; tr_base = (size_t)16 * 128 * SEQ + (size_t)bh * 128 * 16; tr_ld = 16; }
  const int h = bh & 3;
  const float gl2 = gamma_l2(h);
  const float gC = exp2f(gl2 * (float)C);
  const u16* Qg = (const u16*)(arena + 1 * SLOT);
  const u16* Kg = (const u16*)(arena + 2 * SLOT);
  const u16* Gg = (const u16*)(arena + 3 * SLOT);
  const u16* Vt = (const u16*)(arena + 4 * SLOT) + tr_base;
  const u16* Ktd = (const u16*)(arena + 5 * SLOT) + tr_base;
  u16* reto = (u16*)(arena + 7 * SLOT);
  u16* sQ = (u16*)smem;
  u16* sK = sQ + 64 * 144;
  u16* sV = sK + 128 * LDS_STRIDE;
  u16* sS = sV + 128 * LDS_STRIDE;
  float* sR = (float*)(sS + 64 * LDS_STRIDE);

  f32x4 S[8][2];
  if (samp) {
    const float* s0 = p.ret0 + ((size_t)(l * 64 + bh)) * 16384;
#pragma unroll
    for (int mt = 0; mt < 8; ++mt)
#pragma unroll
      for (int nt = 0; nt < 2; ++nt)
#pragma unroll
        for (int j = 0; j < 4; ++j) S[mt][nt][j] = s0[(mt * 16 + (lane >> 4) * 4 + j) * 128 + 32 * w + nt * 16 + (lane & 15)];
  } else {
#pragma unroll
    for (int mt = 0; mt < 8; ++mt)
#pragma unroll
      for (int nt = 0; nt < 2; ++nt) S[mt][nt] = (f32x4){0.f, 0.f, 0.f, 0.f};
    const float g512 = exp2f(gl2 * 512.0f);
    for (int s2 = 0; s2 < sc; ++s2) {
      const float* sl = (const float*)(ws + OFF_SLOC) + ((size_t)(bh * 16 + s2)) * 16384;
#pragma unroll
      for (int mt = 0; mt < 8; ++mt)
#pragma unroll
        for (int nt = 0; nt < 2; ++nt)
#pragma unroll
          for (int j = 0; j < 4; ++j)
            S[mt][nt][j] = S[mt][nt][j] * g512 + ld_sc1_f(sl + (mt * 16 + (lane >> 4) * 4 + j) * 128 + 32 * w + nt * 16 + (lane & 15));
    }
  }
  const u32x4 z4 = (u32x4){0, 0, 0, 0};
  for (int c = 0; c < nchunk; ++c) {
    const int r0 = row_base + c * 64;
    __syncthreads();
#pragma unroll
    for (int i = 0; i < 4; ++i) {
      const int id = tid + i * NTHR, r = id >> 4, cc = (id & 15) * 8;
      u32x4 q4 = z4, k4 = z4;
      if (r < C) {
        q4 = ld_ws16(ws, Qg + (size_t)(r0 + r) * 512 + h * 128 + cc);
        k4 = ld_ws16(ws, Kg + (size_t)(r0 + r) * 512 + h * 128 + cc);
      }
      *(u32x4*)(sQ + r * 144 + cc) = q4;
      *(u32x4*)(sK + r * 144 + cc) = k4;
    }
#pragma unroll
    for (int i = 0; i < 4; ++i) {
      const int id = tid + i * NTHR, r = id >> 3, cc = (id & 7) * 8;
      u32x4 v4 = z4;
      if (cc < C) v4 = ld_ws16(ws, Vt + (size_t)r * tr_ld + c * 64 + cc);
      *(u32x4*)(sV + r * LDS_STRIDE + cc) = v4;
    }
    __syncthreads();
    {
      f32x4 sc4[4];
#pragma unroll
      for (int m = 0; m < 4; ++m) sc4[m] = (f32x4){0.f, 0.f, 0.f, 0.f};
#pragma unroll
      for (int ks = 0; ks < 4; ++ks) {
        const bf16x8 bk = *(const bf16x8*)(sK + (16 * w + (lane & 15)) * 144 + ks * 32 + (lane >> 4) * 8);
#pragma unroll
        for (int m = 0; m < 4; ++m) {
          const bf16x8 aq = *(const bf16x8*)(sQ + (m * 16 + (lane & 15)) * 144 + ks * 32 + (lane >> 4) * 8);
          sc4[m] = MFMA16(aq, bk, sc4[m]);
        }
      }
      MFMA_FENCE();
      const int jc = 16 * w + (lane & 15);
#pragma unroll
      for (int m = 0; m < 4; ++m)
#pragma unroll
        for (int j = 0; j < 4; ++j) {
          const int i = m * 16 + (lane >> 4) * 4 + j;
          const int dd = i > jc ? i - jc : jc - i;
          sS[i * LDS_STRIDE + jc] = f2bf(sc4[m][j] * exp2f(gl2 * (float)dd));
        }
    }
    __syncthreads();
#pragma unroll
    for (int i = 0; i < 4; ++i) {
      const int id = tid + i * NTHR, r = id >> 3, cc = (id & 7) * 8;
      u32x4 v4 = z4;
      if (cc < C) v4 = ld_ws16(ws, Ktd + (size_t)r * tr_ld + c * 64 + cc);
      *(u32x4*)(sK + r * LDS_STRIDE + cc) = v4;
    }
    f32x4 o[4][2];
#pragma unroll
    for (int m = 0; m < 4; ++m) { o[m][0] = (f32x4){0.f, 0.f, 0.f, 0.f}; o[m][1] = o[m][0]; }
#pragma unroll
    for (int a = 0; a < 4; ++a) {
      bf16x8 bs[2];
#pragma unroll
      for (int nt = 0; nt < 2; ++nt) {
        u32x4 u;
        u.x = pack2(S[2 * a][nt][0], S[2 * a][nt][1]); u.y = pack2(S[2 * a][nt][2], S[2 * a][nt][3]);
        u.z = pack2(S[2 * a + 1][nt][0], S[2 * a + 1][nt][1]); u.w = pack2(S[2 * a + 1][nt][2], S[2 * a + 1][nt][3]);
        bs[nt] = __builtin_bit_cast(bf16x8, u);
      }
#pragma unroll
      for (int m = 0; m < 4; ++m) {
        const u16* qp = sQ + (m * 16 + (lane & 15)) * 144 + (lane >> 4) * 4;
        const u32x2 lo = *(const u32x2*)(qp + (2 * a) * 16);
        const u32x2 hi = *(const u32x2*)(qp + (2 * a + 1) * 16);
        const bf16x8 aq = __builtin_bit_cast(bf16x8, ((u32x4){lo.x, lo.y, hi.x, hi.y}));
        o[m][0] = MFMA16(aq, bs[0], o[m][0]);
        o[m][1] = MFMA16(aq, bs[1], o[m][1]);
      }
      __builtin_amdgcn_sched_barrier(0);
    }
    MFMA_FENCE();
#pragma unroll
    for (int m = 0; m < 4; ++m)
#pragma unroll
      for (int j = 0; j < 4; ++j) {
        const int i = m * 16 + (lane >> 4) * 4 + j;
        const float f = exp2f(gl2 * (float)(i + 1));
        o[m][0][j] *= f;
        o[m][1][j] *= f;
      }
#pragma unroll
    for (int ks = 0; ks < 2; ++ks) {
      bf16x8 bv[2];
#pragma unroll
      for (int nt = 0; nt < 2; ++nt) bv[nt] = *(const bf16x8*)(sV + (32 * w + nt * 16 + (lane & 15)) * LDS_STRIDE + ks * 32 + (lane >> 4) * 8);
#pragma unroll
      for (int m = 0; m < 4; ++m) {
        const bf16x8 as = *(const bf16x8*)(sS + (m * 16 + (lane & 15)) * LDS_STRIDE + ks * 32 + (lane >> 4) * 8);
        o[m][0] = MFMA16(as, bv[0], o[m][0]);
        o[m][1] = MFMA16(as, bv[1], o[m][1]);
      }
      __builtin_amdgcn_sched_barrier(0);
    }
    MFMA_FENCE();
#pragma unroll
    for (int m = 0; m < 4; ++m)
#pragma unroll
      for (int j = 0; j < 4; ++j) {
        float v = o[m][0][j] * o[m][0][j] + o[m][1][j] * o[m][1][j];
        v = red16(v);
        if ((lane & 15) == 0) sR[w * 64 + m * 16 + (lane >> 4) * 4 + j] = v;
      }
    __syncthreads();
#pragma unroll
    for (int m = 0; m < 4; ++m)
#pragma unroll
      for (int j = 0; j < 4; ++j) {
        const int i = m * 16 + (lane >> 4) * 4 + j;
        if (i < C) {
          const float ss = sR[i] + sR[64 + i] + sR[128 + i] + sR[192 + i];
          const float rs = rsqrtf(ss * (1.0f / 128.0f) + EPSF);
#pragma unroll
          for (int nt = 0; nt < 2; ++nt) {
            const int e = 32 * w + nt * 16 + (lane & 15);
            const float g = bf2f(ld_sc1_2(Gg + (size_t)(r0 + i) * 512 + h * 128 + e));
            reto[(size_t)(r0 + i) * 512 + h * 128 + e] = f2bf(o[m][nt][j] * rs * siluf_(g));
          }
        }
      }
#pragma unroll
    for (int mt = 0; mt < 8; ++mt) { S[mt][0] *= gC; S[mt][1] *= gC; }
#pragma unroll 1
    for (int ks = 0; ks < 2; ++ks) {
      bf16x8 bv[2];
#pragma unroll
      for (int nt = 0; nt < 2; ++nt) bv[nt] = *(const bf16x8*)(sV + (32 * w + nt * 16 + (lane & 15)) * LDS_STRIDE + ks * 32 + (lane >> 4) * 8);
#pragma unroll
      for (int mt = 0; mt < 8; ++mt) {
        const bf16x8 ak = *(const bf16x8*)(sK + (mt * 16 + (lane & 15)) * LDS_STRIDE + ks * 32 + (lane >> 4) * 8);
        S[mt][0] = MFMA16(ak, bv[0], S[mt][0]);
        S[mt][1] = MFMA16(ak, bv[1], S[mt][1]);
      }
    }
    MFMA_FENCE();
  }
  if (samp || sc == 15) {
    float* so = samp ? (p.out + O_RET_S + ((size_t)(l * 64 + bh)) * 16384) : (p.out + O_RET_P + ((size_t)(l * 16 + bh)) * 16384);
#pragma unroll
    for (int mt = 0; mt < 8; ++mt)
#pragma unroll
      for (int nt = 0; nt < 2; ++nt)
#pragma unroll
        for (int j = 0; j < 4; ++j) so[(mt * 16 + (lane >> 4) * 4 + j) * 128 + 32 * w + nt * 16 + (lane & 15)] = S[mt][nt][j];
  }
}

DI void s5_task(const Params& p, int l, int t, int mode) {
  char* ws = p.ws;
  char* arena = ws + OFF_ARENA;
  const int tid = ltid(), lane = tid & 63, w = tid >> 6;
  const bool samp = t >= 512;
  int b, lc, g, row_base, nsub;
  if (!samp) { b = t >> 7; lc = (t >> 3) & 15; g = (t & 7) * 4 + w; row_base = b * SEQ + lc * 512; nsub = 32; }
  else { const int q = t - 512; b = q >> 3; lc = 0; g = (q & 7) * 4 + w; row_base = PROWS + b * 16; nsub = 1; }
  const char* sp = ws + OFF_S5P + (size_t)l * S5P_LAYER;
  const u16* bbt = (const u16*)(sp + S5P_BBT) + g * 2048;
  const u16* cm = (const u16*)(sp + S5P_CM) + g * 2048;
  const float* ab = (const float*)(sp + S5P_ABAR) + g * 128;
  const u16* U = (const u16*)(arena + 0 * SLOT);
  u16* Z = (u16*)(arena + 6 * SLOT);
  float* bu = (float*)(smem + w * 13056);
  u16* xs = (u16*)(smem + w * 13056 + 8448);
  const float ar = ld_sc1_f(ab + lane * 2), ai = ld_sc1_f(ab + lane * 2 + 1);
  const int slab = lane >> 4;
  const u32x4 z4 = (u32x4){0, 0, 0, 0};
  bf16x8 Bf[8], Cf[4];
#pragma unroll
  for (int nt = 0; nt < 8; ++nt) {
    u32x4 u = z4;
    if (slab < 2) u = ld_ws16(ws, bbt + (nt * 16 + (lane & 15)) * 16 + slab * 8);
    Bf[nt] = __builtin_bit_cast(bf16x8, u);
  }
#pragma unroll
  for (int ks = 0; ks < 4; ++ks) Cf[ks] = __builtin_bit_cast(bf16x8, ld_ws16(ws, cm + (lane & 15) * 128 + ks * 32 + slab * 8));
  const float Dh = p.s5_d[(l * 32 + g) * 16 + (lane & 15)];
  float xr = 0.f, xi = 0.f;
  if (samp) {
    xr = p.s5re0[((size_t)(l * 16 + b) * 32 + g) * 64 + lane];
    xi = p.s5im0[((size_t)(l * 16 + b) * 32 + g) * 64 + lane];
  } else if (mode == 1 && lc > 0) {
    float pr = ar, pi = ai;
#pragma unroll
    for (int s = 0; s < 9; ++s) { const float nr = pr * pr - pi * pi, ni = 2.f * pr * pi; pr = nr; pi = ni; }
    const float* el = (const float*)(ws + OFF_ELOC);
    for (int c2 = 0; c2 < lc; ++c2) {
      const float er = ld_sc1_f(el + (((size_t)(b * 16 + c2) * 32 + g) * 64 + lane) * 2), ei = ld_sc1_f(el + (((size_t)(b * 16 + c2) * 32 + g) * 64 + lane) * 2 + 1);
      const float nr = pr * xr - pi * xi + er, ni = pr * xi + pi * xr + ei;
      xr = nr; xi = ni;
    }
  }
  u16* usm = (u16*)(smem + 52224 + w * 512);
  const u16* up = U + (size_t)(row_base + (lane & 15)) * 512 + g * 16 + (slab & 1) * 8;
  u32x4 ua = ld_ws16(ws, up);
  for (int sub = 0; sub < nsub; ++sub) {
    const int r0 = row_base + sub * 16;
    u32x4 un = z4;
    if (sub + 1 < nsub) un = ld_ws16(ws, up + (size_t)(sub + 1) * 16 * 512);
    if (slab >= 2) ua = z4;
    const bf16x8 Af = __builtin_bit_cast(bf16x8, ua);
    __syncthreads();
    if (mode == 1 && slab < 2) *(u32x4*)(usm + (lane & 15) * 16 + slab * 8) = ua;
    f32x4 a8[8];
#pragma unroll
    for (int nt = 0; nt < 8; ++nt) a8[nt] = MFMA16(Af, Bf[nt], ((f32x4){0.f, 0.f, 0.f, 0.f}));
    __builtin_amdgcn_sched_barrier(0);
    asm volatile("s_nop 15\n\ts_nop 15\n\ts_nop 15" ::: "memory");
    __builtin_amdgcn_sched_barrier(0);
#pragma unroll
    for (int nt = 0; nt < 8; ++nt) {
#pragma unroll
      for (int j = 0; j < 4; ++j) bu[(slab * 4 + j) * 132 + nt * 16 + (lane & 15)] = a8[nt][j];
    }
    __syncthreads();
#pragma unroll
    for (int tt = 0; tt < 16; ++tt) {
      const float br = bu[tt * 132 + lane], bi = bu[tt * 132 + 64 + lane];
      const float nr = ar * xr - ai * xi + br, ni = ar * xi + ai * xr + bi;
      xr = nr; xi = ni;
      if (mode == 1) { xs[tt * 144 + lane] = f2bf(xr); xs[tt * 144 + 64 + lane] = f2bf(xi); }
    }
    if (mode == 1) {
      __syncthreads();
      f32x4 y = (f32x4){0.f, 0.f, 0.f, 0.f};
#pragma unroll
      for (int ks = 0; ks < 4; ++ks) {
        const bf16x8 ax = *(const bf16x8*)(xs + (lane & 15) * 144 + ks * 32 + slab * 8);
        y = MFMA16(ax, Cf[ks], y);
      }
      __builtin_amdgcn_sched_barrier(0);
      asm volatile("s_nop 15\n\ts_nop 15" ::: "memory");
      __builtin_amdgcn_sched_barrier(0);
#pragma unroll
      for (int j = 0; j < 4; ++j) {
        const int rr = r0 + slab * 4 + j, cc = g * 16 + (lane & 15);
        const float u = bf2f(usm[(slab * 4 + j) * 16 + (lane & 15)]);
        Z[(size_t)rr * 512 + cc] = f2bf(geluf_(y[j] + Dh * u));
      }
    }
    ua = un;
  }
  if (mode == 0) {
    float* el = (float*)(ws + OFF_ELOC);
    el[(((size_t)(b * 16 + lc) * 32 + g) * 64 + lane) * 2] = xr;
    el[(((size_t)(b * 16 + lc) * 32 + g) * 64 + lane) * 2 + 1] = xi;
  } else if (samp) {
    p.out[O_S5RE_S + ((size_t)(l * 16 + b) * 32 + g) * 64 + lane] = xr;
    p.out[O_S5IM_S + ((size_t)(l * 16 + b) * 32 + g) * 64 + lane] = xi;
  } else if (lc == 15) {
    p.out[O_S5RE_P + ((size_t)(l * 4 + b) * 32 + g) * 64 + lane] = xr;
    p.out[O_S5IM_P + ((size_t)(l * 4 + b) * 32 + g) * 64 + lane] = xi;
  }
}

DI void glu_tile(const Params& p, int l, int t) {
  char* ws = p.ws;
  char* arena = ws + OFF_ARENA;
  const int rt = t >> 2, ct = t & 3, row0 = rt * 128, col0 = ct * 128;
  const u16* Zb = (const u16*)(arena + 6 * SLOT);
  const u16* A = Zb + (size_t)row0 * 512;
  const u16* B = (const u16*)(ws + OFF_W) + (size_t)l * W_LAYER + W_GLU + (size_t)col0 * 512;
  f32x4 acc[4][4];
  zero_acc(acc);
  u16* sA = (u16*)smem; u16* sB = sA + 128 * LDS_STRIDE;
  gemm_mainloop<128, 128, 2, 2>(A, 512, B, 512, 512, 1 << 30, acc, sA, sB, NoHook());
  const int lane = ltid() & 63, wid = ltid() >> 6, wm = wid >> 1, wn = wid & 1;
  u16* Z2 = (u16*)(arena + 0 * SLOT);
  float* zsq = (float*)(ws + OFF_ZSQ);
  const float* bg = p.b_glu + l * 512;
  u16* sT = (u16*)smem;
  __syncthreads();
  {
    const int tq = ltid();
#pragma unroll
    for (int i = 0; i < 8; ++i) {
      const int id = tq + i * NTHR, rr = id >> 4, cc = (id & 15) * 8;
      *(u32x4*)(sT + rr * 136 + cc) = ld_ws16(ws, Zb + (size_t)(row0 + rr) * 512 + col0 + cc);
    }
  }
  __syncthreads();
#pragma unroll
  for (int m = 0; m < 4; ++m) {
    float ss[4] = {0.f, 0.f, 0.f, 0.f};
    const int rl = wm * 64 + m * 16 + (lane >> 4) * 4;
#pragma unroll
    for (int n = 0; n < 4; ++n) {
      const int cl = wn * 64 + n * 16 + (lane & 15);
      const float bb = bg[col0 + cl];
#pragma unroll
      for (int j = 0; j < 4; ++j) {
        const float z = bf2f(sT[(rl + j) * 136 + cl]);
        const float z2 = z * sigmoidf_(acc[m][n][j] + bb);
        ss[j] += z2 * z2;
        sT[(rl + j) * 136 + cl] = f2bf(z2);
      }
    }
#pragma unroll
    for (int j = 0; j < 4; ++j) {
      const float v = red16(ss[j]);
      if ((lane & 15) == 0) zsq[(size_t)(ct * 2 + wn) * NTOK + row0 + rl + j] = v;
    }
  }
  __syncthreads();
  tile_flush128(sT, Z2, 512, row0, col0);
}

DI void store_raw_rsq(const f32x4 (&acc)[4][4], u16* raw, float* rsq, int row0, int col0, int ct) {
  tile_out_128(acc, raw, 1024, row0, col0);
}

DI void out_tile(const Params& p, int l, int t) {
  char* ws = p.ws;
  char* arena = ws + OFF_ARENA;
  const int rt = t >> 3, ct = t & 7, row0 = rt * 128, col0 = ct * 128;
  const u16* B = (const u16*)(ws + OFF_W) + (size_t)l * W_LAYER + W_OUT + (size_t)col0 * 1024;
  f32x4 acc[4][4];
  zero_acc(acc);
  u16* sA = (u16*)smem; u16* sB = sA + 128 * LDS_STRIDE;
  float* rsl = (float*)(smem + 40960);
  const float* zsq = (const float*)(ws + OFF_ZSQ);
  {
    const int tq = ltid();
    if (tq < 128) {
      float zs = 0.f;
#pragma unroll
      for (int q = 0; q < 8; ++q) zs += ld_sc1_f(zsq + (size_t)q * NTOK + row0 + tq);
      rsl[tq] = rsqrtf(zs * (1.0f / 512.0f) + EPSF);
    }
  }
  gemm_mainloop<128, 128, 2, 2>((const u16*)(arena + 0 * SLOT) + (size_t)row0 * 512, 512, B, 1024, 512, 1 << 30, acc, sA, sB, NoHook());
  const int lane = ltid() & 63, wid = ltid() >> 6, wm = wid >> 1;
#pragma unroll
  for (int m = 0; m < 4; ++m)
#pragma unroll
    for (int j = 0; j < 4; ++j) {
      const float rs = rsl[wm * 64 + m * 16 + (lane >> 4) * 4 + j];
#pragma unroll
      for (int n = 0; n < 4; ++n) acc[m][n][j] *= rs;
    }
  gemm_mainloop<128, 128, 2, 2>((const u16*)(arena + 7 * SLOT) + (size_t)row0 * 512, 512, B + 512, 1024, 512, 1 << 30, acc, sA, sB, NoHook());
  store_raw_rsq(acc, (u16*)(arena + 1 * SLOT), (float*)(ws + OFF_RSQ), row0, col0, ct);
}

DI void raw_tile(const Params& p, const u16* Abase, int lda, const u16* Bbase, int K, u16* raw, int t) {
  char* ws = p.ws;
  const int rt = t >> 3, ct = t & 7, row0 = rt * 128, col0 = ct * 128;
  f32x4 acc[4][4];
  zero_acc(acc);
  u16* sA = (u16*)smem; u16* sB = sA + 128 * LDS_STRIDE;
  gemm_mainloop<128, 128, 2, 2>(Abase + (size_t)row0 * lda, lda, Bbase + (size_t)col0 * K, K, K, 1 << 30, acc, sA, sB, NoHook());
  store_raw_rsq(acc, raw, (float*)(ws + OFF_RSQ), row0, col0, ct);
}

DI void post_task(const Params& p, const u16* raw, const float* gpost, int t, bool last) {
  char* ws = p.ws;
  const int lane = ltid() & 63;
  const int row = t * 4 + (ltid() >> 6);
  const u16* rw = raw + (size_t)row * 1024;
  u16* hb = (u16*)(ws + OFF_HB) + (size_t)row * 1024;
  float* xsp = (float*)(ws + OFF_RSQ) + row;
  const float xscale = ld_sc1_f(xsp);
  float4 rv[4];
  float s = 0.f;
#pragma unroll
  for (int i = 0; i < 4; ++i) {
    const int c = i * 256 + lane * 4;
    const u32x2 r2 = ld_sc1_8(rw + c);
    rv[i].x = bf2f((u16)(r2.x & 0xffff)); rv[i].y = bf2f((u16)(r2.x >> 16));
    rv[i].z = bf2f((u16)(r2.y & 0xffff)); rv[i].w = bf2f((u16)(r2.y >> 16));
    s += rv[i].x * rv[i].x + rv[i].y * rv[i].y + rv[i].z * rv[i].z + rv[i].w * rv[i].w;
  }
  s = red64(s);
  const float rr = rsqrtf(s * (1.0f / 1024.0f) + EPSF);
  float4 v[4];
  float ss = 0.f;
#pragma unroll
  for (int i = 0; i < 4; ++i) {
    const int c = i * 256 + lane * 4;
    const u32x2 h2 = ld_sc1_8(hb + c);
    const float4 g = *(const float4*)(gpost + c);
    v[i].x = bf2f((u16)(h2.x & 0xffff)) * xscale + rv[i].x * rr * g.x;
    v[i].y = bf2f((u16)(h2.x >> 16)) * xscale + rv[i].y * rr * g.y;
    v[i].z = bf2f((u16)(h2.y & 0xffff)) * xscale + rv[i].z * rr * g.z;
    v[i].w = bf2f((u16)(h2.y >> 16)) * xscale + rv[i].w * rr * g.w;
    ss += v[i].x * v[i].x + v[i].y * v[i].y + v[i].z * v[i].z + v[i].w * v[i].w;
  }
  ss = red64(ss);
  const float r = rsqrtf(ss * (1.0f / 1024.0f) + EPSF);
  if (lane == 0) *xsp = 1.0f / r;
  float* y = p.out + O_Y + (size_t)row * 1024;
#pragma unroll
  for (int i = 0; i < 4; ++i) {
    const int c = i * 256 + lane * 4;
    if (last) *(float4*)(y + c) = v[i];
    u32x2 o; o.x = pack2(v[i].x * r, v[i].y * r); o.y = pack2(v[i].z * r, v[i].w * r);
    *(u32x2*)(hb + c) = o;
  }
}

DI void cq_tile(const Params& p, int l, int t) {
  char* ws = p.ws;
  char* arena = ws + OFF_ARENA;
  const int rt = t >> 3, ct = t & 7, row0 = rt * 128, col0 = ct * 128;
  f32x4 acc[4][4];
  zero_acc(acc);
  u16* sA = (u16*)smem; u16* sB = sA + 128 * LDS_STRIDE;
  gemm_mainloop<128, 128, 2, 2>((const u16*)(ws + OFF_HB) + (size_t)row0 * 1024, 1024,
                                (const u16*)(ws + OFF_W) + (size_t)l * W_LAYER + W_CQ + (size_t)col0 * 1024, 1024, 1024, 1 << 30, acc, sA, sB, NoHook());
  tile_out_128(acc, (u16*)(arena + 3 * SLOT), 1024, row0, col0);
}

DI void att_task(const Params& p, int l, int t) {
  char* ws = p.ws;
  char* arena = ws + OFF_ARENA;
  const int tid = ltid(), lane = tid & 63, w = tid >> 6;
  int row0, h, nvalid;
  const u16 *KX, *VTX;
  if (t < 2048) {
    const int rt = t >> 2; h = t & 3; row0 = rt * 64; nvalid = 64;
    const int b = row0 >> 13;
    KX = (const u16*)(ws + OFF_KXP) + ((size_t)(l * 4 + b)) * 256 * 1024 + h * 256;
    VTX = (const u16*)(ws + OFF_VTXP) + ((size_t)((l * 4 + b) * 4 + h)) * 65536;
  } else {
    const int q = t - 2048, b = q >> 2; h = q & 3; row0 = PROWS + b * 16; nvalid = 16;
    KX = (const u16*)(ws + OFF_KXS) + (size_t)b * 256 * 1024 + h * 256;
    VTX = (const u16*)(ws + OFF_VTXS) + ((size_t)(b * 4 + h)) * 65536;
  }
  const u16* QX = (const u16*)(arena + 3 * SLOT);
  u16* OX = (u16*)(arena + 5 * SLOT);
#ifdef EXP_ATT_COPY
  for (int e = tid; e < nvalid * 256; e += NTHR) { const int r = e >> 8, c = e & 255; OX[(size_t)(row0 + r) * 1024 + h * 256 + c] = QX[(size_t)(row0 + r) * 1024 + h * 256 + c]; }
  return;
#endif
  const int arow0 = (row0 + 64 <= NTOK) ? row0 : (NTOK - 64);
  const int shift = row0 - arow0;
  u16* sA = (u16*)smem;
  u16* sB = (u16*)(smem + 34816);
  f32x4 acc[1][16];
  zero_acc(acc);
  gemm_mainloop<64, 256, 4, 1>(QX + (size_t)arow0 * 1024 + h * 256, 1024, KX, 1024, 256, 1 << 30, acc, sA, sB, NoHook());
  float inv[4];
#pragma unroll
  for (int j = 0; j < 4; ++j) {
    float mx = -3.0e38f;
#pragma unroll
    for (int n = 0; n < 16; ++n) mx = fmaxf(mx, acc[0][n][j]);
    mx = max16(mx);
    float s = 0.f;
#pragma unroll
    for (int n = 0; n < 16; ++n) { const float e = __expf(acc[0][n][j] - mx); acc[0][n][j] = e; s += e; }
    s = red16(s);
    inv[j] = 1.0f / s;
  }
  __syncthreads();
  u16* sP = (u16*)smem;
#pragma unroll
  for (int n = 0; n < 16; ++n)
#pragma unroll
    for (int j = 0; j < 4; ++j) sP[(w * 16 + (lane >> 4) * 4 + j) * 272 + n * 16 + (lane & 15)] = f2bf(acc[0][n][j] * inv[j]);
  zero_acc(acc);
  gemm_mainloop_alds<64, 256, 4, 1>(sP, 272, VTX, 256, 256, acc, sB);
#pragma unroll
  for (int n = 0; n < 16; ++n)
#pragma unroll
    for (int j = 0; j < 4; ++j) {
      const int rl = w * 16 + (lane >> 4) * 4 + j - shift;
      if (rl >= 0 && rl < nvalid) OX[(size_t)(row0 + rl) * 1024 + h * 256 + n * 16 + (lane & 15)] = f2bf(acc[0][n][j]);
    }
}

DI void gu_tile(const Params& p, int l, int t) {
  char* ws = p.ws;
  char* arena = ws + OFF_ARENA;
  const int rt = t / 44, ct = t % 44, row0 = rt * 128, col0 = ct * 128;
  f32x4 acc[4][4];
  zero_acc(acc);
  u16* sA = (u16*)smem; u16* sB = sA + 128 * LDS_STRIDE;
  gemm_mainloop<128, 128, 2, 2>((const u16*)(ws + OFF_HB) + (size_t)row0 * 1024, 1024,
                                (const u16*)(ws + OFF_W) + (size_t)l * W_LAYER + W_GU + (size_t)col0 * 1024, 1024, 1024, 1 << 30, acc, sA, sB, NoHook());
  const int tid = ltid(), lane = tid & 63, wid = tid >> 6, wm = wid >> 1, wn = wid & 1;
  u16* act = (u16*)(arena + 2 * SLOT);
  u16* sT = (u16*)smem;
  __syncthreads();
#pragma unroll
  for (int m = 0; m < 4; ++m)
#pragma unroll
    for (int np = 0; np < 2; ++np)
#pragma unroll
      for (int j = 0; j < 4; ++j)
        tile_put(sT, 72, wm * 64 + m * 16 + (lane >> 4) * 4 + j, wn * 32 + np * 16 + (lane & 15), siluf_(acc[m][2 * np][j]) * acc[m][2 * np + 1][j]);
  __syncthreads();
#pragma unroll
  for (int i = 0; i < 4; ++i) {
    const int id = tid + i * NTHR, r = id >> 3, c = (id & 7) * 8;
    *(u32x4*)(act + (size_t)(row0 + r) * DFF + (col0 >> 1) + c) = *(const u32x4*)(sT + r * 72 + c);
  }
}

DI void dbg_dump(const Params& p) {
#ifdef DUMP_SLOT
  const u16* src = (const u16*)(p.ws + OFF_ARENA + (size_t)DUMP_SLOT * SLOT);
  float* dst = p.out + O_Y;
  for (size_t i = (size_t)blockIdx.x * NTHR + threadIdx.x; i < (size_t)NTOK * 1024; i += (size_t)gridDim.x * NTHR) dst[i] = bf2f(src[i]);
#endif
#ifdef DUMP_HB
  const u16* src = (const u16*)(p.ws + OFF_HB);
  float* dst = p.out + O_Y;
  for (size_t i = (size_t)blockIdx.x * NTHR + threadIdx.x; i < (size_t)NTOK * 1024; i += (size_t)gridDim.x * NTHR) dst[i] = bf2f(src[i]);
#endif
}
#define PH_BEGIN { const int myph = ph++; const bool act_ = (myph >= p.ph_lo && myph < p.ph_hi); if (act_) { unsigned* c = &ctr[myph]; (void)c; phase_begin();
#define PH_END } if (act_ && myph + 1 < p.ph_hi) grid_barrier(bar); }

__global__ void __launch_bounds__(NTHR, 2) fwd_megakernel(Params p) {
  unsigned* bar = (unsigned*)(p.ws + OFF_BAR);
  unsigned* ctr = (unsigned*)(p.ws + OFF_CTR);
  if (threadIdx.x == 0) { g_xb[0] = 0u; g_xb[1] = 0u; g_xb[2] = 0u; g_xb[3] = 0u; }
  __syncthreads();
  if (USE_XCD_BARRIER) { if (threadIdx.x == 0) (void)xb_add(&bar[XB_XCNT(xb_xcc_id())], 1u); }
  if (p.never) cg::this_grid().sync();
  int ph = 0;
  char* ws = p.ws;
  char* arena = ws + OFF_ARENA;
#ifdef DUMP_AFTER
  if (p.ph_lo < 0) {
    const u16* src = (const u16*)(ws + DUMP_OFF);
    for (size_t j = (size_t)blockIdx.x * NTHR + threadIdx.x; j < (size_t)1048576; j += (size_t)gridDim.x * NTHR) {
      float acc = 0.f;
      size_t idx = (j * 131u) % DUMP_N;
      for (int k = 0; k < 512; ++k) {
        const float e = bf2f((u16)(src[idx] & 0xBFFF));
        acc = acc * 0.75f + e * (1.0f + 0.001f * (float)(k & 15));
        idx += 65537u; if (idx >= DUMP_N) idx -= DUMP_N;
      }
      float v = acc;
      for (int k = 0; k < 200; ++k) { v = bf2f(f2bf(v * 1.37f + 0.11f)); if (fabsf(v) > 4.f) v *= 0.125f; }
      p.out[O_Y + j] = v;
    }
    return;
  }
#endif
#ifdef EXP_CHAOS
  if (p.ph_lo == 0) {
    for (size_t i = (size_t)blockIdx.x * NTHR + threadIdx.x; i < (size_t)NTOK * 1024; i += (size_t)gridDim.x * NTHR) {
      float v = (i < (size_t)PROWS * 1024) ? p.x_prompt[i] : p.x_sample[i - (size_t)PROWS * 1024];
      float w = p.w_in[i % (4u * 1024u * 2560u)];
      for (int k = 0; k < 200; ++k) { v = bf2f(f2bf(v * 1.37f + w)); if (fabsf(v) > 4.f) v *= 0.125f; }
      p.out[O_Y + i] = v;
    }
  }
  return;
#endif

  PH_BEGIN
    phase_prep(p, c);
  PH_END

  for (int l_ = 0; l_ < DEPTHC; ++l_) {
    const int l = lsgpr(l_);
    const u16* wl = (const u16*)(ws + OFF_W) + (size_t)l * W_LAYER;
    PH_BEGIN
      const int n_g1 = 258 * 20, n_mk = (l == 0) ? 512 : 0, n_cc = 2048;
      for (;;) {
        int t = next_task(c);
        if (t >= n_g1 + n_mk + n_cc) break;
        if (t < n_g1) g1_tile(p, l, t);
        else if (t < n_g1 + n_mk) memkv_tile(p, t - n_g1);
        else cache_task(p, l, t - n_g1 - n_mk);
      }
    PH_END
    PH_BEGIN
      for (;;) {
        int t = next_task(c);
        if (t >= 256 + 512) break;
        if (t < 256) ret_local_task(p, t);
        else s5_task(p, l, t - 256, 0);
      }
    PH_END
    PH_BEGIN
      for (;;) {
        int t = next_task(c);
        if (t >= 320 + 640) break;
        if (t < 320) ret_final_task(p, l, t);
        else s5_task(p, l, t - 320, 1);
      }
    PH_END
    PH_BEGIN
      TASK_LOOP(c, 258 * 4, glu_tile(p, l, t))
    PH_END
    PH_BEGIN
      TASK_LOOP(c, 258 * 8, out_tile(p, l, t))
    PH_END
    PH_BEGIN
      for (int t = blockIdx.x; t < NTOK / 4; t += gridDim.x) { post_task(p, (const u16*)(arena + 1 * SLOT), p.mix_post + l * 1024, t, false); }
    PH_END
    PH_BEGIN
      TASK_LOOP(c, 258 * 8, cq_tile(p, l, t))
    PH_END
    PH_BEGIN
      TASK_LOOP(c, 2112, att_task(p, l, t))
    PH_END
    PH_BEGIN
      TASK_LOOP(c, 258 * 8, raw_tile(p, (const u16*)(arena + 5 * SLOT), 1024, wl + W_CO, 1024, (u16*)(arena + 1 * SLOT), t))
    PH_END
    PH_BEGIN
      for (int t = blockIdx.x; t < NTOK / 4; t += gridDim.x) { post_task(p, (const u16*)(arena + 1 * SLOT), p.xa_post + l * 1024, t, false); }
    PH_END
    PH_BEGIN
      TASK_LOOP(c, 258 * 44, gu_tile(p, l, t))
    PH_END
    PH_BEGIN
      TASK_LOOP(c, 258 * 8, raw_tile(p, (const u16*)(arena + 2 * SLOT), DFF, wl + W_DN, DFF, (u16*)(arena + 0 * SLOT), t))
    PH_END
    PH_BEGIN
      for (int t = blockIdx.x; t < NTOK / 4; t += gridDim.x) { post_task(p, (const u16*)(arena + 0 * SLOT), p.ffn_post + l * 1024, t, l == DEPTHC - 1); }
    PH_END
  }
}

#ifndef N_LAUNCH_SPLIT
#define N_LAUNCH_SPLIT 0
#endif
constexpr int N_PHASES = 1 + 13 * DEPTHC;

extern "C" void kernel_launch(void* const* d_in, const int* in_sizes, int n_in, void* d_out, int out_size, void* d_ws,
                              size_t ws_size, hipStream_t stream) {
  static int grid_blocks = 0;
  if (!grid_blocks) {
    int dev = 0, cus = 0, per_cu = 0;
    (void)hipGetDevice(&dev);
    (void)hipDeviceGetAttribute(&cus, hipDeviceAttributeMultiprocessorCount, dev);
    (void)hipOccupancyMaxActiveBlocksPerMultiprocessor(&per_cu, fwd_megakernel, NTHR, 0);
    if (per_cu > 2) per_cu = 2;
    if (per_cu < 1) per_cu = 1;
    grid_blocks = cus * per_cu;
  }
  if (ws_size < WS_NEEDED) fprintf(stderr, "workspace too small: %zu < %zu\n", ws_size, (size_t)WS_NEEDED);
  Params p{};
  const float** f = (const float**)&p;
  for (int i = 0; i < 36; ++i) f[i] = (const float*)d_in[i];
  p.out = (float*)d_out;
  p.ws = (char*)d_ws;
  p.never = 0;
  p.ph_lo = 0;
  p.ph_hi = N_PHASES;
  p.pad = 0;
  (void)hipMemsetAsync(d_ws, 0, 32768, stream);
  if (N_LAUNCH_SPLIT) {
#ifdef DUMP_AFTER
    const int nrun = DUMP_AFTER;
#else
    const int nrun = N_PHASES;
#endif
    for (int i = 0; i <= nrun; ++i) {
      if (i == nrun) {
#ifdef DUMP_AFTER
        p.ph_lo = -1; p.ph_hi = -1;
#else
        break;
#endif
      } else { p.ph_lo = i; p.ph_hi = i + 1; }
      void* args[] = {&p};
      hipError_t e = hipLaunchCooperativeKernel((void*)fwd_megakernel, dim3(grid_blocks), dim3(NTHR), args, 0, stream);
      if (e != hipSuccess) fprintf(stderr, "launch failed: %s (grid %d)\n", hipGetErrorString(e), grid_blocks);
    }
  } else {
    void* args[] = {&p};
    hipError_t e = hipLaunchCooperativeKernel((void*)fwd_megakernel, dim3(grid_blocks), dim3(NTHR), args, 0, stream);
    if (e != hipSuccess) fprintf(stderr, "cooperative launch failed: %s (grid %d)\n", hipGetErrorString(e), grid_blocks);
  }
}
```

```cpp
#include <hip/hip_runtime.h>
#include <hip/hip_bf16.h>
#include <hip/hip_cooperative_groups.h>
#include <stdint.h>
#include <stdio.h>
namespace cg = cooperative_groups;

typedef __attribute__((ext_vector_type(8))) short bf16x8;
typedef __attribute__((ext_vector_type(4))) float f32x4;
typedef unsigned short u16;
typedef __attribute__((ext_vector_type(4))) unsigned u32x4;
typedef __attribute__((ext_vector_type(2))) unsigned u32x2;
#define DI __device__ __forceinline__
#define MFMA16(a, b, c) __builtin_amdgcn_mfma_f32_16x16x32_bf16((a), (b), (c), 0, 0, 0)
#define MFMA_FENCE() do { __builtin_amdgcn_sched_barrier(0); asm volatile("s_nop 15\n\ts_nop 15" ::: "memory"); __builtin_amdgcn_sched_barrier(0); } while (0)

constexpr int NTOK = 33024, PROWS = 32768, DM = 1024, DFF = 2816, DEPTHC = 4;
constexpr int SEQ = 8192;
constexpr float EPSF = 1e-6f;
constexpr int NTHR = 256;
constexpr int LDS_STRIDE = 80;
constexpr int SMEM_BYTES = 76800;

constexpr size_t SLOT = (size_t)NTOK * 512 * 2;
constexpr size_t OFF_BAR = 0;
constexpr size_t OFF_CTR = 16384;
constexpr size_t OFF_W = 32768;
constexpr size_t W_IN = 0, W_GLU = W_IN + 2560 * 1024, W_OUT = W_GLU + 512 * 512, W_CQ = W_OUT + 1024 * 1024,
                 W_CK = W_CQ + 1024 * 1024, W_CV = W_CK + 1024 * 1024, W_CO = W_CV + 1024 * 1024,
                 W_GU = W_CO + 1024 * 1024, W_DN = W_GU + 5632 * 1024, W_LAYER = W_DN + 1024 * 2816;
constexpr size_t OFF_S5P = OFF_W + 4 * W_LAYER * 2;
constexpr size_t S5P_BBT = 0, S5P_CM = 131072, S5P_ABAR = 262144, S5P_LAYER = 278528;
constexpr size_t OFF_HB = OFF_S5P + 4 * S5P_LAYER;
constexpr size_t OFF_MEMB = OFF_HB + (size_t)NTOK * 1024 * 2;
constexpr size_t OFF_KXP = OFF_MEMB + 1024 * 1024 * 2;
constexpr size_t OFF_VTXP = OFF_KXP + 4 * 4 * 256 * 1024 * 2;
constexpr size_t OFF_KXS = OFF_VTXP + 4 * 4 * 256 * 1024 * 2;
constexpr size_t OFF_VTXS = OFF_KXS + 16 * 256 * 1024 * 2;
constexpr size_t OFF_SLOC = OFF_VTXS + 16 * 256 * 1024 * 2;
constexpr size_t OFF_ELOC = OFF_SLOC + 16 * 16 * 128 * 128 * 4;
constexpr size_t OFF_ZSQ = OFF_ELOC + 4 * 16 * 32 * 64 * 2 * 4;
constexpr size_t OFF_RSQ = OFF_ZSQ + (size_t)NTOK * 8 * 4;
constexpr size_t OFF_ARENA = OFF_RSQ + (size_t)NTOK * 16 * 4;
constexpr size_t WS_NEEDED = OFF_ARENA + 8 * SLOT;

constexpr size_t O_Y = 0, O_S5RE_P = 33816576, O_S5IM_P = 33849344, O_RET_P = 33882112, O_MK_P = 34930688,
                 O_MV_P = 39124992, O_S5RE_S = 43319296, O_S5IM_S = 43450368, O_RET_S = 43581440;

struct Params {
  const float *x_prompt, *x_sample, *mem_prompt, *s5re0, *s5im0, *ret0, *cmk, *cmv;
  const float *mix_pre, *mix_post, *w_in, *lam_re, *lam_im, *log_step, *b_re, *b_im, *c_re, *c_im, *s5_d, *w_glu,
      *b_glu, *s5_onorm, *ret_onorm, *w_out, *xa_pre, *xa_post, *mem_norm, *w_cq, *w_ck, *w_cv, *w_co, *ffn_pre,
      *ffn_post, *w_gate, *w_up, *w_down;
  float* out;
  char* ws;
  int never;
  int ph_lo;
  int ph_hi;
  int pad;
};

DI u16 f2bf(float f) {
  unsigned u = __float_as_uint(f);
  u += 0x7fffu + ((u >> 16) & 1u);
  return (u16)(u >> 16);
}
DI float bf2f(u16 h) { return __uint_as_float(((unsigned)h) << 16); }
DI unsigned pack2(float a, float b) { return (unsigned)f2bf(a) | ((unsigned)f2bf(b) << 16); }
DI float sigmoidf_(float x) { return 1.0f / (1.0f + __expf(-x)); }
DI float siluf_(float x) { return x * sigmoidf_(x); }
DI float geluf_(float x) {
  float t = 0.7978845608028654f * (x + 0.044715f * x * x * x);
  return 0.5f * x * (1.0f + tanhf(t));
}
DI float red16(float v) {
  v += __shfl_xor(v, 1); v += __shfl_xor(v, 2); v += __shfl_xor(v, 4); v += __shfl_xor(v, 8);
  return v;
}
DI float max16(float v) {
  v = fmaxf(v, __shfl_xor(v, 1)); v = fmaxf(v, __shfl_xor(v, 2)); v = fmaxf(v, __shfl_xor(v, 4)); v = fmaxf(v, __shfl_xor(v, 8));
  return v;
}
DI float red64(float v) {
  v = red16(v); v += __shfl_xor(v, 16); v += __shfl_xor(v, 32);
  return v;
}
DI void sincos_cw(float x, float* sn, float* cs) {
  const float k = rintf(x * 0.15915494309189535f);
  float r = fmaf(-k, 6.2831854820251465f, x);
  r = fmaf(-k, -1.7484555e-07f, r);
  *sn = __sinf(r); *cs = __cosf(r);
}
DI int ltid() { int x = threadIdx.x; asm volatile("" : "+v"(x)); return x; }
DI int lsgpr(int x) { asm volatile("" : "+s"(x)); return x; }
DI u32x4 ld_sc1_16(const void* p) {
  const unsigned long long* q = (const unsigned long long*)p;
  const unsigned long long a = __hip_atomic_load(q, __ATOMIC_RELAXED, __HIP_MEMORY_SCOPE_AGENT);
  const unsigned long long b = __hip_atomic_load(q + 1, __ATOMIC_RELAXED, __HIP_MEMORY_SCOPE_AGENT);
  return (u32x4){(unsigned)a, (unsigned)(a >> 32), (unsigned)b, (unsigned)(b >> 32)};
}
DI __amdgpu_buffer_rsrc_t mk_rsrc(const void* p) {
  const unsigned long long a = (unsigned long long)p;
  const unsigned lo = __builtin_amdgcn_readfirstlane((unsigned)a), hi = __builtin_amdgcn_readfirstlane((unsigned)(a >> 32));
  return __builtin_amdgcn_make_buffer_rsrc((void*)(((unsigned long long)hi << 32) | lo), 0, 0x7fffffff, 0x00020000);
}
DI u32x4 bld16(__amdgpu_buffer_rsrc_t r, unsigned voff, unsigned soff) { return __builtin_amdgcn_raw_buffer_load_b128(r, voff, soff, 16); }
DI u32x4 ld_ws16(const char* ws, const void* p) {
  const __amdgpu_buffer_rsrc_t r = __builtin_amdgcn_make_buffer_rsrc((void*)ws, 0, 0x7fffffff, 0x00020000);
  return __builtin_amdgcn_raw_buffer_load_b128(r, (unsigned)((const char*)p - ws), 0, 16);
}
DI u32x2 ld_sc1_8(const void* p) {
  const unsigned long long a = __hip_atomic_load((const unsigned long long*)p, __ATOMIC_RELAXED, __HIP_MEMORY_SCOPE_AGENT);
  return (u32x2){(unsigned)a, (unsigned)(a >> 32)};
}
DI u16 ld_sc1_2(const u16* p) { return __hip_atomic_load(p, __ATOMIC_RELAXED, __HIP_MEMORY_SCOPE_AGENT); }
DI float ld_sc1_f(const float* p) { return __hip_atomic_load(p, __ATOMIC_RELAXED, __HIP_MEMORY_SCOPE_AGENT); }
DI float gamma_l2(int h) { return log2f(1.0f - exp2f(-5.0f - (float)h)); }

#define XB_TMO 128
#define XB_XCNT(j) (256 + 64 * (j))
#define XB_XSUB(j) (1280 + 64 * (j))
#define XB_XGEN(j) (2304 + 64 * (j))
#define XB_TOP 3328
#define XB_TOPGEN 3392
#define XB_SPIN_CAP (1u << 26)
DI unsigned xb_ld(unsigned* p) { return __hip_atomic_load(p, __ATOMIC_RELAXED, __HIP_MEMORY_SCOPE_AGENT); }
DI unsigned xb_add(unsigned* p, unsigned v) { return __hip_atomic_fetch_add(p, v, __ATOMIC_RELAXED, __HIP_MEMORY_SCOPE_AGENT); }
DI unsigned xb_xcc_id() { return (unsigned)__builtin_amdgcn_s_getreg((3 << 11) | 20) & 0xFu; }
#define XB_SPIN(cond, bar) do { unsigned _sp = 0; while (cond) { __builtin_amdgcn_s_sleep(1); \
    if ((++_sp & 255u) == 0u) { if (xb_ld(&(bar)[XB_TMO])) break; if (_sp > XB_SPIN_CAP) { atomicAdd(&(bar)[XB_TMO], 1u); break; } } } } while (0)

__shared__ unsigned g_xb[4];
__shared__ __attribute__((aligned(16))) char smem[SMEM_BYTES];

DI void xcd_complete(unsigned* bar, unsigned x, unsigned& nloc, unsigned& nx) {
  const unsigned G = gridDim.x;
  unsigned sum, cnt, mine, sp = 0u;
  for (;;) {
    sum = 0u; cnt = 0u; mine = 0u;
#pragma unroll
    for (unsigned j = 0; j < 16; ++j) { const unsigned c = xb_ld(&bar[XB_XCNT(j)]); sum += c; cnt += (c > 0u) ? 1u : 0u; mine = (j == x) ? c : mine; }
    if (sum == G) break;
    __builtin_amdgcn_s_sleep(1);
    if ((++sp & 255u) == 0u) { if (xb_ld(&bar[XB_TMO])) break; if (sp > XB_SPIN_CAP) { atomicAdd(&bar[XB_TMO], 1u); break; } }
  }
  nloc = mine > 0u ? mine : 1u; nx = cnt > 0u ? cnt : 1u;
}
#ifndef USE_XCD_BARRIER
#define USE_XCD_BARRIER 1
#endif
DI void grid_barrier(unsigned* bar) {
  if (!USE_XCD_BARRIER) {
    asm volatile("s_waitcnt vmcnt(0)" ::: "memory");
    __syncthreads();
    if (threadIdx.x == 0) asm volatile("buffer_wbl2 sc0 sc1\n\ts_waitcnt vmcnt(0)" ::: "memory");
    cg::this_grid().sync();
    if (threadIdx.x == 0) asm volatile("buffer_inv sc0 sc1\n\ts_waitcnt vmcnt(0)" ::: "memory");
    __syncthreads();
    return;
  }
  asm volatile("s_waitcnt vmcnt(0)" ::: "memory");
  __syncthreads();
  if (threadIdx.x == 0) {
    __builtin_amdgcn_s_waitcnt(0);
    const unsigned xcc = xb_xcc_id();
    unsigned nloc = g_xb[0], nx = g_xb[1];
    if (nloc == 0u) { xcd_complete(bar, xcc, nloc, nx); g_xb[0] = nloc; g_xb[1] = nx; }
    const unsigned old = xb_add(&bar[XB_XSUB(xcc)], 1u);
    const unsigned gen = old / nloc;
    if (old + 1u == (gen + 1u) * nloc) {
      __builtin_amdgcn_fence(__ATOMIC_RELEASE, "agent");
      asm volatile("s_waitcnt vmcnt(0)" ::: "memory");
      const unsigned og = xb_add(&bar[XB_TOP], 1u);
      const unsigned tg = og / nx;
      if (og + 1u == (tg + 1u) * nx) xb_add(&bar[XB_TOPGEN], 1u);
      else XB_SPIN(xb_ld(&bar[XB_TOPGEN]) == tg, bar);
      __builtin_amdgcn_fence(__ATOMIC_ACQUIRE, "agent");
      xb_add(&bar[XB_XGEN(xcc)], 1u);
      asm volatile("s_waitcnt vmcnt(0)" ::: "memory");
    } else {
      XB_SPIN(xb_ld(&bar[XB_XGEN(xcc)]) == gen, bar);
      __builtin_amdgcn_fence(__ATOMIC_ACQUIRE, "agent");
      asm volatile("s_waitcnt vmcnt(0)" ::: "memory");
    }
  }
  __syncthreads();
}

#define DUMP_OFF (OFF_ELOC)
#define DUMP_N ((size_t)524288)
#define DUMP_F32 0
#ifndef MAXPH
#define MAXPH 10
#endif
#ifndef STATIC_SCHED
#define STATIC_SCHED 0
#endif
#ifndef ONE_XCD
#define ONE_XCD 0
#endif
DI int next_task(unsigned* ctr) {
  __syncthreads();
#ifdef LDS_NAN_PER_TASK
  __syncthreads();
#endif
  if (ONE_XCD) {
    if (threadIdx.x == 0) g_xb[2] = (xb_xcc_id() == 0u) ? atomicAdd(ctr, 1u) : 0x7fffffffu;
    __syncthreads();
    return (int)g_xb[2];
  }
  if (STATIC_SCHED) {
    if (threadIdx.x == 0) { unsigned it = g_xb[3]; g_xb[3] = it + 1u; g_xb[2] = blockIdx.x + it * gridDim.x; }
  } else {
    if (threadIdx.x == 0) g_xb[2] = atomicAdd(ctr, 1u);
  }
  __syncthreads();
  return (int)g_xb[2];
}
DI unsigned task_prefetch(unsigned* ctr) { unsigned v = 0u; if (threadIdx.x == 0) v = atomicAdd(ctr, 1u); return v; }
DI int task_commit(unsigned v) {
  __syncthreads();
  if (threadIdx.x == 0) g_xb[2] = v;
  __syncthreads();
  return (int)g_xb[2];
}
#define TASK_LOOP(ctr, N, BODY) { int t = next_task(ctr); while (t < (N)) { const unsigned tn_ = task_prefetch(ctr); BODY; t = task_commit(tn_); } }
DI void phase_begin() { __syncthreads(); if (threadIdx.x == 0) g_xb[3] = 0u; __syncthreads(); }

template <int BM, int BN, int WGM, int WGN, class Hook>
DI void gemm_mainloop(const u16* A, int lda, const u16* B, int ldb, int K, int kvalid,
                      f32x4 (&acc)[BM / WGM / 16][BN / WGN / 16], u16* sA, u16* sB, Hook hook) {
  constexpr int MT = BM / WGM / 16, NTL = BN / WGN / 16, CA = BM / 32, CB = BN / 32;
  const int tid = ltid(), lane = tid & 63, wid = tid >> 6, wm = wid / WGN, wn = wid % WGN;
  const __amdgpu_buffer_rsrc_t ra_ = mk_rsrc(A), rb_ = mk_rsrc(B);
  u32x4 ra0[CA], rb0[CB], ra1[CA], rb1[CB];
  unsigned va[CA], vb[CB];
  const u32x4 z4 = (u32x4){0u, 0u, 0u, 0u};
  const int cc0 = (tid & 7) * 8;
#pragma unroll
  for (int i = 0; i < CA; ++i) { const int r = (tid + i * NTHR) >> 3; va[i] = (unsigned)(r * lda + cc0) * 2u; }
#pragma unroll
  for (int i = 0; i < CB; ++i) { const int r = (tid + i * NTHR) >> 3; vb[i] = (unsigned)(r * ldb + cc0) * 2u; }
#define GM_LOAD(RA, RB, kn)                                                                          \
  {                                                                                                  \
    const bool kok = ((kn) + cc0) < kvalid;                                                          \
    _Pragma("unroll") for (int i = 0; i < CA; ++i) RA[i] = kok ? bld16(ra_, va[i], (unsigned)(kn) * 2u) : z4; \
    _Pragma("unroll") for (int i = 0; i < CB; ++i) RB[i] = kok ? bld16(rb_, vb[i], (unsigned)(kn) * 2u) : z4; \
  }
#define GM_STEP(RA, RB, kcur)                                                                        \
  {                                                                                                  \
    __syncthreads();                                                                                 \
    _Pragma("unroll") for (int i = 0; i < CA; ++i) { const int r = (tid + i * NTHR) >> 3; *(u32x4*)(sA + r * LDS_STRIDE + cc0) = RA[i]; } \
    _Pragma("unroll") for (int i = 0; i < CB; ++i) { const int r = (tid + i * NTHR) >> 3; *(u32x4*)(sB + r * LDS_STRIDE + cc0) = RB[i]; } \
    __syncthreads();                                                                                 \
    if ((kcur) + 128 < K) GM_LOAD(RA, RB, (kcur) + 128)                                              \
    _Pragma("unroll") for (int kk = 0; kk < 2; ++kk) {                                               \
      bf16x8 af[MT], bfr[NTL];                                                                       \
      _Pragma("unroll") for (int m = 0; m < MT; ++m) af[m] = *(const bf16x8*)(sA + (wm * (BM / WGM) + m * 16 + (lane & 15)) * LDS_STRIDE + kk * 32 + (lane >> 4) * 8); \
      _Pragma("unroll") for (int n = 0; n < NTL; ++n) bfr[n] = *(const bf16x8*)(sB + (wn * (BN / WGN) + n * 16 + (lane & 15)) * LDS_STRIDE + kk * 32 + (lane >> 4) * 8); \
      _Pragma("unroll") for (int m = 0; m < MT; ++m)                                                 \
        _Pragma("unroll") for (int n = 0; n < NTL; ++n) acc[m][n] = MFMA16(af[m], bfr[n], acc[m][n]); \
    }                                                                                                \
    hook((kcur), acc);                                                                               \
  }
  GM_LOAD(ra0, rb0, 0)
  if (64 < K) GM_LOAD(ra1, rb1, 64)
#pragma unroll
  for (int k0 = 0; k0 < K; k0 += 128) {
    GM_STEP(ra0, rb0, k0)
    GM_STEP(ra1, rb1, k0 + 64)
  }
  MFMA_FENCE();
#undef GM_LOAD
#undef GM_STEP
}
struct NoHook { template <class T> DI void operator()(int, T&) const {} };

template <int BM, int BN, int WGM, int WGN>
DI void gemm_mainloop_alds(const u16* sAimg, int lda_s, const u16* B, int ldb, int K,
                           f32x4 (&acc)[BM / WGM / 16][BN / WGN / 16], u16* sB) {
  constexpr int MT = BM / WGM / 16, NTL = BN / WGN / 16, CB = BN / 32;
  const int tid = ltid(), lane = tid & 63, wid = tid >> 6, wm = wid / WGN, wn = wid % WGN;
  const __amdgpu_buffer_rsrc_t rb_ = mk_rsrc(B);
  u32x4 rb0[CB], rb1[CB];
  unsigned vb[CB];
  const int cc0 = (tid & 7) * 8;
#pragma unroll
  for (int i = 0; i < CB; ++i) { const int r = (tid + i * NTHR) >> 3; vb[i] = (unsigned)(r * ldb + cc0) * 2u; }
#define GA_STEP(RB, kcur)                                                                            \
  {                                                                                                  \
    __syncthreads();                                                                                 \
    _Pragma("unroll") for (int i = 0; i < CB; ++i) { const int r = (tid + i * NTHR) >> 3; *(u32x4*)(sB + r * LDS_STRIDE + cc0) = RB[i]; } \
    __syncthreads();                                                                                 \
    if ((kcur) + 128 < K) { _Pragma("unroll") for (int i = 0; i < CB; ++i) RB[i] = bld16(rb_, vb[i], (unsigned)((kcur) + 128) * 2u); } \
    _Pragma("unroll") for (int kk = 0; kk < 2; ++kk) {                                               \
      bf16x8 af[MT], bfr[NTL];                                                                       \
      _Pragma("unroll") for (int m = 0; m < MT; ++m) af[m] = *(const bf16x8*)(sAimg + (wm * (BM / WGM) + m * 16 + (lane & 15)) * lda_s + (kcur) + kk * 32 + (lane >> 4) * 8); \
      _Pragma("unroll") for (int n = 0; n < NTL; ++n) bfr[n] = *(const bf16x8*)(sB + (wn * (BN / WGN) + n * 16 + (lane & 15)) * LDS_STRIDE + kk * 32 + (lane >> 4) * 8); \
      _Pragma("unroll") for (int m = 0; m < MT; ++m)                                                 \
        _Pragma("unroll") for (int n = 0; n < NTL; ++n) acc[m][n] = MFMA16(af[m], bfr[n], acc[m][n]); \
    }                                                                                                \
  }
#pragma unroll
  for (int i = 0; i < CB; ++i) rb0[i] = bld16(rb_, vb[i], 0u);
#pragma unroll
  for (int i = 0; i < CB; ++i) rb1[i] = bld16(rb_, vb[i], 128u);
#pragma unroll 1
  for (int k0 = 0; k0 < K; k0 += 128) {
    GA_STEP(rb0, k0)
    GA_STEP(rb1, k0 + 64)
  }
  MFMA_FENCE();
#undef GA_STEP
}

template <int MT, int NTL>
DI void zero_acc(f32x4 (&acc)[MT][NTL]) {
#pragma unroll
  for (int m = 0; m < MT; ++m)
#pragma unroll
    for (int n = 0; n < NTL; ++n) acc[m][n] = (f32x4){0.f, 0.f, 0.f, 0.f};
}

DI void tile_put(u16* sT, int stride, int r, int c, float v) { sT[r * stride + c] = f2bf(v); }
DI void tile_flush128(const u16* sT, u16* dst, int ld, int row0, int col0) {
  const int tid = ltid();
#pragma unroll
  for (int i = 0; i < 8; ++i) {
    const int id = tid + i * NTHR, r = id >> 4, c = (id & 15) * 8;
    *(u32x4*)(dst + (size_t)(row0 + r) * ld + col0 + c) = *(const u32x4*)(sT + r * 136 + c);
  }
}
DI void tile_out_128(const f32x4 (&v)[4][4], u16* dst, int ld, int row0, int col0) {
  u16* sT = (u16*)smem;
  const int lane = ltid() & 63, wid = ltid() >> 6, wm = wid >> 1, wn = wid & 1;
  __syncthreads();
#pragma unroll
  for (int m = 0; m < 4; ++m)
#pragma unroll
    for (int n = 0; n < 4; ++n)
#pragma unroll
      for (int j = 0; j < 4; ++j) tile_put(sT, 136, wm * 64 + m * 16 + (lane >> 4) * 4 + j, wn * 64 + n * 16 + (lane & 15), v[m][n][j]);
  __syncthreads();
  tile_flush128(sT, dst, ld, row0, col0);
}

DI int dst_row_map(int n, int mode) {
  if (mode == 0) return n;
  if (mode == 1) {
    if (n < 512 || n >= 1536) return n;
    int sec = n & ~127, d = n & 127;
    int xh = d >> 6, idx = d & 63;
    return sec + (((idx >> 4) * 2 + xh) << 4) + (idx & 15);
  }
  if (mode == 2) return (n >> 4) * 32 + (n & 15);
  return (n >> 4) * 32 + 16 + (n & 15);
}
DI void transpose_tile(const float* src, int lds_, int k0, int n0, u16* dst, int ldd,
                       const float* gain, int mode, float scale) {
  float* t = (float*)smem;
  const int tid = ltid(), ty = tid >> 4, tx = tid & 15;
  __syncthreads();
#pragma unroll
  for (int i = 0; i < 4; ++i) {
    int k = ty + 16 * i;
    float4 v = *(const float4*)(src + (size_t)(k0 + k) * lds_ + n0 + tx * 4);
    float g = gain ? gain[k0 + k] : 1.0f;
    t[k * 65 + tx * 4 + 0] = v.x * g; t[k * 65 + tx * 4 + 1] = v.y * g;
    t[k * 65 + tx * 4 + 2] = v.z * g; t[k * 65 + tx * 4 + 3] = v.w * g;
  }
  __syncthreads();
  const int nl = tid >> 2, ks = (tid & 3) * 16;
  const int n = n0 + nl;
  float sc = scale;
  if (mode == 1) sc = (n >= 512 && n < 1024) ? 0.08838834764831845f : 1.0f;
  unsigned w[8];
#pragma unroll
  for (int i = 0; i < 8; ++i) w[i] = pack2(t[(ks + 2 * i) * 65 + nl] * sc, t[(ks + 2 * i + 1) * 65 + nl] * sc);
  u16* d = dst + (size_t)dst_row_map(n, mode) * ldd + k0 + ks;
  *(u32x4*)d = (u32x4){w[0], w[1], w[2], w[3]};
  *(u32x4*)(d + 8) = (u32x4){w[4], w[5], w[6], w[7]};
}

DI void rownorm_task(const float* src, float* xs_out, u16* dst) {
  const int lane = ltid() & 63;
  float4 v[4];
  float ss = 0.f;
#pragma unroll
  for (int i = 0; i < 4; ++i) {
    v[i] = *(const float4*)(src + i * 256 + lane * 4);
    ss += v[i].x * v[i].x + v[i].y * v[i].y + v[i].z * v[i].z + v[i].w * v[i].w;
  }
  ss = red64(ss);
  const float r = rsqrtf(ss * (1.0f / 1024.0f) + EPSF);
  if (xs_out && lane == 0) *xs_out = 1.0f / r;
#pragma unroll
  for (int i = 0; i < 4; ++i) {
    u32x2 o; o.x = pack2(v[i].x * r, v[i].y * r); o.y = pack2(v[i].z * r, v[i].w * r);
    *(u32x2*)(dst + i * 256 + lane * 4) = o;
  }
}

DI void phase_prep(const Params& p, unsigned* ctr) {
  char* ws = p.ws;
  const int tid = ltid();
  constexpr int T_W = 16384, T_X = NTOK / 4, T_M = 256, T_S = 128;
  constexpr int TOT = T_W + T_X + T_M + T_S;
  for (int t = blockIdx.x; t < TOT; t += gridDim.x) {
    if (t < T_W) {
      const int l = t >> 12; int q = t & 4095;
      u16* wl = (u16*)(ws + OFF_W) + (size_t)l * W_LAYER;
      if (q < 640) {
        transpose_tile(p.w_in + (size_t)l * 1024 * 2560, 2560, (q / 40) * 64, (q % 40) * 64, wl + W_IN, 1024, p.mix_pre + l * 1024, 1, 1.0f);
      } else if ((q -= 640) < 64) {
        transpose_tile(p.w_glu + (size_t)l * 512 * 512, 512, (q / 8) * 64, (q % 8) * 64, wl + W_GLU, 512, nullptr, 0, 1.0f);
      } else if ((q -= 64) < 256) {
        const int k0 = (q / 16) * 64;
        const float* gain = (k0 < 512) ? (p.s5_onorm + l * 512) : (p.ret_onorm + l * 512 - 512);
        transpose_tile(p.w_out + (size_t)l * 1024 * 1024, 1024, k0, (q % 16) * 64, wl + W_OUT, 1024, gain, 0, 1.0f);
      } else if ((q -= 256) < 256) {
        transpose_tile(p.w_cq + (size_t)l * 1024 * 1024, 1024, (q / 16) * 64, (q % 16) * 64, wl + W_CQ, 1024, p.xa_pre + l * 1024, 0, 0.0625f);
      } else if ((q -= 256) < 256) {
        transpose_tile(p.w_ck + (size_t)l * 1024 * 1024, 1024, (q / 16) * 64, (q % 16) * 64, wl + W_CK, 1024, p.mem_norm + l * 1024, 0, 1.0f);
      } else if ((q -= 256) < 256) {
        transpose_tile(p.w_cv + (size_t)l * 1024 * 1024, 1024, (q / 16) * 64, (q % 16) * 64, wl + W_CV, 1024, p.mem_norm + l * 1024, 0, 1.0f);
      } else if ((q -= 256) < 256) {
        transpose_tile(p.w_co + (size_t)l * 1024 * 1024, 1024, (q / 16) * 64, (q % 16) * 64, wl + W_CO, 1024, nullptr, 0, 1.0f);
      } else if ((q -= 256) < 704) {
        transpose_tile(p.w_gate + (size_t)l * 1024 * 2816, 2816, (q / 44) * 64, (q % 44) * 64, wl + W_GU, 1024, p.ffn_pre + l * 1024, 2, 1.0f);
      } else if ((q -= 704) < 704) {
        transpose_tile(p.w_up + (size_t)l * 1024 * 2816, 2816, (q / 44) * 64, (q % 44) * 64, wl + W_GU, 1024, p.ffn_pre + l * 1024, 3, 1.0f);
      } else {
        q -= 704;
        transpose_tile(p.w_down + (size_t)l * 2816 * 1024, 1024, (q / 16) * 64, (q % 16) * 64, wl + W_DN, 2816, nullptr, 0, 1.0f);
      }
    } else if (t < T_W + T_X) {
      const int row = (t - T_W) * 4 + (tid >> 6);
      const float* src = (row < PROWS) ? p.x_prompt + (size_t)row * 1024 : p.x_sample + (size_t)(row - PROWS) * 1024;
      rownorm_task(src, (float*)(ws + OFF_RSQ) + row, (u16*)(ws + OFF_HB) + (size_t)row * 1024);
    } else if (t < T_W + T_X + T_M) {
      const int row = (t - T_W - T_X) * 4 + (tid >> 6);
      rownorm_task(p.mem_prompt + (size_t)row * 1024, nullptr, (u16*)(ws + OFF_MEMB) + (size_t)row * 1024);
    } else {
      const int lg = t - T_W - T_X - T_M, l = lg >> 5, g = lg & 31;
      char* sp = ws + OFF_S5P + (size_t)l * S5P_LAYER;
      u16* bbt = (u16*)(sp + S5P_BBT) + g * 2048;
      u16* cm = (u16*)(sp + S5P_CM) + g * 2048;
      float* ab = (float*)(sp + S5P_ABAR) + g * 128;
      const float dt = __expf(p.log_step[l * 32 + g]);
      for (int e = tid; e < 1024; e += NTHR) {
        const int pp = e >> 4, h = e & 15;
        const float lr = p.lam_re[(l * 32 + g) * 64 + pp], li = p.lam_im[(l * 32 + g) * 64 + pp];
        const float ar = lr * dt, ai = li * dt, mag = expf(ar);
        float sn_, cs_; sincos_cw(ai, &sn_, &cs_);
        const float abr = mag * cs_, abi = mag * sn_;
        const float den = lr * lr + li * li, nr = abr - 1.0f, ni = abi;
        const float fr = (nr * lr + ni * li) / den, fi = (ni * lr - nr * li) / den;
        const float br = p.b_re[((size_t)(l * 32 + g) * 64 + pp) * 16 + h], bi = p.b_im[((size_t)(l * 32 + g) * 64 + pp) * 16 + h];
        bbt[pp * 16 + h] = f2bf(fr * br - fi * bi);
        bbt[(64 + pp) * 16 + h] = f2bf(fr * bi + fi * br);
        if (h == 0) { ab[pp * 2] = abr; ab[pp * 2 + 1] = abi; }
        const int hh = e >> 6, kk = e & 63;
        cm[hh * 128 + kk] = f2bf(p.c_re[((size_t)(l * 32 + g) * 16 + hh) * 64 + kk]);
        cm[hh * 128 + 64 + kk] = f2bf(-p.c_im[((size_t)(l * 32 + g) * 16 + hh) * 64 + kk]);
      }
    }
  }
}

DI void memkv_tile(const Params& p, int t) {
  char* ws = p.ws;
  const int l = t >> 7, rt = (t >> 4) & 7, ct = t & 15;
  const int isv = ct >> 3, col0 = (ct & 7) * 128, row0 = rt * 128;
  const u16* A = (const u16*)(ws + OFF_MEMB) + (size_t)row0 * 1024;
  const u16* B = (const u16*)(ws + OFF_W) + (size_t)l * W_LAYER + (isv ? W_CV : W_CK) + (size_t)col0 * 1024;
  f32x4 acc[4][4];
  zero_acc(acc);
  u16* sA = (u16*)smem; u16* sB = sA + 128 * LDS_STRIDE;
  gemm_mainloop<128, 128, 2, 2>(A, 1024, B, 1024, 1024, 1 << 30, acc, sA, sB, NoHook());
  const int lane = ltid() & 63, wid = ltid() >> 6, wm = wid >> 1, wn = wid & 1;
  float* of = p.out + (isv ? O_MV_P : O_MK_P) + (size_t)l * 1024 * 1024;
  u16* kx = (u16*)(ws + OFF_KXP) + (size_t)l * 1024 * 1024;
  u16* vx = (u16*)(ws + OFF_VTXP) + (size_t)l * 1024 * 1024;
#pragma unroll
  for (int m = 0; m < 4; ++m)
#pragma unroll
    for (int n = 0; n < 4; ++n) {
      const int r = row0 + wm * 64 + m * 16 + (lane >> 4) * 4, c = col0 + wn * 64 + n * 16 + (lane & 15);
#pragma unroll
      for (int j = 0; j < 4; ++j) of[(size_t)(r + j) * 1024 + c] = acc[m][n][j];
      if (!isv) {
#pragma unroll
        for (int j = 0; j < 4; ++j) kx[(size_t)(r + j) * 1024 + c] = f2bf(acc[m][n][j]);
      } else {
        const int b = r >> 8, mm = r & 255, h = c >> 8, d = c & 255;
        u32x2 o; o.x = pack2(acc[m][n][0], acc[m][n][1]); o.y = pack2(acc[m][n][2], acc[m][n][3]);
        *(u32x2*)(vx + ((size_t)((b * 4 + h) * 256 + d)) * 256 + mm) = o;
      }
    }
}
DI void cache_task(const Params& p, int l, int t) {
  char* ws = p.ws;
  if (t < 1024) {
    const float* src = p.cmk + (size_t)l * 16 * 256 * 1024 + (size_t)t * 4096 + ltid() * 16;
    u16* dst = (u16*)(ws + OFF_KXS) + (size_t)t * 4096 + ltid() * 16;
    float4 a = *(const float4*)src, b = *(const float4*)(src + 4), c = *(const float4*)(src + 8), d = *(const float4*)(src + 12);
    *(u32x4*)dst = (u32x4){pack2(a.x, a.y), pack2(a.z, a.w), pack2(b.x, b.y), pack2(b.z, b.w)};
    *(u32x4*)(dst + 8) = (u32x4){pack2(c.x, c.y), pack2(c.z, c.w), pack2(d.x, d.y), pack2(d.z, d.w)};
  } else {
    t -= 1024;
    const int bh = t >> 4, q = t & 15, b = bh >> 2, h = bh & 3;
    const float* src = p.cmv + ((size_t)(l * 16 + b) * 256) * 1024 + h * 256;
    u16* dst = (u16*)(ws + OFF_VTXS) + (size_t)bh * 256 * 256;
    transpose_tile(src, 1024, (q >> 2) * 64, (q & 3) * 64, dst, 256, nullptr, 0, 1.0f);
  }
}

DI void g1_tile(const Params& p, int l, int t) {
  char* ws = p.ws;
  const int rt = t / 20, ct = t % 20;
  const int row0 = rt * 128, col0 = ct * 128;
  const u16* A = (const u16*)(ws + OFF_HB) + (size_t)row0 * 1024;
  const u16* B = (const u16*)(ws + OFF_W) + (size_t)l * W_LAYER + W_IN + (size_t)col0 * 1024;
  f32x4 acc[4][4];
  zero_acc(acc);
  u16* sA = (u16*)smem; u16* sB = sA + 128 * LDS_STRIDE;
  gemm_mainloop<128, 128, 2, 2>(A, 1024, B, 1024, 1024, 1 << 30, acc, sA, sB, NoHook());
  const int lane = ltid() & 63, wid = ltid() >> 6, wm = wid >> 1, wn = wid & 1;
  char* arena = ws + OFF_ARENA;
  const int sec = ct >> 2, hd = ct & 3;
  const bool samp = row0 >= PROWS;
  if (sec == 0 || sec == 4) {
    tile_out_128(acc, (u16*)(arena + (sec == 0 ? 0 : 3) * SLOT), 512, row0, hd * 128);
  } else if (sec == 3) {
    u16* vt = (u16*)(arena + 4 * SLOT);
#pragma unroll
    for (int m = 0; m < 4; ++m)
#pragma unroll
      for (int n = 0; n < 4; ++n) {
        const int r = row0 + wm * 64 + m * 16 + (lane >> 4) * 4, e = wn * 64 + n * 16 + (lane & 15);
        u32x2 o; o.x = pack2(acc[m][n][0], acc[m][n][1]); o.y = pack2(acc[m][n][2], acc[m][n][3]);
        size_t off;
        if (!samp) { const int b = r >> 13, tt = r & 8191; off = ((size_t)((b * 4 + hd) * 128 + e)) * SEQ + tt; }
        else { const int sr = r - PROWS, b = sr >> 4, tt = sr & 15; off = (size_t)16 * 128 * SEQ + ((size_t)((b * 4 + hd) * 128 + e)) * 16 + tt; }
        *(u32x2*)(vt + off) = o;
      }
  } else {
    u16* dst = (u16*)(arena + (sec == 1 ? 1 : 2) * SLOT);
    u16* ktd = (u16*)(arena + 5 * SLOT);
    const float gl2 = gamma_l2(hd);
    u16* sT = (u16*)smem;
    __syncthreads();
#pragma unroll
    for (int m = 0; m < 4; ++m)
#pragma unroll
      for (int np = 0; np < 2; ++np) {
        const int r = row0 + wm * 64 + m * 16 + (lane >> 4) * 4;
        const int idx = (wn * 2 + np) * 16 + (lane & 15);
        const float inv = exp2f(-(float)idx * (13.287712379549449f / 64.0f));
        float o1[4], o2[4];
#pragma unroll
        for (int j = 0; j < 4; ++j) {
          const int rr = r + j;
          const int pos = samp ? (1024 + ((rr - PROWS) & 15)) : (rr & 8191);
          float sn, cs;
          sincos_cw((float)pos * inv, &sn, &cs);
          const float x1 = acc[m][2 * np][j], x2 = acc[m][2 * np + 1][j];
          o1[j] = x1 * cs - x2 * sn; o2[j] = x1 * sn + x2 * cs;
          tile_put(sT, 136, rr - row0, idx, o1[j]);
          tile_put(sT, 136, rr - row0, 64 + idx, o2[j]);
        }
        if (sec == 2) {
          size_t off1; int tloc;
          if (!samp) { const int b = r >> 13, tt = r & 8191; off1 = ((size_t)((b * 4 + hd) * 128 + idx)) * SEQ + tt; tloc = 63 - (tt & 63); }
          else { const int sr = r - PROWS, b = sr >> 4, tt = sr & 15; off1 = (size_t)16 * 128 * SEQ + ((size_t)((b * 4 + hd) * 128 + idx)) * 16 + tt; tloc = 15 - tt; }
          const size_t off2 = off1 + (size_t)64 * (samp ? 16 : SEQ);
          float dc[4];
#pragma unroll
          for (int j = 0; j < 4; ++j) dc[j] = exp2f(gl2 * (float)(tloc - j));
          u32x2 a, b2;
          a.x = pack2(o1[0] * dc[0], o1[1] * dc[1]); a.y = pack2(o1[2] * dc[2], o1[3] * dc[3]);
          b2.x = pack2(o2[0] * dc[0], o2[1] * dc[1]); b2.y = pack2(o2[2] * dc[2], o2[3] * dc[3]);
          *(u32x2*)(ktd + off1) = a;
          *(u32x2*)(ktd + off2) = b2;
        }
      }
    __syncthreads();
    tile_flush128(sT, dst, 512, row0, hd * 128);
  }
}

struct DecayHook {
  float g64;
  template <class T> DI void operator()(int k0, T& acc) const {
    if (k0 + 64 < 512) {
#pragma unroll
      for (int m = 0; m < 4; ++m)
#pragma unroll
        for (int n = 0; n < 4; ++n) acc[m][n] *= g64;
    }
  }
};
DI void ret_local_task(const Params& p, int t) {
  char* ws = p.ws;
  char* arena = ws + OFF_ARENA;
  const int bh = t >> 4, sc = t & 15, h = bh & 3;
  const u16* A = (const u16*)(arena + 5 * SLOT) + (size_t)bh * 128 * SEQ + sc * 512;
  const u16* B = (const u16*)(arena + 4 * SLOT) + (size_t)bh * 128 * SEQ + sc * 512;
  f32x4 acc[4][4];
  zero_acc(acc);
  u16* sA = (u16*)smem; u16* sB = sA + 128 * LDS_STRIDE;
  DecayHook hk; hk.g64 = exp2f(gamma_l2(h) * 64.0f);
  gemm_mainloop<128, 128, 2, 2>(A, SEQ, B, SEQ, 512, 1 << 30, acc, sA, sB, hk);
  const int lane = ltid() & 63, wid = ltid() >> 6, wm = wid >> 1, wn = wid & 1;
  float* dst = (float*)(ws + OFF_SLOC) + (size_t)t * 16384;
#pragma unroll
  for (int m = 0; m < 4; ++m)
#pragma unroll
    for (int n = 0; n < 4; ++n) {
      const int r = wm * 64 + m * 16 + (lane >> 4) * 4, c = wn * 64 + n * 16 + (lane & 15);
#pragma unroll
      for (int j = 0; j < 4; ++j) dst[(r + j) * 128 + c] = acc[m][n][j];
    }
}

DI void ret_final_task(const Params& p, int l, int t) {
  char* ws = p.ws;
  char* arena = ws + OFF_ARENA;
  const int tid = ltid(), lane = tid & 63, w = tid >> 6;
  const bool samp = t >= 256;
  int bh, sc, nchunk, C, row_base;
  size_t tr_base; int tr_ld;
  if (!samp) { bh = t >> 4; sc = t & 15; nchunk = 8; C = 64; row_base = (bh >> 2) * SEQ + sc * 512; tr_base = (size_t)bh * 128 * SEQ + sc * 512; tr_ld = SEQ; }
  else { bh = t - 256; sc = 0; nchunk = 1; C = 16; row_base = PROWS + (bh >> 2) * 16; tr_base = (size_t)16 * 128 * SEQ + (size_t)bh * 128 * 16; tr_ld = 16; }
  const int h = bh & 3;
  const float gl2 = gamma_l2(h);
  const float gC = exp2f(gl2 * (float)C);
  const u16* Qg = (const u16*)(arena + 1 * SLOT);
  const u16* Kg = (const u16*)(arena + 2 * SLOT);
  const u16* Gg = (const u16*)(arena + 3 * SLOT);
  const u16* Vt = (const u16*)(arena + 4 * SLOT) + tr_base;
  const u16* Ktd = (const u16*)(arena + 5 * SLOT) + tr_base;
  u16* reto = (u16*)(arena + 7 * SLOT);
  u16* sQ = (u16*)smem;
  u16* sK = sQ + 64 * 144;
  u16* sV = sK + 128 * LDS_STRIDE;
  u16* sS = sV + 128 * LDS_STRIDE;
  float* sR = (float*)(sS + 64 * LDS_STRIDE);

  f32x4 S[8][2];
  if (samp) {
    const float* s0 = p.ret0 + ((size_t)(l * 64 + bh)) * 16384;
#pragma unroll
    for (int mt = 0; mt < 8; ++mt)
#pragma unroll
      for (int nt = 0; nt < 2; ++nt)
#pragma unroll
        for (int j = 0; j < 4; ++j) S[mt][nt][j] = s0[(mt * 16 + (lane >> 4) * 4 + j) * 128 + 32 * w + nt * 16 + (lane & 15)];
  } else {
#pragma unroll
    for (int mt = 0; mt < 8; ++mt)
#pragma unroll
      for (int nt = 0; nt < 2; ++nt) S[mt][nt] = (f32x4){0.f, 0.f, 0.f, 0.f};
    const float g512 = exp2f(gl2 * 512.0f);
    for (int s2 = 0; s2 < sc; ++s2) {
      const float* sl = (const float*)(ws + OFF_SLOC) + ((size_t)(bh * 16 + s2)) * 16384;
#pragma unroll
      for (int mt = 0; mt < 8; ++mt)
#pragma unroll
        for (int nt = 0; nt < 2; ++nt)
#pragma unroll
          for (int j = 0; j < 4; ++j)
            S[mt][nt][j] = S[mt][nt][j] * g512 + ld_sc1_f(sl + (mt * 16 + (lane >> 4) * 4 + j) * 128 + 32 * w + nt * 16 + (lane & 15));
    }
  }
  const u32x4 z4 = (u32x4){0, 0, 0, 0};
  for (int c = 0; c < nchunk; ++c) {
    const int r0 = row_base + c * 64;
    __syncthreads();
#pragma unroll
    for (int i = 0; i < 4; ++i) {
      const int id = tid + i * NTHR, r = id >> 4, cc = (id & 15) * 8;
      u32x4 q4 = z4, k4 = z4;
      if (r < C) {
        q4 = ld_ws16(ws, Qg + (size_t)(r0 + r) * 512 + h * 128 + cc);
        k4 = ld_ws16(ws, Kg + (size_t)(r0 + r) * 512 + h * 128 + cc);
      }
      *(u32x4*)(sQ + r * 144 + cc) = q4;
      *(u32x4*)(sK + r * 144 + cc) = k4;
    }
#pragma unroll
    for (int i = 0; i < 4; ++i) {
      const int id = tid + i * NTHR, r = id >> 3, cc = (id & 7) * 8;
      u32x4 v4 = z4;
      if (cc < C) v4 = ld_ws16(ws, Vt + (size_t)r * tr_ld + c * 64 + cc);
      *(u32x4*)(sV + r * LDS_STRIDE + cc) = v4;
    }
    __syncthreads();
    {
      f32x4 sc4[4];
#pragma unroll
      for (int m = 0; m < 4; ++m) sc4[m] = (f32x4){0.f, 0.f, 0.f, 0.f};
#pragma unroll
      for (int ks = 0; ks < 4; ++ks) {
        const bf16x8 bk = *(const bf16x8*)(sK + (16 * w + (lane & 15)) * 144 + ks * 32 + (lane >> 4) * 8);
#pragma unroll
        for (int m = 0; m < 4; ++m) {
          const bf16x8 aq = *(const bf16x8*)(sQ + (m * 16 + (lane & 15)) * 144 + ks * 32 + (lane >> 4) * 8);
          sc4[m] = MFMA16(aq, bk, sc4[m]);
        }
      }
      MFMA_FENCE();
      const int jc = 16 * w + (lane & 15);
#pragma unroll
      for (int m = 0; m < 4; ++m)
#pragma unroll
        for (int j = 0; j < 4; ++j) {
          const int i = m * 16 + (lane >> 4) * 4 + j;
          const int dd = i > jc ? i - jc : jc - i;
          sS[i * LDS_STRIDE + jc] = f2bf(sc4[m][j] * exp2f(gl2 * (float)dd));
        }
    }
    __syncthreads();
#pragma unroll
    for (int i = 0; i < 4; ++i) {
      const int id = tid + i * NTHR, r = id >> 3, cc = (id & 7) * 8;
      u32x4 v4 = z4;
      if (cc < C) v4 = ld_ws16(ws, Ktd + (size_t)r * tr_ld + c * 64 + cc);
      *(u32x4*)(sK + r * LDS_STRIDE + cc) = v4;
    }
    f32x4 o[4][2];
#pragma unroll
    for (int m = 0; m < 4; ++m) { o[m][0] = (f32x4){0.f, 0.f, 0.f, 0.f}; o[m][1] = o[m][0]; }
#pragma unroll
    for (int a = 0; a < 4; ++a) {
      bf16x8 bs[2];
#pragma unroll
      for (int nt = 0; nt < 2; ++nt) {
        u32x4 u;
        u.x = pack2(S[2 * a][nt][0], S[2 * a][nt][1]); u.y = pack2(S[2 * a][nt][2], S[2 * a][nt][3]);
        u.z = pack2(S[2 * a + 1][nt][0], S[2 * a + 1][nt][1]); u.w = pack2(S[2 * a + 1][nt][2], S[2 * a + 1][nt][3]);
        bs[nt] = __builtin_bit_cast(bf16x8, u);
      }
#pragma unroll
      for (int m = 0; m < 4; ++m) {
        const u16* qp = sQ + (m * 16 + (lane & 15)) * 144 + (lane >> 4) * 4;
        const u32x2 lo = *(const u32x2*)(qp + (2 * a) * 16);
        const u32x2 hi = *(const u32x2*)(qp + (2 * a + 1) * 16);
        const bf16x8 aq = __builtin_bit_cast(bf16x8, ((u32x4){lo.x, lo.y, hi.x, hi.y}));
        o[m][0] = MFMA16(aq, bs[0], o[m][0]);
        o[m][1] = MFMA16(aq, bs[1], o[m][1]);
      }
      __builtin_amdgcn_sched_barrier(0);
    }
    MFMA_FENCE();
#pragma unroll
    for (int m = 0; m < 4; ++m)
#pragma unroll
      for (int j = 0; j < 4; ++j) {
        const int i = m * 16 + (lane >> 4) * 4 + j;
        const float f = exp2f(gl2 * (float)(i + 1));
        o[m][0][j] *= f;
        o[m][1][j] *= f;
      }
#pragma unroll
    for (int ks = 0; ks < 2; ++ks) {
      bf16x8 bv[2];
#pragma unroll
      for (int nt = 0; nt < 2; ++nt) bv[nt] = *(const bf16x8*)(sV + (32 * w + nt * 16 + (lane & 15)) * LDS_STRIDE + ks * 32 + (lane >> 4) * 8);
#pragma unroll
      for (int m = 0; m < 4; ++m) {
        const bf16x8 as = *(const bf16x8*)(sS + (m * 16 + (lane & 15)) * LDS_STRIDE + ks * 32 + (lane >> 4) * 8);
        o[m][0] = MFMA16(as, bv[0], o[m][0]);
        o[m][1] = MFMA16(as, bv[1], o[m][1]);
      }
      __builtin_amdgcn_sched_barrier(0);
    }
    MFMA_FENCE();
#pragma unroll
    for (int m = 0; m < 4; ++m)
#pragma unroll
      for (int j = 0; j < 4; ++j) {
        float v = o[m][0][j] * o[m][0][j] + o[m][1][j] * o[m][1][j];
        v = red16(v);
        if ((lane & 15) == 0) sR[w * 64 + m * 16 + (lane >> 4) * 4 + j] = v;
      }
    __syncthreads();
#pragma unroll
    for (int m = 0; m < 4; ++m)
#pragma unroll
      for (int j = 0; j < 4; ++j) {
        const int i = m * 16 + (lane >> 4) * 4 + j;
        if (i < C) {
          const float ss = sR[i] + sR[64 + i] + sR[128 + i] + sR[192 + i];
          const float rs = rsqrtf(ss * (1.0f / 128.0f) + EPSF);
#pragma unroll
          for (int nt = 0; nt < 2; ++nt) {
            const int e = 32 * w + nt * 16 + (lane & 15);
            const float g = bf2f(ld_sc1_2(Gg + (size_t)(r0 + i) * 512 + h * 128 + e));
            reto[(size_t)(r0 + i) * 512 + h * 128 + e] = f2bf(o[m][nt][j] * rs * siluf_(g));
          }
        }
      }
#pragma unroll
    for (int mt = 0; mt < 8; ++mt) { S[mt][0] *= gC; S[mt][1] *= gC; }
#pragma unroll 1
    for (int ks = 0; ks < 2; ++ks) {
      bf16x8 bv[2];
#pragma unroll
      for (int nt = 0; nt < 2; ++nt) bv[nt] = *(const bf16x8*)(sV + (32 * w + nt * 16 + (lane & 15)) * LDS_STRIDE + ks * 32 + (lane >> 4) * 8);
#pragma unroll
      for (int mt = 0; mt < 8; ++mt) {
        const bf16x8 ak = *(const bf16x8*)(sK + (mt * 16 + (lane & 15)) * LDS_STRIDE + ks * 32 + (lane >> 4) * 8);
        S[mt][0] = MFMA16(ak, bv[0], S[mt][0]);
        S[mt][1] = MFMA16(ak, bv[1], S[mt][1]);
      }
    }
    MFMA_FENCE();
  }
  if (samp || sc == 15) {
    float* so = samp ? (p.out + O_RET_S + ((size_t)(l * 64 + bh)) * 16384) : (p.out + O_RET_P + ((size_t)(l * 16 + bh)) * 16384);
#pragma unroll
    for (int mt = 0; mt < 8; ++mt)
#pragma unroll
      for (int nt = 0; nt < 2; ++nt)
#pragma unroll
        for (int j = 0; j < 4; ++j) so[(mt * 16 + (lane >> 4) * 4 + j) * 128 + 32 * w + nt * 16 + (lane & 15)] = S[mt][nt][j];
  }
}

DI void s5_task(const Params& p, int l, int t, int mode) {
  char* ws = p.ws;
  char* arena = ws + OFF_ARENA;
  const int tid = ltid(), lane = tid & 63, w = tid >> 6;
  const bool samp = t >= 512;
  int b, lc, g, row_base, nsub;
  if (!samp) { b = t >> 7; lc = (t >> 3) & 15; g = (t & 7) * 4 + w; row_base = b * SEQ + lc * 512; nsub = 32; }
  else { const int q = t - 512; b = q >> 3; lc = 0; g = (q & 7) * 4 + w; row_base = PROWS + b * 16; nsub = 1; }
  const char* sp = ws + OFF_S5P + (size_t)l * S5P_LAYER;
  const u16* bbt = (const u16*)(sp + S5P_BBT) + g * 2048;
  const u16* cm = (const u16*)(sp + S5P_CM) + g * 2048;
  const float* ab = (const float*)(sp + S5P_ABAR) + g * 128;
  const u16* U = (const u16*)(arena + 0 * SLOT);
  u16* Z = (u16*)(arena + 6 * SLOT);
  float* bu = (float*)(smem + w * 13056);
  u16* xs = (u16*)(smem + w * 13056 + 8448);
  const float ar = ld_sc1_f(ab + lane * 2), ai = ld_sc1_f(ab + lane * 2 + 1);
  const int slab = lane >> 4;
  const u32x4 z4 = (u32x4){0, 0, 0, 0};
  bf16x8 Bf[8], Cf[4];
#pragma unroll
  for (int nt = 0; nt < 8; ++nt) {
    u32x4 u = z4;
    if (slab < 2) u = ld_ws16(ws, bbt + (nt * 16 + (lane & 15)) * 16 + slab * 8);
    Bf[nt] = __builtin_bit_cast(bf16x8, u);
  }
#pragma unroll
  for (int ks = 0; ks < 4; ++ks) Cf[ks] = __builtin_bit_cast(bf16x8, ld_ws16(ws, cm + (lane & 15) * 128 + ks * 32 + slab * 8));
  const float Dh = p.s5_d[(l * 32 + g) * 16 + (lane & 15)];
  float xr = 0.f, xi = 0.f;
  if (samp) {
    xr = p.s5re0[((size_t)(l * 16 + b) * 32 + g) * 64 + lane];
    xi = p.s5im0[((size_t)(l * 16 + b) * 32 + g) * 64 + lane];
  } else if (mode == 1 && lc > 0) {
    float pr = ar, pi = ai;
#pragma unroll
    for (int s = 0; s < 9; ++s) { const float nr = pr * pr - pi * pi, ni = 2.f * pr * pi; pr = nr; pi = ni; }
    const float* el = (const float*)(ws + OFF_ELOC);
    for (int c2 = 0; c2 < lc; ++c2) {
      const float er = ld_sc1_f(el + (((size_t)(b * 16 + c2) * 32 + g) * 64 + lane) * 2), ei = ld_sc1_f(el + (((size_t)(b * 16 + c2) * 32 + g) * 64 + lane) * 2 + 1);
      const float nr = pr * xr - pi * xi + er, ni = pr * xi + pi * xr + ei;
      xr = nr; xi = ni;
    }
  }
  u16* usm = (u16*)(smem + 52224 + w * 512);
  const u16* up = U + (size_t)(row_base + (lane & 15)) * 512 + g * 16 + (slab & 1) * 8;
  u32x4 ua = ld_ws16(ws, up);
  for (int sub = 0; sub < nsub; ++sub) {
    const int r0 = row_base + sub * 16;
    u32x4 un = z4;
    if (sub + 1 < nsub) un = ld_ws16(ws, up + (size_t)(sub + 1) * 16 * 512);
    if (slab >= 2) ua = z4;
    const bf16x8 Af = __builtin_bit_cast(bf16x8, ua);
    __syncthreads();
    if (mode == 1 && slab < 2) *(u32x4*)(usm + (lane & 15) * 16 + slab * 8) = ua;
    f32x4 a8[8];
#pragma unroll
    for (int nt = 0; nt < 8; ++nt) a8[nt] = MFMA16(Af, Bf[nt], ((f32x4){0.f, 0.f, 0.f, 0.f}));
    __builtin_amdgcn_sched_barrier(0);
    asm volatile("s_nop 15\n\ts_nop 15\n\ts_nop 15" ::: "memory");
    __builtin_amdgcn_sched_barrier(0);
#pragma unroll
    for (int nt = 0; nt < 8; ++nt) {
#pragma unroll
      for (int j = 0; j < 4; ++j) bu[(slab * 4 + j) * 132 + nt * 16 + (lane & 15)] = a8[nt][j];
    }
    __syncthreads();
#pragma unroll
    for (int tt = 0; tt < 16; ++tt) {
      const float br = bu[tt * 132 + lane], bi = bu[tt * 132 + 64 + lane];
      const float nr = ar * xr - ai * xi + br, ni = ar * xi + ai * xr + bi;
      xr = nr; xi = ni;
      if (mode == 1) { xs[tt * 144 + lane] = f2bf(xr); xs[tt * 144 + 64 + lane] = f2bf(xi); }
    }
    if (mode == 1) {
      __syncthreads();
      f32x4 y = (f32x4){0.f, 0.f, 0.f, 0.f};
#pragma unroll
      for (int ks = 0; ks < 4; ++ks) {
        const bf16x8 ax = *(const bf16x8*)(xs + (lane & 15) * 144 + ks * 32 + slab * 8);
        y = MFMA16(ax, Cf[ks], y);
      }
      __builtin_amdgcn_sched_barrier(0);
      asm volatile("s_nop 15\n\ts_nop 15" ::: "memory");
      __builtin_amdgcn_sched_barrier(0);
#pragma unroll
      for (int j = 0; j < 4; ++j) {
        const int rr = r0 + slab * 4 + j, cc = g * 16 + (lane & 15);
        const float u = bf2f(usm[(slab * 4 + j) * 16 + (lane & 15)]);
        Z[(size_t)rr * 512 + cc] = f2bf(geluf_(y[j] + Dh * u));
      }
    }
    ua = un;
  }
  if (mode == 0) {
    float* el = (float*)(ws + OFF_ELOC);
    el[(((size_t)(b * 16 + lc) * 32 + g) * 64 + lane) * 2] = xr;
    el[(((size_t)(b * 16 + lc) * 32 + g) * 64 + lane) * 2 + 1] = xi;
  } else if (samp) {
    p.out[O_S5RE_S + ((size_t)(l * 16 + b) * 32 + g) * 64 + lane] = xr;
    p.out[O_S5IM_S + ((size_t)(l * 16 + b) * 32 + g) * 64 + lane] = xi;
  } else if (lc == 15) {
    p.out[O_S5RE_P + ((size_t)(l * 4 + b) * 32 + g) * 64 + lane] = xr;
    p.out[O_S5IM_P + ((size_t)(l * 4 + b) * 32 + g) * 64 + lane] = xi;
  }
}

DI void glu_tile(const Params& p, int l, int t) {
  char* ws = p.ws;
  char* arena = ws + OFF_ARENA;
  const int rt = t >> 2, ct = t & 3, row0 = rt * 128, col0 = ct * 128;
  const u16* Zb = (const u16*)(arena + 6 * SLOT);
  const u16* A = Zb + (size_t)row0 * 512;
  const u16* B = (const u16*)(ws + OFF_W) + (size_t)l * W_LAYER + W_GLU + (size_t)col0 * 512;
  f32x4 acc[4][4];
  zero_acc(acc);
  u16* sA = (u16*)smem; u16* sB = sA + 128 * LDS_STRIDE;
  gemm_mainloop<128, 128, 2, 2>(A, 512, B, 512, 512, 1 << 30, acc, sA, sB, NoHook());
  const int lane = ltid() & 63, wid = ltid() >> 6, wm = wid >> 1, wn = wid & 1;
  u16* Z2 = (u16*)(arena + 0 * SLOT);
  float* zsq = (float*)(ws + OFF_ZSQ);
  const float* bg = p.b_glu + l * 512;
  u16* sT = (u16*)smem;
  __syncthreads();
  {
    const int tq = ltid();
#pragma unroll
    for (int i = 0; i < 8; ++i) {
      const int id = tq + i * NTHR, rr = id >> 4, cc = (id & 15) * 8;
      *(u32x4*)(sT + rr * 136 + cc) = ld_ws16(ws, Zb + (size_t)(row0 + rr) * 512 + col0 + cc);
    }
  }
  __syncthreads();
#pragma unroll
  for (int m = 0; m < 4; ++m) {
    float ss[4] = {0.f, 0.f, 0.f, 0.f};
    const int rl = wm * 64 + m * 16 + (lane >> 4) * 4;
#pragma unroll
    for (int n = 0; n < 4; ++n) {
      const int cl = wn * 64 + n * 16 + (lane & 15);
      const float bb = bg[col0 + cl];
#pragma unroll
      for (int j = 0; j < 4; ++j) {
        const float z = bf2f(sT[(rl + j) * 136 + cl]);
        const float z2 = z * sigmoidf_(acc[m][n][j] + bb);
        ss[j] += z2 * z2;
        sT[(rl + j) * 136 + cl] = f2bf(z2);
      }
    }
#pragma unroll
    for (int j = 0; j < 4; ++j) {
      const float v = red16(ss[j]);
      if ((lane & 15) == 0) zsq[(size_t)(ct * 2 + wn) * NTOK + row0 + rl + j] = v;
    }
  }
  __syncthreads();
  tile_flush128(sT, Z2, 512, row0, col0);
}

DI void store_raw_rsq(const f32x4 (&acc)[4][4], u16* raw, float* rsq, int row0, int col0, int ct) {
  tile_out_128(acc, raw, 1024, row0, col0);
}

DI void out_tile(const Params& p, int l, int t) {
  char* ws = p.ws;
  char* arena = ws + OFF_ARENA;
  const int rt = t >> 3, ct = t & 7, row0 = rt * 128, col0 = ct * 128;
  const u16* B = (const u16*)(ws + OFF_W) + (size_t)l * W_LAYER + W_OUT + (size_t)col0 * 1024;
  f32x4 acc[4][4];
  zero_acc(acc);
  u16* sA = (u16*)smem; u16* sB = sA + 128 * LDS_STRIDE;
  float* rsl = (float*)(smem + 40960);
  const float* zsq = (const float*)(ws + OFF_ZSQ);
  {
    const int tq = ltid();
    if (tq < 128) {
      float zs = 0.f;
#pragma unroll
      for (int q = 0; q < 8; ++q) zs += ld_sc1_f(zsq + (size_t)q * NTOK + row0 + tq);
      rsl[tq] = rsqrtf(zs * (1.0f / 512.0f) + EPSF);
    }
  }
  gemm_mainloop<128, 128, 2, 2>((const u16*)(arena + 0 * SLOT) + (size_t)row0 * 512, 512, B, 1024, 512, 1 << 30, acc, sA, sB, NoHook());
  const int lane = ltid() & 63, wid = ltid() >> 6, wm = wid >> 1;
#pragma unroll
  for (int m = 0; m < 4; ++m)
#pragma unroll
    for (int j = 0; j < 4; ++j) {
      const float rs = rsl[wm * 64 + m * 16 + (lane >> 4) * 4 + j];
#pragma unroll
      for (int n = 0; n < 4; ++n) acc[m][n][j] *= rs;
    }
  gemm_mainloop<128, 128, 2, 2>((const u16*)(arena + 7 * SLOT) + (size_t)row0 * 512, 512, B + 512, 1024, 512, 1 << 30, acc, sA, sB, NoHook());
  store_raw_rsq(acc, (u16*)(arena + 1 * SLOT), (float*)(ws + OFF_RSQ), row0, col0, ct);
}

DI void raw_tile(const Params& p, const u16* Abase, int lda, const u16* Bbase, int K, u16* raw, int t) {
  char* ws = p.ws;
  const int rt = t >> 3, ct = t & 7, row0 = rt * 128, col0 = ct * 128;
  f32x4 acc[4][4];
  zero_acc(acc);
  u16* sA = (u16*)smem; u16* sB = sA + 128 * LDS_STRIDE;
  gemm_mainloop<128, 128, 2, 2>(Abase + (size_t)row0 * lda, lda, Bbase + (size_t)col0 * K, K, K, 1 << 30, acc, sA, sB, NoHook());
  store_raw_rsq(acc, raw, (float*)(ws + OFF_RSQ), row0, col0, ct);
}

DI void post_task(const Params& p, const u16* raw, const float* gpost, int t, bool last) {
  char* ws = p.ws;
  const int lane = ltid() & 63, w = ltid() >> 6;
  const int rowb = t * 16 + w * 4;
  u32x2 r2[4][4], h2[4][4];
  float xsc[4];
  float* xsb = (float*)(ws + OFF_RSQ);
#pragma unroll
  for (int k = 0; k < 4; ++k) {
    const int row = rowb + k;
    const u16* rw = raw + (size_t)row * 1024;
    const u16* hbr = (const u16*)(ws + OFF_HB) + (size_t)row * 1024;
    xsc[k] = ld_sc1_f(xsb + row);
#pragma unroll
    for (int i = 0; i < 4; ++i) { const int c = i * 256 + lane * 4; r2[k][i] = ld_sc1_8(rw + c); h2[k][i] = ld_sc1_8(hbr + c); }
  }
  float4 g[4];
#pragma unroll
  for (int i = 0; i < 4; ++i) g[i] = *(const float4*)(gpost + i * 256 + lane * 4);
#pragma unroll
  for (int k = 0; k < 4; ++k) {
    const int row = rowb + k;
    float4 rv[4];
    float s = 0.f;
#pragma unroll
    for (int i = 0; i < 4; ++i) {
      rv[i].x = bf2f((u16)(r2[k][i].x & 0xffff)); rv[i].y = bf2f((u16)(r2[k][i].x >> 16));
      rv[i].z = bf2f((u16)(r2[k][i].y & 0xffff)); rv[i].w = bf2f((u16)(r2[k][i].y >> 16));
      s += rv[i].x * rv[i].x + rv[i].y * rv[i].y + rv[i].z * rv[i].z + rv[i].w * rv[i].w;
    }
    s = red64(s);
    const float rr = rsqrtf(s * (1.0f / 1024.0f) + EPSF);
    const float xscale = xsc[k];
    float4 v[4];
    float ss = 0.f;
#pragma unroll
    for (int i = 0; i < 4; ++i) {
      v[i].x = bf2f((u16)(h2[k][i].x & 0xffff)) * xscale + rv[i].x * rr * g[i].x;
      v[i].y = bf2f((u16)(h2[k][i].x >> 16)) * xscale + rv[i].y * rr * g[i].y;
      v[i].z = bf2f((u16)(h2[k][i].y & 0xffff)) * xscale + rv[i].z * rr * g[i].z;
      v[i].w = bf2f((u16)(h2[k][i].y >> 16)) * xscale + rv[i].w * rr * g[i].w;
      ss += v[i].x * v[i].x + v[i].y * v[i].y + v[i].z * v[i].z + v[i].w * v[i].w;
    }
    ss = red64(ss);
    const float r = rsqrtf(ss * (1.0f / 1024.0f) + EPSF);
    if (lane == 0) xsb[row] = 1.0f / r;
    float* y = p.out + O_Y + (size_t)row * 1024;
    u16* hb = (u16*)(ws + OFF_HB) + (size_t)row * 1024;
#pragma unroll
    for (int i = 0; i < 4; ++i) {
      const int c = i * 256 + lane * 4;
      if (last) *(float4*)(y + c) = v[i];
      u32x2 o; o.x = pack2(v[i].x * r, v[i].y * r); o.y = pack2(v[i].z * r, v[i].w * r);
      *(u32x2*)(hb + c) = o;
    }
  }
}

DI void cq_tile(const Params& p, int l, int t) {
  char* ws = p.ws;
  char* arena = ws + OFF_ARENA;
  const int rt = t >> 3, ct = t & 7, row0 = rt * 128, col0 = ct * 128;
  f32x4 acc[4][4];
  zero_acc(acc);
  u16* sA = (u16*)smem; u16* sB = sA + 128 * LDS_STRIDE;
  gemm_mainloop<128, 128, 2, 2>((const u16*)(ws + OFF_HB) + (size_t)row0 * 1024, 1024,
                                (const u16*)(ws + OFF_W) + (size_t)l * W_LAYER + W_CQ + (size_t)col0 * 1024, 1024, 1024, 1 << 30, acc, sA, sB, NoHook());
  tile_out_128(acc, (u16*)(arena + 3 * SLOT), 1024, row0, col0);
}

DI void att_task(const Params& p, int l, int t) {
  char* ws = p.ws;
  char* arena = ws + OFF_ARENA;
  const int tid = ltid(), lane = tid & 63, w = tid >> 6;
  int row0, h, nvalid;
  const u16 *KX, *VTX;
  if (t < 2048) {
    const int rt = t >> 2; h = t & 3; row0 = rt * 64; nvalid = 64;
    const int b = row0 >> 13;
    KX = (const u16*)(ws + OFF_KXP) + ((size_t)(l * 4 + b)) * 256 * 1024 + h * 256;
    VTX = (const u16*)(ws + OFF_VTXP) + ((size_t)((l * 4 + b) * 4 + h)) * 65536;
  } else {
    const int q = t - 2048, b = q >> 2; h = q & 3; row0 = PROWS + b * 16; nvalid = 16;
    KX = (const u16*)(ws + OFF_KXS) + (size_t)b * 256 * 1024 + h * 256;
    VTX = (const u16*)(ws + OFF_VTXS) + ((size_t)(b * 4 + h)) * 65536;
  }
  const u16* QX = (const u16*)(arena + 3 * SLOT);
  u16* OX = (u16*)(arena + 5 * SLOT);
#ifdef EXP_ATT_COPY
  for (int e = tid; e < nvalid * 256; e += NTHR) { const int r = e >> 8, c = e & 255; OX[(size_t)(row0 + r) * 1024 + h * 256 + c] = QX[(size_t)(row0 + r) * 1024 + h * 256 + c]; }
  return;
#endif
  const int arow0 = (row0 + 64 <= NTOK) ? row0 : (NTOK - 64);
  const int shift = row0 - arow0;
  u16* sA = (u16*)smem;
  u16* sB = (u16*)(smem + 34816);
  f32x4 acc[1][16];
  zero_acc(acc);
  gemm_mainloop<64, 256, 4, 1>(QX + (size_t)arow0 * 1024 + h * 256, 1024, KX, 1024, 256, 1 << 30, acc, sA, sB, NoHook());
  float inv[4];
#pragma unroll
  for (int j = 0; j < 4; ++j) {
    float mx = -3.0e38f;
#pragma unroll
    for (int n = 0; n < 16; ++n) mx = fmaxf(mx, acc[0][n][j]);
    mx = max16(mx);
    float s = 0.f;
#pragma unroll
    for (int n = 0; n < 16; ++n) { const float e = __expf(acc[0][n][j] - mx); acc[0][n][j] = e; s += e; }
    s = red16(s);
    inv[j] = 1.0f / s;
  }
  __syncthreads();
  u16* sP = (u16*)smem;
#pragma unroll
  for (int n = 0; n < 16; ++n)
#pragma unroll
    for (int j = 0; j < 4; ++j) sP[(w * 16 + (lane >> 4) * 4 + j) * 272 + n * 16 + (lane & 15)] = f2bf(acc[0][n][j] * inv[j]);
  zero_acc(acc);
  gemm_mainloop_alds<64, 256, 4, 1>(sP, 272, VTX, 256, 256, acc, sB);
#pragma unroll
  for (int n = 0; n < 16; ++n)
#pragma unroll
    for (int j = 0; j < 4; ++j) {
      const int rl = w * 16 + (lane >> 4) * 4 + j - shift;
      if (rl >= 0 && rl < nvalid) OX[(size_t)(row0 + rl) * 1024 + h * 256 + n * 16 + (lane & 15)] = f2bf(acc[0][n][j]);
    }
}

DI void gu_tile(const Params& p, int l, int t) {
  char* ws = p.ws;
  char* arena = ws + OFF_ARENA;
  const int rt = t / 44, ct = t % 44, row0 = rt * 128, col0 = ct * 128;
  f32x4 acc[4][4];
  zero_acc(acc);
  u16* sA = (u16*)smem; u16* sB = sA + 128 * LDS_STRIDE;
  gemm_mainloop<128, 128, 2, 2>((const u16*)(ws + OFF_HB) + (size_t)row0 * 1024, 1024,
                                (const u16*)(ws + OFF_W) + (size_t)l * W_LAYER + W_GU + (size_t)col0 * 1024, 1024, 1024, 1 << 30, acc, sA, sB, NoHook());
  const int tid = ltid(), lane = tid & 63, wid = tid >> 6, wm = wid >> 1, wn = wid & 1;
  u16* act = (u16*)(arena + 2 * SLOT);
  u16* sT = (u16*)smem;
  __syncthreads();
#pragma unroll
  for (int m = 0; m < 4; ++m)
#pragma unroll
    for (int np = 0; np < 2; ++np)
#pragma unroll
      for (int j = 0; j < 4; ++j)
        tile_put(sT, 72, wm * 64 + m * 16 + (lane >> 4) * 4 + j, wn * 32 + np * 16 + (lane & 15), siluf_(acc[m][2 * np][j]) * acc[m][2 * np + 1][j]);
  __syncthreads();
#pragma unroll
  for (int i = 0; i < 4; ++i) {
    const int id = tid + i * NTHR, r = id >> 3, c = (id & 7) * 8;
    *(u32x4*)(act + (size_t)(row0 + r) * DFF + (col0 >> 1) + c) = *(const u32x4*)(sT + r * 72 + c);
  }
}

DI void dbg_dump(const Params& p) {
#ifdef DUMP_SLOT
  const u16* src = (const u16*)(p.ws + OFF_ARENA + (size_t)DUMP_SLOT * SLOT);
  float* dst = p.out + O_Y;
  for (size_t i = (size_t)blockIdx.x * NTHR + threadIdx.x; i < (size_t)NTOK * 1024; i += (size_t)gridDim.x * NTHR) dst[i] = bf2f(src[i]);
#endif
#ifdef DUMP_HB
  const u16* src = (const u16*)(p.ws + OFF_HB);
  float* dst = p.out + O_Y;
  for (size_t i = (size_t)blockIdx.x * NTHR + threadIdx.x; i < (size_t)NTOK * 1024; i += (size_t)gridDim.x * NTHR) dst[i] = bf2f(src[i]);
#endif
}
#define PH_BEGIN { const int myph = ph++; const bool act_ = (myph >= p.ph_lo && myph < p.ph_hi); if (act_) { unsigned* c = &ctr[myph]; (void)c; phase_begin();
#define PH_END } if (act_ && myph + 1 < p.ph_hi) grid_barrier(bar); }

__global__ void __launch_bounds__(NTHR, 2) fwd_megakernel(Params p) {
  unsigned* bar = (unsigned*)(p.ws + OFF_BAR);
  unsigned* ctr = (unsigned*)(p.ws + OFF_CTR);
  if (threadIdx.x == 0) { g_xb[0] = 0u; g_xb[1] = 0u; g_xb[2] = 0u; g_xb[3] = 0u; }
  __syncthreads();
  if (USE_XCD_BARRIER) { if (threadIdx.x == 0) (void)xb_add(&bar[XB_XCNT(xb_xcc_id())], 1u); }
  if (p.never) cg::this_grid().sync();
  int ph = 0;
  char* ws = p.ws;
  char* arena = ws + OFF_ARENA;
#ifdef DUMP_AFTER
  if (p.ph_lo < 0) {
    const u16* src = (const u16*)(ws + DUMP_OFF);
    for (size_t j = (size_t)blockIdx.x * NTHR + threadIdx.x; j < (size_t)1048576; j += (size_t)gridDim.x * NTHR) {
      float acc = 0.f;
      size_t idx = (j * 131u) % DUMP_N;
      for (int k = 0; k < 512; ++k) {
        const float e = bf2f((u16)(src[idx] & 0xBFFF));
        acc = acc * 0.75f + e * (1.0f + 0.001f * (float)(k & 15));
        idx += 65537u; if (idx >= DUMP_N) idx -= DUMP_N;
      }
      float v = acc;
      for (int k = 0; k < 200; ++k) { v = bf2f(f2bf(v * 1.37f + 0.11f)); if (fabsf(v) > 4.f) v *= 0.125f; }
      p.out[O_Y + j] = v;
    }
    return;
  }
#endif
#ifdef EXP_CHAOS
  if (p.ph_lo == 0) {
    for (size_t i = (size_t)blockIdx.x * NTHR + threadIdx.x; i < (size_t)NTOK * 1024; i += (size_t)gridDim.x * NTHR) {
      float v = (i < (size_t)PROWS * 1024) ? p.x_prompt[i] : p.x_sample[i - (size_t)PROWS * 1024];
      float w = p.w_in[i % (4u * 1024u * 2560u)];
      for (int k = 0; k < 200; ++k) { v = bf2f(f2bf(v * 1.37f + w)); if (fabsf(v) > 4.f) v *= 0.125f; }
      p.out[O_Y + i] = v;
    }
  }
  return;
#endif

  PH_BEGIN
    phase_prep(p, c);
  PH_END

  for (int l_ = 0; l_ < DEPTHC; ++l_) {
    const int l = lsgpr(l_);
    const u16* wl = (const u16*)(ws + OFF_W) + (size_t)l * W_LAYER;
    PH_BEGIN
      const int n_g1 = 258 * 20, n_mk = (l == 0) ? 512 : 0, n_cc = 2048;
      for (;;) {
        int t = next_task(c);
        if (t >= n_g1 + n_mk + n_cc) break;
        if (t < n_g1) g1_tile(p, l, t);
        else if (t < n_g1 + n_mk) memkv_tile(p, t - n_g1);
        else cache_task(p, l, t - n_g1 - n_mk);
      }
    PH_END
    PH_BEGIN
      for (;;) {
        int t = next_task(c);
        if (t >= 256 + 512) break;
        if (t < 256) ret_local_task(p, t);
        else s5_task(p, l, t - 256, 0);
      }
    PH_END
    PH_BEGIN
      for (;;) {
        int t = next_task(c);
        if (t >= 320 + 640) break;
        if (t < 320) ret_final_task(p, l, t);
        else s5_task(p, l, t - 320, 1);
      }
    PH_END
    PH_BEGIN
      TASK_LOOP(c, 258 * 4, glu_tile(p, l, t))
    PH_END
    PH_BEGIN
      TASK_LOOP(c, 258 * 8, out_tile(p, l, t))
    PH_END
    PH_BEGIN
      for (int t = blockIdx.x; t < NTOK / 16; t += gridDim.x) { post_task(p, (const u16*)(arena + 1 * SLOT), p.mix_post + l * 1024, t, false); }
    PH_END
    PH_BEGIN
      TASK_LOOP(c, 258 * 8, cq_tile(p, l, t))
    PH_END
    PH_BEGIN
      TASK_LOOP(c, 2112, att_task(p, l, t))
    PH_END
    PH_BEGIN
      TASK_LOOP(c, 258 * 8, raw_tile(p, (const u16*)(arena + 5 * SLOT), 1024, wl + W_CO, 1024, (u16*)(arena + 1 * SLOT), t))
    PH_END
    PH_BEGIN
      for (int t = blockIdx.x; t < NTOK / 16; t += gridDim.x) { post_task(p, (const u16*)(arena + 1 * SLOT), p.xa_post + l * 1024, t, false); }
    PH_END
    PH_BEGIN
      TASK_LOOP(c, 258 * 44, gu_tile(p, l, t))
    PH_END
    PH_BEGIN
      TASK_LOOP(c, 258 * 8, raw_tile(p, (const u16*)(arena + 2 * SLOT), DFF, wl + W_DN, DFF, (u16*)(arena + 0 * SLOT), t))
    PH_END
    PH_BEGIN
      for (int t = blockIdx.x; t < NTOK / 16; t += gridDim.x) { post_task(p, (const u16*)(arena + 0 * SLOT), p.ffn_post + l * 1024, t, l == DEPTHC - 1); }
    PH_END
  }
}

#ifndef N_LAUNCH_SPLIT
#define N_LAUNCH_SPLIT 0
#endif
constexpr int N_PHASES = 1 + 13 * DEPTHC;

extern "C" void kernel_launch(void* const* d_in, const int* in_sizes, int n_in, void* d_out, int out_size, void* d_ws,
                              size_t ws_size, hipStream_t stream) {
  static int grid_blocks = 0;
  if (!grid_blocks) {
    int dev = 0, cus = 0, per_cu = 0;
    (void)hipGetDevice(&dev);
    (void)hipDeviceGetAttribute(&cus, hipDeviceAttributeMultiprocessorCount, dev);
    (void)hipOccupancyMaxActiveBlocksPerMultiprocessor(&per_cu, fwd_megakernel, NTHR, 0);
    if (per_cu > 2) per_cu = 2;
    if (per_cu < 1) per_cu = 1;
    grid_blocks = cus * per_cu;
  }
  if (ws_size < WS_NEEDED) fprintf(stderr, "workspace too small: %zu < %zu\n", ws_size, (size_t)WS_NEEDED);
  Params p{};
  const float** f = (const float**)&p;
  for (int i = 0; i < 36; ++i) f[i] = (const float*)d_in[i];
  p.out = (float*)d_out;
  p.ws = (char*)d_ws;
  p.never = 0;
  p.ph_lo = 0;
  p.ph_hi = N_PHASES;
  p.pad = 0;
  (void)hipMemsetAsync(d_ws, 0, 32768, stream);
  if (N_LAUNCH_SPLIT) {
#ifdef DUMP_AFTER
    const int nrun = DUMP_AFTER;
#else
    const int nrun = N_PHASES;
#endif
    for (int i = 0; i <= nrun; ++i) {
      if (i == nrun) {
#ifdef DUMP_AFTER
        p.ph_lo = -1; p.ph_hi = -1;
#else
        break;
#endif
      } else { p.ph_lo = i; p.ph_hi = i + 1; }
      void* args[] = {&p};
      hipError_t e = hipLaunchCooperativeKernel((void*)fwd_megakernel, dim3(grid_blocks), dim3(NTHR), args, 0, stream);
      if (e != hipSuccess) fprintf(stderr, "launch failed: %s (grid %d)\n", hipGetErrorString(e), grid_blocks);
    }
  } else {
    void* args[] = {&p};
    hipError_t e = hipLaunchCooperativeKernel((void*)fwd_megakernel, dim3(grid_blocks), dim3(NTHR), args, 0, stream);
    if (e != hipSuccess) fprintf(stderr, "cooperative launch failed: %s (grid %d)\n", hipGetErrorString(e), grid_blocks);
  }
}
```

```cpp
#include <hip/hip_runtime.h>
#include <hip/hip_bf16.h>
#include <hip/hip_cooperative_groups.h>
#include <stdint.h>
#include <stdio.h>
namespace cg = cooperative_groups;

typedef __attribute__((ext_vector_type(8))) short bf16x8;
typedef __attribute__((ext_vector_type(4))) float f32x4;
typedef unsigned short u16;
typedef __attribute__((ext_vector_type(4))) unsigned u32x4;
typedef __attribute__((ext_vector_type(2))) unsigned u32x2;
#define DI __device__ __forceinline__
#define MFMA16(a, b, c) __builtin_amdgcn_mfma_f32_16x16x32_bf16((a), (b), (c), 0, 0, 0)
#define MFMA_FENCE() do { __builtin_amdgcn_sched_barrier(0); asm volatile("s_nop 15\n\ts_nop 15" ::: "memory"); __builtin_amdgcn_sched_barrier(0); } while (0)

constexpr int NTOK = 33024, PROWS = 32768, DM = 1024, DFF = 2816, DEPTHC = 4;
constexpr int SEQ = 8192;
constexpr float EPSF = 1e-6f;
constexpr int NTHR = 256;
constexpr int LDS_STRIDE = 80;
constexpr int SMEM_BYTES = 76800;

constexpr size_t SLOT = (size_t)NTOK * 512 * 2;
constexpr size_t OFF_BAR = 0;
constexpr size_t OFF_CTR = 16384;
constexpr size_t OFF_W = 32768;
constexpr size_t W_IN = 0, W_GLU = W_IN + 2560 * 1024, W_OUT = W_GLU + 512 * 512, W_CQ = W_OUT + 1024 * 1024,
                 W_CK = W_CQ + 1024 * 1024, W_CV = W_CK + 1024 * 1024, W_CO = W_CV + 1024 * 1024,
                 W_GU = W_CO + 1024 * 1024, W_DN = W_GU + 5632 * 1024, W_LAYER = W_DN + 1024 * 2816;
constexpr size_t OFF_S5P = OFF_W + 4 * W_LAYER * 2;
constexpr size_t S5P_BBT = 0, S5P_CM = 131072, S5P_ABAR = 262144, S5P_LAYER = 278528;
constexpr size_t OFF_HB = OFF_S5P + 4 * S5P_LAYER;
constexpr size_t OFF_MEMB = OFF_HB + (size_t)NTOK * 1024 * 2;
constexpr size_t OFF_KXP = OFF_MEMB + 1024 * 1024 * 2;
constexpr size_t OFF_VTXP = OFF_KXP + 4 * 4 * 256 * 1024 * 2;
constexpr size_t OFF_KXS = OFF_VTXP + 4 * 4 * 256 * 1024 * 2;
constexpr size_t OFF_VTXS = OFF_KXS + 16 * 256 * 1024 * 2;
constexpr size_t OFF_SLOC = OFF_VTXS + 16 * 256 * 1024 * 2;
constexpr size_t OFF_ELOC = OFF_SLOC + 16 * 16 * 128 * 128 * 4;
constexpr size_t OFF_ZSQ = OFF_ELOC + 4 * 16 * 32 * 64 * 2 * 4;
constexpr size_t OFF_RSQ = OFF_ZSQ + (size_t)NTOK * 8 * 4;
constexpr size_t OFF_ARENA = OFF_RSQ + (size_t)NTOK * 16 * 4;
constexpr size_t WS_NEEDED = OFF_ARENA + 8 * SLOT;

constexpr size_t O_Y = 0, O_S5RE_P = 33816576, O_S5IM_P = 33849344, O_RET_P = 33882112, O_MK_P = 34930688,
                 O_MV_P = 39124992, O_S5RE_S = 43319296, O_S5IM_S = 43450368, O_RET_S = 43581440;

struct Params {
  const float *x_prompt, *x_sample, *mem_prompt, *s5re0, *s5im0, *ret0, *cmk, *cmv;
  const float *mix_pre, *mix_post, *w_in, *lam_re, *lam_im, *log_step, *b_re, *b_im, *c_re, *c_im, *s5_d, *w_glu,
      *b_glu, *s5_onorm, *ret_onorm, *w_out, *xa_pre, *xa_post, *mem_norm, *w_cq, *w_ck, *w_cv, *w_co, *ffn_pre,
      *ffn_post, *w_gate, *w_up, *w_down;
  float* out;
  char* ws;
  int never;
  int ph_lo;
  int ph_hi;
  int pad;
};

DI u16 f2bf(float f) {
  unsigned u = __float_as_uint(f);
  u += 0x7fffu + ((u >> 16) & 1u);
  return (u16)(u >> 16);
}
DI float bf2f(u16 h) { return __uint_as_float(((unsigned)h) << 16); }
DI unsigned pack2(float a, float b) { return (unsigned)f2bf(a) | ((unsigned)f2bf(b) << 16); }
DI float sigmoidf_(float x) { return 1.0f / (1.0f + __expf(-x)); }
DI float siluf_(float x) { return x * sigmoidf_(x); }
DI float geluf_(float x) {
  float t = 0.7978845608028654f * (x + 0.044715f * x * x * x);
  return 0.5f * x * (1.0f + tanhf(t));
}
DI float red16(float v) {
  v += __shfl_xor(v, 1); v += __shfl_xor(v, 2); v += __shfl_xor(v, 4); v += __shfl_xor(v, 8);
  return v;
}
DI float max16(float v) {
  v = fmaxf(v, __shfl_xor(v, 1)); v = fmaxf(v, __shfl_xor(v, 2)); v = fmaxf(v, __shfl_xor(v, 4)); v = fmaxf(v, __shfl_xor(v, 8));
  return v;
}
DI float red64(float v) {
  v = red16(v); v += __shfl_xor(v, 16); v += __shfl_xor(v, 32);
  return v;
}
DI void sincos_cw(float x, float* sn, float* cs) {
  const float k = rintf(x * 0.15915494309189535f);
  float r = fmaf(-k, 6.2831854820251465f, x);
  r = fmaf(-k, -1.7484555e-07f, r);
  *sn = __sinf(r); *cs = __cosf(r);
}
DI int ltid() { int x = threadIdx.x; asm volatile("" : "+v"(x)); return x; }
DI int lsgpr(int x) { asm volatile("" : "+s"(x)); return x; }
DI u32x4 ld_sc1_16(const void* p) {
  const unsigned long long* q = (const unsigned long long*)p;
  const unsigned long long a = __hip_atomic_load(q, __ATOMIC_RELAXED, __HIP_MEMORY_SCOPE_AGENT);
  const unsigned long long b = __hip_atomic_load(q + 1, __ATOMIC_RELAXED, __HIP_MEMORY_SCOPE_AGENT);
  return (u32x4){(unsigned)a, (unsigned)(a >> 32), (unsigned)b, (unsigned)(b >> 32)};
}
DI __amdgpu_buffer_rsrc_t mk_rsrc(const void* p) {
  const unsigned long long a = (unsigned long long)p;
  const unsigned lo = __builtin_amdgcn_readfirstlane((unsigned)a), hi = __builtin_amdgcn_readfirstlane((unsigned)(a >> 32));
  return __builtin_amdgcn_make_buffer_rsrc((void*)(((unsigned long long)hi << 32) | lo), 0, 0x7fffffff, 0x00020000);
}
DI u32x4 bld16(__amdgpu_buffer_rsrc_t r, unsigned voff, unsigned soff) { return __builtin_amdgcn_raw_buffer_load_b128(r, voff, soff, 16); }
DI u32x4 ld_ws16(const char* ws, const void* p) {
  const __amdgpu_buffer_rsrc_t r = __builtin_amdgcn_make_buffer_rsrc((void*)ws, 0, 0x7fffffff, 0x00020000);
  return __builtin_amdgcn_raw_buffer_load_b128(r, (unsigned)((const char*)p - ws), 0, 16);
}
DI u32x2 ld_sc1_8(const void* p) {
  const unsigned long long a = __hip_atomic_load((const unsigned long long*)p, __ATOMIC_RELAXED, __HIP_MEMORY_SCOPE_AGENT);
  return (u32x2){(unsigned)a, (unsigned)(a >> 32)};
}
DI u16 ld_sc1_2(const u16* p) { return __hip_atomic_load(p, __ATOMIC_RELAXED, __HIP_MEMORY_SCOPE_AGENT); }
DI float ld_sc1_f(const float* p) { return __hip_atomic_load(p, __ATOMIC_RELAXED, __HIP_MEMORY_SCOPE_AGENT); }
DI float gamma_l2(int h) { return log2f(1.0f - exp2f(-5.0f - (float)h)); }

#define XB_TMO 128
#define XB_XCNT(j) (256 + 64 * (j))
#define XB_XSUB(j) (1280 + 64 * (j))
#define XB_XGEN(j) (2304 + 64 * (j))
#define XB_TOP 3328
#define XB_TOPGEN 3392
#define XB_SPIN_CAP (1u << 26)
DI unsigned xb_ld(unsigned* p) { return __hip_atomic_load(p, __ATOMIC_RELAXED, __HIP_MEMORY_SCOPE_AGENT); }
DI unsigned xb_add(unsigned* p, unsigned v) { return __hip_atomic_fetch_add(p, v, __ATOMIC_RELAXED, __HIP_MEMORY_SCOPE_AGENT); }
DI unsigned xb_xcc_id() { return (unsigned)__builtin_amdgcn_s_getreg((3 << 11) | 20) & 0xFu; }
#define XB_SPIN(cond, bar) do { unsigned _sp = 0; while (cond) { __builtin_amdgcn_s_sleep(1); \
    if ((++_sp & 255u) == 0u) { if (xb_ld(&(bar)[XB_TMO])) break; if (_sp > XB_SPIN_CAP) { atomicAdd(&(bar)[XB_TMO], 1u); break; } } } } while (0)

__shared__ unsigned g_xb[4];
__shared__ __attribute__((aligned(16))) char smem[SMEM_BYTES];

DI void xcd_complete(unsigned* bar, unsigned x, unsigned& nloc, unsigned& nx) {
  const unsigned G = gridDim.x;
  unsigned sum, cnt, mine, sp = 0u;
  for (;;) {
    sum = 0u; cnt = 0u; mine = 0u;
#pragma unroll
    for (unsigned j = 0; j < 16; ++j) { const unsigned c = xb_ld(&bar[XB_XCNT(j)]); sum += c; cnt += (c > 0u) ? 1u : 0u; mine = (j == x) ? c : mine; }
    if (sum == G) break;
    __builtin_amdgcn_s_sleep(1);
    if ((++sp & 255u) == 0u) { if (xb_ld(&bar[XB_TMO])) break; if (sp > XB_SPIN_CAP) { atomicAdd(&bar[XB_TMO], 1u); break; } }
  }
  nloc = mine > 0u ? mine : 1u; nx = cnt > 0u ? cnt : 1u;
}
#ifndef USE_XCD_BARRIER
#define USE_XCD_BARRIER 1
#endif
DI void grid_barrier(unsigned* bar) {
  if (!USE_XCD_BARRIER) {
    asm volatile("s_waitcnt vmcnt(0)" ::: "memory");
    __syncthreads();
    if (threadIdx.x == 0) asm volatile("buffer_wbl2 sc0 sc1\n\ts_waitcnt vmcnt(0)" ::: "memory");
    cg::this_grid().sync();
    if (threadIdx.x == 0) asm volatile("buffer_inv sc0 sc1\n\ts_waitcnt vmcnt(0)" ::: "memory");
    __syncthreads();
    return;
  }
  asm volatile("s_waitcnt vmcnt(0)" ::: "memory");
  __syncthreads();
  if (threadIdx.x == 0) {
    __builtin_amdgcn_s_waitcnt(0);
    const unsigned xcc = xb_xcc_id();
    unsigned nloc = g_xb[0], nx = g_xb[1];
    if (nloc == 0u) { xcd_complete(bar, xcc, nloc, nx); g_xb[0] = nloc; g_xb[1] = nx; }
    const unsigned old = xb_add(&bar[XB_XSUB(xcc)], 1u);
    const unsigned gen = old / nloc;
    if (old + 1u == (gen + 1u) * nloc) {
      __builtin_amdgcn_fence(__ATOMIC_RELEASE, "agent");
      asm volatile("s_waitcnt vmcnt(0)" ::: "memory");
      const unsigned og = xb_add(&bar[XB_TOP], 1u);
      const unsigned tg = og / nx;
      if (og + 1u == (tg + 1u) * nx) xb_add(&bar[XB_TOPGEN], 1u);
      else XB_SPIN(xb_ld(&bar[XB_TOPGEN]) == tg, bar);
      __builtin_amdgcn_fence(__ATOMIC_ACQUIRE, "agent");
      xb_add(&bar[XB_XGEN(xcc)], 1u);
      asm volatile("s_waitcnt vmcnt(0)" ::: "memory");
    } else {
      XB_SPIN(xb_ld(&bar[XB_XGEN(xcc)]) == gen, bar);
      __builtin_amdgcn_fence(__ATOMIC_ACQUIRE, "agent");
      asm volatile("s_waitcnt vmcnt(0)" ::: "memory");
    }
  }
  __syncthreads();
}

#define DUMP_OFF (OFF_ELOC)
#define DUMP_N ((size_t)524288)
#define DUMP_F32 0
#ifndef MAXPH
#define MAXPH 10
#endif
#ifndef STATIC_SCHED
#define STATIC_SCHED 0
#endif
#ifndef ONE_XCD
#define ONE_XCD 0
#endif
DI int next_task(unsigned* ctr) {
  __syncthreads();
#ifdef LDS_NAN_PER_TASK
  __syncthreads();
#endif
  if (ONE_XCD) {
    if (threadIdx.x == 0) g_xb[2] = (xb_xcc_id() == 0u) ? atomicAdd(ctr, 1u) : 0x7fffffffu;
    __syncthreads();
    return (int)g_xb[2];
  }
  if (STATIC_SCHED) {
    if (threadIdx.x == 0) { unsigned it = g_xb[3]; g_xb[3] = it + 1u; g_xb[2] = blockIdx.x + it * gridDim.x; }
  } else {
    if (threadIdx.x == 0) g_xb[2] = atomicAdd(ctr, 1u);
  }
  __syncthreads();
  return (int)g_xb[2];
}
DI unsigned task_prefetch(unsigned* ctr) { unsigned v = 0u; if (threadIdx.x == 0) v = atomicAdd(ctr, 1u); return v; }
DI int task_commit(unsigned v) {
  __syncthreads();
  if (threadIdx.x == 0) g_xb[2] = v;
  __syncthreads();
  return (int)g_xb[2];
}
#define TASK_LOOP(ctr, N, BODY) { int t = next_task(ctr); while (t < (N)) { const unsigned tn_ = task_prefetch(ctr); BODY; t = task_commit(tn_); } }
DI void phase_begin() { __syncthreads(); if (threadIdx.x == 0) g_xb[3] = 0u; __syncthreads(); }

template <int BM, int BN, int WGM, int WGN, class Hook>
DI void gemm_mainloop(const u16* A, int lda, const u16* B, int ldb, int K, int kvalid,
                      f32x4 (&acc)[BM / WGM / 16][BN / WGN / 16], u16* sA, u16* sB, Hook hook) {
  constexpr int MT = BM / WGM / 16, NTL = BN / WGN / 16, CA = BM / 32, CB = BN / 32;
  const int tid = ltid(), lane = tid & 63, wid = tid >> 6, wm = wid / WGN, wn = wid % WGN;
  const __amdgpu_buffer_rsrc_t ra_ = mk_rsrc(A), rb_ = mk_rsrc(B);
  u32x4 ra0[CA], rb0[CB], ra1[CA], rb1[CB];
  unsigned va[CA], vb[CB];
  const u32x4 z4 = (u32x4){0u, 0u, 0u, 0u};
  const int cc0 = (tid & 7) * 8;
#pragma unroll
  for (int i = 0; i < CA; ++i) { const int r = (tid + i * NTHR) >> 3; va[i] = (unsigned)(r * lda + cc0) * 2u; }
#pragma unroll
  for (int i = 0; i < CB; ++i) { const int r = (tid + i * NTHR) >> 3; vb[i] = (unsigned)(r * ldb + cc0) * 2u; }
#define GM_LOAD(RA, RB, kn)                                                                          \
  {                                                                                                  \
    const bool kok = ((kn) + cc0) < kvalid;                                                          \
    _Pragma("unroll") for (int i = 0; i < CA; ++i) RA[i] = kok ? bld16(ra_, va[i], (unsigned)(kn) * 2u) : z4; \
    _Pragma("unroll") for (int i = 0; i < CB; ++i) RB[i] = kok ? bld16(rb_, vb[i], (unsigned)(kn) * 2u) : z4; \
  }
#define GM_STEP(RA, RB, kcur)                                                                        \
  {                                                                                                  \
    __syncthreads();                                                                                 \
    _Pragma("unroll") for (int i = 0; i < CA; ++i) { const int r = (tid + i * NTHR) >> 3; *(u32x4*)(sA + r * LDS_STRIDE + cc0) = RA[i]; } \
    _Pragma("unroll") for (int i = 0; i < CB; ++i) { const int r = (tid + i * NTHR) >> 3; *(u32x4*)(sB + r * LDS_STRIDE + cc0) = RB[i]; } \
    __syncthreads();                                                                                 \
    if ((kcur) + 128 < K) GM_LOAD(RA, RB, (kcur) + 128)                                              \
    _Pragma("unroll") for (int kk = 0; kk < 2; ++kk) {                                               \
      bf16x8 af[MT], bfr[NTL];                                                                       \
      _Pragma("unroll") for (int m = 0; m < MT; ++m) af[m] = *(const bf16x8*)(sA + (wm * (BM / WGM) + m * 16 + (lane & 15)) * LDS_STRIDE + kk * 32 + (lane >> 4) * 8); \
      _Pragma("unroll") for (int n = 0; n < NTL; ++n) bfr[n] = *(const bf16x8*)(sB + (wn * (BN / WGN) + n * 16 + (lane & 15)) * LDS_STRIDE + kk * 32 + (lane >> 4) * 8); \
      _Pragma("unroll") for (int m = 0; m < MT; ++m)                                                 \
        _Pragma("unroll") for (int n = 0; n < NTL; ++n) acc[m][n] = MFMA16(af[m], bfr[n], acc[m][n]); \
    }                                                                                                \
    hook((kcur), acc);                                                                               \
  }
  GM_LOAD(ra0, rb0, 0)
  if (64 < K) GM_LOAD(ra1, rb1, 64)
#pragma unroll
  for (int k0 = 0; k0 < K; k0 += 128) {
    GM_STEP(ra0, rb0, k0)
    GM_STEP(ra1, rb1, k0 + 64)
  }
  MFMA_FENCE();
#undef GM_LOAD
#undef GM_STEP
}
struct NoHook { template <class T> DI void operator()(int, T&) const {} };

template <int BM, int BN, int WGM, int WGN>
DI void gemm_mainloop_alds(const u16* sAimg, int lda_s, const u16* B, int ldb, int K,
                           f32x4 (&acc)[BM / WGM / 16][BN / WGN / 16], u16* sB) {
  constexpr int MT = BM / WGM / 16, NTL = BN / WGN / 16, CB = BN / 32;
  const int tid = ltid(), lane = tid & 63, wid = tid >> 6, wm = wid / WGN, wn = wid % WGN;
  const __amdgpu_buffer_rsrc_t rb_ = mk_rsrc(B);
  u32x4 rb0[CB], rb1[CB];
  unsigned vb[CB];
  const int cc0 = (tid & 7) * 8;
#pragma unroll
  for (int i = 0; i < CB; ++i) { const int r = (tid + i * NTHR) >> 3; vb[i] = (unsigned)(r * ldb + cc0) * 2u; }
#define GA_STEP(RB, kcur)                                                                            \
  {                                                                                                  \
    __syncthreads();                                                                                 \
    _Pragma("unroll") for (int i = 0; i < CB; ++i) { const int r = (tid + i * NTHR) >> 3; *(u32x4*)(sB + r * LDS_STRIDE + cc0) = RB[i]; } \
    __syncthreads();                                                                                 \
    if ((kcur) + 128 < K) { _Pragma("unroll") for (int i = 0; i < CB; ++i) RB[i] = bld16(rb_, vb[i], (unsigned)((kcur) + 128) * 2u); } \
    _Pragma("unroll") for (int kk = 0; kk < 2; ++kk) {                                               \
      bf16x8 af[MT], bfr[NTL];                                                                       \
      _Pragma("unroll") for (int m = 0; m < MT; ++m) af[m] = *(const bf16x8*)(sAimg + (wm * (BM / WGM) + m * 16 + (lane & 15)) * lda_s + (kcur) + kk * 32 + (lane >> 4) * 8); \
      _Pragma("unroll") for (int n = 0; n < NTL; ++n) bfr[n] = *(const bf16x8*)(sB + (wn * (BN / WGN) + n * 16 + (lane & 15)) * LDS_STRIDE + kk * 32 + (lane >> 4) * 8); \
      _Pragma("unroll") for (int m = 0; m < MT; ++m)                                                 \
        _Pragma("unroll") for (int n = 0; n < NTL; ++n) acc[m][n] = MFMA16(af[m], bfr[n], acc[m][n]); \
    }                                                                                                \
  }
#pragma unroll
  for (int i = 0; i < CB; ++i) rb0[i] = bld16(rb_, vb[i], 0u);
#pragma unroll
  for (int i = 0; i < CB; ++i) rb1[i] = bld16(rb_, vb[i], 128u);
#pragma unroll 1
  for (int k0 = 0; k0 < K; k0 += 128) {
    GA_STEP(rb0, k0)
    GA_STEP(rb1, k0 + 64)
  }
  MFMA_FENCE();
#undef GA_STEP
}

DI void gemm_128x256(const u16* A, int lda, const u16* B, int ldb, int K, f32x4 (&acc)[4][8], u16* sA, u16* sB) {
  const int tid = ltid(), lane = tid & 63, wid = tid >> 6, wm = wid >> 1, wn = wid & 1;
  const __amdgpu_buffer_rsrc_t ra_ = mk_rsrc(A), rb_ = mk_rsrc(B);
  u32x4 ra[4], rb[8];
  unsigned va[4], vb[8];
  const int cc0 = (tid & 7) * 8;
#pragma unroll
  for (int i = 0; i < 4; ++i) { const int r = (tid + i * NTHR) >> 3; va[i] = (unsigned)(r * lda + cc0) * 2u; }
#pragma unroll
  for (int i = 0; i < 8; ++i) { const int r = (tid + i * NTHR) >> 3; vb[i] = (unsigned)(r * ldb + cc0) * 2u; }
#pragma unroll
  for (int i = 0; i < 4; ++i) ra[i] = bld16(ra_, va[i], 0u);
#pragma unroll
  for (int i = 0; i < 8; ++i) rb[i] = bld16(rb_, vb[i], 0u);
#pragma unroll
  for (int k0 = 0; k0 < K; k0 += 64) {
    __syncthreads();
#pragma unroll
    for (int i = 0; i < 4; ++i) { const int r = (tid + i * NTHR) >> 3; *(u32x4*)(sA + r * LDS_STRIDE + cc0) = ra[i]; }
#pragma unroll
    for (int i = 0; i < 8; ++i) { const int r = (tid + i * NTHR) >> 3; *(u32x4*)(sB + r * LDS_STRIDE + cc0) = rb[i]; }
    __syncthreads();
    if (k0 + 64 < K) {
      const unsigned ko = (unsigned)(k0 + 64) * 2u;
#pragma unroll
      for (int i = 0; i < 4; ++i) ra[i] = bld16(ra_, va[i], ko);
#pragma unroll
      for (int i = 0; i < 8; ++i) rb[i] = bld16(rb_, vb[i], ko);
    }
#pragma unroll
    for (int kk = 0; kk < 2; ++kk) {
      bf16x8 af[4];
#pragma unroll
      for (int m = 0; m < 4; ++m) af[m] = *(const bf16x8*)(sA + (wm * 64 + m * 16 + (lane & 15)) * LDS_STRIDE + kk * 32 + (lane >> 4) * 8);
#pragma unroll
      for (int nh = 0; nh < 2; ++nh) {
        bf16x8 bfr[4];
#pragma unroll
        for (int n = 0; n < 4; ++n) bfr[n] = *(const bf16x8*)(sB + (wn * 128 + (nh * 4 + n) * 16 + (lane & 15)) * LDS_STRIDE + kk * 32 + (lane >> 4) * 8);
#pragma unroll
        for (int m = 0; m < 4; ++m)
#pragma unroll
          for (int n = 0; n < 4; ++n) acc[m][nh * 4 + n] = MFMA16(af[m], bfr[n], acc[m][nh * 4 + n]);
      }
    }
  }
  MFMA_FENCE();
}

template <int MT, int NTL>
DI void zero_acc(f32x4 (&acc)[MT][NTL]) {
#pragma unroll
  for (int m = 0; m < MT; ++m)
#pragma unroll
    for (int n = 0; n < NTL; ++n) acc[m][n] = (f32x4){0.f, 0.f, 0.f, 0.f};
}

DI void tile_put(u16* sT, int stride, int r, int c, float v) { sT[r * stride + c] = f2bf(v); }
DI void tile_flush128(const u16* sT, u16* dst, int ld, int row0, int col0) {
  const int tid = ltid();
#pragma unroll
  for (int i = 0; i < 8; ++i) {
    const int id = tid + i * NTHR, r = id >> 4, c = (id & 15) * 8;
    *(u32x4*)(dst + (size_t)(row0 + r) * ld + col0 + c) = *(const u32x4*)(sT + r * 136 + c);
  }
}
DI void tile_out_128(const f32x4 (&v)[4][4], u16* dst, int ld, int row0, int col0) {
  u16* sT = (u16*)smem;
  const int lane = ltid() & 63, wid = ltid() >> 6, wm = wid >> 1, wn = wid & 1;
  __syncthreads();
#pragma unroll
  for (int m = 0; m < 4; ++m)
#pragma unroll
    for (int n = 0; n < 4; ++n)
#pragma unroll
      for (int j = 0; j < 4; ++j) tile_put(sT, 136, wm * 64 + m * 16 + (lane >> 4) * 4 + j, wn * 64 + n * 16 + (lane & 15), v[m][n][j]);
  __syncthreads();
  tile_flush128(sT, dst, ld, row0, col0);
}

DI int dst_row_map(int n, int mode) {
  if (mode == 0) return n;
  if (mode == 1) {
    if (n < 512 || n >= 1536) return n;
    int sec = n & ~127, d = n & 127;
    int xh = d >> 6, idx = d & 63;
    return sec + (((idx >> 4) * 2 + xh) << 4) + (idx & 15);
  }
  if (mode == 2) return (n >> 4) * 32 + (n & 15);
  return (n >> 4) * 32 + 16 + (n & 15);
}
DI void transpose_tile(const float* src, int lds_, int k0, int n0, u16* dst, int ldd,
                       const float* gain, int mode, float scale) {
  float* t = (float*)smem;
  const int tid = ltid(), ty = tid >> 4, tx = tid & 15;
  __syncthreads();
#pragma unroll
  for (int i = 0; i < 4; ++i) {
    int k = ty + 16 * i;
    float4 v = *(const float4*)(src + (size_t)(k0 + k) * lds_ + n0 + tx * 4);
    float g = gain ? gain[k0 + k] : 1.0f;
    t[k * 65 + tx * 4 + 0] = v.x * g; t[k * 65 + tx * 4 + 1] = v.y * g;
    t[k * 65 + tx * 4 + 2] = v.z * g; t[k * 65 + tx * 4 + 3] = v.w * g;
  }
  __syncthreads();
  const int nl = tid >> 2, ks = (tid & 3) * 16;
  const int n = n0 + nl;
  float sc = scale;
  if (mode == 1) sc = (n >= 512 && n < 1024) ? 0.08838834764831845f : 1.0f;
  unsigned w[8];
#pragma unroll
  for (int i = 0; i < 8; ++i) w[i] = pack2(t[(ks + 2 * i) * 65 + nl] * sc, t[(ks + 2 * i + 1) * 65 + nl] * sc);
  u16* d = dst + (size_t)dst_row_map(n, mode) * ldd + k0 + ks;
  *(u32x4*)d = (u32x4){w[0], w[1], w[2], w[3]};
  *(u32x4*)(d + 8) = (u32x4){w[4], w[5], w[6], w[7]};
}

DI void rownorm_task(const float* src, float* xs_out, u16* dst) {
  const int lane = ltid() & 63;
  float4 v[4];
  float ss = 0.f;
#pragma unroll
  for (int i = 0; i < 4; ++i) {
    v[i] = *(const float4*)(src + i * 256 + lane * 4);
    ss += v[i].x * v[i].x + v[i].y * v[i].y + v[i].z * v[i].z + v[i].w * v[i].w;
  }
  ss = red64(ss);
  const float r = rsqrtf(ss * (1.0f / 1024.0f) + EPSF);
  if (xs_out && lane == 0) *xs_out = 1.0f / r;
#pragma unroll
  for (int i = 0; i < 4; ++i) {
    u32x2 o; o.x = pack2(v[i].x * r, v[i].y * r); o.y = pack2(v[i].z * r, v[i].w * r);
    *(u32x2*)(dst + i * 256 + lane * 4) = o;
  }
}

DI void phase_prep(const Params& p, unsigned* ctr) {
  char* ws = p.ws;
  const int tid = ltid();
  constexpr int T_W = 16384, T_X = NTOK / 4, T_M = 256, T_S = 128;
  constexpr int TOT = T_W + T_X + T_M + T_S;
  for (int t = blockIdx.x; t < TOT; t += gridDim.x) {
    if (t < T_W) {
      const int l = t >> 12; int q = t & 4095;
      u16* wl = (u16*)(ws + OFF_W) + (size_t)l * W_LAYER;
      if (q < 640) {
        transpose_tile(p.w_in + (size_t)l * 1024 * 2560, 2560, (q / 40) * 64, (q % 40) * 64, wl + W_IN, 1024, p.mix_pre + l * 1024, 1, 1.0f);
      } else if ((q -= 640) < 64) {
        transpose_tile(p.w_glu + (size_t)l * 512 * 512, 512, (q / 8) * 64, (q % 8) * 64, wl + W_GLU, 512, nullptr, 0, 1.0f);
      } else if ((q -= 64) < 256) {
        const int k0 = (q / 16) * 64;
        const float* gain = (k0 < 512) ? (p.s5_onorm + l * 512) : (p.ret_onorm + l * 512 - 512);
        transpose_tile(p.w_out + (size_t)l * 1024 * 1024, 1024, k0, (q % 16) * 64, wl + W_OUT, 1024, gain, 0, 1.0f);
      } else if ((q -= 256) < 256) {
        transpose_tile(p.w_cq + (size_t)l * 1024 * 1024, 1024, (q / 16) * 64, (q % 16) * 64, wl + W_CQ, 1024, p.xa_pre + l * 1024, 0, 0.0625f);
      } else if ((q -= 256) < 256) {
        transpose_tile(p.w_ck + (size_t)l * 1024 * 1024, 1024, (q / 16) * 64, (q % 16) * 64, wl + W_CK, 1024, p.mem_norm + l * 1024, 0, 1.0f);
      } else if ((q -= 256) < 256) {
        transpose_tile(p.w_cv + (size_t)l * 1024 * 1024, 1024, (q / 16) * 64, (q % 16) * 64, wl + W_CV, 1024, p.mem_norm + l * 1024, 0, 1.0f);
      } else if ((q -= 256) < 256) {
        transpose_tile(p.w_co + (size_t)l * 1024 * 1024, 1024, (q / 16) * 64, (q % 16) * 64, wl + W_CO, 1024, nullptr, 0, 1.0f);
      } else if ((q -= 256) < 704) {
        transpose_tile(p.w_gate + (size_t)l * 1024 * 2816, 2816, (q / 44) * 64, (q % 44) * 64, wl + W_GU, 1024, p.ffn_pre + l * 1024, 2, 1.0f);
      } else if ((q -= 704) < 704) {
        transpose_tile(p.w_up + (size_t)l * 1024 * 2816, 2816, (q / 44) * 64, (q % 44) * 64, wl + W_GU, 1024, p.ffn_pre + l * 1024, 3, 1.0f);
      } else {
        q -= 704;
        transpose_tile(p.w_down + (size_t)l * 2816 * 1024, 1024, (q / 16) * 64, (q % 16) * 64, wl + W_DN, 2816, nullptr, 0, 1.0f);
      }
    } else if (t < T_W + T_X) {
      const int row = (t - T_W) * 4 + (tid >> 6);
      const float* src = (row < PROWS) ? p.x_prompt + (size_t)row * 1024 : p.x_sample + (size_t)(row - PROWS) * 1024;
      rownorm_task(src, (float*)(ws + OFF_RSQ) + row, (u16*)(ws + OFF_HB) + (size_t)row * 1024);
    } else if (t < T_W + T_X + T_M) {
      const int row = (t - T_W - T_X) * 4 + (tid >> 6);
      rownorm_task(p.mem_prompt + (size_t)row * 1024, nullptr, (u16*)(ws + OFF_MEMB) + (size_t)row * 1024);
    } else {
      const int lg = t - T_W - T_X - T_M, l = lg >> 5, g = lg & 31;
      char* sp = ws + OFF_S5P + (size_t)l * S5P_LAYER;
      u16* bbt = (u16*)(sp + S5P_BBT) + g * 2048;
      u16* cm = (u16*)(sp + S5P_CM) + g * 2048;
      float* ab = (float*)(sp + S5P_ABAR) + g * 128;
      const float dt = __expf(p.log_step[l * 32 + g]);
      for (int e = tid; e < 1024; e += NTHR) {
        const int pp = e >> 4, h = e & 15;
        const float lr = p.lam_re[(l * 32 + g) * 64 + pp], li = p.lam_im[(l * 32 + g) * 64 + pp];
        const float ar = lr * dt, ai = li * dt, mag = expf(ar);
        float sn_, cs_; sincos_cw(ai, &sn_, &cs_);
        const float abr = mag * cs_, abi = mag * sn_;
        const float den = lr * lr + li * li, nr = abr - 1.0f, ni = abi;
        const float fr = (nr * lr + ni * li) / den, fi = (ni * lr - nr * li) / den;
        const float br = p.b_re[((size_t)(l * 32 + g) * 64 + pp) * 16 + h], bi = p.b_im[((size_t)(l * 32 + g) * 64 + pp) * 16 + h];
        bbt[pp * 16 + h] = f2bf(fr * br - fi * bi);
        bbt[(64 + pp) * 16 + h] = f2bf(fr * bi + fi * br);
        if (h == 0) { ab[pp * 2] = abr; ab[pp * 2 + 1] = abi; }
        const int hh = e >> 6, kk = e & 63;
        cm[hh * 128 + kk] = f2bf(p.c_re[((size_t)(l * 32 + g) * 16 + hh) * 64 + kk]);
        cm[hh * 128 + 64 + kk] = f2bf(-p.c_im[((size_t)(l * 32 + g) * 16 + hh) * 64 + kk]);
      }
    }
  }
}

DI void memkv_tile(const Params& p, int t) {
  char* ws = p.ws;
  const int l = t >> 7, rt = (t >> 4) & 7, ct = t & 15;
  const int isv = ct >> 3, col0 = (ct & 7) * 128, row0 = rt * 128;
  const u16* A = (const u16*)(ws + OFF_MEMB) + (size_t)row0 * 1024;
  const u16* B = (const u16*)(ws + OFF_W) + (size_t)l * W_LAYER + (isv ? W_CV : W_CK) + (size_t)col0 * 1024;
  f32x4 acc[4][4];
  zero_acc(acc);
  u16* sA = (u16*)smem; u16* sB = sA + 128 * LDS_STRIDE;
  gemm_mainloop<128, 128, 2, 2>(A, 1024, B, 1024, 1024, 1 << 30, acc, sA, sB, NoHook());
  const int lane = ltid() & 63, wid = ltid() >> 6, wm = wid >> 1, wn = wid & 1;
  float* of = p.out + (isv ? O_MV_P : O_MK_P) + (size_t)l * 1024 * 1024;
  u16* kx = (u16*)(ws + OFF_KXP) + (size_t)l * 1024 * 1024;
  u16* vx = (u16*)(ws + OFF_VTXP) + (size_t)l * 1024 * 1024;
#pragma unroll
  for (int m = 0; m < 4; ++m)
#pragma unroll
    for (int n = 0; n < 4; ++n) {
      const int r = row0 + wm * 64 + m * 16 + (lane >> 4) * 4, c = col0 + wn * 64 + n * 16 + (lane & 15);
#pragma unroll
      for (int j = 0; j < 4; ++j) of[(size_t)(r + j) * 1024 + c] = acc[m][n][j];
      if (!isv) {
#pragma unroll
        for (int j = 0; j < 4; ++j) kx[(size_t)(r + j) * 1024 + c] = f2bf(acc[m][n][j]);
      } else {
        const int b = r >> 8, mm = r & 255, h = c >> 8, d = c & 255;
        u32x2 o; o.x = pack2(acc[m][n][0], acc[m][n][1]); o.y = pack2(acc[m][n][2], acc[m][n][3]);
        *(u32x2*)(vx + ((size_t)((b * 4 + h) * 256 + d)) * 256 + mm) = o;
      }
    }
}
DI void cache_task(const Params& p, int l, int t) {
  char* ws = p.ws;
  if (t < 1024) {
    const float* src = p.cmk + (size_t)l * 16 * 256 * 1024 + (size_t)t * 4096 + ltid() * 16;
    u16* dst = (u16*)(ws + OFF_KXS) + (size_t)t * 4096 + ltid() * 16;
    float4 a = *(const float4*)src, b = *(const float4*)(src + 4), c = *(const float4*)(src + 8), d = *(const float4*)(src + 12);
    *(u32x4*)dst = (u32x4){pack2(a.x, a.y), pack2(a.z, a.w), pack2(b.x, b.y), pack2(b.z, b.w)};
    *(u32x4*)(dst + 8) = (u32x4){pack2(c.x, c.y), pack2(c.z, c.w), pack2(d.x, d.y), pack2(d.z, d.w)};
  } else {
    t -= 1024;
    const int bh = t >> 4, q = t & 15, b = bh >> 2, h = bh & 3;
    const float* src = p.cmv + ((size_t)(l * 16 + b) * 256) * 1024 + h * 256;
    u16* dst = (u16*)(ws + OFF_VTXS) + (size_t)bh * 256 * 256;
    transpose_tile(src, 1024, (q >> 2) * 64, (q & 3) * 64, dst, 256, nullptr, 0, 1.0f);
  }
}

DI void g1_tile(const Params& p, int l, int t) {
  char* ws = p.ws;
  const int rt = t / 20, ct = t % 20;
  const int row0 = rt * 128, col0 = ct * 128;
  const u16* A = (const u16*)(ws + OFF_HB) + (size_t)row0 * 1024;
  const u16* B = (const u16*)(ws + OFF_W) + (size_t)l * W_LAYER + W_IN + (size_t)col0 * 1024;
  f32x4 acc[4][4];
  zero_acc(acc);
  u16* sA = (u16*)smem; u16* sB = sA + 128 * LDS_STRIDE;
  gemm_mainloop<128, 128, 2, 2>(A, 1024, B, 1024, 1024, 1 << 30, acc, sA, sB, NoHook());
  const int lane = ltid() & 63, wid = ltid() >> 6, wm = wid >> 1, wn = wid & 1;
  char* arena = ws + OFF_ARENA;
  const int sec = ct >> 2, hd = ct & 3;
  const bool samp = row0 >= PROWS;
  if (sec == 0 || sec == 4) {
    tile_out_128(acc, (u16*)(arena + (sec == 0 ? 0 : 3) * SLOT), 512, row0, hd * 128);
  } else if (sec == 3) {
    u16* vt = (u16*)(arena + 4 * SLOT);
#pragma unroll
    for (int m = 0; m < 4; ++m)
#pragma unroll
      for (int n = 0; n < 4; ++n) {
        const int r = row0 + wm * 64 + m * 16 + (lane >> 4) * 4, e = wn * 64 + n * 16 + (lane & 15);
        u32x2 o; o.x = pack2(acc[m][n][0], acc[m][n][1]); o.y = pack2(acc[m][n][2], acc[m][n][3]);
        size_t off;
        if (!samp) { const int b = r >> 13, tt = r & 8191; off = ((size_t)((b * 4 + hd) * 128 + e)) * SEQ + tt; }
        else { const int sr = r - PROWS, b = sr >> 4, tt = sr & 15; off = (size_t)16 * 128 * SEQ + ((size_t)((b * 4 + hd) * 128 + e)) * 16 + tt; }
        *(u32x2*)(vt + off) = o;
      }
  } else {
    u16* dst = (u16*)(arena + (sec == 1 ? 1 : 2) * SLOT);
    u16* ktd = (u16*)(arena + 5 * SLOT);
    const float gl2 = gamma_l2(hd);
    u16* sT = (u16*)smem;
    __syncthreads();
#pragma unroll
    for (int m = 0; m < 4; ++m)
#pragma unroll
      for (int np = 0; np < 2; ++np) {
        const int r = row0 + wm * 64 + m * 16 + (lane >> 4) * 4;
        const int idx = (wn * 2 + np) * 16 + (lane & 15);
        const float inv = exp2f(-(float)idx * (13.287712379549449f / 64.0f));
        float o1[4], o2[4];
#pragma unroll
        for (int j = 0; j < 4; ++j) {
          const int rr = r + j;
          const int pos = samp ? (1024 + ((rr - PROWS) & 15)) : (rr & 8191);
          float sn, cs;
          sincos_cw((float)pos * inv, &sn, &cs);
          const float x1 = acc[m][2 * np][j], x2 = acc[m][2 * np + 1][j];
          o1[j] = x1 * cs - x2 * sn; o2[j] = x1 * sn + x2 * cs;
          tile_put(sT, 136, rr - row0, idx, o1[j]);
          tile_put(sT, 136, rr - row0, 64 + idx, o2[j]);
        }
        if (sec == 2) {
          size_t off1; int tloc;
          if (!samp) { const int b = r >> 13, tt = r & 8191; off1 = ((size_t)((b * 4 + hd) * 128 + idx)) * SEQ + tt; tloc = 63 - (tt & 63); }
          else { const int sr = r - PROWS, b = sr >> 4, tt = sr & 15; off1 = (size_t)16 * 128 * SEQ + ((size_t)((b * 4 + hd) * 128 + idx)) * 16 + tt; tloc = 15 - tt; }
          const size_t off2 = off1 + (size_t)64 * (samp ? 16 : SEQ);
          float dc[4];
#pragma unroll
          for (int j = 0; j < 4; ++j) dc[j] = exp2f(gl2 * (float)(tloc - j));
          u32x2 a, b2;
          a.x = pack2(o1[0] * dc[0], o1[1] * dc[1]); a.y = pack2(o1[2] * dc[2], o1[3] * dc[3]);
          b2.x = pack2(o2[0] * dc[0], o2[1] * dc[1]); b2.y = pack2(o2[2] * dc[2], o2[3] * dc[3]);
          *(u32x2*)(ktd + off1) = a;
          *(u32x2*)(ktd + off2) = b2;
        }
      }
    __syncthreads();
    tile_flush128(sT, dst, 512, row0, hd * 128);
  }
}

struct DecayHook {
  float g64;
  template <class T> DI void operator()(int k0, T& acc) const {
    if (k0 + 64 < 512) {
#pragma unroll
      for (int m = 0; m < 4; ++m)
#pragma unroll
        for (int n = 0; n < 4; ++n) acc[m][n] *= g64;
    }
  }
};
DI void ret_local_task(const Params& p, int t) {
  char* ws = p.ws;
  char* arena = ws + OFF_ARENA;
  const int bh = t >> 4, sc = t & 15, h = bh & 3;
  const u16* A = (const u16*)(arena + 5 * SLOT) + (size_t)bh * 128 * SEQ + sc * 512;
  const u16* B = (const u16*)(arena + 4 * SLOT) + (size_t)bh * 128 * SEQ + sc * 512;
  f32x4 acc[4][4];
  zero_acc(acc);
  u16* sA = (u16*)smem; u16* sB = sA + 128 * LDS_STRIDE;
  DecayHook hk; hk.g64 = exp2f(gamma_l2(h) * 64.0f);
  gemm_mainloop<128, 128, 2, 2>(A, SEQ, B, SEQ, 512, 1 << 30, acc, sA, sB, hk);
  const int lane = ltid() & 63, wid = ltid() >> 6, wm = wid >> 1, wn = wid & 1;
  float* dst = (float*)(ws + OFF_SLOC) + (size_t)t * 16384;
#pragma unroll
  for (int m = 0; m < 4; ++m)
#pragma unroll
    for (int n = 0; n < 4; ++n) {
      const int r = wm * 64 + m * 16 + (lane >> 4) * 4, c = wn * 64 + n * 16 + (lane & 15);
#pragma unroll
      for (int j = 0; j < 4; ++j) dst[(r + j) * 128 + c] = acc[m][n][j];
    }
}

DI void ret_final_task(const Params& p, int l, int t) {
  char* ws = p.ws;
  char* arena = ws + OFF_ARENA;
  const int tid = ltid(), lane = tid & 63, w = tid >> 6;
  const bool samp = t >= 256;
  int bh, sc, nchunk, C, row_base;
  size_t tr_base; int tr_ld;
  if (!samp) { bh = t >> 4; sc = t & 15; nchunk = 8; C = 64; row_base = (bh >> 2) * SEQ + sc * 512; tr_base = (size_t)bh * 128 * SEQ + sc * 512; tr_ld = SEQ; }
  else { bh = t - 256; sc = 0; nchunk = 1; C = 16; row_base = PROWS + (bh >> 2) * 16; tr_base = (size_t)16 * 128 * SEQ + (size_t)bh * 128 * 16; tr_ld = 16; }
  const int h = bh & 3;
  const float gl2 = gamma_l2(h);
  const float gC = exp2f(gl2 * (float)C);
  const u16* Qg = (const u16*)(arena + 1 * SLOT);
  const u16* Kg = (const u16*)(arena + 2 * SLOT);
  const u16* Gg = (const u16*)(arena + 3 * SLOT);
  const u16* Vt = (const u16*)(arena + 4 * SLOT) + tr_base;
  const u16* Ktd = (const u16*)(arena + 5 * SLOT) + tr_base;
  u16* reto = (u16*)(arena + 7 * SLOT);
  u16* sQ = (u16*)smem;
  u16* sK = sQ + 64 * 144;
  u16* sV = sK + 128 * LDS_STRIDE;
  u16* sS = sV + 128 * LDS_STRIDE;
  float* sR = (float*)(sS + 64 * LDS_STRIDE);

  f32x4 S[8][2];
  if (samp) {
    const float* s0 = p.ret0 + ((size_t)(l * 64 + bh)) * 16384;
#pragma unroll
    for (int mt = 0; mt < 8; ++mt)
#pragma unroll
      for (int nt = 0; nt < 2; ++nt)
#pragma unroll
        for (int j = 0; j < 4; ++j) S[mt][nt][j] = s0[(mt * 16 + (lane >> 4) * 4 + j) * 128 + 32 * w + nt * 16 + (lane & 15)];
  } else {
#pragma unroll
    for (int mt = 0; mt < 8; ++mt)
#pragma unroll
      for (int nt = 0; nt < 2; ++nt) S[mt][nt] = (f32x4){0.f, 0.f, 0.f, 0.f};
    const float g512 = exp2f(gl2 * 512.0f);
    for (int s2 = 0; s2 < sc; ++s2) {
      const float* sl = (const float*)(ws + OFF_SLOC) + ((size_t)(bh * 16 + s2)) * 16384;
#pragma unroll
      for (int mt = 0; mt < 8; ++mt)
#pragma unroll
        for (int nt = 0; nt < 2; ++nt)
#pragma unroll
          for (int j = 0; j < 4; ++j)
            S[mt][nt][j] = S[mt][nt][j] * g512 + ld_sc1_f(sl + (mt * 16 + (lane >> 4) * 4 + j) * 128 + 32 * w + nt * 16 + (lane & 15));
    }
  }
  const u32x4 z4 = (u32x4){0, 0, 0, 0};
  for (int c = 0; c < nchunk; ++c) {
    const int r0 = row_base + c * 64;
    __syncthreads();
#pragma unroll
    for (int i = 0; i < 4; ++i) {
      const int id = tid + i * NTHR, r = id >> 4, cc = (id & 15) * 8;
      u32x4 q4 = z4, k4 = z4;
      if (r < C) {
        q4 = ld_ws16(ws, Qg + (size_t)(r0 + r) * 512 + h * 128 + cc);
        k4 = ld_ws16(ws, Kg + (size_t)(r0 + r) * 512 + h * 128 + cc);
      }
      *(u32x4*)(sQ + r * 144 + cc) = q4;
      *(u32x4*)(sK + r * 144 + cc) = k4;
    }
#pragma unroll
    for (int i = 0; i < 4; ++i) {
      const int id = tid + i * NTHR, r = id >> 3, cc = (id & 7) * 8;
      u32x4 v4 = z4;
      if (cc < C) v4 = ld_ws16(ws, Vt + (size_t)r * tr_ld + c * 64 + cc);
      *(u32x4*)(sV + r * LDS_STRIDE + cc) = v4;
    }
    __syncthreads();
    {
      f32x4 sc4[4];
#pragma unroll
      for (int m = 0; m < 4; ++m) sc4[m] = (f32x4){0.f, 0.f, 0.f, 0.f};
#pragma unroll
      for (int ks = 0; ks < 4; ++ks) {
        const bf16x8 bk = *(const bf16x8*)(sK + (16 * w + (lane & 15)) * 144 + ks * 32 + (lane >> 4) * 8);
#pragma unroll
        for (int m = 0; m < 4; ++m) {
          const bf16x8 aq = *(const bf16x8*)(sQ + (m * 16 + (lane & 15)) * 144 + ks * 32 + (lane >> 4) * 8);
          sc4[m] = MFMA16(aq, bk, sc4[m]);
        }
      }
      MFMA_FENCE();
      const int jc = 16 * w + (lane & 15);
#pragma unroll
      for (int m = 0; m < 4; ++m)
#pragma unroll
        for (int j = 0; j < 4; ++j) {
          const int i = m * 16 + (lane >> 4) * 4 + j;
          const int dd = i > jc ? i - jc : jc - i;
          sS[i * LDS_STRIDE + jc] = f2bf(sc4[m][j] * exp2f(gl2 * (float)dd));
        }
    }
    __syncthreads();
#pragma unroll
    for (int i = 0; i < 4; ++i) {
      const int id = tid + i * NTHR, r = id >> 3, cc = (id & 7) * 8;
      u32x4 v4 = z4;
      if (cc < C) v4 = ld_ws16(ws, Ktd + (size_t)r * tr_ld + c * 64 + cc);
      *(u32x4*)(sK + r * LDS_STRIDE + cc) = v4;
    }
    f32x4 o[4][2];
#pragma unroll
    for (int m = 0; m < 4; ++m) { o[m][0] = (f32x4){0.f, 0.f, 0.f, 0.f}; o[m][1] = o[m][0]; }
#pragma unroll
    for (int a = 0; a < 4; ++a) {
      bf16x8 bs[2];
#pragma unroll
      for (int nt = 0; nt < 2; ++nt) {
        u32x4 u;
        u.x = pack2(S[2 * a][nt][0], S[2 * a][nt][1]); u.y = pack2(S[2 * a][nt][2], S[2 * a][nt][3]);
        u.z = pack2(S[2 * a + 1][nt][0], S[2 * a + 1][nt][1]); u.w = pack2(S[2 * a + 1][nt][2], S[2 * a + 1][nt][3]);
        bs[nt] = __builtin_bit_cast(bf16x8, u);
      }
#pragma unroll
      for (int m = 0; m < 4; ++m) {
        const u16* qp = sQ + (m * 16 + (lane & 15)) * 144 + (lane >> 4) * 4;
        const u32x2 lo = *(const u32x2*)(qp + (2 * a) * 16);
        const u32x2 hi = *(const u32x2*)(qp + (2 * a + 1) * 16);
        const bf16x8 aq = __builtin_bit_cast(bf16x8, ((u32x4){lo.x, lo.y, hi.x, hi.y}));
        o[m][0] = MFMA16(aq, bs[0], o[m][0]);
        o[m][1] = MFMA16(aq, bs[1], o[m][1]);
      }
      __builtin_amdgcn_sched_barrier(0);
    }
    MFMA_FENCE();
#pragma unroll
    for (int m = 0; m < 4; ++m)
#pragma unroll
      for (int j = 0; j < 4; ++j) {
        const int i = m * 16 + (lane >> 4) * 4 + j;
        const float f = exp2f(gl2 * (float)(i + 1));
        o[m][0][j] *= f;
        o[m][1][j] *= f;
      }
#pragma unroll
    for (int ks = 0; ks < 2; ++ks) {
      bf16x8 bv[2];
#pragma unroll
      for (int nt = 0; nt < 2; ++nt) bv[nt] = *(const bf16x8*)(sV + (32 * w + nt * 16 + (lane & 15)) * LDS_STRIDE + ks * 32 + (lane >> 4) * 8);
#pragma unroll
      for (int m = 0; m < 4; ++m) {
        const bf16x8 as = *(const bf16x8*)(sS + (m * 16 + (lane & 15)) * LDS_STRIDE + ks * 32 + (lane >> 4) * 8);
        o[m][0] = MFMA16(as, bv[0], o[m][0]);
        o[m][1] = MFMA16(as, bv[1], o[m][1]);
      }
      __builtin_amdgcn_sched_barrier(0);
    }
    MFMA_FENCE();
#pragma unroll
    for (int m = 0; m < 4; ++m)
#pragma unroll
      for (int j = 0; j < 4; ++j) {
        float v = o[m][0][j] * o[m][0][j] + o[m][1][j] * o[m][1][j];
        v = red16(v);
        if ((lane & 15) == 0) sR[w * 64 + m * 16 + (lane >> 4) * 4 + j] = v;
      }
    __syncthreads();
#pragma unroll
    for (int m = 0; m < 4; ++m)
#pragma unroll
      for (int j = 0; j < 4; ++j) {
        const int i = m * 16 + (lane >> 4) * 4 + j;
        if (i < C) {
          const float ss = sR[i] + sR[64 + i] + sR[128 + i] + sR[192 + i];
          const float rs = rsqrtf(ss * (1.0f / 128.0f) + EPSF);
#pragma unroll
          for (int nt = 0; nt < 2; ++nt) {
            const int e = 32 * w + nt * 16 + (lane & 15);
            const float g = bf2f(ld_sc1_2(Gg + (size_t)(r0 + i) * 512 + h * 128 + e));
            reto[(size_t)(r0 + i) * 512 + h * 128 + e] = f2bf(o[m][nt][j] * rs * siluf_(g));
          }
        }
      }
#pragma unroll
    for (int mt = 0; mt < 8; ++mt) { S[mt][0] *= gC; S[mt][1] *= gC; }
#pragma unroll 1
    for (int ks = 0; ks < 2; ++ks) {
      bf16x8 bv[2];
#pragma unroll
      for (int nt = 0; nt < 2; ++nt) bv[nt] = *(const bf16x8*)(sV + (32 * w + nt * 16 + (lane & 15)) * LDS_STRIDE + ks * 32 + (lane >> 4) * 8);
#pragma unroll
      for (int mt = 0; mt < 8; ++mt) {
        const bf16x8 ak = *(const bf16x8*)(sK + (mt * 16 + (lane & 15)) * LDS_STRIDE + ks * 32 + (lane >> 4) * 8);
        S[mt][0] = MFMA16(ak, bv[0], S[mt][0]);
        S[mt][1] = MFMA16(ak, bv[1], S[mt][1]);
      }
    }
    MFMA_FENCE();
  }
  if (samp || sc == 15) {
    float* so = samp ? (p.out + O_RET_S + ((size_t)(l * 64 + bh)) * 16384) : (p.out + O_RET_P + ((size_t)(l * 16 + bh)) * 16384);
#pragma unroll
    for (int mt = 0; mt < 8; ++mt)
#pragma unroll
      for (int nt = 0; nt < 2; ++nt)
#pragma unroll
        for (int j = 0; j < 4; ++j) so[(mt * 16 + (lane >> 4) * 4 + j) * 128 + 32 * w + nt * 16 + (lane & 15)] = S[mt][nt][j];
  }
}

DI void s5_task(const Params& p, int l, int t, int mode) {
  char* ws = p.ws;
  char* arena = ws + OFF_ARENA;
  const int tid = ltid(), lane = tid & 63, w = tid >> 6;
  const bool samp = t >= 512;
  int b, lc, g, row_base, nsub;
  if (!samp) { b = t >> 7; lc = (t >> 3) & 15; g = (t & 7) * 4 + w; row_base = b * SEQ + lc * 512; nsub = 32; }
  else { const int q = t - 512; b = q >> 3; lc = 0; g = (q & 7) * 4 + w; row_base = PROWS + b * 16; nsub = 1; }
  const char* sp = ws + OFF_S5P + (size_t)l * S5P_LAYER;
  const u16* bbt = (const u16*)(sp + S5P_BBT) + g * 2048;
  const u16* cm = (const u16*)(sp + S5P_CM) + g * 2048;
  const float* ab = (const float*)(sp + S5P_ABAR) + g * 128;
  const u16* U = (const u16*)(arena + 0 * SLOT);
  u16* Z = (u16*)(arena + 6 * SLOT);
  float* bu = (float*)(smem + w * 13056);
  u16* xs = (u16*)(smem + w * 13056 + 8448);
  const float ar = ld_sc1_f(ab + lane * 2), ai = ld_sc1_f(ab + lane * 2 + 1);
  const int slab = lane >> 4;
  const u32x4 z4 = (u32x4){0, 0, 0, 0};
  bf16x8 Bf[8], Cf[4];
#pragma unroll
  for (int nt = 0; nt < 8; ++nt) {
    u32x4 u = z4;
    if (slab < 2) u = ld_ws16(ws, bbt + (nt * 16 + (lane & 15)) * 16 + slab * 8);
    Bf[nt] = __builtin_bit_cast(bf16x8, u);
  }
#pragma unroll
  for (int ks = 0; ks < 4; ++ks) Cf[ks] = __builtin_bit_cast(bf16x8, ld_ws16(ws, cm + (lane & 15) * 128 + ks * 32 + slab * 8));
  const float Dh = p.s5_d[(l * 32 + g) * 16 + (lane & 15)];
  float xr = 0.f, xi = 0.f;
  if (samp) {
    xr = p.s5re0[((size_t)(l * 16 + b) * 32 + g) * 64 + lane];
    xi = p.s5im0[((size_t)(l * 16 + b) * 32 + g) * 64 + lane];
  } else if (mode == 1 && lc > 0) {
    float pr = ar, pi = ai;
#pragma unroll
    for (int s = 0; s < 9; ++s) { const float nr = pr * pr - pi * pi, ni = 2.f * pr * pi; pr = nr; pi = ni; }
    const float* el = (const float*)(ws + OFF_ELOC);
    for (int c2 = 0; c2 < lc; ++c2) {
      const float er = ld_sc1_f(el + (((size_t)(b * 16 + c2) * 32 + g) * 64 + lane) * 2), ei = ld_sc1_f(el + (((size_t)(b * 16 + c2) * 32 + g) * 64 + lane) * 2 + 1);
      const float nr = pr * xr - pi * xi + er, ni = pr * xi + pi * xr + ei;
      xr = nr; xi = ni;
    }
  }
  u16* usm = (u16*)(smem + 52224 + w * 512);
  const u16* up = U + (size_t)(row_base + (lane & 15)) * 512 + g * 16 + (slab & 1) * 8;
  u32x4 ua = ld_ws16(ws, up);
  for (int sub = 0; sub < nsub; ++sub) {
    const int r0 = row_base + sub * 16;
    u32x4 un = z4;
    if (sub + 1 < nsub) un = ld_ws16(ws, up + (size_t)(sub + 1) * 16 * 512);
    if (slab >= 2) ua = z4;
    const bf16x8 Af = __builtin_bit_cast(bf16x8, ua);
    __syncthreads();
    if (mode == 1 && slab < 2) *(u32x4*)(usm + (lane & 15) * 16 + slab * 8) = ua;
    f32x4 a8[8];
#pragma unroll
    for (int nt = 0; nt < 8; ++nt) a8[nt] = MFMA16(Af, Bf[nt], ((f32x4){0.f, 0.f, 0.f, 0.f}));
    __builtin_amdgcn_sched_barrier(0);
    asm volatile("s_nop 15\n\ts_nop 15\n\ts_nop 15" ::: "memory");
    __builtin_amdgcn_sched_barrier(0);
#pragma unroll
    for (int nt = 0; nt < 8; ++nt) {
#pragma unroll
      for (int j = 0; j < 4; ++j) bu[(slab * 4 + j) * 132 + nt * 16 + (lane & 15)] = a8[nt][j];
    }
    __syncthreads();
#pragma unroll
    for (int tt = 0; tt < 16; ++tt) {
      const float br = bu[tt * 132 + lane], bi = bu[tt * 132 + 64 + lane];
      const float nr = ar * xr - ai * xi + br, ni = ar * xi + ai * xr + bi;
      xr = nr; xi = ni;
      if (mode == 1) { xs[tt * 144 + lane] = f2bf(xr); xs[tt * 144 + 64 + lane] = f2bf(xi); }
    }
    if (mode == 1) {
      __syncthreads();
      f32x4 y = (f32x4){0.f, 0.f, 0.f, 0.f};
#pragma unroll
      for (int ks = 0; ks < 4; ++ks) {
        const bf16x8 ax = *(const bf16x8*)(xs + (lane & 15) * 144 + ks * 32 + slab * 8);
        y = MFMA16(ax, Cf[ks], y);
      }
      __builtin_amdgcn_sched_barrier(0);
      asm volatile("s_nop 15\n\ts_nop 15" ::: "memory");
      __builtin_amdgcn_sched_barrier(0);
#pragma unroll
      for (int j = 0; j < 4; ++j) {
        const int rr = r0 + slab * 4 + j, cc = g * 16 + (lane & 15);
        const float u = bf2f(usm[(slab * 4 + j) * 16 + (lane & 15)]);
        Z[(size_t)rr * 512 + cc] = f2bf(geluf_(y[j] + Dh * u));
      }
    }
    ua = un;
  }
  if (mode == 0) {
    float* el = (float*)(ws + OFF_ELOC);
    el[(((size_t)(b * 16 + lc) * 32 + g) * 64 + lane) * 2] = xr;
    el[(((size_t)(b * 16 + lc) * 32 + g) * 64 + lane) * 2 + 1] = xi;
  } else if (samp) {
    p.out[O_S5RE_S + ((size_t)(l * 16 + b) * 32 + g) * 64 + lane] = xr;
    p.out[O_S5IM_S + ((size_t)(l * 16 + b) * 32 + g) * 64 + lane] = xi;
  } else if (lc == 15) {
    p.out[O_S5RE_P + ((size_t)(l * 4 + b) * 32 + g) * 64 + lane] = xr;
    p.out[O_S5IM_P + ((size_t)(l * 4 + b) * 32 + g) * 64 + lane] = xi;
  }
}

DI void glu_tile(const Params& p, int l, int t) {
  char* ws = p.ws;
  char* arena = ws + OFF_ARENA;
  const int rt = t >> 2, ct = t & 3, row0 = rt * 128, col0 = ct * 128;
  const u16* Zb = (const u16*)(arena + 6 * SLOT);
  const u16* A = Zb + (size_t)row0 * 512;
  const u16* B = (const u16*)(ws + OFF_W) + (size_t)l * W_LAYER + W_GLU + (size_t)col0 * 512;
  f32x4 acc[4][4];
  zero_acc(acc);
  u16* sA = (u16*)smem; u16* sB = sA + 128 * LDS_STRIDE;
  gemm_mainloop<128, 128, 2, 2>(A, 512, B, 512, 512, 1 << 30, acc, sA, sB, NoHook());
  const int lane = ltid() & 63, wid = ltid() >> 6, wm = wid >> 1, wn = wid & 1;
  u16* Z2 = (u16*)(arena + 0 * SLOT);
  float* zsq = (float*)(ws + OFF_ZSQ);
  const float* bg = p.b_glu + l * 512;
  u16* sT = (u16*)smem;
  __syncthreads();
  {
    const int tq = ltid();
#pragma unroll
    for (int i = 0; i < 8; ++i) {
      const int id = tq + i * NTHR, rr = id >> 4, cc = (id & 15) * 8;
      *(u32x4*)(sT + rr * 136 + cc) = ld_ws16(ws, Zb + (size_t)(row0 + rr) * 512 + col0 + cc);
    }
  }
  __syncthreads();
#pragma unroll
  for (int m = 0; m < 4; ++m) {
    float ss[4] = {0.f, 0.f, 0.f, 0.f};
    const int rl = wm * 64 + m * 16 + (lane >> 4) * 4;
#pragma unroll
    for (int n = 0; n < 4; ++n) {
      const int cl = wn * 64 + n * 16 + (lane & 15);
      const float bb = bg[col0 + cl];
#pragma unroll
      for (int j = 0; j < 4; ++j) {
        const float z = bf2f(sT[(rl + j) * 136 + cl]);
        const float z2 = z * sigmoidf_(acc[m][n][j] + bb);
        ss[j] += z2 * z2;
        sT[(rl + j) * 136 + cl] = f2bf(z2);
      }
    }
#pragma unroll
    for (int j = 0; j < 4; ++j) {
      const float v = red16(ss[j]);
      if ((lane & 15) == 0) zsq[(size_t)(ct * 2 + wn) * NTOK + row0 + rl + j] = v;
    }
  }
  __syncthreads();
  tile_flush128(sT, Z2, 512, row0, col0);
}

DI void store_raw_rsq(const f32x4 (&acc)[4][4], u16* raw, float* rsq, int row0, int col0, int ct) {
  tile_out_128(acc, raw, 1024, row0, col0);
}

DI void out_tile(const Params& p, int l, int t) {
  char* ws = p.ws;
  char* arena = ws + OFF_ARENA;
  const int rt = t >> 3, ct = t & 7, row0 = rt * 128, col0 = ct * 128;
  const u16* B = (const u16*)(ws + OFF_W) + (size_t)l * W_LAYER + W_OUT + (size_t)col0 * 1024;
  f32x4 acc[4][4];
  zero_acc(acc);
  u16* sA = (u16*)smem; u16* sB = sA + 128 * LDS_STRIDE;
  float* rsl = (float*)(smem + 40960);
  const float* zsq = (const float*)(ws + OFF_ZSQ);
  {
    const int tq = ltid();
    if (tq < 128) {
      float zs = 0.f;
#pragma unroll
      for (int q = 0; q < 8; ++q) zs += ld_sc1_f(zsq + (size_t)q * NTOK + row0 + tq);
      rsl[tq] = rsqrtf(zs * (1.0f / 512.0f) + EPSF);
    }
  }
  gemm_mainloop<128, 128, 2, 2>((const u16*)(arena + 0 * SLOT) + (size_t)row0 * 512, 512, B, 1024, 512, 1 << 30, acc, sA, sB, NoHook());
  const int lane = ltid() & 63, wid = ltid() >> 6, wm = wid >> 1;
#pragma unroll
  for (int m = 0; m < 4; ++m)
#pragma unroll
    for (int j = 0; j < 4; ++j) {
      const float rs = rsl[wm * 64 + m * 16 + (lane >> 4) * 4 + j];
#pragma unroll
      for (int n = 0; n < 4; ++n) acc[m][n][j] *= rs;
    }
  gemm_mainloop<128, 128, 2, 2>((const u16*)(arena + 7 * SLOT) + (size_t)row0 * 512, 512, B + 512, 1024, 512, 1 << 30, acc, sA, sB, NoHook());
  store_raw_rsq(acc, (u16*)(arena + 1 * SLOT), (float*)(ws + OFF_RSQ), row0, col0, ct);
}

DI void raw_tile(const Params& p, const u16* Abase, int lda, const u16* Bbase, int K, u16* raw, int t) {
  char* ws = p.ws;
  const int rt = t >> 3, ct = t & 7, row0 = rt * 128, col0 = ct * 128;
  f32x4 acc[4][4];
  zero_acc(acc);
  u16* sA = (u16*)smem; u16* sB = sA + 128 * LDS_STRIDE;
  gemm_mainloop<128, 128, 2, 2>(Abase + (size_t)row0 * lda, lda, Bbase + (size_t)col0 * K, K, K, 1 << 30, acc, sA, sB, NoHook());
  store_raw_rsq(acc, raw, (float*)(ws + OFF_RSQ), row0, col0, ct);
}

DI void post_task(const Params& p, const u16* raw, const float* gpost, int t, bool last) {
  char* ws = p.ws;
  const int lane = ltid() & 63, w = ltid() >> 6;
  const int rowb = t * 16 + w * 4;
  u32x2 r2[4][4], h2[4][4];
  float xsc[4];
  float* xsb = (float*)(ws + OFF_RSQ);
#pragma unroll
  for (int k = 0; k < 4; ++k) {
    const int row = rowb + k;
    const u16* rw = raw + (size_t)row * 1024;
    const u16* hbr = (const u16*)(ws + OFF_HB) + (size_t)row * 1024;
    xsc[k] = ld_sc1_f(xsb + row);
#pragma unroll
    for (int i = 0; i < 4; ++i) { const int c = i * 256 + lane * 4; r2[k][i] = ld_sc1_8(rw + c); h2[k][i] = ld_sc1_8(hbr + c); }
  }
  float4 g[4];
#pragma unroll
  for (int i = 0; i < 4; ++i) g[i] = *(const float4*)(gpost + i * 256 + lane * 4);
#pragma unroll
  for (int k = 0; k < 4; ++k) {
    const int row = rowb + k;
    float4 rv[4];
    float s = 0.f;
#pragma unroll
    for (int i = 0; i < 4; ++i) {
      rv[i].x = bf2f((u16)(r2[k][i].x & 0xffff)); rv[i].y = bf2f((u16)(r2[k][i].x >> 16));
      rv[i].z = bf2f((u16)(r2[k][i].y & 0xffff)); rv[i].w = bf2f((u16)(r2[k][i].y >> 16));
      s += rv[i].x * rv[i].x + rv[i].y * rv[i].y + rv[i].z * rv[i].z + rv[i].w * rv[i].w;
    }
    s = red64(s);
    const float rr = rsqrtf(s * (1.0f / 1024.0f) + EPSF);
    const float xscale = xsc[k];
    float4 v[4];
    float ss = 0.f;
#pragma unroll
    for (int i = 0; i < 4; ++i) {
      v[i].x = bf2f((u16)(h2[k][i].x & 0xffff)) * xscale + rv[i].x * rr * g[i].x;
      v[i].y = bf2f((u16)(h2[k][i].x >> 16)) * xscale + rv[i].y * rr * g[i].y;
      v[i].z = bf2f((u16)(h2[k][i].y & 0xffff)) * xscale + rv[i].z * rr * g[i].z;
      v[i].w = bf2f((u16)(h2[k][i].y >> 16)) * xscale + rv[i].w * rr * g[i].w;
      ss += v[i].x * v[i].x + v[i].y * v[i].y + v[i].z * v[i].z + v[i].w * v[i].w;
    }
    ss = red64(ss);
    const float r = rsqrtf(ss * (1.0f / 1024.0f) + EPSF);
    if (lane == 0) xsb[row] = 1.0f / r;
    float* y = p.out + O_Y + (size_t)row * 1024;
    u16* hb = (u16*)(ws + OFF_HB) + (size_t)row * 1024;
#pragma unroll
    for (int i = 0; i < 4; ++i) {
      const int c = i * 256 + lane * 4;
      if (last) *(float4*)(y + c) = v[i];
      u32x2 o; o.x = pack2(v[i].x * r, v[i].y * r); o.y = pack2(v[i].z * r, v[i].w * r);
      *(u32x2*)(hb + c) = o;
    }
  }
}

DI void cq_tile(const Params& p, int l, int t) {
  char* ws = p.ws;
  char* arena = ws + OFF_ARENA;
  const int rt = t >> 3, ct = t & 7, row0 = rt * 128, col0 = ct * 128;
  f32x4 acc[4][4];
  zero_acc(acc);
  u16* sA = (u16*)smem; u16* sB = sA + 128 * LDS_STRIDE;
  gemm_mainloop<128, 128, 2, 2>((const u16*)(ws + OFF_HB) + (size_t)row0 * 1024, 1024,
                                (const u16*)(ws + OFF_W) + (size_t)l * W_LAYER + W_CQ + (size_t)col0 * 1024, 1024, 1024, 1 << 30, acc, sA, sB, NoHook());
  tile_out_128(acc, (u16*)(arena + 3 * SLOT), 1024, row0, col0);
}

DI void att_task(const Params& p, int l, int t) {
  char* ws = p.ws;
  char* arena = ws + OFF_ARENA;
  const int tid = ltid(), lane = tid & 63, w = tid >> 6;
  int row0, h, nvalid;
  const u16 *KX, *VTX;
  if (t < 2048) {
    const int rt = t >> 2; h = t & 3; row0 = rt * 64; nvalid = 64;
    const int b = row0 >> 13;
    KX = (const u16*)(ws + OFF_KXP) + ((size_t)(l * 4 + b)) * 256 * 1024 + h * 256;
    VTX = (const u16*)(ws + OFF_VTXP) + ((size_t)((l * 4 + b) * 4 + h)) * 65536;
  } else {
    const int q = t - 2048, b = q >> 2; h = q & 3; row0 = PROWS + b * 16; nvalid = 16;
    KX = (const u16*)(ws + OFF_KXS) + (size_t)b * 256 * 1024 + h * 256;
    VTX = (const u16*)(ws + OFF_VTXS) + ((size_t)(b * 4 + h)) * 65536;
  }
  const u16* QX = (const u16*)(arena + 3 * SLOT);
  u16* OX = (u16*)(arena + 5 * SLOT);
#ifdef EXP_ATT_COPY
  for (int e = tid; e < nvalid * 256; e += NTHR) { const int r = e >> 8, c = e & 255; OX[(size_t)(row0 + r) * 1024 + h * 256 + c] = QX[(size_t)(row0 + r) * 1024 + h * 256 + c]; }
  return;
#endif
  const int arow0 = (row0 + 64 <= NTOK) ? row0 : (NTOK - 64);
  const int shift = row0 - arow0;
  u16* sA = (u16*)smem;
  u16* sB = (u16*)(smem + 34816);
  f32x4 acc[1][16];
  zero_acc(acc);
  gemm_mainloop<64, 256, 4, 1>(QX + (size_t)arow0 * 1024 + h * 256, 1024, KX, 1024, 256, 1 << 30, acc, sA, sB, NoHook());
  float inv[4];
#pragma unroll
  for (int j = 0; j < 4; ++j) {
    float mx = -3.0e38f;
#pragma unroll
    for (int n = 0; n < 16; ++n) mx = fmaxf(mx, acc[0][n][j]);
    mx = max16(mx);
    float s = 0.f;
#pragma unroll
    for (int n = 0; n < 16; ++n) { const float e = __expf(acc[0][n][j] - mx); acc[0][n][j] = e; s += e; }
    s = red16(s);
    inv[j] = 1.0f / s;
  }
  __syncthreads();
  u16* sP = (u16*)smem;
#pragma unroll
  for (int n = 0; n < 16; ++n)
#pragma unroll
    for (int j = 0; j < 4; ++j) sP[(w * 16 + (lane >> 4) * 4 + j) * 272 + n * 16 + (lane & 15)] = f2bf(acc[0][n][j] * inv[j]);
  zero_acc(acc);
  gemm_mainloop_alds<64, 256, 4, 1>(sP, 272, VTX, 256, 256, acc, sB);
#pragma unroll
  for (int n = 0; n < 16; ++n)
#pragma unroll
    for (int j = 0; j < 4; ++j) {
      const int rl = w * 16 + (lane >> 4) * 4 + j - shift;
      if (rl >= 0 && rl < nvalid) OX[(size_t)(row0 + rl) * 1024 + h * 256 + n * 16 + (lane & 15)] = f2bf(acc[0][n][j]);
    }
}

DI void gu_tile(const Params& p, int l, int t) {
  char* ws = p.ws;
  char* arena = ws + OFF_ARENA;
  const int rt = t / 22, ct = t % 22, row0 = rt * 128, col0 = ct * 256;
  f32x4 acc[4][8];
  zero_acc(acc);
  u16* sA = (u16*)smem; u16* sB = sA + 128 * LDS_STRIDE;
  gemm_128x256((const u16*)(ws + OFF_HB) + (size_t)row0 * 1024, 1024,
               (const u16*)(ws + OFF_W) + (size_t)l * W_LAYER + W_GU + (size_t)col0 * 1024, 1024, 1024, acc, sA, sB);
  const int tid = ltid(), lane = tid & 63, wid = tid >> 6, wm = wid >> 1, wn = wid & 1;
  u16* act = (u16*)(arena + 2 * SLOT);
  u16* sT = (u16*)smem;
  __syncthreads();
#pragma unroll
  for (int m = 0; m < 4; ++m)
#pragma unroll
    for (int np = 0; np < 4; ++np)
#pragma unroll
      for (int j = 0; j < 4; ++j)
        tile_put(sT, 136, wm * 64 + m * 16 + (lane >> 4) * 4 + j, wn * 64 + np * 16 + (lane & 15), siluf_(acc[m][2 * np][j]) * acc[m][2 * np + 1][j]);
  __syncthreads();
  tile_flush128(sT, act, DFF, row0, col0 >> 1);
}

DI void dbg_dump(const Params& p) {
#ifdef DUMP_SLOT
  const u16* src = (const u16*)(p.ws + OFF_ARENA + (size_t)DUMP_SLOT * SLOT);
  float* dst = p.out + O_Y;
  for (size_t i = (size_t)blockIdx.x * NTHR + threadIdx.x; i < (size_t)NTOK * 1024; i += (size_t)gridDim.x * NTHR) dst[i] = bf2f(src[i]);
#endif
#ifdef DUMP_HB
  const u16* src = (const u16*)(p.ws + OFF_HB);
  float* dst = p.out + O_Y;
  for (size_t i = (size_t)blockIdx.x * NTHR + threadIdx.x; i < (size_t)NTOK * 1024; i += (size_t)gridDim.x * NTHR) dst[i] = bf2f(src[i]);
#endif
}
#define PH_BEGIN { const int myph = ph++; const bool act_ = (myph >= p.ph_lo && myph < p.ph_hi); if (act_) { unsigned* c = &ctr[myph]; (void)c; phase_begin();
#define PH_END } if (act_ && myph + 1 < p.ph_hi) grid_barrier(bar); }

__global__ void __launch_bounds__(NTHR, 2) fwd_megakernel(Params p) {
  unsigned* bar = (unsigned*)(p.ws + OFF_BAR);
  unsigned* ctr = (unsigned*)(p.ws + OFF_CTR);
  if (threadIdx.x == 0) { g_xb[0] = 0u; g_xb[1] = 0u; g_xb[2] = 0u; g_xb[3] = 0u; }
  __syncthreads();
  if (USE_XCD_BARRIER) { if (threadIdx.x == 0) (void)xb_add(&bar[XB_XCNT(xb_xcc_id())], 1u); }
  if (p.never) cg::this_grid().sync();
  int ph = 0;
  char* ws = p.ws;
  char* arena = ws + OFF_ARENA;
#ifdef DUMP_AFTER
  if (p.ph_lo < 0) {
    const u16* src = (const u16*)(ws + DUMP_OFF);
    for (size_t j = (size_t)blockIdx.x * NTHR + threadIdx.x; j < (size_t)1048576; j += (size_t)gridDim.x * NTHR) {
      float acc = 0.f;
      size_t idx = (j * 131u) % DUMP_N;
      for (int k = 0; k < 512; ++k) {
        const float e = bf2f((u16)(src[idx] & 0xBFFF));
        acc = acc * 0.75f + e * (1.0f + 0.001f * (float)(k & 15));
        idx += 65537u; if (idx >= DUMP_N) idx -= DUMP_N;
      }
      float v = acc;
      for (int k = 0; k < 200; ++k) { v = bf2f(f2bf(v * 1.37f + 0.11f)); if (fabsf(v) > 4.f) v *= 0.125f; }
      p.out[O_Y + j] = v;
    }
    return;
  }
#endif
#ifdef EXP_CHAOS
  if (p.ph_lo == 0) {
    for (size_t i = (size_t)blockIdx.x * NTHR + threadIdx.x; i < (size_t)NTOK * 1024; i += (size_t)gridDim.x * NTHR) {
      float v = (i < (size_t)PROWS * 1024) ? p.x_prompt[i] : p.x_sample[i - (size_t)PROWS * 1024];
      float w = p.w_in[i % (4u * 1024u * 2560u)];
      for (int k = 0; k < 200; ++k) { v = bf2f(f2bf(v * 1.37f + w)); if (fabsf(v) > 4.f) v *= 0.125f; }
      p.out[O_Y + i] = v;
    }
  }
  return;
#endif

  PH_BEGIN
    phase_prep(p, c);
  PH_END

  for (int l_ = 0; l_ < DEPTHC; ++l_) {
    const int l = lsgpr(l_);
    const u16* wl = (const u16*)(ws + OFF_W) + (size_t)l * W_LAYER;
    PH_BEGIN
      const int n_g1 = 258 * 20, n_mk = (l == 0) ? 512 : 0, n_cc = 2048;
      for (;;) {
        int t = next_task(c);
        if (t >= n_g1 + n_mk + n_cc) break;
        if (t < n_g1) g1_tile(p, l, t);
        else if (t < n_g1 + n_mk) memkv_tile(p, t - n_g1);
        else cache_task(p, l, t - n_g1 - n_mk);
      }
    PH_END
    PH_BEGIN
      for (;;) {
        int t = next_task(c);
        if (t >= 256 + 512) break;
        if (t < 256) ret_local_task(p, t);
        else s5_task(p, l, t - 256, 0);
      }
    PH_END
    PH_BEGIN
      for (;;) {
        int t = next_task(c);
        if (t >= 320 + 640) break;
        if (t < 320) ret_final_task(p, l, t);
        else s5_task(p, l, t - 320, 1);
      }
    PH_END
    PH_BEGIN
      TASK_LOOP(c, 258 * 4, glu_tile(p, l, t))
    PH_END
    PH_BEGIN
      TASK_LOOP(c, 258 * 8, out_tile(p, l, t))
    PH_END
    PH_BEGIN
      for (int t = blockIdx.x; t < NTOK / 16; t += gridDim.x) { post_task(p, (const u16*)(arena + 1 * SLOT), p.mix_post + l * 1024, t, false); }
    PH_END
    PH_BEGIN
      TASK_LOOP(c, 258 * 8, cq_tile(p, l, t))
    PH_END
    PH_BEGIN
      TASK_LOOP(c, 2112, att_task(p, l, t))
    PH_END
    PH_BEGIN
      TASK_LOOP(c, 258 * 8, raw_tile(p, (const u16*)(arena + 5 * SLOT), 1024, wl + W_CO, 1024, (u16*)(arena + 1 * SLOT), t))
    PH_END
    PH_BEGIN
      for (int t = blockIdx.x; t < NTOK / 16; t += gridDim.x) { post_task(p, (const u16*)(arena + 1 * SLOT), p.xa_post + l * 1024, t, false); }
    PH_END
    PH_BEGIN
      TASK_LOOP(c, 258 * 22, gu_tile(p, l, t))
    PH_END
    PH_BEGIN
      TASK_LOOP(c, 258 * 8, raw_tile(p, (const u16*)(arena + 2 * SLOT), DFF, wl + W_DN, DFF, (u16*)(arena + 0 * SLOT), t))
    PH_END
    PH_BEGIN
      for (int t = blockIdx.x; t < NTOK / 16; t += gridDim.x) { post_task(p, (const u16*)(arena + 0 * SLOT), p.ffn_post + l * 1024, t, l == DEPTHC - 1); }
    PH_END
  }
}

#ifndef N_LAUNCH_SPLIT
#define N_LAUNCH_SPLIT 0
#endif
constexpr int N_PHASES = 1 + 13 * DEPTHC;

extern "C" void kernel_launch(void* const* d_in, const int* in_sizes, int n_in, void* d_out, int out_size, void* d_ws,
                              size_t ws_size, hipStream_t stream) {
  static int grid_blocks = 0;
  if (!grid_blocks) {
    int dev = 0, cus = 0, per_cu = 0;
    (void)hipGetDevice(&dev);
    (void)hipDeviceGetAttribute(&cus, hipDeviceAttributeMultiprocessorCount, dev);
    (void)hipOccupancyMaxActiveBlocksPerMultiprocessor(&per_cu, fwd_megakernel, NTHR, 0);
    if (per_cu > 2) per_cu = 2;
    if (per_cu < 1) per_cu = 1;
    grid_blocks = cus * per_cu;
  }
  if (ws_size < WS_NEEDED) fprintf(stderr, "workspace too small: %zu < %zu\n", ws_size, (size_t)WS_NEEDED);
  Params p{};
  const float** f = (const float**)&p;
  for (int i = 0; i < 36; ++i) f[i] = (const float*)d_in[i];
  p.out = (float*)d_out;
  p.ws = (char*)d_ws;
  p.never = 0;
  p.ph_lo = 0;
  p.ph_hi = N_PHASES;
  p.pad = 0;
  (void)hipMemsetAsync(d_ws, 0, 32768, stream);
  if (N_LAUNCH_SPLIT) {
#ifdef DUMP_AFTER
    const int nrun = DUMP_AFTER;
#else
    const int nrun = N_PHASES;
#endif
    for (int i = 0; i <= nrun; ++i) {
      if (i == nrun) {
#ifdef DUMP_AFTER
        p.ph_lo = -1; p.ph_hi = -1;
#else
        break;
#endif
      } else { p.ph_lo = i; p.ph_hi = i + 1; }
      void* args[] = {&p};
      hipError_t e = hipLaunchCooperativeKernel((void*)fwd_megakernel, dim3(grid_blocks), dim3(NTHR), args, 0, stream);
      if (e != hipSuccess) fprintf(stderr, "launch failed: %s (grid %d)\n", hipGetErrorString(e), grid_blocks);
    }
  } else {
    void* args[] = {&p};
    hipError_t e = hipLaunchCooperativeKernel((void*)fwd_megakernel, dim3(grid_blocks), dim3(NTHR), args, 0, stream);
    if (e != hipSuccess) fprintf(stderr, "cooperative launch failed: %s (grid %d)\n", hipGetErrorString(e), grid_blocks);
  }
}
```

```cpp
#include <hip/hip_runtime.h>
#include <hip/hip_bf16.h>
#include <hip/hip_cooperative_groups.h>
#include <stdint.h>
#include <stdio.h>
namespace cg = cooperative_groups;

typedef __attribute__((ext_vector_type(8))) short bf16x8;
typedef __attribute__((ext_vector_type(4))) float f32x4;
typedef unsigned short u16;
typedef __attribute__((ext_vector_type(4))) unsigned u32x4;
typedef __attribute__((ext_vector_type(2))) unsigned u32x2;
#define DI __device__ __forceinline__
#define MFMA16(a, b, c) __builtin_amdgcn_mfma_f32_16x16x32_bf16((a), (b), (c), 0, 0, 0)
#define MFMA_FENCE() do { __builtin_amdgcn_sched_barrier(0); asm volatile("s_nop 15\n\ts_nop 15" ::: "memory"); __builtin_amdgcn_sched_barrier(0); } while (0)

constexpr int NTOK = 33024, PROWS = 32768, DM = 1024, DFF = 2816, DEPTHC = 4;
constexpr int SEQ = 8192;
constexpr float EPSF = 1e-6f;
constexpr int NTHR = 256;
constexpr int LDS_STRIDE = 80;
constexpr int SMEM_BYTES = 76800;

constexpr size_t SLOT = (size_t)NTOK * 512 * 2;
constexpr size_t OFF_BAR = 0;
constexpr size_t OFF_CTR = 16384;
constexpr size_t OFF_W = 32768;
constexpr size_t W_IN = 0, W_GLU = W_IN + 2560 * 1024, W_OUT = W_GLU + 512 * 512, W_CQ = W_OUT + 1024 * 1024,
                 W_CK = W_CQ + 1024 * 1024, W_CV = W_CK + 1024 * 1024, W_CO = W_CV + 1024 * 1024,
                 W_GU = W_CO + 1024 * 1024, W_DN = W_GU + 5632 * 1024, W_LAYER = W_DN + 1024 * 2816;
constexpr size_t OFF_S5P = OFF_W + 4 * W_LAYER * 2;
constexpr size_t S5P_BBT = 0, S5P_CM = 131072, S5P_ABAR = 262144, S5P_LAYER = 278528;
constexpr size_t OFF_HB = OFF_S5P + 4 * S5P_LAYER;
constexpr size_t OFF_MEMB = OFF_HB + (size_t)NTOK * 1024 * 2;
constexpr size_t OFF_KXP = OFF_MEMB + 1024 * 1024 * 2;
constexpr size_t OFF_VTXP = OFF_KXP + 4 * 4 * 256 * 1024 * 2;
constexpr size_t OFF_KXS = OFF_VTXP + 4 * 4 * 256 * 1024 * 2;
constexpr size_t OFF_VTXS = OFF_KXS + 16 * 256 * 1024 * 2;
constexpr size_t OFF_SLOC = OFF_VTXS + 16 * 256 * 1024 * 2;
constexpr size_t OFF_ELOC = OFF_SLOC + 16 * 16 * 128 * 128 * 4;
constexpr size_t OFF_ZSQ = OFF_ELOC + 4 * 16 * 32 * 64 * 2 * 4;
constexpr size_t OFF_RSQ = OFF_ZSQ + (size_t)NTOK * 8 * 4;
constexpr size_t OFF_ARENA = OFF_RSQ + (size_t)NTOK * 16 * 4;
constexpr size_t WS_NEEDED = OFF_ARENA + 8 * SLOT;

constexpr size_t O_Y = 0, O_S5RE_P = 33816576, O_S5IM_P = 33849344, O_RET_P = 33882112, O_MK_P = 34930688,
                 O_MV_P = 39124992, O_S5RE_S = 43319296, O_S5IM_S = 43450368, O_RET_S = 43581440;

struct Params {
  const float *x_prompt, *x_sample, *mem_prompt, *s5re0, *s5im0, *ret0, *cmk, *cmv;
  const float *mix_pre, *mix_post, *w_in, *lam_re, *lam_im, *log_step, *b_re, *b_im, *c_re, *c_im, *s5_d, *w_glu,
      *b_glu, *s5_onorm, *ret_onorm, *w_out, *xa_pre, *xa_post, *mem_norm, *w_cq, *w_ck, *w_cv, *w_co, *ffn_pre,
      *ffn_post, *w_gate, *w_up, *w_down;
  float* out;
  char* ws;
  int never;
  int ph_lo;
  int ph_hi;
  int pad;
};

DI u16 f2bf(float f) {
  unsigned u = __float_as_uint(f);
  u += 0x7fffu + ((u >> 16) & 1u);
  return (u16)(u >> 16);
}
DI float bf2f(u16 h) { return __uint_as_float(((unsigned)h) << 16); }
DI unsigned pack2(float a, float b) { return (unsigned)f2bf(a) | ((unsigned)f2bf(b) << 16); }
DI float sigmoidf_(float x) { return 1.0f / (1.0f + __expf(-x)); }
DI float siluf_(float x) { return x * sigmoidf_(x); }
DI float geluf_(float x) {
  float t = 0.7978845608028654f * (x + 0.044715f * x * x * x);
  return 0.5f * x * (1.0f + tanhf(t));
}
DI float red16(float v) {
  v += __shfl_xor(v, 1); v += __shfl_xor(v, 2); v += __shfl_xor(v, 4); v += __shfl_xor(v, 8);
  return v;
}
DI float max16(float v) {
  v = fmaxf(v, __shfl_xor(v, 1)); v = fmaxf(v, __shfl_xor(v, 2)); v = fmaxf(v, __shfl_xor(v, 4)); v = fmaxf(v, __shfl_xor(v, 8));
  return v;
}
DI float red64(float v) {
  v = red16(v); v += __shfl_xor(v, 16); v += __shfl_xor(v, 32);
  return v;
}
DI void sincos_cw(float x, float* sn, float* cs) {
  const float k = rintf(x * 0.15915494309189535f);
  float r = fmaf(-k, 6.2831854820251465f, x);
  r = fmaf(-k, -1.7484555e-07f, r);
  *sn = __sinf(r); *cs = __cosf(r);
}
DI int ltid() { int x = threadIdx.x; asm volatile("" : "+v"(x)); return x; }
DI int lsgpr(int x) { asm volatile("" : "+s"(x)); return x; }
DI u32x4 ld_sc1_16(const void* p) {
  const unsigned long long* q = (const unsigned long long*)p;
  const unsigned long long a = __hip_atomic_load(q, __ATOMIC_RELAXED, __HIP_MEMORY_SCOPE_AGENT);
  const unsigned long long b = __hip_atomic_load(q + 1, __ATOMIC_RELAXED, __HIP_MEMORY_SCOPE_AGENT);
  return (u32x4){(unsigned)a, (unsigned)(a >> 32), (unsigned)b, (unsigned)(b >> 32)};
}
DI __amdgpu_buffer_rsrc_t mk_rsrc(const void* p) {
  const unsigned long long a = (unsigned long long)p;
  const unsigned lo = __builtin_amdgcn_readfirstlane((unsigned)a), hi = __builtin_amdgcn_readfirstlane((unsigned)(a >> 32));
  return __builtin_amdgcn_make_buffer_rsrc((void*)(((unsigned long long)hi << 32) | lo), 0, 0x7fffffff, 0x00020000);
}
DI u32x4 bld16(__amdgpu_buffer_rsrc_t r, unsigned voff, unsigned soff) { return __builtin_amdgcn_raw_buffer_load_b128(r, voff, soff, 16); }
DI u32x4 ld_ws16(const char* ws, const void* p) {
  const __amdgpu_buffer_rsrc_t r = __builtin_amdgcn_make_buffer_rsrc((void*)ws, 0, 0x7fffffff, 0x00020000);
  return __builtin_amdgcn_raw_buffer_load_b128(r, (unsigned)((const char*)p - ws), 0, 16);
}
DI u32x2 ld_sc1_8(const void* p) {
  const unsigned long long a = __hip_atomic_load((const unsigned long long*)p, __ATOMIC_RELAXED, __HIP_MEMORY_SCOPE_AGENT);
  return (u32x2){(unsigned)a, (unsigned)(a >> 32)};
}
DI u16 ld_sc1_2(const u16* p) { return __hip_atomic_load(p, __ATOMIC_RELAXED, __HIP_MEMORY_SCOPE_AGENT); }
DI float ld_sc1_f(const float* p) { return __hip_atomic_load(p, __ATOMIC_RELAXED, __HIP_MEMORY_SCOPE_AGENT); }
DI float gamma_l2(int h) { return log2f(1.0f - exp2f(-5.0f - (float)h)); }

#define XB_TMO 128
#define XB_XCNT(j) (256 + 64 * (j))
#define XB_XSUB(j) (1280 + 64 * (j))
#define XB_XGEN(j) (2304 + 64 * (j))
#define XB_TOP 3328
#define XB_TOPGEN 3392
#define XB_SPIN_CAP (1u << 26)
DI unsigned xb_ld(unsigned* p) { return __hip_atomic_load(p, __ATOMIC_RELAXED, __HIP_MEMORY_SCOPE_AGENT); }
DI unsigned xb_add(unsigned* p, unsigned v) { return __hip_atomic_fetch_add(p, v, __ATOMIC_RELAXED, __HIP_MEMORY_SCOPE_AGENT); }
DI unsigned xb_xcc_id() { return (unsigned)__builtin_amdgcn_s_getreg((3 << 11) | 20) & 0xFu; }
#define XB_SPIN(cond, bar) do { unsigned _sp = 0; while (cond) { __builtin_amdgcn_s_sleep(1); \
    if ((++_sp & 255u) == 0u) { if (xb_ld(&(bar)[XB_TMO])) break; if (_sp > XB_SPIN_CAP) { atomicAdd(&(bar)[XB_TMO], 1u); break; } } } } while (0)

__shared__ unsigned g_xb[4];
__shared__ __attribute__((aligned(16))) char smem[SMEM_BYTES];

DI void xcd_complete(unsigned* bar, unsigned x, unsigned& nloc, unsigned& nx) {
  const unsigned G = gridDim.x;
  unsigned sum, cnt, mine, sp = 0u;
  for (;;) {
    sum = 0u; cnt = 0u; mine = 0u;
#pragma unroll
    for (unsigned j = 0; j < 16; ++j) { const unsigned c = xb_ld(&bar[XB_XCNT(j)]); sum += c; cnt += (c > 0u) ? 1u : 0u; mine = (j == x) ? c : mine; }
    if (sum == G) break;
    __builtin_amdgcn_s_sleep(1);
    if ((++sp & 255u) == 0u) { if (xb_ld(&bar[XB_TMO])) break; if (sp > XB_SPIN_CAP) { atomicAdd(&bar[XB_TMO], 1u); break; } }
  }
  nloc = mine > 0u ? mine : 1u; nx = cnt > 0u ? cnt : 1u;
}
#ifndef USE_XCD_BARRIER
#define USE_XCD_BARRIER 1
#endif
DI void grid_barrier(unsigned* bar) {
  if (!USE_XCD_BARRIER) {
    asm volatile("s_waitcnt vmcnt(0)" ::: "memory");
    __syncthreads();
    if (threadIdx.x == 0) asm volatile("buffer_wbl2 sc0 sc1\n\ts_waitcnt vmcnt(0)" ::: "memory");
    cg::this_grid().sync();
    if (threadIdx.x == 0) asm volatile("buffer_inv sc0 sc1\n\ts_waitcnt vmcnt(0)" ::: "memory");
    __syncthreads();
    return;
  }
  asm volatile("s_waitcnt vmcnt(0)" ::: "memory");
  __syncthreads();
  if (threadIdx.x == 0) {
    __builtin_amdgcn_s_waitcnt(0);
    const unsigned xcc = xb_xcc_id();
    unsigned nloc = g_xb[0], nx = g_xb[1];
    if (nloc == 0u) { xcd_complete(bar, xcc, nloc, nx); g_xb[0] = nloc; g_xb[1] = nx; }
    const unsigned old = xb_add(&bar[XB_XSUB(xcc)], 1u);
    const unsigned gen = old / nloc;
    if (old + 1u == (gen + 1u) * nloc) {
      __builtin_amdgcn_fence(__ATOMIC_RELEASE, "agent");
      asm volatile("s_waitcnt vmcnt(0)" ::: "memory");
      const unsigned og = xb_add(&bar[XB_TOP], 1u);
      const unsigned tg = og / nx;
      if (og + 1u == (tg + 1u) * nx) xb_add(&bar[XB_TOPGEN], 1u);
      else XB_SPIN(xb_ld(&bar[XB_TOPGEN]) == tg, bar);
      __builtin_amdgcn_fence(__ATOMIC_ACQUIRE, "agent");
      xb_add(&bar[XB_XGEN(xcc)], 1u);
      asm volatile("s_waitcnt vmcnt(0)" ::: "memory");
    } else {
      XB_SPIN(xb_ld(&bar[XB_XGEN(xcc)]) == gen, bar);
      __builtin_amdgcn_fence(__ATOMIC_ACQUIRE, "agent");
      asm volatile("s_waitcnt vmcnt(0)" ::: "memory");
    }
  }
  __syncthreads();
}

#define DUMP_OFF (OFF_ELOC)
#define DUMP_N ((size_t)524288)
#define DUMP_F32 0
#ifndef MAXPH
#define MAXPH 10
#endif
#ifndef STATIC_SCHED
#define STATIC_SCHED 0
#endif
#ifndef ONE_XCD
#define ONE_XCD 0
#endif
DI int next_task(unsigned* ctr) {
  __syncthreads();
#ifdef LDS_NAN_PER_TASK
  __syncthreads();
#endif
  if (ONE_XCD) {
    if (threadIdx.x == 0) g_xb[2] = (xb_xcc_id() == 0u) ? atomicAdd(ctr, 1u) : 0x7fffffffu;
    __syncthreads();
    return (int)g_xb[2];
  }
  if (STATIC_SCHED) {
    if (threadIdx.x == 0) { unsigned it = g_xb[3]; g_xb[3] = it + 1u; g_xb[2] = blockIdx.x + it * gridDim.x; }
  } else {
    if (threadIdx.x == 0) g_xb[2] = atomicAdd(ctr, 1u);
  }
  __syncthreads();
  return (int)g_xb[2];
}
DI unsigned task_prefetch(unsigned* ctr) { unsigned v = 0u; if (threadIdx.x == 0) v = atomicAdd(ctr, 1u); return v; }
DI int task_commit(unsigned v) {
  __syncthreads();
  if (threadIdx.x == 0) g_xb[2] = v;
  __syncthreads();
  return (int)g_xb[2];
}
#define TASK_LOOP(ctr, N, BODY) { int t = next_task(ctr); while (t < (N)) { const unsigned tn_ = task_prefetch(ctr); BODY; t = task_commit(tn_); } }
DI void phase_begin() { __syncthreads(); if (threadIdx.x == 0) g_xb[3] = 0u; __syncthreads(); }

template <int BM, int BN, int WGM, int WGN, class Hook>
DI void gemm_mainloop(const u16* A, int lda, const u16* B, int ldb, int K, int kvalid,
                      f32x4 (&acc)[BM / WGM / 16][BN / WGN / 16], u16* sA, u16* sB, Hook hook) {
  constexpr int MT = BM / WGM / 16, NTL = BN / WGN / 16, CA = BM / 32, CB = BN / 32;
  const int tid = ltid(), lane = tid & 63, wid = tid >> 6, wm = wid / WGN, wn = wid % WGN;
  const __amdgpu_buffer_rsrc_t ra_ = mk_rsrc(A), rb_ = mk_rsrc(B);
  u32x4 ra0[CA], rb0[CB], ra1[CA], rb1[CB];
  unsigned va[CA], vb[CB];
  const u32x4 z4 = (u32x4){0u, 0u, 0u, 0u};
  const int cc0 = (tid & 7) * 8;
#pragma unroll
  for (int i = 0; i < CA; ++i) { const int r = (tid + i * NTHR) >> 3; va[i] = (unsigned)(r * lda + cc0) * 2u; }
#pragma unroll
  for (int i = 0; i < CB; ++i) { const int r = (tid + i * NTHR) >> 3; vb[i] = (unsigned)(r * ldb + cc0) * 2u; }
#define GM_LOAD(RA, RB, kn)                                                                          \
  {                                                                                                  \
    const bool kok = ((kn) + cc0) < kvalid;                                                          \
    _Pragma("unroll") for (int i = 0; i < CA; ++i) RA[i] = kok ? bld16(ra_, va[i], (unsigned)(kn) * 2u) : z4; \
    _Pragma("unroll") for (int i = 0; i < CB; ++i) RB[i] = kok ? bld16(rb_, vb[i], (unsigned)(kn) * 2u) : z4; \
  }
#define GM_STEP(RA, RB, kcur)                                                                        \
  {                                                                                                  \
    __syncthreads();                                                                                 \
    _Pragma("unroll") for (int i = 0; i < CA; ++i) { const int r = (tid + i * NTHR) >> 3; *(u32x4*)(sA + r * LDS_STRIDE + cc0) = RA[i]; } \
    _Pragma("unroll") for (int i = 0; i < CB; ++i) { const int r = (tid + i * NTHR) >> 3; *(u32x4*)(sB + r * LDS_STRIDE + cc0) = RB[i]; } \
    __syncthreads();                                                                                 \
    if ((kcur) + 128 < K) GM_LOAD(RA, RB, (kcur) + 128)                                              \
    _Pragma("unroll") for (int kk = 0; kk < 2; ++kk) {                                               \
      bf16x8 af[MT], bfr[NTL];                                                                       \
      _Pragma("unroll") for (int m = 0; m < MT; ++m) af[m] = *(const bf16x8*)(sA + (wm * (BM / WGM) + m * 16 + (lane & 15)) * LDS_STRIDE + kk * 32 + (lane >> 4) * 8); \
      _Pragma("unroll") for (int n = 0; n < NTL; ++n) bfr[n] = *(const bf16x8*)(sB + (wn * (BN / WGN) + n * 16 + (lane & 15)) * LDS_STRIDE + kk * 32 + (lane >> 4) * 8); \
      _Pragma("unroll") for (int m = 0; m < MT; ++m)                                                 \
        _Pragma("unroll") for (int n = 0; n < NTL; ++n) acc[m][n] = MFMA16(af[m], bfr[n], acc[m][n]); \
    }                                                                                                \
    hook((kcur), acc);                                                                               \
  }
  GM_LOAD(ra0, rb0, 0)
  if (64 < K) GM_LOAD(ra1, rb1, 64)
#pragma unroll
  for (int k0 = 0; k0 < K; k0 += 128) {
    GM_STEP(ra0, rb0, k0)
    GM_STEP(ra1, rb1, k0 + 64)
  }
  MFMA_FENCE();
#undef GM_LOAD
#undef GM_STEP
}
struct NoHook { template <class T> DI void operator()(int, T&) const {} };

template <int BM, int BN, int WGM, int WGN>
DI void gemm_mainloop_alds(const u16* sAimg, int lda_s, const u16* B, int ldb, int K,
                           f32x4 (&acc)[BM / WGM / 16][BN / WGN / 16], u16* sB) {
  constexpr int MT = BM / WGM / 16, NTL = BN / WGN / 16, CB = BN / 32;
  const int tid = ltid(), lane = tid & 63, wid = tid >> 6, wm = wid / WGN, wn = wid % WGN;
  const __amdgpu_buffer_rsrc_t rb_ = mk_rsrc(B);
  u32x4 rb0[CB], rb1[CB];
  unsigned vb[CB];
  const int cc0 = (tid & 7) * 8;
#pragma unroll
  for (int i = 0; i < CB; ++i) { const int r = (tid + i * NTHR) >> 3; vb[i] = (unsigned)(r * ldb + cc0) * 2u; }
#define GA_STEP(RB, kcur)                                                                            \
  {                                                                                                  \
    __syncthreads();                                                                                 \
    _Pragma("unroll") for (int i = 0; i < CB; ++i) { const int r = (tid + i * NTHR) >> 3; *(u32x4*)(sB + r * LDS_STRIDE + cc0) = RB[i]; } \
    __syncthreads();                                                                                 \
    if ((kcur) + 128 < K) { _Pragma("unroll") for (int i = 0; i < CB; ++i) RB[i] = bld16(rb_, vb[i], (unsigned)((kcur) + 128) * 2u); } \
    _Pragma("unroll") for (int kk = 0; kk < 2; ++kk) {                                               \
      bf16x8 af[MT], bfr[NTL];                                                                       \
      _Pragma("unroll") for (int m = 0; m < MT; ++m) af[m] = *(const bf16x8*)(sAimg + (wm * (BM / WGM) + m * 16 + (lane & 15)) * lda_s + (kcur) + kk * 32 + (lane >> 4) * 8); \
      _Pragma("unroll") for (int n = 0; n < NTL; ++n) bfr[n] = *(const bf16x8*)(sB + (wn * (BN / WGN) + n * 16 + (lane & 15)) * LDS_STRIDE + kk * 32 + (lane >> 4) * 8); \
      _Pragma("unroll") for (int m = 0; m < MT; ++m)                                                 \
        _Pragma("unroll") for (int n = 0; n < NTL; ++n) acc[m][n] = MFMA16(af[m], bfr[n], acc[m][n]); \
    }                                                                                                \
  }
#pragma unroll
  for (int i = 0; i < CB; ++i) rb0[i] = bld16(rb_, vb[i], 0u);
#pragma unroll
  for (int i = 0; i < CB; ++i) rb1[i] = bld16(rb_, vb[i], 128u);
#pragma unroll 1
  for (int k0 = 0; k0 < K; k0 += 128) {
    GA_STEP(rb0, k0)
    GA_STEP(rb1, k0 + 64)
  }
  MFMA_FENCE();
#undef GA_STEP
}

DI void gemm_128x256(const u16* A, int lda, const u16* B, int ldb, int K, f32x4 (&acc)[4][8], u16* sA, u16* sB) {
  const int tid = ltid(), lane = tid & 63, wid = tid >> 6, wm = wid >> 1, wn = wid & 1;
  const __amdgpu_buffer_rsrc_t ra_ = mk_rsrc(A), rb_ = mk_rsrc(B);
  u32x4 ra[4], rb[8];
  unsigned va[4], vb[8];
  const int cc0 = (tid & 7) * 8;
#pragma unroll
  for (int i = 0; i < 4; ++i) { const int r = (tid + i * NTHR) >> 3; va[i] = (unsigned)(r * lda + cc0) * 2u; }
#pragma unroll
  for (int i = 0; i < 8; ++i) { const int r = (tid + i * NTHR) >> 3; vb[i] = (unsigned)(r * ldb + cc0) * 2u; }
#pragma unroll
  for (int i = 0; i < 4; ++i) ra[i] = bld16(ra_, va[i], 0u);
#pragma unroll
  for (int i = 0; i < 8; ++i) rb[i] = bld16(rb_, vb[i], 0u);
#pragma unroll
  for (int k0 = 0; k0 < K; k0 += 64) {
    __syncthreads();
#pragma unroll
    for (int i = 0; i < 4; ++i) { const int r = (tid + i * NTHR) >> 3; *(u32x4*)(sA + r * LDS_STRIDE + cc0) = ra[i]; }
#pragma unroll
    for (int i = 0; i < 8; ++i) { const int r = (tid + i * NTHR) >> 3; *(u32x4*)(sB + r * LDS_STRIDE + cc0) = rb[i]; }
    __syncthreads();
    if (k0 + 64 < K) {
      const unsigned ko = (unsigned)(k0 + 64) * 2u;
#pragma unroll
      for (int i = 0; i < 4; ++i) ra[i] = bld16(ra_, va[i], ko);
#pragma unroll
      for (int i = 0; i < 8; ++i) rb[i] = bld16(rb_, vb[i], ko);
    }
#pragma unroll
    for (int kk = 0; kk < 2; ++kk) {
      bf16x8 af[4];
#pragma unroll
      for (int m = 0; m < 4; ++m) af[m] = *(const bf16x8*)(sA + (wm * 64 + m * 16 + (lane & 15)) * LDS_STRIDE + kk * 32 + (lane >> 4) * 8);
#pragma unroll
      for (int nh = 0; nh < 2; ++nh) {
        bf16x8 bfr[4];
#pragma unroll
        for (int n = 0; n < 4; ++n) bfr[n] = *(const bf16x8*)(sB + (wn * 128 + (nh * 4 + n) * 16 + (lane & 15)) * LDS_STRIDE + kk * 32 + (lane >> 4) * 8);
#pragma unroll
        for (int m = 0; m < 4; ++m)
#pragma unroll
          for (int n = 0; n < 4; ++n) acc[m][nh * 4 + n] = MFMA16(af[m], bfr[n], acc[m][nh * 4 + n]);
      }
    }
  }
  MFMA_FENCE();
}

template <int MT, int NTL>
DI void zero_acc(f32x4 (&acc)[MT][NTL]) {
#pragma unroll
  for (int m = 0; m < MT; ++m)
#pragma unroll
    for (int n = 0; n < NTL; ++n) acc[m][n] = (f32x4){0.f, 0.f, 0.f, 0.f};
}

DI void tile_put(u16* sT, int stride, int r, int c, float v) { sT[r * stride + c] = f2bf(v); }
DI void tile_flush128(const u16* sT, u16* dst, int ld, int row0, int col0) {
  const int tid = ltid();
#pragma unroll
  for (int i = 0; i < 8; ++i) {
    const int id = tid + i * NTHR, r = id >> 4, c = (id & 15) * 8;
    *(u32x4*)(dst + (size_t)(row0 + r) * ld + col0 + c) = *(const u32x4*)(sT + r * 136 + c);
  }
}
DI void tile_out_128(const f32x4 (&v)[4][4], u16* dst, int ld, int row0, int col0) {
  u16* sT = (u16*)smem;
  const int lane = ltid() & 63, wid = ltid() >> 6, wm = wid >> 1, wn = wid & 1;
  __syncthreads();
#pragma unroll
  for (int m = 0; m < 4; ++m)
#pragma unroll
    for (int n = 0; n < 4; ++n)
#pragma unroll
      for (int j = 0; j < 4; ++j) tile_put(sT, 136, wm * 64 + m * 16 + (lane >> 4) * 4 + j, wn * 64 + n * 16 + (lane & 15), v[m][n][j]);
  __syncthreads();
  tile_flush128(sT, dst, ld, row0, col0);
}

DI int dst_row_map(int n, int mode) {
  if (mode == 0) return n;
  if (mode == 1) {
    if (n < 512 || n >= 1536) return n;
    int sec = n & ~127, d = n & 127;
    int xh = d >> 6, idx = d & 63;
    return sec + (((idx >> 4) * 2 + xh) << 4) + (idx & 15);
  }
  if (mode == 2) return (n >> 4) * 32 + (n & 15);
  return (n >> 4) * 32 + 16 + (n & 15);
}
DI void transpose_tile(const float* src, int lds_, int k0, int n0, u16* dst, int ldd,
                       const float* gain, int mode, float scale) {
  float* t = (float*)smem;
  const int tid = ltid(), ty = tid >> 4, tx = tid & 15;
  __syncthreads();
#pragma unroll
  for (int i = 0; i < 4; ++i) {
    int k = ty + 16 * i;
    float4 v = *(const float4*)(src + (size_t)(k0 + k) * lds_ + n0 + tx * 4);
    float g = gain ? gain[k0 + k] : 1.0f;
    t[k * 65 + tx * 4 + 0] = v.x * g; t[k * 65 + tx * 4 + 1] = v.y * g;
    t[k * 65 + tx * 4 + 2] = v.z * g; t[k * 65 + tx * 4 + 3] = v.w * g;
  }
  __syncthreads();
  const int nl = tid >> 2, ks = (tid & 3) * 16;
  const int n = n0 + nl;
  float sc = scale;
  if (mode == 1) sc = (n >= 512 && n < 1024) ? 0.08838834764831845f : 1.0f;
  unsigned w[8];
#pragma unroll
  for (int i = 0; i < 8; ++i) w[i] = pack2(t[(ks + 2 * i) * 65 + nl] * sc, t[(ks + 2 * i + 1) * 65 + nl] * sc);
  u16* d = dst + (size_t)dst_row_map(n, mode) * ldd + k0 + ks;
  *(u32x4*)d = (u32x4){w[0], w[1], w[2], w[3]};
  *(u32x4*)(d + 8) = (u32x4){w[4], w[5], w[6], w[7]};
}

DI void rownorm_task(const float* src, float* xs_out, u16* dst) {
  const int lane = ltid() & 63;
  float4 v[4];
  float ss = 0.f;
#pragma unroll
  for (int i = 0; i < 4; ++i) {
    v[i] = *(const float4*)(src + i * 256 + lane * 4);
    ss += v[i].x * v[i].x + v[i].y * v[i].y + v[i].z * v[i].z + v[i].w * v[i].w;
  }
  ss = red64(ss);
  const float r = rsqrtf(ss * (1.0f / 1024.0f) + EPSF);
  if (xs_out && lane == 0) *xs_out = 1.0f / r;
#pragma unroll
  for (int i = 0; i < 4; ++i) {
    u32x2 o; o.x = pack2(v[i].x * r, v[i].y * r); o.y = pack2(v[i].z * r, v[i].w * r);
    *(u32x2*)(dst + i * 256 + lane * 4) = o;
  }
}

DI void phase_prep(const Params& p, unsigned* ctr) {
  char* ws = p.ws;
  const int tid = ltid();
  constexpr int T_W = 16384, T_X = NTOK / 4, T_M = 256, T_S = 128;
  constexpr int TOT = T_W + T_X + T_M + T_S;
  for (int t = blockIdx.x; t < TOT; t += gridDim.x) {
    if (t < T_W) {
      const int l = t >> 12; int q = t & 4095;
      u16* wl = (u16*)(ws + OFF_W) + (size_t)l * W_LAYER;
      if (q < 640) {
        transpose_tile(p.w_in + (size_t)l * 1024 * 2560, 2560, (q / 40) * 64, (q % 40) * 64, wl + W_IN, 1024, p.mix_pre + l * 1024, 1, 1.0f);
      } else if ((q -= 640) < 64) {
        transpose_tile(p.w_glu + (size_t)l * 512 * 512, 512, (q / 8) * 64, (q % 8) * 64, wl + W_GLU, 512, nullptr, 0, 1.0f);
      } else if ((q -= 64) < 256) {
        const int k0 = (q / 16) * 64;
        const float* gain = (k0 < 512) ? (p.s5_onorm + l * 512) : (p.ret_onorm + l * 512 - 512);
        transpose_tile(p.w_out + (size_t)l * 1024 * 1024, 1024, k0, (q % 16) * 64, wl + W_OUT, 1024, gain, 0, 1.0f);
      } else if ((q -= 256) < 256) {
        transpose_tile(p.w_cq + (size_t)l * 1024 * 1024, 1024, (q / 16) * 64, (q % 16) * 64, wl + W_CQ, 1024, p.xa_pre + l * 1024, 0, 0.0625f);
      } else if ((q -= 256) < 256) {
        transpose_tile(p.w_ck + (size_t)l * 1024 * 1024, 1024, (q / 16) * 64, (q % 16) * 64, wl + W_CK, 1024, p.mem_norm + l * 1024, 0, 1.0f);
      } else if ((q -= 256) < 256) {
        transpose_tile(p.w_cv + (size_t)l * 1024 * 1024, 1024, (q / 16) * 64, (q % 16) * 64, wl + W_CV, 1024, p.mem_norm + l * 1024, 0, 1.0f);
      } else if ((q -= 256) < 256) {
        transpose_tile(p.w_co + (size_t)l * 1024 * 1024, 1024, (q / 16) * 64, (q % 16) * 64, wl + W_CO, 1024, nullptr, 0, 1.0f);
      } else if ((q -= 256) < 704) {
        transpose_tile(p.w_gate + (size_t)l * 1024 * 2816, 2816, (q / 44) * 64, (q % 44) * 64, wl + W_GU, 1024, p.ffn_pre + l * 1024, 2, 1.0f);
      } else if ((q -= 704) < 704) {
        transpose_tile(p.w_up + (size_t)l * 1024 * 2816, 2816, (q / 44) * 64, (q % 44) * 64, wl + W_GU, 1024, p.ffn_pre + l * 1024, 3, 1.0f);
      } else {
        q -= 704;
        transpose_tile(p.w_down + (size_t)l * 2816 * 1024, 1024, (q / 16) * 64, (q % 16) * 64, wl + W_DN, 2816, nullptr, 0, 1.0f);
      }
    } else if (t < T_W + T_X) {
      const int row = (t - T_W) * 4 + (tid >> 6);
      const float* src = (row < PROWS) ? p.x_prompt + (size_t)row * 1024 : p.x_sample + (size_t)(row - PROWS) * 1024;
      rownorm_task(src, (float*)(ws + OFF_RSQ) + row, (u16*)(ws + OFF_HB) + (size_t)row * 1024);
    } else if (t < T_W + T_X + T_M) {
      const int row = (t - T_W - T_X) * 4 + (tid >> 6);
      rownorm_task(p.mem_prompt + (size_t)row * 1024, nullptr, (u16*)(ws + OFF_MEMB) + (size_t)row * 1024);
    } else {
      const int lg = t - T_W - T_X - T_M, l = lg >> 5, g = lg & 31;
      char* sp = ws + OFF_S5P + (size_t)l * S5P_LAYER;
      u16* bbt = (u16*)(sp + S5P_BBT) + g * 2048;
      u16* cm = (u16*)(sp + S5P_CM) + g * 2048;
      float* ab = (float*)(sp + S5P_ABAR) + g * 128;
      const float dt = __expf(p.log_step[l * 32 + g]);
      for (int e = tid; e < 1024; e += NTHR) {
        const int pp = e >> 4, h = e & 15;
        const float lr = p.lam_re[(l * 32 + g) * 64 + pp], li = p.lam_im[(l * 32 + g) * 64 + pp];
        const float ar = lr * dt, ai = li * dt, mag = expf(ar);
        float sn_, cs_; sincos_cw(ai, &sn_, &cs_);
        const float abr = mag * cs_, abi = mag * sn_;
        const float den = lr * lr + li * li, nr = abr - 1.0f, ni = abi;
        const float fr = (nr * lr + ni * li) / den, fi = (ni * lr - nr * li) / den;
        const float br = p.b_re[((size_t)(l * 32 + g) * 64 + pp) * 16 + h], bi = p.b_im[((size_t)(l * 32 + g) * 64 + pp) * 16 + h];
        bbt[pp * 16 + h] = f2bf(fr * br - fi * bi);
        bbt[(64 + pp) * 16 + h] = f2bf(fr * bi + fi * br);
        if (h == 0) { ab[pp * 2] = abr; ab[pp * 2 + 1] = abi; }
        const int hh = e >> 6, kk = e & 63;
        cm[hh * 128 + kk] = f2bf(p.c_re[((size_t)(l * 32 + g) * 16 + hh) * 64 + kk]);
        cm[hh * 128 + 64 + kk] = f2bf(-p.c_im[((size_t)(l * 32 + g) * 16 + hh) * 64 + kk]);
      }
    }
  }
}

DI void memkv_tile(const Params& p, int t) {
  char* ws = p.ws;
  const int l = t >> 7, rt = (t >> 4) & 7, ct = t & 15;
  const int isv = ct >> 3, col0 = (ct & 7) * 128, row0 = rt * 128;
  const u16* A = (const u16*)(ws + OFF_MEMB) + (size_t)row0 * 1024;
  const u16* B = (const u16*)(ws + OFF_W) + (size_t)l * W_LAYER + (isv ? W_CV : W_CK) + (size_t)col0 * 1024;
  f32x4 acc[4][4];
  zero_acc(acc);
  u16* sA = (u16*)smem; u16* sB = sA + 128 * LDS_STRIDE;
  gemm_mainloop<128, 128, 2, 2>(A, 1024, B, 1024, 1024, 1 << 30, acc, sA, sB, NoHook());
  const int lane = ltid() & 63, wid = ltid() >> 6, wm = wid >> 1, wn = wid & 1;
  float* of = p.out + (isv ? O_MV_P : O_MK_P) + (size_t)l * 1024 * 1024;
  u16* kx = (u16*)(ws + OFF_KXP) + (size_t)l * 1024 * 1024;
  u16* vx = (u16*)(ws + OFF_VTXP) + (size_t)l * 1024 * 1024;
#pragma unroll
  for (int m = 0; m < 4; ++m)
#pragma unroll
    for (int n = 0; n < 4; ++n) {
      const int r = row0 + wm * 64 + m * 16 + (lane >> 4) * 4, c = col0 + wn * 64 + n * 16 + (lane & 15);
#pragma unroll
      for (int j = 0; j < 4; ++j) of[(size_t)(r + j) * 1024 + c] = acc[m][n][j];
      if (!isv) {
#pragma unroll
        for (int j = 0; j < 4; ++j) kx[(size_t)(r + j) * 1024 + c] = f2bf(acc[m][n][j]);
      } else {
        const int b = r >> 8, mm = r & 255, h = c >> 8, d = c & 255;
        u32x2 o; o.x = pack2(acc[m][n][0], acc[m][n][1]); o.y = pack2(acc[m][n][2], acc[m][n][3]);
        *(u32x2*)(vx + ((size_t)((b * 4 + h) * 256 + d)) * 256 + mm) = o;
      }
    }
}
DI void cache_task(const Params& p, int l, int t) {
  char* ws = p.ws;
  if (t < 1024) {
    const float* src = p.cmk + (size_t)l * 16 * 256 * 1024 + (size_t)t * 4096 + ltid() * 16;
    u16* dst = (u16*)(ws + OFF_KXS) + (size_t)t * 4096 + ltid() * 16;
    float4 a = *(const float4*)src, b = *(const float4*)(src + 4), c = *(const float4*)(src + 8), d = *(const float4*)(src + 12);
    *(u32x4*)dst = (u32x4){pack2(a.x, a.y), pack2(a.z, a.w), pack2(b.x, b.y), pack2(b.z, b.w)};
    *(u32x4*)(dst + 8) = (u32x4){pack2(c.x, c.y), pack2(c.z, c.w), pack2(d.x, d.y), pack2(d.z, d.w)};
  } else {
    t -= 1024;
    const int bh = t >> 4, q = t & 15, b = bh >> 2, h = bh & 3;
    const float* src = p.cmv + ((size_t)(l * 16 + b) * 256) * 1024 + h * 256;
    u16* dst = (u16*)(ws + OFF_VTXS) + (size_t)bh * 256 * 256;
    transpose_tile(src, 1024, (q >> 2) * 64, (q & 3) * 64, dst, 256, nullptr, 0, 1.0f);
  }
}

DI void g1_tile(const Params& p, int l, int t) {
  char* ws = p.ws;
  const int rt = t / 20, ct = t % 20;
  const int row0 = rt * 128, col0 = ct * 128;
  const u16* A = (const u16*)(ws + OFF_HB) + (size_t)row0 * 1024;
  const u16* B = (const u16*)(ws + OFF_W) + (size_t)l * W_LAYER + W_IN + (size_t)col0 * 1024;
  f32x4 acc[4][4];
  zero_acc(acc);
  u16* sA = (u16*)smem; u16* sB = sA + 128 * LDS_STRIDE;
  gemm_mainloop<128, 128, 2, 2>(A, 1024, B, 1024, 1024, 1 << 30, acc, sA, sB, NoHook());
  const int lane = ltid() & 63, wid = ltid() >> 6, wm = wid >> 1, wn = wid & 1;
  char* arena = ws + OFF_ARENA;
  const int sec = ct >> 2, hd = ct & 3;
  const bool samp = row0 >= PROWS;
  if (sec == 0 || sec == 4) {
    tile_out_128(acc, (u16*)(arena + (sec == 0 ? 0 : 3) * SLOT), 512, row0, hd * 128);
  } else if (sec == 3) {
    u16* vt = (u16*)(arena + 4 * SLOT);
#pragma unroll
    for (int m = 0; m < 4; ++m)
#pragma unroll
      for (int n = 0; n < 4; ++n) {
        const int r = row0 + wm * 64 + m * 16 + (lane >> 4) * 4, e = wn * 64 + n * 16 + (lane & 15);
        u32x2 o; o.x = pack2(acc[m][n][0], acc[m][n][1]); o.y = pack2(acc[m][n][2], acc[m][n][3]);
        size_t off;
        if (!samp) { const int b = r >> 13, tt = r & 8191; off = ((size_t)((b * 4 + hd) * 128 + e)) * SEQ + tt; }
        else { const int sr = r - PROWS, b = sr >> 4, tt = sr & 15; off = (size_t)16 * 128 * SEQ + ((size_t)((b * 4 + hd) * 128 + e)) * 16 + tt; }
        *(u32x2*)(vt + off) = o;
      }
  } else {
    u16* dst = (u16*)(arena + (sec == 1 ? 1 : 2) * SLOT);
    u16* ktd = (u16*)(arena + 5 * SLOT);
    const float gl2 = gamma_l2(hd);
    u16* sT = (u16*)smem;
    __syncthreads();
#pragma unroll
    for (int m = 0; m < 4; ++m)
#pragma unroll
      for (int np = 0; np < 2; ++np) {
        const int r = row0 + wm * 64 + m * 16 + (lane >> 4) * 4;
        const int idx = (wn * 2 + np) * 16 + (lane & 15);
        const float inv = exp2f(-(float)idx * (13.287712379549449f / 64.0f));
        float o1[4], o2[4];
#pragma unroll
        for (int j = 0; j < 4; ++j) {
          const int rr = r + j;
          const int pos = samp ? (1024 + ((rr - PROWS) & 15)) : (rr & 8191);
          float sn, cs;
          sincos_cw((float)pos * inv, &sn, &cs);
          const float x1 = acc[m][2 * np][j], x2 = acc[m][2 * np + 1][j];
          o1[j] = x1 * cs - x2 * sn; o2[j] = x1 * sn + x2 * cs;
          tile_put(sT, 136, rr - row0, idx, o1[j]);
          tile_put(sT, 136, rr - row0, 64 + idx, o2[j]);
        }
        if (sec == 2) {
          size_t off1; int tloc;
          if (!samp) { const int b = r >> 13, tt = r & 8191; off1 = ((size_t)((b * 4 + hd) * 128 + idx)) * SEQ + tt; tloc = 63 - (tt & 63); }
          else { const int sr = r - PROWS, b = sr >> 4, tt = sr & 15; off1 = (size_t)16 * 128 * SEQ + ((size_t)((b * 4 + hd) * 128 + idx)) * 16 + tt; tloc = 15 - tt; }
          const size_t off2 = off1 + (size_t)64 * (samp ? 16 : SEQ);
          float dc[4];
#pragma unroll
          for (int j = 0; j < 4; ++j) dc[j] = exp2f(gl2 * (float)(tloc - j));
          u32x2 a, b2;
          a.x = pack2(o1[0] * dc[0], o1[1] * dc[1]); a.y = pack2(o1[2] * dc[2], o1[3] * dc[3]);
          b2.x = pack2(o2[0] * dc[0], o2[1] * dc[1]); b2.y = pack2(o2[2] * dc[2], o2[3] * dc[3]);
          *(u32x2*)(ktd + off1) = a;
          *(u32x2*)(ktd + off2) = b2;
        }
      }
    __syncthreads();
    tile_flush128(sT, dst, 512, row0, hd * 128);
  }
}

struct DecayHook {
  float g64;
  template <class T> DI void operator()(int k0, T& acc) const {
    if (k0 + 64 < 512) {
#pragma unroll
      for (int m = 0; m < 4; ++m)
#pragma unroll
        for (int n = 0; n < 4; ++n) acc[m][n] *= g64;
    }
  }
};
DI void ret_local_task(const Params& p, int t) {
  char* ws = p.ws;
  char* arena = ws + OFF_ARENA;
  const int bh = t >> 4, sc = t & 15, h = bh & 3;
  const u16* A = (const u16*)(arena + 5 * SLOT) + (size_t)bh * 128 * SEQ + sc * 512;
  const u16* B = (const u16*)(arena + 4 * SLOT) + (size_t)bh * 128 * SEQ + sc * 512;
  f32x4 acc[4][4];
  zero_acc(acc);
  u16* sA = (u16*)smem; u16* sB = sA + 128 * LDS_STRIDE;
  DecayHook hk; hk.g64 = exp2f(gamma_l2(h) * 64.0f);
  gemm_mainloop<128, 128, 2, 2>(A, SEQ, B, SEQ, 512, 1 << 30, acc, sA, sB, hk);
  const int lane = ltid() & 63, wid = ltid() >> 6, wm = wid >> 1, wn = wid & 1;
  float* dst = (float*)(ws + OFF_SLOC) + (size_t)t * 16384;
#pragma unroll
  for (int m = 0; m < 4; ++m)
#pragma unroll
    for (int n = 0; n < 4; ++n) {
      const int r = wm * 64 + m * 16 + (lane >> 4) * 4, c = wn * 64 + n * 16 + (lane & 15);
#pragma unroll
      for (int j = 0; j < 4; ++j) dst[(r + j) * 128 + c] = acc[m][n][j];
    }
}

DI void ret_final_task(const Params& p, int l, int t) {
  char* ws = p.ws;
  char* arena = ws + OFF_ARENA;
  const int tid = ltid(), lane = tid & 63, w = tid >> 6;
  const bool samp = t >= 256;
  int bh, sc, nchunk, C, row_base;
  size_t tr_base; int tr_ld;
  if (!samp) { bh = t >> 4; sc = t & 15; nchunk = 8; C = 64; row_base = (bh >> 2) * SEQ + sc * 512; tr_base = (size_t)bh * 128 * SEQ + sc * 512; tr_ld = SEQ; }
  else { bh = t - 256; sc = 0; nchunk = 1; C = 16; row_base = PROWS + (bh >> 2) * 16; tr_base = (size_t)16 * 128 * SEQ + (size_t)bh * 128 * 16; tr_ld = 16; }
  const int h = bh & 3;
  const float gl2 = gamma_l2(h);
  const float gC = exp2f(gl2 * (float)C);
  const u16* Qg = (const u16*)(arena + 1 * SLOT);
  const u16* Kg = (const u16*)(arena + 2 * SLOT);
  const u16* Gg = (const u16*)(arena + 3 * SLOT);
  const u16* Vt = (const u16*)(arena + 4 * SLOT) + tr_base;
  const u16* Ktd = (const u16*)(arena + 5 * SLOT) + tr_base;
  u16* reto = (u16*)(arena + 7 * SLOT);
  u16* sQ = (u16*)smem;
  u16* sK = sQ + 64 * 144;
  u16* sV = sK + 128 * LDS_STRIDE;
  u16* sS = sV + 128 * LDS_STRIDE;
  float* sR = (float*)(sS + 64 * LDS_STRIDE);

  f32x4 S[8][2];
  if (samp) {
    const float* s0 = p.ret0 + ((size_t)(l * 64 + bh)) * 16384;
#pragma unroll
    for (int mt = 0; mt < 8; ++mt)
#pragma unroll
      for (int nt = 0; nt < 2; ++nt)
#pragma unroll
        for (int j = 0; j < 4; ++j) S[mt][nt][j] = s0[(mt * 16 + (lane >> 4) * 4 + j) * 128 + 32 * w + nt * 16 + (lane & 15)];
  } else {
#pragma unroll
    for (int mt = 0; mt < 8; ++mt)
#pragma unroll
      for (int nt = 0; nt < 2; ++nt) S[mt][nt] = (f32x4){0.f, 0.f, 0.f, 0.f};
    const float g512 = exp2f(gl2 * 512.0f);
    for (int s2 = 0; s2 < sc; ++s2) {
      const float* sl = (const float*)(ws + OFF_SLOC) + ((size_t)(bh * 16 + s2)) * 16384;
#pragma unroll
      for (int mt = 0; mt < 8; ++mt)
#pragma unroll
        for (int nt = 0; nt < 2; ++nt)
#pragma unroll
          for (int j = 0; j < 4; ++j)
            S[mt][nt][j] = S[mt][nt][j] * g512 + ld_sc1_f(sl + (mt * 16 + (lane >> 4) * 4 + j) * 128 + 32 * w + nt * 16 + (lane & 15));
    }
  }
  const u32x4 z4 = (u32x4){0, 0, 0, 0};
  for (int c = 0; c < nchunk; ++c) {
    const int r0 = row_base + c * 64;
    __syncthreads();
#pragma unroll
    for (int i = 0; i < 4; ++i) {
      const int id = tid + i * NTHR, r = id >> 4, cc = (id & 15) * 8;
      u32x4 q4 = z4, k4 = z4;
      if (r < C) {
        q4 = ld_ws16(ws, Qg + (size_t)(r0 + r) * 512 + h * 128 + cc);
        k4 = ld_ws16(ws, Kg + (size_t)(r0 + r) * 512 + h * 128 + cc);
      }
      *(u32x4*)(sQ + r * 144 + cc) = q4;
      *(u32x4*)(sK + r * 144 + cc) = k4;
    }
#pragma unroll
    for (int i = 0; i < 4; ++i) {
      const int id = tid + i * NTHR, r = id >> 3, cc = (id & 7) * 8;
      u32x4 v4 = z4;
      if (cc < C) v4 = ld_ws16(ws, Vt + (size_t)r * tr_ld + c * 64 + cc);
      *(u32x4*)(sV + r * LDS_STRIDE + cc) = v4;
    }
    __syncthreads();
    {
      f32x4 sc4[4];
#pragma unroll
      for (int m = 0; m < 4; ++m) sc4[m] = (f32x4){0.f, 0.f, 0.f, 0.f};
#pragma unroll
      for (int ks = 0; ks < 4; ++ks) {
        const bf16x8 bk = *(const bf16x8*)(sK + (16 * w + (lane & 15)) * 144 + ks * 32 + (lane >> 4) * 8);
#pragma unroll
        for (int m = 0; m < 4; ++m) {
          const bf16x8 aq = *(const bf16x8*)(sQ + (m * 16 + (lane & 15)) * 144 + ks * 32 + (lane >> 4) * 8);
          sc4[m] = MFMA16(aq, bk, sc4[m]);
        }
      }
      MFMA_FENCE();
      const int jc = 16 * w + (lane & 15);
#pragma unroll
      for (int m = 0; m < 4; ++m)
#pragma unroll
        for (int j = 0; j < 4; ++j) {
          const int i = m * 16 + (lane >> 4) * 4 + j;
          const int dd = i > jc ? i - jc : jc - i;
          sS[i * LDS_STRIDE + jc] = f2bf(sc4[m][j] * exp2f(gl2 * (float)dd));
        }
    }
    __syncthreads();
#pragma unroll
    for (int i = 0; i < 4; ++i) {
      const int id = tid + i * NTHR, r = id >> 3, cc = (id & 7) * 8;
      u32x4 v4 = z4;
      if (cc < C) v4 = ld_ws16(ws, Ktd + (size_t)r * tr_ld + c * 64 + cc);
      *(u32x4*)(sK + r * LDS_STRIDE + cc) = v4;
    }
    f32x4 o[4][2];
#pragma unroll
    for (int m = 0; m < 4; ++m) { o[m][0] = (f32x4){0.f, 0.f, 0.f, 0.f}; o[m][1] = o[m][0]; }
#pragma unroll
    for (int a = 0; a < 4; ++a) {
      bf16x8 bs[2];
#pragma unroll
      for (int nt = 0; nt < 2; ++nt) {
        u32x4 u;
        u.x = pack2(S[2 * a][nt][0], S[2 * a][nt][1]); u.y = pack2(S[2 * a][nt][2], S[2 * a][nt][3]);
        u.z = pack2(S[2 * a + 1][nt][0], S[2 * a + 1][nt][1]); u.w = pack2(S[2 * a + 1][nt][2], S[2 * a + 1][nt][3]);
        bs[nt] = __builtin_bit_cast(bf16x8, u);
      }
#pragma unroll
      for (int m = 0; m < 4; ++m) {
        const u16* qp = sQ + (m * 16 + (lane & 15)) * 144 + (lane >> 4) * 4;
        const u32x2 lo = *(const u32x2*)(qp + (2 * a) * 16);
        const u32x2 hi = *(const u32x2*)(qp + (2 * a + 1) * 16);
        const bf16x8 aq = __builtin_bit_cast(bf16x8, ((u32x4){lo.x, lo.y, hi.x, hi.y}));
        o[m][0] = MFMA16(aq, bs[0], o[m][0]);
        o[m][1] = MFMA16(aq, bs[1], o[m][1]);
      }
      __builtin_amdgcn_sched_barrier(0);
    }
    MFMA_FENCE();
#pragma unroll
    for (int m = 0; m < 4; ++m)
#pragma unroll
      for (int j = 0; j < 4; ++j) {
        const int i = m * 16 + (lane >> 4) * 4 + j;
        const float f = exp2f(gl2 * (float)(i + 1));
        o[m][0][j] *= f;
        o[m][1][j] *= f;
      }
#pragma unroll
    for (int ks = 0; ks < 2; ++ks) {
      bf16x8 bv[2];
#pragma unroll
      for (int nt = 0; nt < 2; ++nt) bv[nt] = *(const bf16x8*)(sV + (32 * w + nt * 16 + (lane & 15)) * LDS_STRIDE + ks * 32 + (lane >> 4) * 8);
#pragma unroll
      for (int m = 0; m < 4; ++m) {
        const bf16x8 as = *(const bf16x8*)(sS + (m * 16 + (lane & 15)) * LDS_STRIDE + ks * 32 + (lane >> 4) * 8);
        o[m][0] = MFMA16(as, bv[0], o[m][0]);
        o[m][1] = MFMA16(as, bv[1], o[m][1]);
      }
      __builtin_amdgcn_sched_barrier(0);
    }
    MFMA_FENCE();
#pragma unroll
    for (int m = 0; m < 4; ++m)
#pragma unroll
      for (int j = 0; j < 4; ++j) {
        float v = o[m][0][j] * o[m][0][j] + o[m][1][j] * o[m][1][j];
        v = red16(v);
        if ((lane & 15) == 0) sR[w * 64 + m * 16 + (lane >> 4) * 4 + j] = v;
      }
    __syncthreads();
#pragma unroll
    for (int m = 0; m < 4; ++m)
#pragma unroll
      for (int j = 0; j < 4; ++j) {
        const int i = m * 16 + (lane >> 4) * 4 + j;
        if (i < C) {
          const float ss = sR[i] + sR[64 + i] + sR[128 + i] + sR[192 + i];
          const float rs = rsqrtf(ss * (1.0f / 128.0f) + EPSF);
#pragma unroll
          for (int nt = 0; nt < 2; ++nt) {
            const int e = 32 * w + nt * 16 + (lane & 15);
            const float g = bf2f(ld_sc1_2(Gg + (size_t)(r0 + i) * 512 + h * 128 + e));
            reto[(size_t)(r0 + i) * 512 + h * 128 + e] = f2bf(o[m][nt][j] * rs * siluf_(g));
          }
        }
      }
#pragma unroll
    for (int mt = 0; mt < 8; ++mt) { S[mt][0] *= gC; S[mt][1] *= gC; }
#pragma unroll 1
    for (int ks = 0; ks < 2; ++ks) {
      bf16x8 bv[2];
#pragma unroll
      for (int nt = 0; nt < 2; ++nt) bv[nt] = *(const bf16x8*)(sV + (32 * w + nt * 16 + (lane & 15)) * LDS_STRIDE + ks * 32 + (lane >> 4) * 8);
#pragma unroll
      for (int mt = 0; mt < 8; ++mt) {
        const bf16x8 ak = *(const bf16x8*)(sK + (mt * 16 + (lane & 15)) * LDS_STRIDE + ks * 32 + (lane >> 4) * 8);
        S[mt][0] = MFMA16(ak, bv[0], S[mt][0]);
        S[mt][1] = MFMA16(ak, bv[1], S[mt][1]);
      }
    }
    MFMA_FENCE();
  }
  if (samp || sc == 15) {
    float* so = samp ? (p.out + O_RET_S + ((size_t)(l * 64 + bh)) * 16384) : (p.out + O_RET_P + ((size_t)(l * 16 + bh)) * 16384);
#pragma unroll
    for (int mt = 0; mt < 8; ++mt)
#pragma unroll
      for (int nt = 0; nt < 2; ++nt)
#pragma unroll
        for (int j = 0; j < 4; ++j) so[(mt * 16 + (lane >> 4) * 4 + j) * 128 + 32 * w + nt * 16 + (lane & 15)] = S[mt][nt][j];
  }
}

DI void s5_task(const Params& p, int l, int t, int mode) {
  char* ws = p.ws;
  char* arena = ws + OFF_ARENA;
  const int tid = ltid(), lane = tid & 63, w = tid >> 6;
  const bool samp = t >= 512;
  int b, lc, g, row_base, nsub;
  if (!samp) { b = t >> 7; lc = (t >> 3) & 15; g = (t & 7) * 4 + w; row_base = b * SEQ + lc * 512; nsub = 32; }
  else { const int q = t - 512; b = q >> 3; lc = 0; g = (q & 7) * 4 + w; row_base = PROWS + b * 16; nsub = 1; }
  const char* sp = ws + OFF_S5P + (size_t)l * S5P_LAYER;
  const u16* bbt = (const u16*)(sp + S5P_BBT) + g * 2048;
  const u16* cm = (const u16*)(sp + S5P_CM) + g * 2048;
  const float* ab = (const float*)(sp + S5P_ABAR) + g * 128;
  const u16* U = (const u16*)(arena + 0 * SLOT);
  u16* Z = (u16*)(arena + 6 * SLOT);
  float* bu = (float*)(smem + w * 13056);
  u16* xs = (u16*)(smem + w * 13056 + 8448);
  const float ar = ld_sc1_f(ab + lane * 2), ai = ld_sc1_f(ab + lane * 2 + 1);
  const int slab = lane >> 4;
  const u32x4 z4 = (u32x4){0, 0, 0, 0};
  bf16x8 Bf[8], Cf[4];
#pragma unroll
  for (int nt = 0; nt < 8; ++nt) {
    u32x4 u = z4;
    if (slab < 2) u = ld_ws16(ws, bbt + (nt * 16 + (lane & 15)) * 16 + slab * 8);
    Bf[nt] = __builtin_bit_cast(bf16x8, u);
  }
#pragma unroll
  for (int ks = 0; ks < 4; ++ks) Cf[ks] = __builtin_bit_cast(bf16x8, ld_ws16(ws, cm + (lane & 15) * 128 + ks * 32 + slab * 8));
  const float Dh = p.s5_d[(l * 32 + g) * 16 + (lane & 15)];
  float xr = 0.f, xi = 0.f;
  if (samp) {
    xr = p.s5re0[((size_t)(l * 16 + b) * 32 + g) * 64 + lane];
    xi = p.s5im0[((size_t)(l * 16 + b) * 32 + g) * 64 + lane];
  } else if (mode == 1 && lc > 0) {
    float pr = ar, pi = ai;
#pragma unroll
    for (int s = 0; s < 9; ++s) { const float nr = pr * pr - pi * pi, ni = 2.f * pr * pi; pr = nr; pi = ni; }
    const float* el = (const float*)(ws + OFF_ELOC);
    for (int c2 = 0; c2 < lc; ++c2) {
      const float er = ld_sc1_f(el + (((size_t)(b * 16 + c2) * 32 + g) * 64 + lane) * 2), ei = ld_sc1_f(el + (((size_t)(b * 16 + c2) * 32 + g) * 64 + lane) * 2 + 1);
      const float nr = pr * xr - pi * xi + er, ni = pr * xi + pi * xr + ei;
      xr = nr; xi = ni;
    }
  }
  u16* usm = (u16*)(smem + 52224 + w * 512);
  const u16* up = U + (size_t)(row_base + (lane & 15)) * 512 + g * 16 + (slab & 1) * 8;
  u32x4 ua = ld_ws16(ws, up);
  for (int sub = 0; sub < nsub; ++sub) {
    const int r0 = row_base + sub * 16;
    u32x4 un = z4;
    if (sub + 1 < nsub) un = ld_ws16(ws, up + (size_t)(sub + 1) * 16 * 512);
    if (slab >= 2) ua = z4;
    const bf16x8 Af = __builtin_bit_cast(bf16x8, ua);
    __syncthreads();
    if (mode == 1 && slab < 2) *(u32x4*)(usm + (lane & 15) * 16 + slab * 8) = ua;
    f32x4 a8[8];
#pragma unroll
    for (int nt = 0; nt < 8; ++nt) a8[nt] = MFMA16(Af, Bf[nt], ((f32x4){0.f, 0.f, 0.f, 0.f}));
    __builtin_amdgcn_sched_barrier(0);
    asm volatile("s_nop 15\n\ts_nop 15\n\ts_nop 15" ::: "memory");
    __builtin_amdgcn_sched_barrier(0);
#pragma unroll
    for (int nt = 0; nt < 8; ++nt) {
#pragma unroll
      for (int j = 0; j < 4; ++j) bu[(slab * 4 + j) * 132 + nt * 16 + (lane & 15)] = a8[nt][j];
    }
    __syncthreads();
#pragma unroll
    for (int tt = 0; tt < 16; ++tt) {
      const float br = bu[tt * 132 + lane], bi = bu[tt * 132 + 64 + lane];
      const float nr = ar * xr - ai * xi + br, ni = ar * xi + ai * xr + bi;
      xr = nr; xi = ni;
      if (mode == 1) { xs[tt * 144 + lane] = f2bf(xr); xs[tt * 144 + 64 + lane] = f2bf(xi); }
    }
    if (mode == 1) {
      __syncthreads();
      f32x4 y = (f32x4){0.f, 0.f, 0.f, 0.f};
#pragma unroll
      for (int ks = 0; ks < 4; ++ks) {
        const bf16x8 ax = *(const bf16x8*)(xs + (lane & 15) * 144 + ks * 32 + slab * 8);
        y = MFMA16(ax, Cf[ks], y);
      }
      __builtin_amdgcn_sched_barrier(0);
      asm volatile("s_nop 15\n\ts_nop 15" ::: "memory");
      __builtin_amdgcn_sched_barrier(0);
#pragma unroll
      for (int j = 0; j < 4; ++j) {
        const int rr = r0 + slab * 4 + j, cc = g * 16 + (lane & 15);
        const float u = bf2f(usm[(slab * 4 + j) * 16 + (lane & 15)]);
        Z[(size_t)rr * 512 + cc] = f2bf(geluf_(y[j] + Dh * u));
      }
    }
    ua = un;
  }
  if (mode == 0) {
    float* el = (float*)(ws + OFF_ELOC);
    el[(((size_t)(b * 16 + lc) * 32 + g) * 64 + lane) * 2] = xr;
    el[(((size_t)(b * 16 + lc) * 32 + g) * 64 + lane) * 2 + 1] = xi;
  } else if (samp) {
    p.out[O_S5RE_S + ((size_t)(l * 16 + b) * 32 + g) * 64 + lane] = xr;
    p.out[O_S5IM_S + ((size_t)(l * 16 + b) * 32 + g) * 64 + lane] = xi;
  } else if (lc == 15) {
    p.out[O_S5RE_P + ((size_t)(l * 4 + b) * 32 + g) * 64 + lane] = xr;
    p.out[O_S5IM_P + ((size_t)(l * 4 + b) * 32 + g) * 64 + lane] = xi;
  }
}

DI void glu_tile(const Params& p, int l, int t) {
  char* ws = p.ws;
  char* arena = ws + OFF_ARENA;
  const int rt = t >> 2, ct = t & 3, row0 = rt * 128, col0 = ct * 128;
  const u16* Zb = (const u16*)(arena + 6 * SLOT);
  const u16* A = Zb + (size_t)row0 * 512;
  const u16* B = (const u16*)(ws + OFF_W) + (size_t)l * W_LAYER + W_GLU + (size_t)col0 * 512;
  f32x4 acc[4][4];
  zero_acc(acc);
  u16* sA = (u16*)smem; u16* sB = sA + 128 * LDS_STRIDE;
  gemm_mainloop<128, 128, 2, 2>(A, 512, B, 512, 512, 1 << 30, acc, sA, sB, NoHook());
  const int lane = ltid() & 63, wid = ltid() >> 6, wm = wid >> 1, wn = wid & 1;
  u16* Z2 = (u16*)(arena + 0 * SLOT);
  float* zsq = (float*)(ws + OFF_ZSQ);
  const float* bg = p.b_glu + l * 512;
  u16* sT = (u16*)smem;
  __syncthreads();
  {
    const int tq = ltid();
#pragma unroll
    for (int i = 0; i < 8; ++i) {
      const int id = tq + i * NTHR, rr = id >> 4, cc = (id & 15) * 8;
      *(u32x4*)(sT + rr * 136 + cc) = ld_ws16(ws, Zb + (size_t)(row0 + rr) * 512 + col0 + cc);
    }
  }
  __syncthreads();
#pragma unroll
  for (int m = 0; m < 4; ++m) {
    float ss[4] = {0.f, 0.f, 0.f, 0.f};
    const int rl = wm * 64 + m * 16 + (lane >> 4) * 4;
#pragma unroll
    for (int n = 0; n < 4; ++n) {
      const int cl = wn * 64 + n * 16 + (lane & 15);
      const float bb = bg[col0 + cl];
#pragma unroll
      for (int j = 0; j < 4; ++j) {
        const float z = bf2f(sT[(rl + j) * 136 + cl]);
        const float z2 = z * sigmoidf_(acc[m][n][j] + bb);
        ss[j] += z2 * z2;
        sT[(rl + j) * 136 + cl] = f2bf(z2);
      }
    }
#pragma unroll
    for (int j = 0; j < 4; ++j) {
      const float v = red16(ss[j]);
      if ((lane & 15) == 0) zsq[(size_t)(ct * 2 + wn) * NTOK + row0 + rl + j] = v;
    }
  }
  __syncthreads();
  tile_flush128(sT, Z2, 512, row0, col0);
}

DI void store_raw_rsq(const f32x4 (&acc)[4][4], u16* raw, float* rsq, int row0, int col0, int ct) {
  tile_out_128(acc, raw, 1024, row0, col0);
}

DI void out_tile(const Params& p, int l, int t) {
  char* ws = p.ws;
  char* arena = ws + OFF_ARENA;
  const int rt = t >> 3, ct = t & 7, row0 = rt * 128, col0 = ct * 128;
  const u16* B = (const u16*)(ws + OFF_W) + (size_t)l * W_LAYER + W_OUT + (size_t)col0 * 1024;
  f32x4 acc[4][4];
  zero_acc(acc);
  u16* sA = (u16*)smem; u16* sB = sA + 128 * LDS_STRIDE;
  float* rsl = (float*)(smem + 40960);
  const float* zsq = (const float*)(ws + OFF_ZSQ);
  {
    const int tq = ltid();
    if (tq < 128) {
      float zs = 0.f;
#pragma unroll
      for (int q = 0; q < 8; ++q) zs += ld_sc1_f(zsq + (size_t)q * NTOK + row0 + tq);
      rsl[tq] = rsqrtf(zs * (1.0f / 512.0f) + EPSF);
    }
  }
  gemm_mainloop<128, 128, 2, 2>((const u16*)(arena + 0 * SLOT) + (size_t)row0 * 512, 512, B, 1024, 512, 1 << 30, acc, sA, sB, NoHook());
  const int lane = ltid() & 63, wid = ltid() >> 6, wm = wid >> 1;
#pragma unroll
  for (int m = 0; m < 4; ++m)
#pragma unroll
    for (int j = 0; j < 4; ++j) {
      const float rs = rsl[wm * 64 + m * 16 + (lane >> 4) * 4 + j];
#pragma unroll
      for (int n = 0; n < 4; ++n) acc[m][n][j] *= rs;
    }
  gemm_mainloop<128, 128, 2, 2>((const u16*)(arena + 7 * SLOT) + (size_t)row0 * 512, 512, B + 512, 1024, 512, 1 << 30, acc, sA, sB, NoHook());
  store_raw_rsq(acc, (u16*)(arena + 1 * SLOT), (float*)(ws + OFF_RSQ), row0, col0, ct);
}

DI void small_tile(const u16* Abase, int lda, const u16* Bbase, int K, u16* dst, int ld, int q) {
  const int row0 = PROWS + (q >> 4) * 64, col0 = (q & 15) * 64;
  f32x4 acc[2][2];
  zero_acc(acc);
  u16* sA = (u16*)smem; u16* sB = sA + 64 * LDS_STRIDE;
  gemm_mainloop<64, 64, 2, 2>(Abase + (size_t)row0 * lda, lda, Bbase + (size_t)col0 * K, K, K, 1 << 30, acc, sA, sB, NoHook());
  const int lane = ltid() & 63, wid = ltid() >> 6, wm = wid >> 1, wn = wid & 1;
#pragma unroll
  for (int m = 0; m < 2; ++m)
#pragma unroll
    for (int n = 0; n < 2; ++n)
#pragma unroll
      for (int j = 0; j < 4; ++j)
        dst[(size_t)(row0 + wm * 32 + m * 16 + (lane >> 4) * 4 + j) * ld + col0 + wn * 32 + n * 16 + (lane & 15)] = f2bf(acc[m][n][j]);
}
DI void tile_out_256(const f32x4 (&v)[4][8], u16* dst, int ld, int row0, int col0) {
  u16* sT = (u16*)smem;
  const int tid = ltid(), lane = tid & 63, wid = tid >> 6, wm = wid >> 1, wn = wid & 1;
  __syncthreads();
#pragma unroll
  for (int m = 0; m < 4; ++m)
#pragma unroll
    for (int n = 0; n < 8; ++n)
#pragma unroll
      for (int j = 0; j < 4; ++j) sT[(wm * 64 + m * 16 + (lane >> 4) * 4 + j) * 264 + wn * 128 + n * 16 + (lane & 15)] = f2bf(v[m][n][j]);
  __syncthreads();
#pragma unroll
  for (int i = 0; i < 16; ++i) {
    const int id = tid + i * NTHR, r = id >> 5, c = (id & 31) * 8;
    *(u32x4*)(dst + (size_t)(row0 + r) * ld + col0 + c) = *(const u32x4*)(sT + r * 264 + c);
  }
}
DI void big_tile(const u16* Abase, int lda, const u16* Bbase, int K, u16* dst, int ld, int t) {
  const int rt = t >> 2, ct = t & 3, row0 = rt * 128, col0 = ct * 256;
  f32x4 acc[4][8];
  zero_acc(acc);
  u16* sA = (u16*)smem; u16* sB = sA + 128 * LDS_STRIDE;
  gemm_128x256(Abase + (size_t)row0 * lda, lda, Bbase + (size_t)col0 * K, K, K, acc, sA, sB);
  tile_out_256(acc, dst, ld, row0, col0);
}

DI void raw_tile(const Params& p, const u16* Abase, int lda, const u16* Bbase, int K, u16* raw, int t) {
  char* ws = p.ws;
  const int rt = t >> 3, ct = t & 7, row0 = rt * 128, col0 = ct * 128;
  f32x4 acc[4][4];
  zero_acc(acc);
  u16* sA = (u16*)smem; u16* sB = sA + 128 * LDS_STRIDE;
  gemm_mainloop<128, 128, 2, 2>(Abase + (size_t)row0 * lda, lda, Bbase + (size_t)col0 * K, K, K, 1 << 30, acc, sA, sB, NoHook());
  store_raw_rsq(acc, raw, (float*)(ws + OFF_RSQ), row0, col0, ct);
}

DI void post_task(const Params& p, const u16* raw, const float* gpost, int t, bool last) {
  char* ws = p.ws;
  const int lane = ltid() & 63, w = ltid() >> 6;
  const int rowb = t * 16 + w * 4;
  u32x2 r2[4][4], h2[4][4];
  float xsc[4];
  float* xsb = (float*)(ws + OFF_RSQ);
#pragma unroll
  for (int k = 0; k < 4; ++k) {
    const int row = rowb + k;
    const u16* rw = raw + (size_t)row * 1024;
    const u16* hbr = (const u16*)(ws + OFF_HB) + (size_t)row * 1024;
    xsc[k] = ld_sc1_f(xsb + row);
#pragma unroll
    for (int i = 0; i < 4; ++i) { const int c = i * 256 + lane * 4; r2[k][i] = ld_sc1_8(rw + c); h2[k][i] = ld_sc1_8(hbr + c); }
  }
  float4 g[4];
#pragma unroll
  for (int i = 0; i < 4; ++i) g[i] = *(const float4*)(gpost + i * 256 + lane * 4);
#pragma unroll
  for (int k = 0; k < 4; ++k) {
    const int row = rowb + k;
    float4 rv[4];
    float s = 0.f;
#pragma unroll
    for (int i = 0; i < 4; ++i) {
      rv[i].x = bf2f((u16)(r2[k][i].x & 0xffff)); rv[i].y = bf2f((u16)(r2[k][i].x >> 16));
      rv[i].z = bf2f((u16)(r2[k][i].y & 0xffff)); rv[i].w = bf2f((u16)(r2[k][i].y >> 16));
      s += rv[i].x * rv[i].x + rv[i].y * rv[i].y + rv[i].z * rv[i].z + rv[i].w * rv[i].w;
    }
    s = red64(s);
    const float rr = rsqrtf(s * (1.0f / 1024.0f) + EPSF);
    const float xscale = xsc[k];
    float4 v[4];
    float ss = 0.f;
#pragma unroll
    for (int i = 0; i < 4; ++i) {
      v[i].x = bf2f((u16)(h2[k][i].x & 0xffff)) * xscale + rv[i].x * rr * g[i].x;
      v[i].y = bf2f((u16)(h2[k][i].x >> 16)) * xscale + rv[i].y * rr * g[i].y;
      v[i].z = bf2f((u16)(h2[k][i].y & 0xffff)) * xscale + rv[i].z * rr * g[i].z;
      v[i].w = bf2f((u16)(h2[k][i].y >> 16)) * xscale + rv[i].w * rr * g[i].w;
      ss += v[i].x * v[i].x + v[i].y * v[i].y + v[i].z * v[i].z + v[i].w * v[i].w;
    }
    ss = red64(ss);
    const float r = rsqrtf(ss * (1.0f / 1024.0f) + EPSF);
    if (lane == 0) xsb[row] = 1.0f / r;
    float* y = p.out + O_Y + (size_t)row * 1024;
    u16* hb = (u16*)(ws + OFF_HB) + (size_t)row * 1024;
#pragma unroll
    for (int i = 0; i < 4; ++i) {
      const int c = i * 256 + lane * 4;
      if (last) *(float4*)(y + c) = v[i];
      u32x2 o; o.x = pack2(v[i].x * r, v[i].y * r); o.y = pack2(v[i].z * r, v[i].w * r);
      *(u32x2*)(hb + c) = o;
    }
  }
}

DI void cq_tile(const Params& p, int l, int t) {
  char* ws = p.ws;
  char* arena = ws + OFF_ARENA;
  const int rt = t >> 3, ct = t & 7, row0 = rt * 128, col0 = ct * 128;
  f32x4 acc[4][4];
  zero_acc(acc);
  u16* sA = (u16*)smem; u16* sB = sA + 128 * LDS_STRIDE;
  gemm_mainloop<128, 128, 2, 2>((const u16*)(ws + OFF_HB) + (size_t)row0 * 1024, 1024,
                                (const u16*)(ws + OFF_W) + (size_t)l * W_LAYER + W_CQ + (size_t)col0 * 1024, 1024, 1024, 1 << 30, acc, sA, sB, NoHook());
  tile_out_128(acc, (u16*)(arena + 3 * SLOT), 1024, row0, col0);
}

DI void att_task(const Params& p, int l, int t) {
  char* ws = p.ws;
  char* arena = ws + OFF_ARENA;
  const int tid = ltid(), lane = tid & 63, w = tid >> 6;
  int row0, h, nvalid;
  const u16 *KX, *VTX;
  if (t < 2048) {
    const int rt = t >> 2; h = t & 3; row0 = rt * 64; nvalid = 64;
    const int b = row0 >> 13;
    KX = (const u16*)(ws + OFF_KXP) + ((size_t)(l * 4 + b)) * 256 * 1024 + h * 256;
    VTX = (const u16*)(ws + OFF_VTXP) + ((size_t)((l * 4 + b) * 4 + h)) * 65536;
  } else {
    const int q = t - 2048, b = q >> 2; h = q & 3; row0 = PROWS + b * 16; nvalid = 16;
    KX = (const u16*)(ws + OFF_KXS) + (size_t)b * 256 * 1024 + h * 256;
    VTX = (const u16*)(ws + OFF_VTXS) + ((size_t)(b * 4 + h)) * 65536;
  }
  const u16* QX = (const u16*)(arena + 3 * SLOT);
  u16* OX = (u16*)(arena + 5 * SLOT);
#ifdef EXP_ATT_COPY
  for (int e = tid; e < nvalid * 256; e += NTHR) { const int r = e >> 8, c = e & 255; OX[(size_t)(row0 + r) * 1024 + h * 256 + c] = QX[(size_t)(row0 + r) * 1024 + h * 256 + c]; }
  return;
#endif
  const int arow0 = (row0 + 64 <= NTOK) ? row0 : (NTOK - 64);
  const int shift = row0 - arow0;
  u16* sA = (u16*)smem;
  u16* sB = (u16*)(smem + 34816);
  f32x4 acc[1][16];
  zero_acc(acc);
  gemm_mainloop<64, 256, 4, 1>(QX + (size_t)arow0 * 1024 + h * 256, 1024, KX, 1024, 256, 1 << 30, acc, sA, sB, NoHook());
  float inv[4];
#pragma unroll
  for (int j = 0; j < 4; ++j) {
    float mx = -3.0e38f;
#pragma unroll
    for (int n = 0; n < 16; ++n) mx = fmaxf(mx, acc[0][n][j]);
    mx = max16(mx);
    float s = 0.f;
#pragma unroll
    for (int n = 0; n < 16; ++n) { const float e = __expf(acc[0][n][j] - mx); acc[0][n][j] = e; s += e; }
    s = red16(s);
    inv[j] = 1.0f / s;
  }
  __syncthreads();
  u16* sP = (u16*)smem;
#pragma unroll
  for (int n = 0; n < 16; ++n)
#pragma unroll
    for (int j = 0; j < 4; ++j) sP[(w * 16 + (lane >> 4) * 4 + j) * 272 + n * 16 + (lane & 15)] = f2bf(acc[0][n][j] * inv[j]);
  zero_acc(acc);
  gemm_mainloop_alds<64, 256, 4, 1>(sP, 272, VTX, 256, 256, acc, sB);
#pragma unroll
  for (int n = 0; n < 16; ++n)
#pragma unroll
    for (int j = 0; j < 4; ++j) {
      const int rl = w * 16 + (lane >> 4) * 4 + j - shift;
      if (rl >= 0 && rl < nvalid) OX[(size_t)(row0 + rl) * 1024 + h * 256 + n * 16 + (lane & 15)] = f2bf(acc[0][n][j]);
    }
}

DI void gu_tile(const Params& p, int l, int t) {
  char* ws = p.ws;
  char* arena = ws + OFF_ARENA;
  const int rt = t / 22, ct = t % 22, row0 = rt * 128, col0 = ct * 256;
  f32x4 acc[4][8];
  zero_acc(acc);
  u16* sA = (u16*)smem; u16* sB = sA + 128 * LDS_STRIDE;
  gemm_128x256((const u16*)(ws + OFF_HB) + (size_t)row0 * 1024, 1024,
               (const u16*)(ws + OFF_W) + (size_t)l * W_LAYER + W_GU + (size_t)col0 * 1024, 1024, 1024, acc, sA, sB);
  const int tid = ltid(), lane = tid & 63, wid = tid >> 6, wm = wid >> 1, wn = wid & 1;
  u16* act = (u16*)(arena + 2 * SLOT);
  u16* sT = (u16*)smem;
  __syncthreads();
#pragma unroll
  for (int m = 0; m < 4; ++m)
#pragma unroll
    for (int np = 0; np < 4; ++np)
#pragma unroll
      for (int j = 0; j < 4; ++j)
        tile_put(sT, 136, wm * 64 + m * 16 + (lane >> 4) * 4 + j, wn * 64 + np * 16 + (lane & 15), siluf_(acc[m][2 * np][j]) * acc[m][2 * np + 1][j]);
  __syncthreads();
  tile_flush128(sT, act, DFF, row0, col0 >> 1);
}

DI void dbg_dump(const Params& p) {
#ifdef DUMP_SLOT
  const u16* src = (const u16*)(p.ws + OFF_ARENA + (size_t)DUMP_SLOT * SLOT);
  float* dst = p.out + O_Y;
  for (size_t i = (size_t)blockIdx.x * NTHR + threadIdx.x; i < (size_t)NTOK * 1024; i += (size_t)gridDim.x * NTHR) dst[i] = bf2f(src[i]);
#endif
#ifdef DUMP_HB
  const u16* src = (const u16*)(p.ws + OFF_HB);
  float* dst = p.out + O_Y;
  for (size_t i = (size_t)blockIdx.x * NTHR + threadIdx.x; i < (size_t)NTOK * 1024; i += (size_t)gridDim.x * NTHR) dst[i] = bf2f(src[i]);
#endif
}
#define PH_BEGIN { const int myph = ph++; const bool act_ = (myph >= p.ph_lo && myph < p.ph_hi); if (act_) { unsigned* c = &ctr[myph]; (void)c; phase_begin();
#define PH_END } if (act_ && myph + 1 < p.ph_hi) grid_barrier(bar); }

__global__ void __launch_bounds__(NTHR, 2) fwd_megakernel(Params p) {
  unsigned* bar = (unsigned*)(p.ws + OFF_BAR);
  unsigned* ctr = (unsigned*)(p.ws + OFF_CTR);
  if (threadIdx.x == 0) { g_xb[0] = 0u; g_xb[1] = 0u; g_xb[2] = 0u; g_xb[3] = 0u; }
  __syncthreads();
  if (USE_XCD_BARRIER) { if (threadIdx.x == 0) (void)xb_add(&bar[XB_XCNT(xb_xcc_id())], 1u); }
  if (p.never) cg::this_grid().sync();
  int ph = 0;
  char* ws = p.ws;
  char* arena = ws + OFF_ARENA;
#ifdef DUMP_AFTER
  if (p.ph_lo < 0) {
    const u16* src = (const u16*)(ws + DUMP_OFF);
    for (size_t j = (size_t)blockIdx.x * NTHR + threadIdx.x; j < (size_t)1048576; j += (size_t)gridDim.x * NTHR) {
      float acc = 0.f;
      size_t idx = (j * 131u) % DUMP_N;
      for (int k = 0; k < 512; ++k) {
        const float e = bf2f((u16)(src[idx] & 0xBFFF));
        acc = acc * 0.75f + e * (1.0f + 0.001f * (float)(k & 15));
        idx += 65537u; if (idx >= DUMP_N) idx -= DUMP_N;
      }
      float v = acc;
      for (int k = 0; k < 200; ++k) { v = bf2f(f2bf(v * 1.37f + 0.11f)); if (fabsf(v) > 4.f) v *= 0.125f; }
      p.out[O_Y + j] = v;
    }
    return;
  }
#endif
#ifdef EXP_CHAOS
  if (p.ph_lo == 0) {
    for (size_t i = (size_t)blockIdx.x * NTHR + threadIdx.x; i < (size_t)NTOK * 1024; i += (size_t)gridDim.x * NTHR) {
      float v = (i < (size_t)PROWS * 1024) ? p.x_prompt[i] : p.x_sample[i - (size_t)PROWS * 1024];
      float w = p.w_in[i % (4u * 1024u * 2560u)];
      for (int k = 0; k < 200; ++k) { v = bf2f(f2bf(v * 1.37f + w)); if (fabsf(v) > 4.f) v *= 0.125f; }
      p.out[O_Y + i] = v;
    }
  }
  return;
#endif

  PH_BEGIN
    phase_prep(p, c);
  PH_END

  for (int l_ = 0; l_ < DEPTHC; ++l_) {
    const int l = lsgpr(l_);
    const u16* wl = (const u16*)(ws + OFF_W) + (size_t)l * W_LAYER;
    PH_BEGIN
      const int n_g1 = 258 * 20, n_mk = (l == 0) ? 512 : 0, n_cc = 2048;
      for (;;) {
        int t = next_task(c);
        if (t >= n_g1 + n_mk + n_cc) break;
        if (t < n_g1) g1_tile(p, l, t);
        else if (t < n_g1 + n_mk) memkv_tile(p, t - n_g1);
        else cache_task(p, l, t - n_g1 - n_mk);
      }
    PH_END
    PH_BEGIN
      for (;;) {
        int t = next_task(c);
        if (t >= 256 + 512) break;
        if (t < 256) ret_local_task(p, t);
        else s5_task(p, l, t - 256, 0);
      }
    PH_END
    PH_BEGIN
      for (;;) {
        int t = next_task(c);
        if (t >= 320 + 640) break;
        if (t < 320) ret_final_task(p, l, t);
        else s5_task(p, l, t - 320, 1);
      }
    PH_END
    PH_BEGIN
      TASK_LOOP(c, 258 * 4, glu_tile(p, l, t))
    PH_END
    PH_BEGIN
      TASK_LOOP(c, 258 * 8, out_tile(p, l, t))
    PH_END
    PH_BEGIN
      for (int t = blockIdx.x; t < NTOK / 16; t += gridDim.x) { post_task(p, (const u16*)(arena + 1 * SLOT), p.mix_post + l * 1024, t, false); }
    PH_END
    PH_BEGIN
      TASK_LOOP(c, 1088, if (t < 1024) big_tile((const u16*)(ws + OFF_HB), 1024, wl + W_CQ, 1024, (u16*)(arena + 3 * SLOT), 1024, t); else small_tile((const u16*)(ws + OFF_HB), 1024, wl + W_CQ, 1024, (u16*)(arena + 3 * SLOT), 1024, t - 1024))
    PH_END
    PH_BEGIN
      TASK_LOOP(c, 2112, att_task(p, l, t))
    PH_END
    PH_BEGIN
      TASK_LOOP(c, 1088, if (t < 1024) big_tile((const u16*)(arena + 5 * SLOT), 1024, wl + W_CO, 1024, (u16*)(arena + 1 * SLOT), 1024, t); else small_tile((const u16*)(arena + 5 * SLOT), 1024, wl + W_CO, 1024, (u16*)(arena + 1 * SLOT), 1024, t - 1024))
    PH_END
    PH_BEGIN
      for (int t = blockIdx.x; t < NTOK / 16; t += gridDim.x) { post_task(p, (const u16*)(arena + 1 * SLOT), p.xa_post + l * 1024, t, false); }
    PH_END
    PH_BEGIN
      TASK_LOOP(c, 258 * 22, gu_tile(p, l, t))
    PH_END
    PH_BEGIN
      TASK_LOOP(c, 1088, if (t < 1024) big_tile((const u16*)(arena + 2 * SLOT), DFF, wl + W_DN, DFF, (u16*)(arena + 0 * SLOT), 1024, t); else small_tile((const u16*)(arena + 2 * SLOT), DFF, wl + W_DN, DFF, (u16*)(arena + 0 * SLOT), 1024, t - 1024))
    PH_END
    PH_BEGIN
      for (int t = blockIdx.x; t < NTOK / 16; t += gridDim.x) { post_task(p, (const u16*)(arena + 0 * SLOT), p.ffn_post + l * 1024, t, l == DEPTHC - 1); }
    PH_END
  }
}

#ifndef N_LAUNCH_SPLIT
#define N_LAUNCH_SPLIT 0
#endif
constexpr int N_PHASES = 1 + 13 * DEPTHC;

extern "C" void kernel_launch(void* const* d_in, const int* in_sizes, int n_in, void* d_out, int out_size, void* d_ws,
                              size_t ws_size, hipStream_t stream) {
  static int grid_blocks = 0;
  if (!grid_blocks) {
    int dev = 0, cus = 0, per_cu = 0;
    (void)hipGetDevice(&dev);
    (void)hipDeviceGetAttribute(&cus, hipDeviceAttributeMultiprocessorCount, dev);
    (void)hipOccupancyMaxActiveBlocksPerMultiprocessor(&per_cu, fwd_megakernel, NTHR, 0);
    if (per_cu > 2) per_cu = 2;
    if (per_cu < 1) per_cu = 1;
    grid_blocks = cus * per_cu;
  }
  if (ws_size < WS_NEEDED) fprintf(stderr, "workspace too small: %zu < %zu\n", ws_size, (size_t)WS_NEEDED);
  Params p{};
  const float** f = (const float**)&p;
  for (int i = 0; i < 36; ++i) f[i] = (const float*)d_in[i];
  p.out = (float*)d_out;
  p.ws = (char*)d_ws;
  p.never = 0;
  p.ph_lo = 0;
  p.ph_hi = N_PHASES;
  p.pad = 0;
  (void)hipMemsetAsync(d_ws, 0, 32768, stream);
  if (N_LAUNCH_SPLIT) {
#ifdef DUMP_AFTER
    const int nrun = DUMP_AFTER;
#else
    const int nrun = N_PHASES;
#endif
    for (int i = 0; i <= nrun; ++i) {
      if (i == nrun) {
#ifdef DUMP_AFTER
        p.ph_lo = -1; p.ph_hi = -1;
#else
        break;
#endif
      } else { p.ph_lo = i; p.ph_hi = i + 1; }
      void* args[] = {&p};
      hipError_t e = hipLaunchCooperativeKernel((void*)fwd_megakernel, dim3(grid_blocks), dim3(NTHR), args, 0, stream);
      if (e != hipSuccess) fprintf(stderr, "launch failed: %s (grid %d)\n", hipGetErrorString(e), grid_blocks);
    }
  } else {
    void* args[] = {&p};
    hipError_t e = hipLaunchCooperativeKernel((void*)fwd_megakernel, dim3(grid_blocks), dim3(NTHR), args, 0, stream);
    if (e != hipSuccess) fprintf(stderr, "cooperative launch failed: %s (grid %d)\n", hipGetErrorString(e), grid_blocks);
  }
}
```

```cpp
#include <hip/hip_runtime.h>
#include <hip/hip_bf16.h>
#include <hip/hip_cooperative_groups.h>
#include <stdint.h>
#include <stdio.h>
namespace cg = cooperative_groups;

typedef __attribute__((ext_vector_type(8))) short bf16x8;
typedef __attribute__((ext_vector_type(4))) float f32x4;
typedef unsigned short u16;
typedef __attribute__((ext_vector_type(4))) unsigned u32x4;
typedef __attribute__((ext_vector_type(2))) unsigned u32x2;
#define DI __device__ __forceinline__
#define MFMA16(a, b, c) __builtin_amdgcn_mfma_f32_16x16x32_bf16((a), (b), (c), 0, 0, 0)
#define MFMA_FENCE() do { __builtin_amdgcn_sched_barrier(0); asm volatile("s_nop 15\n\ts_nop 15" ::: "memory"); __builtin_amdgcn_sched_barrier(0); } while (0)

constexpr int NTOK = 33024, PROWS = 32768, DM = 1024, DFF = 2816, DEPTHC = 4;
constexpr int SEQ = 8192;
constexpr float EPSF = 1e-6f;
constexpr int NTHR = 256;
constexpr int LDS_STRIDE = 80;
constexpr int SMEM_BYTES = 76800;

constexpr size_t SLOT = (size_t)NTOK * 512 * 2;
constexpr size_t OFF_BAR = 0;
constexpr size_t OFF_CTR = 16384;
constexpr size_t OFF_W = 32768;
constexpr size_t W_IN = 0, W_GLU = W_IN + 2560 * 1024, W_OUT = W_GLU + 512 * 512, W_CQ = W_OUT + 1024 * 1024,
                 W_CK = W_CQ + 1024 * 1024, W_CV = W_CK + 1024 * 1024, W_CO = W_CV + 1024 * 1024,
                 W_GU = W_CO + 1024 * 1024, W_DN = W_GU + 5632 * 1024, W_LAYER = W_DN + 1024 * 2816;
constexpr size_t OFF_S5P = OFF_W + 4 * W_LAYER * 2;
constexpr size_t S5P_BBT = 0, S5P_CM = 131072, S5P_ABAR = 262144, S5P_LAYER = 278528;
constexpr size_t OFF_HB = OFF_S5P + 4 * S5P_LAYER;
constexpr size_t OFF_MEMB = OFF_HB + (size_t)NTOK * 1024 * 2;
constexpr size_t OFF_KXP = OFF_MEMB + 1024 * 1024 * 2;
constexpr size_t OFF_VTXP = OFF_KXP + 4 * 4 * 256 * 1024 * 2;
constexpr size_t OFF_KXS = OFF_VTXP + 4 * 4 * 256 * 1024 * 2;
constexpr size_t OFF_VTXS = OFF_KXS + 16 * 256 * 1024 * 2;
constexpr size_t OFF_SLOC = OFF_VTXS + 16 * 256 * 1024 * 2;
constexpr size_t OFF_ELOC = OFF_SLOC + 16 * 16 * 128 * 128 * 4;
constexpr size_t OFF_ZSQ = OFF_ELOC + 4 * 16 * 32 * 64 * 2 * 4;
constexpr size_t OFF_RSQ = OFF_ZSQ + (size_t)NTOK * 8 * 4;
constexpr size_t OFF_ARENA = OFF_RSQ + (size_t)NTOK * 16 * 4;
constexpr size_t WS_NEEDED = OFF_ARENA + 8 * SLOT;

constexpr size_t O_Y = 0, O_S5RE_P = 33816576, O_S5IM_P = 33849344, O_RET_P = 33882112, O_MK_P = 34930688,
                 O_MV_P = 39124992, O_S5RE_S = 43319296, O_S5IM_S = 43450368, O_RET_S = 43581440;

struct Params {
  const float *x_prompt, *x_sample, *mem_prompt, *s5re0, *s5im0, *ret0, *cmk, *cmv;
  const float *mix_pre, *mix_post, *w_in, *lam_re, *lam_im, *log_step, *b_re, *b_im, *c_re, *c_im, *s5_d, *w_glu,
      *b_glu, *s5_onorm, *ret_onorm, *w_out, *xa_pre, *xa_post, *mem_norm, *w_cq, *w_ck, *w_cv, *w_co, *ffn_pre,
      *ffn_post, *w_gate, *w_up, *w_down;
  float* out;
  char* ws;
  int never;
  int ph_lo;
  int ph_hi;
  int pad;
};

DI u16 f2bf(float f) {
  unsigned u = __float_as_uint(f);
  u += 0x7fffu + ((u >> 16) & 1u);
  return (u16)(u >> 16);
}
DI float bf2f(u16 h) { return __uint_as_float(((unsigned)h) << 16); }
DI unsigned pack2(float a, float b) { return (unsigned)f2bf(a) | ((unsigned)f2bf(b) << 16); }
DI float sigmoidf_(float x) { return 1.0f / (1.0f + __expf(-x)); }
DI float siluf_(float x) { return x * sigmoidf_(x); }
DI float geluf_(float x) {
  float t = 0.7978845608028654f * (x + 0.044715f * x * x * x);
  return 0.5f * x * (1.0f + tanhf(t));
}
DI float red16(float v) {
  v += __shfl_xor(v, 1); v += __shfl_xor(v, 2); v += __shfl_xor(v, 4); v += __shfl_xor(v, 8);
  return v;
}
DI float max16(float v) {
  v = fmaxf(v, __shfl_xor(v, 1)); v = fmaxf(v, __shfl_xor(v, 2)); v = fmaxf(v, __shfl_xor(v, 4)); v = fmaxf(v, __shfl_xor(v, 8));
  return v;
}
DI float red64(float v) {
  v = red16(v); v += __shfl_xor(v, 16); v += __shfl_xor(v, 32);
  return v;
}
DI void sincos_cw(float x, float* sn, float* cs) {
  const float k = rintf(x * 0.15915494309189535f);
  float r = fmaf(-k, 6.2831854820251465f, x);
  r = fmaf(-k, -1.7484555e-07f, r);
  *sn = __sinf(r); *cs = __cosf(r);
}
DI int ltid() { int x = threadIdx.x; asm volatile("" : "+v"(x)); return x; }
DI int lsgpr(int x) { asm volatile("" : "+s"(x)); return x; }
DI u32x4 ld_sc1_16(const void* p) {
  const unsigned long long* q = (const unsigned long long*)p;
  const unsigned long long a = __hip_atomic_load(q, __ATOMIC_RELAXED, __HIP_MEMORY_SCOPE_AGENT);
  const unsigned long long b = __hip_atomic_load(q + 1, __ATOMIC_RELAXED, __HIP_MEMORY_SCOPE_AGENT);
  return (u32x4){(unsigned)a, (unsigned)(a >> 32), (unsigned)b, (unsigned)(b >> 32)};
}
DI __amdgpu_buffer_rsrc_t mk_rsrc(const void* p) {
  const unsigned long long a = (unsigned long long)p;
  const unsigned lo = __builtin_amdgcn_readfirstlane((unsigned)a), hi = __builtin_amdgcn_readfirstlane((unsigned)(a >> 32));
  return __builtin_amdgcn_make_buffer_rsrc((void*)(((unsigned long long)hi << 32) | lo), 0, 0x7fffffff, 0x00020000);
}
DI u32x4 bld16(__amdgpu_buffer_rsrc_t r, unsigned voff, unsigned soff) { return __builtin_amdgcn_raw_buffer_load_b128(r, voff, soff, 16); }
DI u32x4 ld_ws16(const char* ws, const void* p) {
  const __amdgpu_buffer_rsrc_t r = __builtin_amdgcn_make_buffer_rsrc((void*)ws, 0, 0x7fffffff, 0x00020000);
  return __builtin_amdgcn_raw_buffer_load_b128(r, (unsigned)((const char*)p - ws), 0, 16);
}
DI u32x2 ld_sc1_8(const void* p) {
  const unsigned long long a = __hip_atomic_load((const unsigned long long*)p, __ATOMIC_RELAXED, __HIP_MEMORY_SCOPE_AGENT);
  return (u32x2){(unsigned)a, (unsigned)(a >> 32)};
}
DI u16 ld_sc1_2(const u16* p) { return __hip_atomic_load(p, __ATOMIC_RELAXED, __HIP_MEMORY_SCOPE_AGENT); }
DI float ld_sc1_f(const float* p) { return __hip_atomic_load(p, __ATOMIC_RELAXED, __HIP_MEMORY_SCOPE_AGENT); }
DI float gamma_l2(int h) { return log2f(1.0f - exp2f(-5.0f - (float)h)); }

#define XB_TMO 128
#define XB_XCNT(j) (256 + 64 * (j))
#define XB_XSUB(j) (1280 + 64 * (j))
#define XB_XGEN(j) (2304 + 64 * (j))
#define XB_TOP 3328
#define XB_TOPGEN 3392
#define XB_SPIN_CAP (1u << 26)
DI unsigned xb_ld(unsigned* p) { return __hip_atomic_load(p, __ATOMIC_RELAXED, __HIP_MEMORY_SCOPE_AGENT); }
DI unsigned xb_add(unsigned* p, unsigned v) { return __hip_atomic_fetch_add(p, v, __ATOMIC_RELAXED, __HIP_MEMORY_SCOPE_AGENT); }
DI unsigned xb_xcc_id() { return (unsigned)__builtin_amdgcn_s_getreg((3 << 11) | 20) & 0xFu; }
#define XB_SPIN(cond, bar) do { unsigned _sp = 0; while (cond) { __builtin_amdgcn_s_sleep(1); \
    if ((++_sp & 255u) == 0u) { if (xb_ld(&(bar)[XB_TMO])) break; if (_sp > XB_SPIN_CAP) { atomicAdd(&(bar)[XB_TMO], 1u); break; } } } } while (0)

__shared__ unsigned g_xb[4];
__shared__ __attribute__((aligned(16))) char smem[SMEM_BYTES];

DI void xcd_complete(unsigned* bar, unsigned x, unsigned& nloc, unsigned& nx) {
  const unsigned G = gridDim.x;
  unsigned sum, cnt, mine, sp = 0u;
  for (;;) {
    sum = 0u; cnt = 0u; mine = 0u;
#pragma unroll
    for (unsigned j = 0; j < 16; ++j) { const unsigned c = xb_ld(&bar[XB_XCNT(j)]); sum += c; cnt += (c > 0u) ? 1u : 0u; mine = (j == x) ? c : mine; }
    if (sum == G) break;
    __builtin_amdgcn_s_sleep(1);
    if ((++sp & 255u) == 0u) { if (xb_ld(&bar[XB_TMO])) break; if (sp > XB_SPIN_CAP) { atomicAdd(&bar[XB_TMO], 1u); break; } }
  }
  nloc = mine > 0u ? mine : 1u; nx = cnt > 0u ? cnt : 1u;
}
#ifndef USE_XCD_BARRIER
#define USE_XCD_BARRIER 1
#endif
DI void grid_barrier(unsigned* bar) {
  if (!USE_XCD_BARRIER) {
    asm volatile("s_waitcnt vmcnt(0)" ::: "memory");
    __syncthreads();
    if (threadIdx.x == 0) asm volatile("buffer_wbl2 sc0 sc1\n\ts_waitcnt vmcnt(0)" ::: "memory");
    cg::this_grid().sync();
    if (threadIdx.x == 0) asm volatile("buffer_inv sc0 sc1\n\ts_waitcnt vmcnt(0)" ::: "memory");
    __syncthreads();
    return;
  }
  asm volatile("s_waitcnt vmcnt(0)" ::: "memory");
  __syncthreads();
  if (threadIdx.x == 0) {
    __builtin_amdgcn_s_waitcnt(0);
    const unsigned xcc = xb_xcc_id();
    unsigned nloc = g_xb[0], nx = g_xb[1];
    if (nloc == 0u) { xcd_complete(bar, xcc, nloc, nx); g_xb[0] = nloc; g_xb[1] = nx; }
    const unsigned old = xb_add(&bar[XB_XSUB(xcc)], 1u);
    const unsigned gen = old / nloc;
    if (old + 1u == (gen + 1u) * nloc) {
      __builtin_amdgcn_fence(__ATOMIC_RELEASE, "agent");
      asm volatile("s_waitcnt vmcnt(0)" ::: "memory");
      const unsigned og = xb_add(&bar[XB_TOP], 1u);
      const unsigned tg = og / nx;
      if (og + 1u == (tg + 1u) * nx) xb_add(&bar[XB_TOPGEN], 1u);
      else XB_SPIN(xb_ld(&bar[XB_TOPGEN]) == tg, bar);
      __builtin_amdgcn_fence(__ATOMIC_ACQUIRE, "agent");
      xb_add(&bar[XB_XGEN(xcc)], 1u);
      asm volatile("s_waitcnt vmcnt(0)" ::: "memory");
    } else {
      XB_SPIN(xb_ld(&bar[XB_XGEN(xcc)]) == gen, bar);
      __builtin_amdgcn_fence(__ATOMIC_ACQUIRE, "agent");
      asm volatile("s_waitcnt vmcnt(0)" ::: "memory");
    }
  }
  __syncthreads();
}

#define DUMP_OFF (OFF_ELOC)
#define DUMP_N ((size_t)524288)
#define DUMP_F32 0
#ifndef MAXPH
#define MAXPH 10
#endif
#ifndef STATIC_SCHED
#define STATIC_SCHED 0
#endif
#ifndef ONE_XCD
#define ONE_XCD 0
#endif
DI int next_task(unsigned* ctr) {
  __syncthreads();
#ifdef LDS_NAN_PER_TASK
  __syncthreads();
#endif
  if (ONE_XCD) {
    if (threadIdx.x == 0) g_xb[2] = (xb_xcc_id() == 0u) ? atomicAdd(ctr, 1u) : 0x7fffffffu;
    __syncthreads();
    return (int)g_xb[2];
  }
  if (STATIC_SCHED) {
    if (threadIdx.x == 0) { unsigned it = g_xb[3]; g_xb[3] = it + 1u; g_xb[2] = blockIdx.x + it * gridDim.x; }
  } else {
    if (threadIdx.x == 0) g_xb[2] = atomicAdd(ctr, 1u);
  }
  __syncthreads();
  return (int)g_xb[2];
}
DI unsigned task_prefetch(unsigned* ctr) { unsigned v = 0u; if (threadIdx.x == 0) v = atomicAdd(ctr, 1u); return v; }
DI int task_commit(unsigned v) {
  __syncthreads();
  if (threadIdx.x == 0) g_xb[2] = v;
  __syncthreads();
  return (int)g_xb[2];
}
#define TASK_LOOP(ctr, N, BODY) { int t = next_task(ctr); while (t < (N)) { const unsigned tn_ = task_prefetch(ctr); BODY; t = task_commit(tn_); } }
DI void phase_begin() { __syncthreads(); if (threadIdx.x == 0) g_xb[3] = 0u; __syncthreads(); }

template <int BM, int BN, int WGM, int WGN, class Hook>
DI void gemm_mainloop(const u16* A, int lda, const u16* B, int ldb, int K, int kvalid,
                      f32x4 (&acc)[BM / WGM / 16][BN / WGN / 16], u16* sA, u16* sB, Hook hook) {
  constexpr int MT = BM / WGM / 16, NTL = BN / WGN / 16, CA = BM / 32, CB = BN / 32;
  const int tid = ltid(), lane = tid & 63, wid = tid >> 6, wm = wid / WGN, wn = wid % WGN;
  const __amdgpu_buffer_rsrc_t ra_ = mk_rsrc(A), rb_ = mk_rsrc(B);
  u32x4 ra0[CA], rb0[CB], ra1[CA], rb1[CB];
  unsigned va[CA], vb[CB];
  const u32x4 z4 = (u32x4){0u, 0u, 0u, 0u};
  const int cc0 = (tid & 7) * 8;
#pragma unroll
  for (int i = 0; i < CA; ++i) { const int r = (tid + i * NTHR) >> 3; va[i] = (unsigned)(r * lda + cc0) * 2u; }
#pragma unroll
  for (int i = 0; i < CB; ++i) { const int r = (tid + i * NTHR) >> 3; vb[i] = (unsigned)(r * ldb + cc0) * 2u; }
#define GM_LOAD(RA, RB, kn)                                                                          \
  {                                                                                                  \
    const bool kok = ((kn) + cc0) < kvalid;                                                          \
    _Pragma("unroll") for (int i = 0; i < CA; ++i) RA[i] = kok ? bld16(ra_, va[i], (unsigned)(kn) * 2u) : z4; \
    _Pragma("unroll") for (int i = 0; i < CB; ++i) RB[i] = kok ? bld16(rb_, vb[i], (unsigned)(kn) * 2u) : z4; \
  }
#define GM_STEP(RA, RB, kcur)                                                                        \
  {                                                                                                  \
    __syncthreads();                                                                                 \
    _Pragma("unroll") for (int i = 0; i < CA; ++i) { const int r = (tid + i * NTHR) >> 3; *(u32x4*)(sA + r * LDS_STRIDE + cc0) = RA[i]; } \
    _Pragma("unroll") for (int i = 0; i < CB; ++i) { const int r = (tid + i * NTHR) >> 3; *(u32x4*)(sB + r * LDS_STRIDE + cc0) = RB[i]; } \
    __syncthreads();                                                                                 \
    if ((kcur) + 128 < K) GM_LOAD(RA, RB, (kcur) + 128)                                              \
    _Pragma("unroll") for (int kk = 0; kk < 2; ++kk) {                                               \
      bf16x8 af[MT], bfr[NTL];                                                                       \
      _Pragma("unroll") for (int m = 0; m < MT; ++m) af[m] = *(const bf16x8*)(sA + (wm * (BM / WGM) + m * 16 + (lane & 15)) * LDS_STRIDE + kk * 32 + (lane >> 4) * 8); \
      _Pragma("unroll") for (int n = 0; n < NTL; ++n) bfr[n] = *(const bf16x8*)(sB + (wn * (BN / WGN) + n * 16 + (lane & 15)) * LDS_STRIDE + kk * 32 + (lane >> 4) * 8); \
      _Pragma("unroll") for (int m = 0; m < MT; ++m)                                                 \
        _Pragma("unroll") for (int n = 0; n < NTL; ++n) acc[m][n] = MFMA16(af[m], bfr[n], acc[m][n]); \
    }                                                                                                \
    hook((kcur), acc);                                                                               \
  }
  GM_LOAD(ra0, rb0, 0)
  if (64 < K) GM_LOAD(ra1, rb1, 64)
#pragma unroll
  for (int k0 = 0; k0 < K; k0 += 128) {
    GM_STEP(ra0, rb0, k0)
    GM_STEP(ra1, rb1, k0 + 64)
  }
  MFMA_FENCE();
#undef GM_LOAD
#undef GM_STEP
}
struct NoHook { template <class T> DI void operator()(int, T&) const {} };

template <int BM, int BN, int WGM, int WGN>
DI void gemm_mainloop_alds(const u16* sAimg, int lda_s, const u16* B, int ldb, int K,
                           f32x4 (&acc)[BM / WGM / 16][BN / WGN / 16], u16* sB) {
  constexpr int MT = BM / WGM / 16, NTL = BN / WGN / 16, CB = BN / 32;
  const int tid = ltid(), lane = tid & 63, wid = tid >> 6, wm = wid / WGN, wn = wid % WGN;
  const __amdgpu_buffer_rsrc_t rb_ = mk_rsrc(B);
  u32x4 rb0[CB], rb1[CB];
  unsigned vb[CB];
  const int cc0 = (tid & 7) * 8;
#pragma unroll
  for (int i = 0; i < CB; ++i) { const int r = (tid + i * NTHR) >> 3; vb[i] = (unsigned)(r * ldb + cc0) * 2u; }
#define GA_STEP(RB, kcur)                                                                            \
  {                                                                                                  \
    __syncthreads();                                                                                 \
    _Pragma("unroll") for (int i = 0; i < CB; ++i) { const int r = (tid + i * NTHR) >> 3; *(u32x4*)(sB + r * LDS_STRIDE + cc0) = RB[i]; } \
    __syncthreads();                                                                                 \
    if ((kcur) + 128 < K) { _Pragma("unroll") for (int i = 0; i < CB; ++i) RB[i] = bld16(rb_, vb[i], (unsigned)((kcur) + 128) * 2u); } \
    _Pragma("unroll") for (int kk = 0; kk < 2; ++kk) {                                               \
      bf16x8 af[MT], bfr[NTL];                                                                       \
      _Pragma("unroll") for (int m = 0; m < MT; ++m) af[m] = *(const bf16x8*)(sAimg + (wm * (BM / WGM) + m * 16 + (lane & 15)) * lda_s + (kcur) + kk * 32 + (lane >> 4) * 8); \
      _Pragma("unroll") for (int n = 0; n < NTL; ++n) bfr[n] = *(const bf16x8*)(sB + (wn * (BN / WGN) + n * 16 + (lane & 15)) * LDS_STRIDE + kk * 32 + (lane >> 4) * 8); \
      _Pragma("unroll") for (int m = 0; m < MT; ++m)                                                 \
        _Pragma("unroll") for (int n = 0; n < NTL; ++n) acc[m][n] = MFMA16(af[m], bfr[n], acc[m][n]); \
    }                                                                                                \
  }
#pragma unroll
  for (int i = 0; i < CB; ++i) rb0[i] = bld16(rb_, vb[i], 0u);
#pragma unroll
  for (int i = 0; i < CB; ++i) rb1[i] = bld16(rb_, vb[i], 128u);
#pragma unroll 1
  for (int k0 = 0; k0 < K; k0 += 128) {
    GA_STEP(rb0, k0)
    GA_STEP(rb1, k0 + 64)
  }
  MFMA_FENCE();
#undef GA_STEP
}

template <bool SPLIT = false>
DI void gemm_128x256(const u16* A, int lda, const u16* B, int ldb, int K, f32x4 (&acc)[4][8], u16* sA, u16* sB,
                     const u16* A2 = nullptr, const float* rsl = nullptr) {
  const int tid = ltid(), lane = tid & 63, wid = tid >> 6, wm = wid >> 1, wn = wid & 1;
  const __amdgpu_buffer_rsrc_t ra_ = mk_rsrc(A), rb_ = mk_rsrc(B);
  const __amdgpu_buffer_rsrc_t ra2_ = mk_rsrc(SPLIT ? A2 : A);
  u32x4 ra[4], rb[8];
  unsigned va[4], vb[8];
  const int cc0 = (tid & 7) * 8;
#pragma unroll
  for (int i = 0; i < 4; ++i) { const int r = (tid + i * NTHR) >> 3; va[i] = (unsigned)(r * lda + cc0) * 2u; }
#pragma unroll
  for (int i = 0; i < 8; ++i) { const int r = (tid + i * NTHR) >> 3; vb[i] = (unsigned)(r * ldb + cc0) * 2u; }
#pragma unroll
  for (int i = 0; i < 4; ++i) ra[i] = bld16(ra_, va[i], 0u);
#pragma unroll
  for (int i = 0; i < 8; ++i) rb[i] = bld16(rb_, vb[i], 0u);
#pragma unroll
  for (int k0 = 0; k0 < K; k0 += 64) {
    if (SPLIT && k0 == 512) {
#pragma unroll
      for (int m = 0; m < 4; ++m)
#pragma unroll
        for (int j = 0; j < 4; ++j) {
          const float rs = rsl[wm * 64 + m * 16 + (lane >> 4) * 4 + j];
#pragma unroll
          for (int n = 0; n < 8; ++n) acc[m][n][j] *= rs;
        }
    }
    __syncthreads();
#pragma unroll
    for (int i = 0; i < 4; ++i) { const int r = (tid + i * NTHR) >> 3; *(u32x4*)(sA + r * LDS_STRIDE + cc0) = ra[i]; }
#pragma unroll
    for (int i = 0; i < 8; ++i) { const int r = (tid + i * NTHR) >> 3; *(u32x4*)(sB + r * LDS_STRIDE + cc0) = rb[i]; }
    __syncthreads();
    if (k0 + 64 < K) {
      const unsigned ko = (unsigned)(k0 + 64) * 2u;
      if (SPLIT && k0 + 64 >= 512) {
#pragma unroll
        for (int i = 0; i < 4; ++i) ra[i] = bld16(ra2_, va[i], ko - 1024u);
      } else {
#pragma unroll
        for (int i = 0; i < 4; ++i) ra[i] = bld16(ra_, va[i], ko);
      }
#pragma unroll
      for (int i = 0; i < 8; ++i) rb[i] = bld16(rb_, vb[i], ko);
    }
#pragma unroll
    for (int kk = 0; kk < 2; ++kk) {
      bf16x8 af[4];
#pragma unroll
      for (int m = 0; m < 4; ++m) af[m] = *(const bf16x8*)(sA + (wm * 64 + m * 16 + (lane & 15)) * LDS_STRIDE + kk * 32 + (lane >> 4) * 8);
#pragma unroll
      for (int nh = 0; nh < 2; ++nh) {
        bf16x8 bfr[4];
#pragma unroll
        for (int n = 0; n < 4; ++n) bfr[n] = *(const bf16x8*)(sB + (wn * 128 + (nh * 4 + n) * 16 + (lane & 15)) * LDS_STRIDE + kk * 32 + (lane >> 4) * 8);
#pragma unroll
        for (int m = 0; m < 4; ++m)
#pragma unroll
          for (int n = 0; n < 4; ++n) acc[m][nh * 4 + n] = MFMA16(af[m], bfr[n], acc[m][nh * 4 + n]);
      }
    }
  }
  MFMA_FENCE();
}

template <int MT, int NTL>
DI void zero_acc(f32x4 (&acc)[MT][NTL]) {
#pragma unroll
  for (int m = 0; m < MT; ++m)
#pragma unroll
    for (int n = 0; n < NTL; ++n) acc[m][n] = (f32x4){0.f, 0.f, 0.f, 0.f};
}

DI void tile_put(u16* sT, int stride, int r, int c, float v) { sT[r * stride + c] = f2bf(v); }
DI void tile_flush128(const u16* sT, u16* dst, int ld, int row0, int col0) {
  const int tid = ltid();
#pragma unroll
  for (int i = 0; i < 8; ++i) {
    const int id = tid + i * NTHR, r = id >> 4, c = (id & 15) * 8;
    *(u32x4*)(dst + (size_t)(row0 + r) * ld + col0 + c) = *(const u32x4*)(sT + r * 136 + c);
  }
}
DI void tile_out_128(const f32x4 (&v)[4][4], u16* dst, int ld, int row0, int col0) {
  u16* sT = (u16*)smem;
  const int lane = ltid() & 63, wid = ltid() >> 6, wm = wid >> 1, wn = wid & 1;
  __syncthreads();
#pragma unroll
  for (int m = 0; m < 4; ++m)
#pragma unroll
    for (int n = 0; n < 4; ++n)
#pragma unroll
      for (int j = 0; j < 4; ++j) tile_put(sT, 136, wm * 64 + m * 16 + (lane >> 4) * 4 + j, wn * 64 + n * 16 + (lane & 15), v[m][n][j]);
  __syncthreads();
  tile_flush128(sT, dst, ld, row0, col0);
}

DI int dst_row_map(int n, int mode) {
  if (mode == 0) return n;
  if (mode == 1) {
    if (n < 512 || n >= 1536) return n;
    int sec = n & ~127, d = n & 127;
    int xh = d >> 6, idx = d & 63;
    return sec + (((idx >> 4) * 2 + xh) << 4) + (idx & 15);
  }
  if (mode == 2) return (n >> 4) * 32 + (n & 15);
  return (n >> 4) * 32 + 16 + (n & 15);
}
DI void transpose_tile(const float* src, int lds_, int k0, int n0, u16* dst, int ldd,
                       const float* gain, int mode, float scale) {
  float* t = (float*)smem;
  const int tid = ltid(), ty = tid >> 4, tx = tid & 15;
  __syncthreads();
#pragma unroll
  for (int i = 0; i < 4; ++i) {
    int k = ty + 16 * i;
    float4 v = *(const float4*)(src + (size_t)(k0 + k) * lds_ + n0 + tx * 4);
    float g = gain ? gain[k0 + k] : 1.0f;
    t[k * 65 + tx * 4 + 0] = v.x * g; t[k * 65 + tx * 4 + 1] = v.y * g;
    t[k * 65 + tx * 4 + 2] = v.z * g; t[k * 65 + tx * 4 + 3] = v.w * g;
  }
  __syncthreads();
  const int nl = tid >> 2, ks = (tid & 3) * 16;
  const int n = n0 + nl;
  float sc = scale;
  if (mode == 1) sc = (n >= 512 && n < 1024) ? 0.08838834764831845f : 1.0f;
  unsigned w[8];
#pragma unroll
  for (int i = 0; i < 8; ++i) w[i] = pack2(t[(ks + 2 * i) * 65 + nl] * sc, t[(ks + 2 * i + 1) * 65 + nl] * sc);
  u16* d = dst + (size_t)dst_row_map(n, mode) * ldd + k0 + ks;
  *(u32x4*)d = (u32x4){w[0], w[1], w[2], w[3]};
  *(u32x4*)(d + 8) = (u32x4){w[4], w[5], w[6], w[7]};
}

DI void rownorm_task(const float* src, float* xs_out, u16* dst) {
  const int lane = ltid() & 63;
  float4 v[4];
  float ss = 0.f;
#pragma unroll
  for (int i = 0; i < 4; ++i) {
    v[i] = *(const float4*)(src + i * 256 + lane * 4);
    ss += v[i].x * v[i].x + v[i].y * v[i].y + v[i].z * v[i].z + v[i].w * v[i].w;
  }
  ss = red64(ss);
  const float r = rsqrtf(ss * (1.0f / 1024.0f) + EPSF);
  if (xs_out && lane == 0) *xs_out = 1.0f / r;
#pragma unroll
  for (int i = 0; i < 4; ++i) {
    u32x2 o; o.x = pack2(v[i].x * r, v[i].y * r); o.y = pack2(v[i].z * r, v[i].w * r);
    *(u32x2*)(dst + i * 256 + lane * 4) = o;
  }
}

DI void phase_prep(const Params& p, unsigned* ctr) {
  char* ws = p.ws;
  const int tid = ltid();
  constexpr int T_W = 16384, T_X = NTOK / 4, T_M = 256, T_S = 128;
  constexpr int TOT = T_W + T_X + T_M + T_S;
  for (int t = blockIdx.x; t < TOT; t += gridDim.x) {
    if (t < T_W) {
      const int l = t >> 12; int q = t & 4095;
      u16* wl = (u16*)(ws + OFF_W) + (size_t)l * W_LAYER;
      if (q < 640) {
        transpose_tile(p.w_in + (size_t)l * 1024 * 2560, 2560, (q / 40) * 64, (q % 40) * 64, wl + W_IN, 1024, p.mix_pre + l * 1024, 1, 1.0f);
      } else if ((q -= 640) < 64) {
        transpose_tile(p.w_glu + (size_t)l * 512 * 512, 512, (q / 8) * 64, (q % 8) * 64, wl + W_GLU, 512, nullptr, 0, 1.0f);
      } else if ((q -= 64) < 256) {
        const int k0 = (q / 16) * 64;
        const float* gain = (k0 < 512) ? (p.s5_onorm + l * 512) : (p.ret_onorm + l * 512 - 512);
        transpose_tile(p.w_out + (size_t)l * 1024 * 1024, 1024, k0, (q % 16) * 64, wl + W_OUT, 1024, gain, 0, 1.0f);
      } else if ((q -= 256) < 256) {
        transpose_tile(p.w_cq + (size_t)l * 1024 * 1024, 1024, (q / 16) * 64, (q % 16) * 64, wl + W_CQ, 1024, p.xa_pre + l * 1024, 0, 0.0625f);
      } else if ((q -= 256) < 256) {
        transpose_tile(p.w_ck + (size_t)l * 1024 * 1024, 1024, (q / 16) * 64, (q % 16) * 64, wl + W_CK, 1024, p.mem_norm + l * 1024, 0, 1.0f);
      } else if ((q -= 256) < 256) {
        transpose_tile(p.w_cv + (size_t)l * 1024 * 1024, 1024, (q / 16) * 64, (q % 16) * 64, wl + W_CV, 1024, p.mem_norm + l * 1024, 0, 1.0f);
      } else if ((q -= 256) < 256) {
        transpose_tile(p.w_co + (size_t)l * 1024 * 1024, 1024, (q / 16) * 64, (q % 16) * 64, wl + W_CO, 1024, nullptr, 0, 1.0f);
      } else if ((q -= 256) < 704) {
        transpose_tile(p.w_gate + (size_t)l * 1024 * 2816, 2816, (q / 44) * 64, (q % 44) * 64, wl + W_GU, 1024, p.ffn_pre + l * 1024, 2, 1.0f);
      } else if ((q -= 704) < 704) {
        transpose_tile(p.w_up + (size_t)l * 1024 * 2816, 2816, (q / 44) * 64, (q % 44) * 64, wl + W_GU, 1024, p.ffn_pre + l * 1024, 3, 1.0f);
      } else {
        q -= 704;
        transpose_tile(p.w_down + (size_t)l * 2816 * 1024, 1024, (q / 16) * 64, (q % 16) * 64, wl + W_DN, 2816, nullptr, 0, 1.0f);
      }
    } else if (t < T_W + T_X) {
      const int row = (t - T_W) * 4 + (tid >> 6);
      const float* src = (row < PROWS) ? p.x_prompt + (size_t)row * 1024 : p.x_sample + (size_t)(row - PROWS) * 1024;
      rownorm_task(src, (float*)(ws + OFF_RSQ) + row, (u16*)(ws + OFF_HB) + (size_t)row * 1024);
    } else if (t < T_W + T_X + T_M) {
      const int row = (t - T_W - T_X) * 4 + (tid >> 6);
      rownorm_task(p.mem_prompt + (size_t)row * 1024, nullptr, (u16*)(ws + OFF_MEMB) + (size_t)row * 1024);
    } else {
      const int lg = t - T_W - T_X - T_M, l = lg >> 5, g = lg & 31;
      char* sp = ws + OFF_S5P + (size_t)l * S5P_LAYER;
      u16* bbt = (u16*)(sp + S5P_BBT) + g * 2048;
      u16* cm = (u16*)(sp + S5P_CM) + g * 2048;
      float* ab = (float*)(sp + S5P_ABAR) + g * 128;
      const float dt = __expf(p.log_step[l * 32 + g]);
      for (int e = tid; e < 1024; e += NTHR) {
        const int pp = e >> 4, h = e & 15;
        const float lr = p.lam_re[(l * 32 + g) * 64 + pp], li = p.lam_im[(l * 32 + g) * 64 + pp];
        const float ar = lr * dt, ai = li * dt, mag = expf(ar);
        float sn_, cs_; sincos_cw(ai, &sn_, &cs_);
        const float abr = mag * cs_, abi = mag * sn_;
        const float den = lr * lr + li * li, nr = abr - 1.0f, ni = abi;
        const float fr = (nr * lr + ni * li) / den, fi = (ni * lr - nr * li) / den;
        const float br = p.b_re[((size_t)(l * 32 + g) * 64 + pp) * 16 + h], bi = p.b_im[((size_t)(l * 32 + g) * 64 + pp) * 16 + h];
        bbt[pp * 16 + h] = f2bf(fr * br - fi * bi);
        bbt[(64 + pp) * 16 + h] = f2bf(fr * bi + fi * br);
        if (h == 0) { ab[pp * 2] = abr; ab[pp * 2 + 1] = abi; }
        const int hh = e >> 6, kk = e & 63;
        cm[hh * 128 + kk] = f2bf(p.c_re[((size_t)(l * 32 + g) * 16 + hh) * 64 + kk]);
        cm[hh * 128 + 64 + kk] = f2bf(-p.c_im[((size_t)(l * 32 + g) * 16 + hh) * 64 + kk]);
      }
    }
  }
}

DI void memkv_tile(const Params& p, int t) {
  char* ws = p.ws;
  const int l = t >> 7, rt = (t >> 4) & 7, ct = t & 15;
  const int isv = ct >> 3, col0 = (ct & 7) * 128, row0 = rt * 128;
  const u16* A = (const u16*)(ws + OFF_MEMB) + (size_t)row0 * 1024;
  const u16* B = (const u16*)(ws + OFF_W) + (size_t)l * W_LAYER + (isv ? W_CV : W_CK) + (size_t)col0 * 1024;
  f32x4 acc[4][4];
  zero_acc(acc);
  u16* sA = (u16*)smem; u16* sB = sA + 128 * LDS_STRIDE;
  gemm_mainloop<128, 128, 2, 2>(A, 1024, B, 1024, 1024, 1 << 30, acc, sA, sB, NoHook());
  const int lane = ltid() & 63, wid = ltid() >> 6, wm = wid >> 1, wn = wid & 1;
  float* of = p.out + (isv ? O_MV_P : O_MK_P) + (size_t)l * 1024 * 1024;
  u16* kx = (u16*)(ws + OFF_KXP) + (size_t)l * 1024 * 1024;
  u16* vx = (u16*)(ws + OFF_VTXP) + (size_t)l * 1024 * 1024;
#pragma unroll
  for (int m = 0; m < 4; ++m)
#pragma unroll
    for (int n = 0; n < 4; ++n) {
      const int r = row0 + wm * 64 + m * 16 + (lane >> 4) * 4, c = col0 + wn * 64 + n * 16 + (lane & 15);
#pragma unroll
      for (int j = 0; j < 4; ++j) of[(size_t)(r + j) * 1024 + c] = acc[m][n][j];
      if (!isv) {
#pragma unroll
        for (int j = 0; j < 4; ++j) kx[(size_t)(r + j) * 1024 + c] = f2bf(acc[m][n][j]);
      } else {
        const int b = r >> 8, mm = r & 255, h = c >> 8, d = c & 255;
        u32x2 o; o.x = pack2(acc[m][n][0], acc[m][n][1]); o.y = pack2(acc[m][n][2], acc[m][n][3]);
        *(u32x2*)(vx + ((size_t)((b * 4 + h) * 256 + d)) * 256 + mm) = o;
      }
    }
}
DI void cache_task(const Params& p, int l, int t) {
  char* ws = p.ws;
  if (t < 1024) {
    const float* src = p.cmk + (size_t)l * 16 * 256 * 1024 + (size_t)t * 4096 + ltid() * 16;
    u16* dst = (u16*)(ws + OFF_KXS) + (size_t)t * 4096 + ltid() * 16;
    float4 a = *(const float4*)src, b = *(const float4*)(src + 4), c = *(const float4*)(src + 8), d = *(const float4*)(src + 12);
    *(u32x4*)dst = (u32x4){pack2(a.x, a.y), pack2(a.z, a.w), pack2(b.x, b.y), pack2(b.z, b.w)};
    *(u32x4*)(dst + 8) = (u32x4){pack2(c.x, c.y), pack2(c.z, c.w), pack2(d.x, d.y), pack2(d.z, d.w)};
  } else {
    t -= 1024;
    const int bh = t >> 4, q = t & 15, b = bh >> 2, h = bh & 3;
    const float* src = p.cmv + ((size_t)(l * 16 + b) * 256) * 1024 + h * 256;
    u16* dst = (u16*)(ws + OFF_VTXS) + (size_t)bh * 256 * 256;
    transpose_tile(src, 1024, (q >> 2) * 64, (q & 3) * 64, dst, 256, nullptr, 0, 1.0f);
  }
}

DI void g1_tile(const Params& p, int l, int t) {
  char* ws = p.ws;
  const int rt = t / 20, ct = t % 20;
  const int row0 = rt * 128, col0 = ct * 128;
  const u16* A = (const u16*)(ws + OFF_HB) + (size_t)row0 * 1024;
  const u16* B = (const u16*)(ws + OFF_W) + (size_t)l * W_LAYER + W_IN + (size_t)col0 * 1024;
  f32x4 acc[4][4];
  zero_acc(acc);
  u16* sA = (u16*)smem; u16* sB = sA + 128 * LDS_STRIDE;
  gemm_mainloop<128, 128, 2, 2>(A, 1024, B, 1024, 1024, 1 << 30, acc, sA, sB, NoHook());
  const int lane = ltid() & 63, wid = ltid() >> 6, wm = wid >> 1, wn = wid & 1;
  char* arena = ws + OFF_ARENA;
  const int sec = ct >> 2, hd = ct & 3;
  const bool samp = row0 >= PROWS;
  if (sec == 0 || sec == 4) {
    tile_out_128(acc, (u16*)(arena + (sec == 0 ? 0 : 3) * SLOT), 512, row0, hd * 128);
  } else if (sec == 3) {
    u16* vt = (u16*)(arena + 4 * SLOT);
#pragma unroll
    for (int m = 0; m < 4; ++m)
#pragma unroll
      for (int n = 0; n < 4; ++n) {
        const int r = row0 + wm * 64 + m * 16 + (lane >> 4) * 4, e = wn * 64 + n * 16 + (lane & 15);
        u32x2 o; o.x = pack2(acc[m][n][0], acc[m][n][1]); o.y = pack2(acc[m][n][2], acc[m][n][3]);
        size_t off;
        if (!samp) { const int b = r >> 13, tt = r & 8191; off = ((size_t)((b * 4 + hd) * 128 + e)) * SEQ + tt; }
        else { const int sr = r - PROWS, b = sr >> 4, tt = sr & 15; off = (size_t)16 * 128 * SEQ + ((size_t)((b * 4 + hd) * 128 + e)) * 16 + tt; }
        *(u32x2*)(vt + off) = o;
      }
  } else {
    u16* dst = (u16*)(arena + (sec == 1 ? 1 : 2) * SLOT);
    u16* ktd = (u16*)(arena + 5 * SLOT);
    const float gl2 = gamma_l2(hd);
    u16* sT = (u16*)smem;
    __syncthreads();
#pragma unroll
    for (int m = 0; m < 4; ++m)
#pragma unroll
      for (int np = 0; np < 2; ++np) {
        const int r = row0 + wm * 64 + m * 16 + (lane >> 4) * 4;
        const int idx = (wn * 2 + np) * 16 + (lane & 15);
        const float inv = exp2f(-(float)idx * (13.287712379549449f / 64.0f));
        float o1[4], o2[4];
#pragma unroll
        for (int j = 0; j < 4; ++j) {
          const int rr = r + j;
          const int pos = samp ? (1024 + ((rr - PROWS) & 15)) : (rr & 8191);
          float sn, cs;
          sincos_cw((float)pos * inv, &sn, &cs);
          const float x1 = acc[m][2 * np][j], x2 = acc[m][2 * np + 1][j];
          o1[j] = x1 * cs - x2 * sn; o2[j] = x1 * sn + x2 * cs;
          tile_put(sT, 136, rr - row0, idx, o1[j]);
          tile_put(sT, 136, rr - row0, 64 + idx, o2[j]);
        }
        if (sec == 2) {
          size_t off1; int tloc;
          if (!samp) { const int b = r >> 13, tt = r & 8191; off1 = ((size_t)((b * 4 + hd) * 128 + idx)) * SEQ + tt; tloc = 63 - (tt & 63); }
          else { const int sr = r - PROWS, b = sr >> 4, tt = sr & 15; off1 = (size_t)16 * 128 * SEQ + ((size_t)((b * 4 + hd) * 128 + idx)) * 16 + tt; tloc = 15 - tt; }
          const size_t off2 = off1 + (size_t)64 * (samp ? 16 : SEQ);
          float dc[4];
#pragma unroll
          for (int j = 0; j < 4; ++j) dc[j] = exp2f(gl2 * (float)(tloc - j));
          u32x2 a, b2;
          a.x = pack2(o1[0] * dc[0], o1[1] * dc[1]); a.y = pack2(o1[2] * dc[2], o1[3] * dc[3]);
          b2.x = pack2(o2[0] * dc[0], o2[1] * dc[1]); b2.y = pack2(o2[2] * dc[2], o2[3] * dc[3]);
          *(u32x2*)(ktd + off1) = a;
          *(u32x2*)(ktd + off2) = b2;
        }
      }
    __syncthreads();
    tile_flush128(sT, dst, 512, row0, hd * 128);
  }
}

struct DecayHook {
  float g64;
  template <class T> DI void operator()(int k0, T& acc) const {
    if (k0 + 64 < 512) {
#pragma unroll
      for (int m = 0; m < 4; ++m)
#pragma unroll
        for (int n = 0; n < 4; ++n) acc[m][n] *= g64;
    }
  }
};
DI void ret_local_task(const Params& p, int t) {
  char* ws = p.ws;
  char* arena = ws + OFF_ARENA;
  const int bh = t >> 4, sc = t & 15, h = bh & 3;
  const u16* A = (const u16*)(arena + 5 * SLOT) + (size_t)bh * 128 * SEQ + sc * 512;
  const u16* B = (const u16*)(arena + 4 * SLOT) + (size_t)bh * 128 * SEQ + sc * 512;
  f32x4 acc[4][4];
  zero_acc(acc);
  u16* sA = (u16*)smem; u16* sB = sA + 128 * LDS_STRIDE;
  DecayHook hk; hk.g64 = exp2f(gamma_l2(h) * 64.0f);
  gemm_mainloop<128, 128, 2, 2>(A, SEQ, B, SEQ, 512, 1 << 30, acc, sA, sB, hk);
  const int lane = ltid() & 63, wid = ltid() >> 6, wm = wid >> 1, wn = wid & 1;
  float* dst = (float*)(ws + OFF_SLOC) + (size_t)t * 16384;
#pragma unroll
  for (int m = 0; m < 4; ++m)
#pragma unroll
    for (int n = 0; n < 4; ++n) {
      const int r = wm * 64 + m * 16 + (lane >> 4) * 4, c = wn * 64 + n * 16 + (lane & 15);
#pragma unroll
      for (int j = 0; j < 4; ++j) dst[(r + j) * 128 + c] = acc[m][n][j];
    }
}

DI void ret_final_task(const Params& p, int l, int t) {
  char* ws = p.ws;
  char* arena = ws + OFF_ARENA;
  const int tid = ltid(), lane = tid & 63, w = tid >> 6;
  const bool samp = t >= 256;
  int bh, sc, nchunk, C, row_base;
  size_t tr_base; int tr_ld;
  if (!samp) { bh = t >> 4; sc = t & 15; nchunk = 8; C = 64; row_base = (bh >> 2) * SEQ + sc * 512; tr_base = (size_t)bh * 128 * SEQ + sc * 512; tr_ld = SEQ; }
  else { bh = t - 256; sc = 0; nchunk = 1; C = 16; row_base = PROWS + (bh >> 2) * 16; tr_base = (size_t)16 * 128 * SEQ + (size_t)bh * 128 * 16; tr_ld = 16; }
  const int h = bh & 3;
  const float gl2 = gamma_l2(h);
  const float gC = exp2f(gl2 * (float)C);
  const u16* Qg = (const u16*)(arena + 1 * SLOT);
  const u16* Kg = (const u16*)(arena + 2 * SLOT);
  const u16* Gg = (const u16*)(arena + 3 * SLOT);
  const u16* Vt = (const u16*)(arena + 4 * SLOT) + tr_base;
  const u16* Ktd = (const u16*)(arena + 5 * SLOT) + tr_base;
  u16* reto = (u16*)(arena + 7 * SLOT);
  u16* sQ = (u16*)smem;
  u16* sK = sQ + 64 * 144;
  u16* sV = sK + 128 * LDS_STRIDE;
  u16* sS = sV + 128 * LDS_STRIDE;
  float* sR = (float*)(sS + 64 * LDS_STRIDE);

  f32x4 S[8][2];
  if (samp) {
    const float* s0 = p.ret0 + ((size_t)(l * 64 + bh)) * 16384;
#pragma unroll
    for (int mt = 0; mt < 8; ++mt)
#pragma unroll
      for (int nt = 0; nt < 2; ++nt)
#pragma unroll
        for (int j = 0; j < 4; ++j) S[mt][nt][j] = s0[(mt * 16 + (lane >> 4) * 4 + j) * 128 + 32 * w + nt * 16 + (lane & 15)];
  } else {
#pragma unroll
    for (int mt = 0; mt < 8; ++mt)
#pragma unroll
      for (int nt = 0; nt < 2; ++nt) S[mt][nt] = (f32x4){0.f, 0.f, 0.f, 0.f};
    const float g512 = exp2f(gl2 * 512.0f);
    for (int s2 = 0; s2 < sc; ++s2) {
      const float* sl = (const float*)(ws + OFF_SLOC) + ((size_t)(bh * 16 + s2)) * 16384;
#pragma unroll
      for (int mt = 0; mt < 8; ++mt)
#pragma unroll
        for (int nt = 0; nt < 2; ++nt)
#pragma unroll
          for (int j = 0; j < 4; ++j)
            S[mt][nt][j] = S[mt][nt][j] * g512 + ld_sc1_f(sl + (mt * 16 + (lane >> 4) * 4 + j) * 128 + 32 * w + nt * 16 + (lane & 15));
    }
  }
  unsigned zz_ = 0u; asm volatile("" : "+v"(zz_));
  const u32x4 z4 = (u32x4){zz_, zz_, zz_, zz_};
  for (int c = 0; c < nchunk; ++c) {
    const int r0 = row_base + c * 64;
    __syncthreads();
#pragma unroll
    for (int i = 0; i < 4; ++i) {
      const int id = tid + i * NTHR, r = id >> 4, cc = (id & 15) * 8;
      u32x4 q4 = z4, k4 = z4;
      if (r < C) {
        q4 = ld_ws16(ws, Qg + (size_t)(r0 + r) * 512 + h * 128 + cc);
        k4 = ld_ws16(ws, Kg + (size_t)(r0 + r) * 512 + h * 128 + cc);
      }
      *(u32x4*)(sQ + r * 144 + cc) = q4;
      *(u32x4*)(sK + r * 144 + cc) = k4;
    }
#pragma unroll
    for (int i = 0; i < 4; ++i) {
      const int id = tid + i * NTHR, r = id >> 3, cc = (id & 7) * 8;
      u32x4 v4 = z4;
      if (cc < C) v4 = ld_ws16(ws, Vt + (size_t)r * tr_ld + c * 64 + cc);
      *(u32x4*)(sV + r * LDS_STRIDE + cc) = v4;
    }
    __syncthreads();
    {
      f32x4 sc4[4];
#pragma unroll
      for (int m = 0; m < 4; ++m) sc4[m] = (f32x4){0.f, 0.f, 0.f, 0.f};
#pragma unroll
      for (int ks = 0; ks < 4; ++ks) {
        const bf16x8 bk = *(const bf16x8*)(sK + (16 * w + (lane & 15)) * 144 + ks * 32 + (lane >> 4) * 8);
#pragma unroll
        for (int m = 0; m < 4; ++m) {
          const bf16x8 aq = *(const bf16x8*)(sQ + (m * 16 + (lane & 15)) * 144 + ks * 32 + (lane >> 4) * 8);
          sc4[m] = MFMA16(aq, bk, sc4[m]);
        }
      }
      MFMA_FENCE();
      const int jc = 16 * w + (lane & 15);
#pragma unroll
      for (int m = 0; m < 4; ++m)
#pragma unroll
        for (int j = 0; j < 4; ++j) {
          const int i = m * 16 + (lane >> 4) * 4 + j;
          const int dd = i > jc ? i - jc : jc - i;
          sS[i * LDS_STRIDE + jc] = f2bf(sc4[m][j] * exp2f(gl2 * (float)dd));
        }
    }
    __syncthreads();
#pragma unroll
    for (int i = 0; i < 4; ++i) {
      const int id = tid + i * NTHR, r = id >> 3, cc = (id & 7) * 8;
      u32x4 v4 = z4;
      if (cc < C) v4 = ld_ws16(ws, Ktd + (size_t)r * tr_ld + c * 64 + cc);
      *(u32x4*)(sK + r * LDS_STRIDE + cc) = v4;
    }
    f32x4 o[4][2];
#pragma unroll
    for (int m = 0; m < 4; ++m) { o[m][0] = (f32x4){0.f, 0.f, 0.f, 0.f}; o[m][1] = o[m][0]; }
#pragma unroll
    for (int a = 0; a < 4; ++a) {
      bf16x8 bs[2];
#pragma unroll
      for (int nt = 0; nt < 2; ++nt) {
        u32x4 u;
        u.x = pack2(S[2 * a][nt][0], S[2 * a][nt][1]); u.y = pack2(S[2 * a][nt][2], S[2 * a][nt][3]);
        u.z = pack2(S[2 * a + 1][nt][0], S[2 * a + 1][nt][1]); u.w = pack2(S[2 * a + 1][nt][2], S[2 * a + 1][nt][3]);
        bs[nt] = __builtin_bit_cast(bf16x8, u);
      }
#pragma unroll
      for (int m = 0; m < 4; ++m) {
        const u16* qp = sQ + (m * 16 + (lane & 15)) * 144 + (lane >> 4) * 4;
        const u32x2 lo = *(const u32x2*)(qp + (2 * a) * 16);
        const u32x2 hi = *(const u32x2*)(qp + (2 * a + 1) * 16);
        const bf16x8 aq = __builtin_bit_cast(bf16x8, ((u32x4){lo.x, lo.y, hi.x, hi.y}));
        o[m][0] = MFMA16(aq, bs[0], o[m][0]);
        o[m][1] = MFMA16(aq, bs[1], o[m][1]);
      }
      __builtin_amdgcn_sched_barrier(0);
    }
    MFMA_FENCE();
#pragma unroll
    for (int m = 0; m < 4; ++m)
#pragma unroll
      for (int j = 0; j < 4; ++j) {
        const int i = m * 16 + (lane >> 4) * 4 + j;
        const float f = exp2f(gl2 * (float)(i + 1));
        o[m][0][j] *= f;
        o[m][1][j] *= f;
      }
#pragma unroll
    for (int ks = 0; ks < 2; ++ks) {
      bf16x8 bv[2];
#pragma unroll
      for (int nt = 0; nt < 2; ++nt) bv[nt] = *(const bf16x8*)(sV + (32 * w + nt * 16 + (lane & 15)) * LDS_STRIDE + ks * 32 + (lane >> 4) * 8);
#pragma unroll
      for (int m = 0; m < 4; ++m) {
        const bf16x8 as = *(const bf16x8*)(sS + (m * 16 + (lane & 15)) * LDS_STRIDE + ks * 32 + (lane >> 4) * 8);
        o[m][0] = MFMA16(as, bv[0], o[m][0]);
        o[m][1] = MFMA16(as, bv[1], o[m][1]);
      }
      __builtin_amdgcn_sched_barrier(0);
    }
    MFMA_FENCE();
#pragma unroll
    for (int m = 0; m < 4; ++m)
#pragma unroll
      for (int j = 0; j < 4; ++j) {
        float v = o[m][0][j] * o[m][0][j] + o[m][1][j] * o[m][1][j];
        v = red16(v);
        if ((lane & 15) == 0) sR[w * 64 + m * 16 + (lane >> 4) * 4 + j] = v;
      }
    __syncthreads();
#pragma unroll
    for (int m = 0; m < 4; ++m)
#pragma unroll
      for (int j = 0; j < 4; ++j) {
        const int i = m * 16 + (lane >> 4) * 4 + j;
        if (i < C) {
          const float ss = sR[i] + sR[64 + i] + sR[128 + i] + sR[192 + i];
          const float rs = rsqrtf(ss * (1.0f / 128.0f) + EPSF);
#pragma unroll
          for (int nt = 0; nt < 2; ++nt) {
            const int e = 32 * w + nt * 16 + (lane & 15);
            const float g = bf2f(ld_sc1_2(Gg + (size_t)(r0 + i) * 512 + h * 128 + e));
            reto[(size_t)(r0 + i) * 512 + h * 128 + e] = f2bf(o[m][nt][j] * rs * siluf_(g));
          }
        }
      }
#pragma unroll
    for (int mt = 0; mt < 8; ++mt) { S[mt][0] *= gC; S[mt][1] *= gC; }
#pragma unroll 1
    for (int ks = 0; ks < 2; ++ks) {
      bf16x8 bv[2];
#pragma unroll
      for (int nt = 0; nt < 2; ++nt) bv[nt] = *(const bf16x8*)(sV + (32 * w + nt * 16 + (lane & 15)) * LDS_STRIDE + ks * 32 + (lane >> 4) * 8);
#pragma unroll
      for (int mt = 0; mt < 8; ++mt) {
        const bf16x8 ak = *(const bf16x8*)(sK + (mt * 16 + (lane & 15)) * LDS_STRIDE + ks * 32 + (lane >> 4) * 8);
        S[mt][0] = MFMA16(ak, bv[0], S[mt][0]);
        S[mt][1] = MFMA16(ak, bv[1], S[mt][1]);
      }
    }
    MFMA_FENCE();
  }
  if (samp || sc == 15) {
    float* so = samp ? (p.out + O_RET_S + ((size_t)(l * 64 + bh)) * 16384) : (p.out + O_RET_P + ((size_t)(l * 16 + bh)) * 16384);
#pragma unroll
    for (int mt = 0; mt < 8; ++mt)
#pragma unroll
      for (int nt = 0; nt < 2; ++nt)
#pragma unroll
        for (int j = 0; j < 4; ++j) so[(mt * 16 + (lane >> 4) * 4 + j) * 128 + 32 * w + nt * 16 + (lane & 15)] = S[mt][nt][j];
  }
}

DI void s5_task(const Params& p, int l, int t, int mode) {
  char* ws = p.ws;
  char* arena = ws + OFF_ARENA;
  const int tid = ltid(), lane = tid & 63, w = tid >> 6;
  const bool samp = t >= 512;
  int b, lc, g, row_base, nsub;
  if (!samp) { b = t >> 7; lc = (t >> 3) & 15; g = (t & 7) * 4 + w; row_base = b * SEQ + lc * 512; nsub = 32; }
  else { const int q = t - 512; b = q >> 3; lc = 0; g = (q & 7) * 4 + w; row_base = PROWS + b * 16; nsub = 1; }
  const char* sp = ws + OFF_S5P + (size_t)l * S5P_LAYER;
  const u16* bbt = (const u16*)(sp + S5P_BBT) + g * 2048;
  const u16* cm = (const u16*)(sp + S5P_CM) + g * 2048;
  const float* ab = (const float*)(sp + S5P_ABAR) + g * 128;
  const u16* U = (const u16*)(arena + 0 * SLOT);
  u16* Z = (u16*)(arena + 6 * SLOT);
  float* bu = (float*)(smem + w * 13056);
  u16* xs = (u16*)(smem + w * 13056 + 8448);
  const float ar = ld_sc1_f(ab + lane * 2), ai = ld_sc1_f(ab + lane * 2 + 1);
  const int slab = lane >> 4;
  unsigned zz_ = 0u; asm volatile("" : "+v"(zz_));
  const u32x4 z4 = (u32x4){zz_, zz_, zz_, zz_};
  bf16x8 Bf[8], Cf[4];
#pragma unroll
  for (int nt = 0; nt < 8; ++nt) {
    u32x4 u = z4;
    if (slab < 2) u = ld_ws16(ws, bbt + (nt * 16 + (lane & 15)) * 16 + slab * 8);
    Bf[nt] = __builtin_bit_cast(bf16x8, u);
  }
#pragma unroll
  for (int ks = 0; ks < 4; ++ks) Cf[ks] = __builtin_bit_cast(bf16x8, ld_ws16(ws, cm + (lane & 15) * 128 + ks * 32 + slab * 8));
  const float Dh = p.s5_d[(l * 32 + g) * 16 + (lane & 15)];
  float xr = 0.f, xi = 0.f;
  if (samp) {
    xr = p.s5re0[((size_t)(l * 16 + b) * 32 + g) * 64 + lane];
    xi = p.s5im0[((size_t)(l * 16 + b) * 32 + g) * 64 + lane];
  } else if (mode == 1 && lc > 0) {
    float pr = ar, pi = ai;
#pragma unroll
    for (int s = 0; s < 9; ++s) { const float nr = pr * pr - pi * pi, ni = 2.f * pr * pi; pr = nr; pi = ni; }
    const float* el = (const float*)(ws + OFF_ELOC);
    for (int c2 = 0; c2 < lc; ++c2) {
      const float er = ld_sc1_f(el + (((size_t)(b * 16 + c2) * 32 + g) * 64 + lane) * 2), ei = ld_sc1_f(el + (((size_t)(b * 16 + c2) * 32 + g) * 64 + lane) * 2 + 1);
      const float nr = pr * xr - pi * xi + er, ni = pr * xi + pi * xr + ei;
      xr = nr; xi = ni;
    }
  }
  u16* usm = (u16*)(smem + 52224 + w * 512);
  const u16* up = U + (size_t)(row_base + (lane & 15)) * 512 + g * 16 + (slab & 1) * 8;
  u32x4 ua = ld_ws16(ws, up);
  for (int sub = 0; sub < nsub; ++sub) {
    const int r0 = row_base + sub * 16;
    u32x4 un = z4;
    if (sub + 1 < nsub) un = ld_ws16(ws, up + (size_t)(sub + 1) * 16 * 512);
    if (slab >= 2) ua = z4;
    const bf16x8 Af = __builtin_bit_cast(bf16x8, ua);
    __syncthreads();
    if (mode == 1 && slab < 2) *(u32x4*)(usm + (lane & 15) * 16 + slab * 8) = ua;
    f32x4 a8[8];
#pragma unroll
    for (int nt = 0; nt < 8; ++nt) a8[nt] = MFMA16(Af, Bf[nt], ((f32x4){0.f, 0.f, 0.f, 0.f}));
    __builtin_amdgcn_sched_barrier(0);
    asm volatile("s_nop 15\n\ts_nop 15\n\ts_nop 15" ::: "memory");
    __builtin_amdgcn_sched_barrier(0);
#pragma unroll
    for (int nt = 0; nt < 8; ++nt) {
#pragma unroll
      for (int j = 0; j < 4; ++j) bu[(slab * 4 + j) * 132 + nt * 16 + (lane & 15)] = a8[nt][j];
    }
    __syncthreads();
#pragma unroll
    for (int tt = 0; tt < 16; ++tt) {
      const float br = bu[tt * 132 + lane], bi = bu[tt * 132 + 64 + lane];
      const float nr = ar * xr - ai * xi + br, ni = ar * xi + ai * xr + bi;
      xr = nr; xi = ni;
      if (mode == 1) { xs[tt * 144 + lane] = f2bf(xr); xs[tt * 144 + 64 + lane] = f2bf(xi); }
    }
    if (mode == 1) {
      __syncthreads();
      f32x4 y = (f32x4){0.f, 0.f, 0.f, 0.f};
#pragma unroll
      for (int ks = 0; ks < 4; ++ks) {
        const bf16x8 ax = *(const bf16x8*)(xs + (lane & 15) * 144 + ks * 32 + slab * 8);
        y = MFMA16(ax, Cf[ks], y);
      }
      __builtin_amdgcn_sched_barrier(0);
      asm volatile("s_nop 15\n\ts_nop 15" ::: "memory");
      __builtin_amdgcn_sched_barrier(0);
#pragma unroll
      for (int j = 0; j < 4; ++j) {
        const int rr = r0 + slab * 4 + j, cc = g * 16 + (lane & 15);
        const float u = bf2f(usm[(slab * 4 + j) * 16 + (lane & 15)]);
        Z[(size_t)rr * 512 + cc] = f2bf(geluf_(y[j] + Dh * u));
      }
    }
    ua = un;
  }
  if (mode == 0) {
    float* el = (float*)(ws + OFF_ELOC);
    el[(((size_t)(b * 16 + lc) * 32 + g) * 64 + lane) * 2] = xr;
    el[(((size_t)(b * 16 + lc) * 32 + g) * 64 + lane) * 2 + 1] = xi;
  } else if (samp) {
    p.out[O_S5RE_S + ((size_t)(l * 16 + b) * 32 + g) * 64 + lane] = xr;
    p.out[O_S5IM_S + ((size_t)(l * 16 + b) * 32 + g) * 64 + lane] = xi;
  } else if (lc == 15) {
    p.out[O_S5RE_P + ((size_t)(l * 4 + b) * 32 + g) * 64 + lane] = xr;
    p.out[O_S5IM_P + ((size_t)(l * 4 + b) * 32 + g) * 64 + lane] = xi;
  }
}

DI void glu_tile(const Params& p, int l, int t) {
  char* ws = p.ws;
  char* arena = ws + OFF_ARENA;
  const int rt = t >> 2, ct = t & 3, row0 = rt * 128, col0 = ct * 128;
  const u16* Zb = (const u16*)(arena + 6 * SLOT);
  const u16* A = Zb + (size_t)row0 * 512;
  const u16* B = (const u16*)(ws + OFF_W) + (size_t)l * W_LAYER + W_GLU + (size_t)col0 * 512;
  f32x4 acc[4][4];
  zero_acc(acc);
  u16* sA = (u16*)smem; u16* sB = sA + 128 * LDS_STRIDE;
  gemm_mainloop<128, 128, 2, 2>(A, 512, B, 512, 512, 1 << 30, acc, sA, sB, NoHook());
  const int lane = ltid() & 63, wid = ltid() >> 6, wm = wid >> 1, wn = wid & 1;
  u16* Z2 = (u16*)(arena + 0 * SLOT);
  float* zsq = (float*)(ws + OFF_ZSQ);
  const float* bg = p.b_glu + l * 512;
  u16* sT = (u16*)smem;
  __syncthreads();
  {
    const int tq = ltid();
#pragma unroll
    for (int i = 0; i < 8; ++i) {
      const int id = tq + i * NTHR, rr = id >> 4, cc = (id & 15) * 8;
      *(u32x4*)(sT + rr * 136 + cc) = ld_ws16(ws, Zb + (size_t)(row0 + rr) * 512 + col0 + cc);
    }
  }
  __syncthreads();
#pragma unroll
  for (int m = 0; m < 4; ++m) {
    float ss[4] = {0.f, 0.f, 0.f, 0.f};
    const int rl = wm * 64 + m * 16 + (lane >> 4) * 4;
#pragma unroll
    for (int n = 0; n < 4; ++n) {
      const int cl = wn * 64 + n * 16 + (lane & 15);
      const float bb = bg[col0 + cl];
#pragma unroll
      for (int j = 0; j < 4; ++j) {
        const float z = bf2f(sT[(rl + j) * 136 + cl]);
        const float z2 = z * sigmoidf_(acc[m][n][j] + bb);
        ss[j] += z2 * z2;
        sT[(rl + j) * 136 + cl] = f2bf(z2);
      }
    }
#pragma unroll
    for (int j = 0; j < 4; ++j) {
      const float v = red16(ss[j]);
      if ((lane & 15) == 0) zsq[(size_t)(ct * 2 + wn) * NTOK + row0 + rl + j] = v;
    }
  }
  __syncthreads();
  tile_flush128(sT, Z2, 512, row0, col0);
}

DI void store_raw_rsq(const f32x4 (&acc)[4][4], u16* raw, float* rsq, int row0, int col0, int ct) {
  tile_out_128(acc, raw, 1024, row0, col0);
}

DI void out_tile(const Params& p, int l, int t) {
  char* ws = p.ws;
  char* arena = ws + OFF_ARENA;
  const int rt = t >> 3, ct = t & 7, row0 = rt * 128, col0 = ct * 128;
  const u16* B = (const u16*)(ws + OFF_W) + (size_t)l * W_LAYER + W_OUT + (size_t)col0 * 1024;
  f32x4 acc[4][4];
  zero_acc(acc);
  u16* sA = (u16*)smem; u16* sB = sA + 128 * LDS_STRIDE;
  float* rsl = (float*)(smem + 40960);
  const float* zsq = (const float*)(ws + OFF_ZSQ);
  {
    const int tq = ltid();
    if (tq < 128) {
      float zs = 0.f;
#pragma unroll
      for (int q = 0; q < 8; ++q) zs += ld_sc1_f(zsq + (size_t)q * NTOK + row0 + tq);
      rsl[tq] = rsqrtf(zs * (1.0f / 512.0f) + EPSF);
    }
  }
  gemm_mainloop<128, 128, 2, 2>((const u16*)(arena + 0 * SLOT) + (size_t)row0 * 512, 512, B, 1024, 512, 1 << 30, acc, sA, sB, NoHook());
  const int lane = ltid() & 63, wid = ltid() >> 6, wm = wid >> 1;
#pragma unroll
  for (int m = 0; m < 4; ++m)
#pragma unroll
    for (int j = 0; j < 4; ++j) {
      const float rs = rsl[wm * 64 + m * 16 + (lane >> 4) * 4 + j];
#pragma unroll
      for (int n = 0; n < 4; ++n) acc[m][n][j] *= rs;
    }
  gemm_mainloop<128, 128, 2, 2>((const u16*)(arena + 7 * SLOT) + (size_t)row0 * 512, 512, B + 512, 1024, 512, 1 << 30, acc, sA, sB, NoHook());
  store_raw_rsq(acc, (u16*)(arena + 1 * SLOT), (float*)(ws + OFF_RSQ), row0, col0, ct);
}

DI void small_tile(const u16* Abase, int lda, const u16* Bbase, int K, u16* dst, int ld, int q) {
  const int row0 = PROWS + (q >> 4) * 64, col0 = (q & 15) * 64;
  f32x4 acc[2][2];
  zero_acc(acc);
  u16* sA = (u16*)smem; u16* sB = sA + 64 * LDS_STRIDE;
  gemm_mainloop<64, 64, 2, 2>(Abase + (size_t)row0 * lda, lda, Bbase + (size_t)col0 * K, K, K, 1 << 30, acc, sA, sB, NoHook());
  const int lane = ltid() & 63, wid = ltid() >> 6, wm = wid >> 1, wn = wid & 1;
#pragma unroll
  for (int m = 0; m < 2; ++m)
#pragma unroll
    for (int n = 0; n < 2; ++n)
#pragma unroll
      for (int j = 0; j < 4; ++j)
        dst[(size_t)(row0 + wm * 32 + m * 16 + (lane >> 4) * 4 + j) * ld + col0 + wn * 32 + n * 16 + (lane & 15)] = f2bf(acc[m][n][j]);
}
DI void tile_flush256(const u16* sT, u16* dst, int ld, int row0, int col0) {
  const int tid = ltid();
#pragma unroll
  for (int i = 0; i < 16; ++i) {
    const int id = tid + i * NTHR, r = id >> 5, c = (id & 31) * 8;
    *(u32x4*)(dst + (size_t)(row0 + r) * ld + col0 + c) = *(const u32x4*)(sT + r * 264 + c);
  }
}
DI void tile_out_256(const f32x4 (&v)[4][8], u16* dst, int ld, int row0, int col0) {
  u16* sT = (u16*)smem;
  const int tid = ltid(), lane = tid & 63, wid = tid >> 6, wm = wid >> 1, wn = wid & 1;
  __syncthreads();
#pragma unroll
  for (int m = 0; m < 4; ++m)
#pragma unroll
    for (int n = 0; n < 8; ++n)
#pragma unroll
      for (int j = 0; j < 4; ++j) sT[(wm * 64 + m * 16 + (lane >> 4) * 4 + j) * 264 + wn * 128 + n * 16 + (lane & 15)] = f2bf(v[m][n][j]);
  __syncthreads();
  tile_flush256(sT, dst, ld, row0, col0);
}
DI void big_tile(const u16* Abase, int lda, const u16* Bbase, int K, u16* dst, int ld, int t) {
  const int rt = t >> 2, ct = t & 3, row0 = rt * 128, col0 = ct * 256;
  f32x4 acc[4][8];
  zero_acc(acc);
  u16* sA = (u16*)smem; u16* sB = sA + 128 * LDS_STRIDE;
  gemm_128x256(Abase + (size_t)row0 * lda, lda, Bbase + (size_t)col0 * K, K, K, acc, sA, sB);
  tile_out_256(acc, dst, ld, row0, col0);
}

DI void g1_big_tile(const Params& p, int l, int t) {
  char* ws = p.ws;
  char* arena = ws + OFF_ARENA;
  const int rt = t / 10, ct = t % 10, row0 = rt * 128, col0 = ct * 256;
  const int sec = ct >> 1, half = ct & 1;
  f32x4 acc[4][8];
  zero_acc(acc);
  u16* sA = (u16*)smem; u16* sB = sA + 128 * LDS_STRIDE;
  gemm_128x256((const u16*)(ws + OFF_HB) + (size_t)row0 * 1024, 1024,
               (const u16*)(ws + OFF_W) + (size_t)l * W_LAYER + W_IN + (size_t)col0 * 1024, 1024, 1024, acc, sA, sB);
  const int lane = ltid() & 63, wid = ltid() >> 6, wm = wid >> 1, wn = wid & 1;
  const int hd = half * 2 + wn;
  if (sec == 0 || sec == 4) {
    tile_out_256(acc, (u16*)(arena + (sec == 0 ? 0 : 3) * SLOT), 512, row0, half * 256);
  } else if (sec == 3) {
    u16* vt = (u16*)(arena + 4 * SLOT);
#pragma unroll
    for (int m = 0; m < 4; ++m)
#pragma unroll
      for (int n = 0; n < 8; ++n) {
        const int r = row0 + wm * 64 + m * 16 + (lane >> 4) * 4, e = n * 16 + (lane & 15);
        u32x2 o; o.x = pack2(acc[m][n][0], acc[m][n][1]); o.y = pack2(acc[m][n][2], acc[m][n][3]);
        const int b = r >> 13, tt = r & 8191;
        *(u32x2*)(vt + ((size_t)((b * 4 + hd) * 128 + e)) * SEQ + tt) = o;
      }
  } else {
    u16* dst = (u16*)(arena + (sec == 1 ? 1 : 2) * SLOT);
    u16* ktd = (u16*)(arena + 5 * SLOT);
    const float gl2 = gamma_l2(hd);
    u16* sT = (u16*)smem;
    __syncthreads();
#pragma unroll
    for (int m = 0; m < 4; ++m)
#pragma unroll
      for (int a = 0; a < 4; ++a) {
        const int r = row0 + wm * 64 + m * 16 + (lane >> 4) * 4;
        const int idx = a * 16 + (lane & 15);
        const float inv = exp2f(-(float)idx * (13.287712379549449f / 64.0f));
        float o1[4], o2[4];
#pragma unroll
        for (int j = 0; j < 4; ++j) {
          const int rr = r + j;
          float sn, cs;
          sincos_cw((float)(rr & 8191) * inv, &sn, &cs);
          const float x1 = acc[m][2 * a][j], x2 = acc[m][2 * a + 1][j];
          o1[j] = x1 * cs - x2 * sn; o2[j] = x1 * sn + x2 * cs;
          tile_put(sT, 264, rr - row0, wn * 128 + idx, o1[j]);
          tile_put(sT, 264, rr - row0, wn * 128 + 64 + idx, o2[j]);
        }
        if (sec == 2) {
          const int b = r >> 13, tt = r & 8191;
          const size_t off1 = ((size_t)((b * 4 + hd) * 128 + idx)) * SEQ + tt;
          const size_t off2 = off1 + (size_t)64 * SEQ;
          const int tloc = 63 - (tt & 63);
          float dc[4];
#pragma unroll
          for (int j = 0; j < 4; ++j) dc[j] = exp2f(gl2 * (float)(tloc - j));
          u32x2 ka, kb;
          ka.x = pack2(o1[0] * dc[0], o1[1] * dc[1]); ka.y = pack2(o1[2] * dc[2], o1[3] * dc[3]);
          kb.x = pack2(o2[0] * dc[0], o2[1] * dc[1]); kb.y = pack2(o2[2] * dc[2], o2[3] * dc[3]);
          *(u32x2*)(ktd + off1) = ka;
          *(u32x2*)(ktd + off2) = kb;
        }
      }
    __syncthreads();
    tile_flush256(sT, dst, 512, row0, half * 256);
  }
}

DI void out_big_tile(const Params& p, int l, int t) {
  char* ws = p.ws;
  char* arena = ws + OFF_ARENA;
  const int rt = t >> 2, ct = t & 3, row0 = rt * 128, col0 = ct * 256;
  const u16* B = (const u16*)(ws + OFF_W) + (size_t)l * W_LAYER + W_OUT + (size_t)col0 * 1024;
  f32x4 acc[4][8];
  zero_acc(acc);
  u16* sA = (u16*)smem; u16* sB = sA + 128 * LDS_STRIDE;
  float* rsl = (float*)(smem + 69632);
  const float* zsq = (const float*)(ws + OFF_ZSQ);
  {
    const int tq = ltid();
    if (tq < 128) {
      float zs = 0.f;
#pragma unroll
      for (int q = 0; q < 8; ++q) zs += ld_sc1_f(zsq + (size_t)q * NTOK + row0 + tq);
      rsl[tq] = rsqrtf(zs * (1.0f / 512.0f) + EPSF);
    }
  }
  gemm_128x256<true>((const u16*)(arena + 0 * SLOT) + (size_t)row0 * 512, 512, B, 1024, 1024, acc, sA, sB,
                     (const u16*)(arena + 7 * SLOT) + (size_t)row0 * 512, rsl);
  tile_out_256(acc, (u16*)(arena + 1 * SLOT), 1024, row0, col0);
}

DI void raw_tile(const Params& p, const u16* Abase, int lda, const u16* Bbase, int K, u16* raw, int t) {
  char* ws = p.ws;
  const int rt = t >> 3, ct = t & 7, row0 = rt * 128, col0 = ct * 128;
  f32x4 acc[4][4];
  zero_acc(acc);
  u16* sA = (u16*)smem; u16* sB = sA + 128 * LDS_STRIDE;
  gemm_mainloop<128, 128, 2, 2>(Abase + (size_t)row0 * lda, lda, Bbase + (size_t)col0 * K, K, K, 1 << 30, acc, sA, sB, NoHook());
  store_raw_rsq(acc, raw, (float*)(ws + OFF_RSQ), row0, col0, ct);
}

DI void post_task(const Params& p, const u16* raw, const float* gpost, int t, bool last) {
  char* ws = p.ws;
  const int lane = ltid() & 63, w = ltid() >> 6;
  const int rowb = t * 16 + w * 4;
  u32x2 r2[4][4], h2[4][4];
  float xsc[4];
  float* xsb = (float*)(ws + OFF_RSQ);
#pragma unroll
  for (int k = 0; k < 4; ++k) {
    const int row = rowb + k;
    const u16* rw = raw + (size_t)row * 1024;
    const u16* hbr = (const u16*)(ws + OFF_HB) + (size_t)row * 1024;
    xsc[k] = ld_sc1_f(xsb + row);
#pragma unroll
    for (int i = 0; i < 4; ++i) { const int c = i * 256 + lane * 4; r2[k][i] = ld_sc1_8(rw + c); h2[k][i] = ld_sc1_8(hbr + c); }
  }
  float4 g[4];
#pragma unroll
  for (int i = 0; i < 4; ++i) g[i] = *(const float4*)(gpost + i * 256 + lane * 4);
#pragma unroll
  for (int k = 0; k < 4; ++k) {
    const int row = rowb + k;
    float4 rv[4];
    float s = 0.f;
#pragma unroll
    for (int i = 0; i < 4; ++i) {
      rv[i].x = bf2f((u16)(r2[k][i].x & 0xffff)); rv[i].y = bf2f((u16)(r2[k][i].x >> 16));
      rv[i].z = bf2f((u16)(r2[k][i].y & 0xffff)); rv[i].w = bf2f((u16)(r2[k][i].y >> 16));
      s += rv[i].x * rv[i].x + rv[i].y * rv[i].y + rv[i].z * rv[i].z + rv[i].w * rv[i].w;
    }
    s = red64(s);
    const float rr = rsqrtf(s * (1.0f / 1024.0f) + EPSF);
    const float xscale = xsc[k];
    float4 v[4];
    float ss = 0.f;
#pragma unroll
    for (int i = 0; i < 4; ++i) {
      v[i].x = bf2f((u16)(h2[k][i].x & 0xffff)) * xscale + rv[i].x * rr * g[i].x;
      v[i].y = bf2f((u16)(h2[k][i].x >> 16)) * xscale + rv[i].y * rr * g[i].y;
      v[i].z = bf2f((u16)(h2[k][i].y & 0xffff)) * xscale + rv[i].z * rr * g[i].z;
      v[i].w = bf2f((u16)(h2[k][i].y >> 16)) * xscale + rv[i].w * rr * g[i].w;
      ss += v[i].x * v[i].x + v[i].y * v[i].y + v[i].z * v[i].z + v[i].w * v[i].w;
    }
    ss = red64(ss);
    const float r = rsqrtf(ss * (1.0f / 1024.0f) + EPSF);
    if (lane == 0) xsb[row] = 1.0f / r;
    float* y = p.out + O_Y + (size_t)row * 1024;
    u16* hb = (u16*)(ws + OFF_HB) + (size_t)row * 1024;
#pragma unroll
    for (int i = 0; i < 4; ++i) {
      const int c = i * 256 + lane * 4;
      if (last) *(float4*)(y + c) = v[i];
      u32x2 o; o.x = pack2(v[i].x * r, v[i].y * r); o.y = pack2(v[i].z * r, v[i].w * r);
      *(u32x2*)(hb + c) = o;
    }
  }
}

DI void cq_tile(const Params& p, int l, int t) {
  char* ws = p.ws;
  char* arena = ws + OFF_ARENA;
  const int rt = t >> 3, ct = t & 7, row0 = rt * 128, col0 = ct * 128;
  f32x4 acc[4][4];
  zero_acc(acc);
  u16* sA = (u16*)smem; u16* sB = sA + 128 * LDS_STRIDE;
  gemm_mainloop<128, 128, 2, 2>((const u16*)(ws + OFF_HB) + (size_t)row0 * 1024, 1024,
                                (const u16*)(ws + OFF_W) + (size_t)l * W_LAYER + W_CQ + (size_t)col0 * 1024, 1024, 1024, 1 << 30, acc, sA, sB, NoHook());
  tile_out_128(acc, (u16*)(arena + 3 * SLOT), 1024, row0, col0);
}

DI void att_task(const Params& p, int l, int t) {
  char* ws = p.ws;
  char* arena = ws + OFF_ARENA;
  const int tid = ltid(), lane = tid & 63, w = tid >> 6;
  int row0, h, nvalid;
  const u16 *KX, *VTX;
  if (t < 2048) {
    const int rt = t >> 2; h = t & 3; row0 = rt * 64; nvalid = 64;
    const int b = row0 >> 13;
    KX = (const u16*)(ws + OFF_KXP) + ((size_t)(l * 4 + b)) * 256 * 1024 + h * 256;
    VTX = (const u16*)(ws + OFF_VTXP) + ((size_t)((l * 4 + b) * 4 + h)) * 65536;
  } else {
    const int q = t - 2048, b = q >> 2; h = q & 3; row0 = PROWS + b * 16; nvalid = 16;
    KX = (const u16*)(ws + OFF_KXS) + (size_t)b * 256 * 1024 + h * 256;
    VTX = (const u16*)(ws + OFF_VTXS) + ((size_t)(b * 4 + h)) * 65536;
  }
  const u16* QX = (const u16*)(arena + 3 * SLOT);
  u16* OX = (u16*)(arena + 5 * SLOT);
#ifdef EXP_ATT_COPY
  for (int e = tid; e < nvalid * 256; e += NTHR) { const int r = e >> 8, c = e & 255; OX[(size_t)(row0 + r) * 1024 + h * 256 + c] = QX[(size_t)(row0 + r) * 1024 + h * 256 + c]; }
  return;
#endif
  const int arow0 = (row0 + 64 <= NTOK) ? row0 : (NTOK - 64);
  const int shift = row0 - arow0;
  u16* sA = (u16*)smem;
  u16* sB = (u16*)(smem + 34816);
  f32x4 acc[1][16];
  zero_acc(acc);
  gemm_mainloop<64, 256, 4, 1>(QX + (size_t)arow0 * 1024 + h * 256, 1024, KX, 1024, 256, 1 << 30, acc, sA, sB, NoHook());
  float inv[4];
#pragma unroll
  for (int j = 0; j < 4; ++j) {
    float mx = -3.0e38f;
#pragma unroll
    for (int n = 0; n < 16; ++n) mx = fmaxf(mx, acc[0][n][j]);
    mx = max16(mx);
    float s = 0.f;
#pragma unroll
    for (int n = 0; n < 16; ++n) { const float e = __expf(acc[0][n][j] - mx); acc[0][n][j] = e; s += e; }
    s = red16(s);
    inv[j] = 1.0f / s;
  }
  __syncthreads();
  u16* sP = (u16*)smem;
#pragma unroll
  for (int n = 0; n < 16; ++n)
#pragma unroll
    for (int j = 0; j < 4; ++j) sP[(w * 16 + (lane >> 4) * 4 + j) * 272 + n * 16 + (lane & 15)] = f2bf(acc[0][n][j] * inv[j]);
  zero_acc(acc);
  gemm_mainloop_alds<64, 256, 4, 1>(sP, 272, VTX, 256, 256, acc, sB);
#pragma unroll
  for (int n = 0; n < 16; ++n)
#pragma unroll
    for (int j = 0; j < 4; ++j) {
      const int rl = w * 16 + (lane >> 4) * 4 + j - shift;
      if (rl >= 0 && rl < nvalid) OX[(size_t)(row0 + rl) * 1024 + h * 256 + n * 16 + (lane & 15)] = f2bf(acc[0][n][j]);
    }
}

DI void gu_tile(const Params& p, int l, int t) {
  char* ws = p.ws;
  char* arena = ws + OFF_ARENA;
  const int rt = t / 22, ct = t % 22, row0 = rt * 128, col0 = ct * 256;
  f32x4 acc[4][8];
  zero_acc(acc);
  u16* sA = (u16*)smem; u16* sB = sA + 128 * LDS_STRIDE;
  gemm_128x256((const u16*)(ws + OFF_HB) + (size_t)row0 * 1024, 1024,
               (const u16*)(ws + OFF_W) + (size_t)l * W_LAYER + W_GU + (size_t)col0 * 1024, 1024, 1024, acc, sA, sB);
  const int tid = ltid(), lane = tid & 63, wid = tid >> 6, wm = wid >> 1, wn = wid & 1;
  u16* act = (u16*)(arena + 2 * SLOT);
  u16* sT = (u16*)smem;
  __syncthreads();
#pragma unroll
  for (int m = 0; m < 4; ++m)
#pragma unroll
    for (int np = 0; np < 4; ++np)
#pragma unroll
      for (int j = 0; j < 4; ++j)
        tile_put(sT, 136, wm * 64 + m * 16 + (lane >> 4) * 4 + j, wn * 64 + np * 16 + (lane & 15), siluf_(acc[m][2 * np][j]) * acc[m][2 * np + 1][j]);
  __syncthreads();
  tile_flush128(sT, act, DFF, row0, col0 >> 1);
}

DI void dbg_dump(const Params& p) {
#ifdef DUMP_SLOT
  const u16* src = (const u16*)(p.ws + OFF_ARENA + (size_t)DUMP_SLOT * SLOT);
  float* dst = p.out + O_Y;
  for (size_t i = (size_t)blockIdx.x * NTHR + threadIdx.x; i < (size_t)NTOK * 1024; i += (size_t)gridDim.x * NTHR) dst[i] = bf2f(src[i]);
#endif
#ifdef DUMP_HB
  const u16* src = (const u16*)(p.ws + OFF_HB);
  float* dst = p.out + O_Y;
  for (size_t i = (size_t)blockIdx.x * NTHR + threadIdx.x; i < (size_t)NTOK * 1024; i += (size_t)gridDim.x * NTHR) dst[i] = bf2f(src[i]);
#endif
}
#define PH_BEGIN { const int myph = ph++; const bool act_ = (myph >= p.ph_lo && myph < p.ph_hi); if (act_) { unsigned* c = &ctr[myph]; (void)c; phase_begin();
#define PH_END } if (act_ && myph + 1 < p.ph_hi) grid_barrier(bar); }

__global__ void __launch_bounds__(NTHR, 2) fwd_megakernel(Params p) {
  unsigned* bar = (unsigned*)(p.ws + OFF_BAR);
  unsigned* ctr = (unsigned*)(p.ws + OFF_CTR);
  if (threadIdx.x == 0) { g_xb[0] = 0u; g_xb[1] = 0u; g_xb[2] = 0u; g_xb[3] = 0u; }
  __syncthreads();
  if (USE_XCD_BARRIER) { if (threadIdx.x == 0) (void)xb_add(&bar[XB_XCNT(xb_xcc_id())], 1u); }
  if (p.never) cg::this_grid().sync();
  int ph = 0;
  char* ws = p.ws;
  char* arena = ws + OFF_ARENA;
#ifdef DUMP_AFTER
  if (p.ph_lo < 0) {
    const u16* src = (const u16*)(ws + DUMP_OFF);
    for (size_t j = (size_t)blockIdx.x * NTHR + threadIdx.x; j < (size_t)1048576; j += (size_t)gridDim.x * NTHR) {
      float acc = 0.f;
      size_t idx = (j * 131u) % DUMP_N;
      for (int k = 0; k < 512; ++k) {
        const float e = bf2f((u16)(src[idx] & 0xBFFF));
        acc = acc * 0.75f + e * (1.0f + 0.001f * (float)(k & 15));
        idx += 65537u; if (idx >= DUMP_N) idx -= DUMP_N;
      }
      float v = acc;
      for (int k = 0; k < 200; ++k) { v = bf2f(f2bf(v * 1.37f + 0.11f)); if (fabsf(v) > 4.f) v *= 0.125f; }
      p.out[O_Y + j] = v;
    }
    return;
  }
#endif
#ifdef EXP_CHAOS
  if (p.ph_lo == 0) {
    for (size_t i = (size_t)blockIdx.x * NTHR + threadIdx.x; i < (size_t)NTOK * 1024; i += (size_t)gridDim.x * NTHR) {
      float v = (i < (size_t)PROWS * 1024) ? p.x_prompt[i] : p.x_sample[i - (size_t)PROWS * 1024];
      float w = p.w_in[i % (4u * 1024u * 2560u)];
      for (int k = 0; k < 200; ++k) { v = bf2f(f2bf(v * 1.37f + w)); if (fabsf(v) > 4.f) v *= 0.125f; }
      p.out[O_Y + i] = v;
    }
  }
  return;
#endif

  PH_BEGIN
    phase_prep(p, c);
  PH_END

  for (int l_ = 0; l_ < DEPTHC; ++l_) {
    const int l = lsgpr(l_);
    const u16* wl = (const u16*)(ws + OFF_W) + (size_t)l * W_LAYER;
    PH_BEGIN
      const int n_big = 2560, n_g1 = 2600, n_mk = (l == 0) ? 512 : 0, n_cc = 2048;
      for (;;) {
        int t = next_task(c);
        if (t >= n_g1 + n_mk + n_cc) break;
        if (t < n_big) g1_big_tile(p, l, t);
        else if (t < n_g1) g1_tile(p, l, 5120 + (t - n_big));
        else if (t < n_g1 + n_mk) memkv_tile(p, t - n_g1);
        else cache_task(p, l, t - n_g1 - n_mk);
      }
    PH_END
    PH_BEGIN
      for (;;) {
        int t = next_task(c);
        if (t >= 256 + 512) break;
        if (t < 256) ret_local_task(p, t);
        else s5_task(p, l, t - 256, 0);
      }
    PH_END
    PH_BEGIN
      for (;;) {
        int t = next_task(c);
        if (t >= 320 + 640) break;
        if (t < 320) ret_final_task(p, l, t);
        else s5_task(p, l, t - 320, 1);
      }
    PH_END
    PH_BEGIN
      TASK_LOOP(c, 258 * 4, glu_tile(p, l, t))
    PH_END
    PH_BEGIN
      TASK_LOOP(c, 1040, if (t < 1024) out_big_tile(p, l, t); else out_tile(p, l, 2048 + (t - 1024)))
    PH_END
    PH_BEGIN
      for (int t = blockIdx.x; t < NTOK / 16; t += gridDim.x) { post_task(p, (const u16*)(arena + 1 * SLOT), p.mix_post + l * 1024, t, false); }
    PH_END
    PH_BEGIN
      TASK_LOOP(c, 1088, if (t < 1024) big_tile((const u16*)(ws + OFF_HB), 1024, wl + W_CQ, 1024, (u16*)(arena + 3 * SLOT), 1024, t); else small_tile((const u16*)(ws + OFF_HB), 1024, wl + W_CQ, 1024, (u16*)(arena + 3 * SLOT), 1024, t - 1024))
    PH_END
    PH_BEGIN
      TASK_LOOP(c, 2112, att_task(p, l, t))
    PH_END
    PH_BEGIN
      TASK_LOOP(c, 1088, if (t < 1024) big_tile((const u16*)(arena + 5 * SLOT), 1024, wl + W_CO, 1024, (u16*)(arena + 1 * SLOT), 1024, t); else small_tile((const u16*)(arena + 5 * SLOT), 1024, wl + W_CO, 1024, (u16*)(arena + 1 * SLOT), 1024, t - 1024))
    PH_END
    PH_BEGIN
      for (int t = blockIdx.x; t < NTOK / 16; t += gridDim.x) { post_task(p, (const u16*)(arena + 1 * SLOT), p.xa_post + l * 1024, t, false); }
    PH_END
    PH_BEGIN
      TASK_LOOP(c, 258 * 22, gu_tile(p, l, t))
    PH_END
    PH_BEGIN
      TASK_LOOP(c, 1088, if (t < 1024) big_tile((const u16*)(arena + 2 * SLOT), DFF, wl + W_DN, DFF, (u16*)(arena + 0 * SLOT), 1024, t); else small_tile((const u16*)(arena + 2 * SLOT), DFF, wl + W_DN, DFF, (u16*)(arena + 0 * SLOT), 1024, t - 1024))
    PH_END
    PH_BEGIN
      for (int t = blockIdx.x; t < NTOK / 16; t += gridDim.x) { post_task(p, (const u16*)(arena + 0 * SLOT), p.ffn_post + l * 1024, t, l == DEPTHC - 1); }
    PH_END
  }
}

#ifndef N_LAUNCH_SPLIT
#define N_LAUNCH_SPLIT 0
#endif
constexpr int N_PHASES = 1 + 13 * DEPTHC;

extern "C" void kernel_launch(void* const* d_in, const int* in_sizes, int n_in, void* d_out, int out_size, void* d_ws,
                              size_t ws_size, hipStream_t stream) {
  static int grid_blocks = 0;
  if (!grid_blocks) {
    int dev = 0, cus = 0, per_cu = 0;
    (void)hipGetDevice(&dev);
    (void)hipDeviceGetAttribute(&cus, hipDeviceAttributeMultiprocessorCount, dev);
    (void)hipOccupancyMaxActiveBlocksPerMultiprocessor(&per_cu, fwd_megakernel, NTHR, 0);
    if (per_cu > 2) per_cu = 2;
    if (per_cu < 1) per_cu = 1;
    grid_blocks = cus * per_cu;
  }
  if (ws_size < WS_NEEDED) fprintf(stderr, "workspace too small: %zu < %zu\n", ws_size, (size_t)WS_NEEDED);
  Params p{};
  const float** f = (const float**)&p;
  for (int i = 0; i < 36; ++i) f[i] = (const float*)d_in[i];
  p.out = (float*)d_out;
  p.ws = (char*)d_ws;
  p.never = 0;
  p.ph_lo = 0;
  p.ph_hi = N_PHASES;
  p.pad = 0;
  (void)hipMemsetAsync(d_ws, 0, 32768, stream);
  if (N_LAUNCH_SPLIT) {
#ifdef DUMP_AFTER
    const int nrun = DUMP_AFTER;
#else
    const int nrun = N_PHASES;
#endif
    for (int i = 0; i <= nrun; ++i) {
      if (i == nrun) {
#ifdef DUMP_AFTER
        p.ph_lo = -1; p.ph_hi = -1;
#else
        break;
#endif
      } else { p.ph_lo = i; p.ph_hi = i + 1; }
      void* args[] = {&p};
      hipError_t e = hipLaunchCooperativeKernel((void*)fwd_megakernel, dim3(grid_blocks), dim3(NTHR), args, 0, stream);
      if (e != hipSuccess) fprintf(stderr, "launch failed: %s (grid %d)\n", hipGetErrorString(e), grid_blocks);
    }
  } else {
    void* args[] = {&p};
    hipError_t e = hipLaunchCooperativeKernel((void*)fwd_megakernel, dim3(grid_blocks), dim3(NTHR), args, 0, stream);
    if (e != hipSuccess) fprintf(stderr, "cooperative launch failed: %s (grid %d)\n", hipGetErrorString(e), grid_blocks);
  }
}
```
